# Optimizing an MI355X kernel written in HIP

```python
import jax, jax.numpy as jnp
from jax import lax
import numpy as np

D_MODEL = 1024
BATCH = 8
SEQ = 4096
DEPTH = 2

GRID_W = 64
CTX_LEN = 256
N_MIXERS = 4
MIX_WIDTH = D_MODEL
GROUP_WIDTH = MIX_WIDTH // N_MIXERS
HEAD_DIM = 64
NA_HEADS = GROUP_WIDTH // HEAD_DIM
FOURIER_HEADS = GROUP_WIDTH // HEAD_DIM
CONV_K = 3
POOL_WINDOWS = (2, 4, 8, 16)
POOL_GROUPS = len(POOL_WINDOWS)
POOL_GROUP = GROUP_WIDTH // POOL_GROUPS
WIN_ROWS = 8
WIN_COLS = 16
N_PROJ_CHUNKS = 8
IN_COLS = N_PROJ_CHUNKS * GROUP_WIDTH
N_EXPERTS = 16
N_EXPERT_GROUPS = 4
EXPERTS_PER_GROUP = N_EXPERTS // N_EXPERT_GROUPS
TOP_K = 2
MOE_HIDDEN = D_MODEL // 2
EPS = 1e-6

kernel_name = "hybrid_parallel_mixer_dit_block"

F32 = jnp.float32


def rms_norm(x, g):
    xf = x.astype(F32)
    y = xf * lax.rsqrt(jnp.mean(jnp.square(xf), axis=-1, keepdims=True) + EPS)
    return (y * g.astype(F32)).astype(x.dtype)


def gated_short_conv(val, gate_b, gate_c, w):
    n = val.shape[1]
    pad = CONV_K // 2
    z = jnp.pad(gate_c * val, ((0, 0), (pad, CONV_K - 1 - pad), (0, 0)))
    conv = sum(z[:, j:j + n] * w[j] for j in range(CONV_K))
    return gate_b * conv


def multiscale_pool(u, pool_w, pool_scale):
    b, n, _ = u.shape
    uf = u.astype(F32)
    csum = jnp.concatenate([jnp.zeros((b, 1, GROUP_WIDTH), F32), jnp.cumsum(uf, axis=1)], axis=1)
    t = jnp.arange(n)
    outs = []
    for gi, w in enumerate(POOL_WINDOWS):
        lo = jnp.maximum(t - w // 2, 0)
        hi = jnp.minimum(t + w // 2, n)
        sl = slice(gi * POOL_GROUP, (gi + 1) * POOL_GROUP)
        win_sum = csum[:, hi, sl] - csum[:, lo, sl]
        cnt = (hi - lo).astype(F32)[None, :, None]
        outs.append(win_sum / cnt - uf[:, :, sl])
    d = jnp.stack(outs, axis=2)
    y = jnp.einsum('bngc,gcd->bngd', d, pool_w.astype(F32))
    return (y.reshape(b, n, GROUP_WIDTH) * pool_scale.astype(F32)).astype(u.dtype)


def fourier_mix(u):
    b, n, _ = u.shape
    uh = u.astype(F32).reshape(b, n, FOURIER_HEADS, HEAD_DIM)
    y = jnp.fft.fft2(uh, axes=(1, 3), norm='ortho').real
    return y.reshape(b, n, GROUP_WIDTH).astype(u.dtype)


def neighborhood_attention(q, k, v, kc, vc, rpb):
    b, n, _ = q.shape
    rows = n // GRID_W
    kr = min(WIN_ROWS, rows)
    scale = HEAD_DIM ** -0.5

    def to_grid(a):
        return a.reshape(b, rows, GRID_W, NA_HEADS, HEAD_DIM).transpose(0, 3, 1, 2, 4)

    qg, kg, vg = to_grid(q), to_grid(k), to_grid(v)
    kch = kc.reshape(b, -1, NA_HEADS, HEAD_DIM).transpose(0, 2, 1, 3)
    vch = vc.reshape(b, -1, NA_HEADS, HEAD_DIM).transpose(0, 2, 1, 3)
    r = jnp.arange(rows)
    col = jnp.arange(GRID_W)
    row_idx = jnp.clip(r - kr // 2, 0, rows - kr)[:, None] + jnp.arange(kr)[None, :]
    col_idx = jnp.clip(col - WIN_COLS // 2, 0, GRID_W - WIN_COLS)[:, None] + jnp.arange(WIN_COLS)[None, :]
    k_band = kg[:, :, row_idx]
    v_band = vg[:, :, row_idx]
    s_band = jnp.einsum('bhrqd,bhrkwd->bhrqkw', qg, k_band, preferred_element_type=F32) * scale
    sel = jax.nn.one_hot(col_idx, GRID_W, dtype=F32)
    s_win = jnp.einsum('bhrqkw,qjw->bhrqkj', s_band, sel)
    rel_r = row_idx - r[:, None] + (WIN_ROWS - 1)
    rel_c = col_idx - col[:, None] + (WIN_COLS - 1)
    bias = rpb[:, rel_r[:, None, :, None], rel_c[None, :, None, :]]
    n_win = kr * WIN_COLS
    s_win = (s_win + bias[None].astype(F32)).reshape(b, NA_HEADS, rows, GRID_W, n_win)
    s_ctx = jnp.einsum('bhrqd,bhld->bhrql', qg, kch, preferred_element_type=F32) * scale
    p = jax.nn.softmax(jnp.concatenate([s_win, s_ctx], axis=-1), axis=-1)
    p_win = p[..., :n_win].reshape(b, NA_HEADS, rows, GRID_W, kr, WIN_COLS)
    p_ctx = p[..., n_win:]
    p_band = jnp.einsum('bhrqkj,qjw->bhrqkw', p_win, sel)
    o = (jnp.einsum('bhrqkw,bhrkwd->bhrqd', p_band.astype(v.dtype), v_band)
         + jnp.einsum('bhrql,bhld->bhrqd', p_ctx.astype(v.dtype), vch))
    return o.transpose(0, 2, 3, 1, 4).reshape(b, n, GROUP_WIDTH)


def context_attention(qc, kc, vc):
    b, l, _ = qc.shape
    sp = lambda a: a.reshape(b, l, NA_HEADS, HEAD_DIM)
    s = jnp.einsum('blhd,bmhd->bhlm', sp(qc), sp(kc), preferred_element_type=F32) * (HEAD_DIM ** -0.5)
    p = jax.nn.softmax(s, axis=-1)
    o = jnp.einsum('bhlm,bmhd->blhd', p.astype(vc.dtype), sp(vc))
    return o.reshape(b, l, GROUP_WIDTH)


def moe_ffn(h, router_w, router_b, w1, w3, w2):
    scores = jax.nn.sigmoid(jnp.dot(h.astype(F32), router_w.astype(F32)))
    biased = scores + router_b.astype(F32)
    grp = biased.reshape(h.shape[0], N_EXPERT_GROUPS, EXPERTS_PER_GROUP)
    grp_score = jnp.sum(lax.top_k(grp, TOP_K)[0], axis=-1)
    best = jnp.argmax(grp_score, axis=-1)
    expert_group = jnp.arange(N_EXPERTS) // EXPERTS_PER_GROUP
    masked = jnp.where(expert_group[None, :] == best[:, None], biased, -jnp.inf)
    _, idx = lax.top_k(masked, TOP_K)
    wsel = jnp.take_along_axis(scores, idx, axis=-1)
    wsel = wsel / jnp.sum(wsel, axis=-1, keepdims=True)
    gates = jnp.sum(jax.nn.one_hot(idx, N_EXPERTS, dtype=F32) * wsel[..., None], axis=1)
    y = jnp.zeros(h.shape, F32)
    for e in range(N_EXPERTS):
        he = jax.nn.silu(h @ w1[e]) * (h @ w3[e])
        y = y + gates[:, e:e + 1] * (he @ w2[e]).astype(F32)
    return y.astype(h.dtype)


def setup_inputs(seed: int = 0) -> dict:
    key = jax.random.key(seed)
    ks = jax.random.split(key, 22)
    nrm = lambda k, shape, s: jax.random.normal(k, shape, F32) * s
    return {
        "x": nrm(ks[0], (BATCH, SEQ, D_MODEL), 1.0),
        "c": nrm(ks[1], (BATCH, D_MODEL), 1.0),
        "ctx": nrm(ks[2], (BATCH, CTX_LEN, D_MODEL), 1.0),
        "c_ctx": nrm(ks[3], (D_MODEL,), 1.0),
        "ada_w": nrm(ks[4], (DEPTH, D_MODEL, 6 * D_MODEL), 0.5 * D_MODEL ** -0.5),
        "ada_b": nrm(ks[5], (DEPTH, 6 * D_MODEL), 0.02),
        "norm1_g": 1.0 + nrm(ks[6], (DEPTH, D_MODEL), 0.02),
        "norm2_g": 1.0 + nrm(ks[7], (DEPTH, D_MODEL), 0.02),
        "w_in": nrm(ks[8], (DEPTH, D_MODEL, IN_COLS), D_MODEL ** -0.5),
        "conv_w": nrm(ks[9], (DEPTH, CONV_K, GROUP_WIDTH), CONV_K ** -0.5),
        "pool_w": nrm(ks[10], (DEPTH, POOL_GROUPS, POOL_GROUP, POOL_GROUP), POOL_GROUP ** -0.5),
        "pool_scale": 1.0 + nrm(ks[11], (DEPTH, GROUP_WIDTH), 0.1),
        "na_rpb": nrm(ks[12], (DEPTH, NA_HEADS, 2 * WIN_ROWS - 1, 2 * WIN_COLS - 1), 0.1),
        "w_out": nrm(ks[13], (DEPTH, MIX_WIDTH, D_MODEL), MIX_WIDTH ** -0.5),
        "router_w": nrm(ks[14], (D_MODEL, N_EXPERTS), D_MODEL ** -0.5),
        "router_b": nrm(ks[15], (N_EXPERTS,), 0.01),
        "moe_w1": nrm(ks[16], (DEPTH, N_EXPERTS, D_MODEL, MOE_HIDDEN), D_MODEL ** -0.5),
        "moe_w3": nrm(ks[17], (DEPTH, N_EXPERTS, D_MODEL, MOE_HIDDEN), D_MODEL ** -0.5),
        "moe_w2": nrm(ks[18], (DEPTH, N_EXPERTS, MOE_HIDDEN, D_MODEL), MOE_HIDDEN ** -0.5),
        "final_g": 1.0 + nrm(ks[19], (D_MODEL,), 0.02),
    }


def reference(x, c, ctx, c_ctx, ada_w, ada_b, norm1_g, norm2_g, w_in, conv_w, pool_w, pool_scale,
              na_rpb, w_out, router_w, router_b, moe_w1, moe_w3, moe_w2, final_g):
    b, n, d = x.shape
    l = ctx.shape[1]
    xc = ctx
    c_act = jax.nn.silu(c)
    cc_act = jax.nn.silu(c_ctx)
    for layer in range(DEPTH):
        last = layer == DEPTH - 1
        mod = c_act @ ada_w[layer] + ada_b[layer]
        mod_c = cc_act @ ada_w[layer] + ada_b[layer]
        sh1, sc1, g1, sh2, sc2, g2 = jnp.split(mod[:, None, :], 6, axis=-1)
        csh1, csc1, cg1, csh2, csc2, cg2 = jnp.split(mod_c, 6, axis=-1)

        h = rms_norm(x, norm1_g[layer]) * (1 + sc1) + sh1
        hc = rms_norm(xc, norm1_g[layer]) * (1 + csc1) + csh1
        u = h @ w_in[layer]
        a_v, a_b, a_c, p_in, q, k, v, f_in = jnp.split(u, N_PROJ_CHUNKS, axis=-1)
        if last:
            kc, vc = jnp.split(hc @ w_in[layer][:, 5 * GROUP_WIDTH:7 * GROUP_WIDTH], 2, axis=-1)
        else:
            uc = hc @ w_in[layer]
            ca_v, ca_b, ca_c, cp_in, cq, kc, vc, cf_in = jnp.split(uc, N_PROJ_CHUNKS, axis=-1)

        y = jnp.concatenate([
            gated_short_conv(a_v, a_b, a_c, conv_w[layer]),
            multiscale_pool(p_in, pool_w[layer], pool_scale[layer]),
            neighborhood_attention(q, k, v, kc, vc, na_rpb[layer]),
            fourier_mix(f_in),
        ], axis=-1)
        x = x + g1 * (y @ w_out[layer])
        if not last:
            yc = jnp.concatenate([
                gated_short_conv(ca_v, ca_b, ca_c, conv_w[layer]),
                multiscale_pool(cp_in, pool_w[layer], pool_scale[layer]),
                context_attention(cq, kc, vc),
                fourier_mix(cf_in),
            ], axis=-1)
            xc = xc + cg1 * (yc @ w_out[layer])

        h2 = rms_norm(x, norm2_g[layer]) * (1 + sc2) + sh2
        tokens = h2.reshape(b * n, d)
        if not last:
            h2c = rms_norm(xc, norm2_g[layer]) * (1 + csc2) + csh2
            tokens = jnp.concatenate([tokens, h2c.reshape(b * l, d)], axis=0)
        f = moe_ffn(tokens, router_w, router_b, moe_w1[layer], moe_w3[layer], moe_w2[layer])
        x = x + g2 * f[:b * n].reshape(b, n, d)
        if not last:
            xc = xc + cg2 * f[b * n:].reshape(b, l, d)
    return rms_norm(x, final_g)
```

```cpp
#include <hip/hip_runtime.h>
#include <cstdio>
#include <cstdint>
namespace pg8 {
#define PG8_LAS __attribute__((address_space(3)))
typedef unsigned short bf16_t;
typedef short bf16x8 __attribute__((ext_vector_type(8)));
typedef float f32x4 __attribute__((ext_vector_type(4)));
typedef unsigned u32x4 __attribute__((ext_vector_type(4)));
constexpr int BM = 256, BK = 64, HALF = 128, HTB = HALF * BK * 2  , STAGE_BYTES = 8 * HTB, NXCD = 8, WGM = 8;

__host__ __device__ __forceinline__ int lds_byte(int r, int c) { const int st = (r >> 4) * 2 + (c >> 5), rr = r & 15, cc = c & 31, ob = rr * 64 + cc * 2; return st * 1024 + (ob ^ (((ob >> 9) & 1) << 5)); }
__host__ __device__ __forceinline__ void stage_rc(int b, int& R, int& C) { const int st = b / 1024, sb = b % 1024, swz = sb ^ (((sb >> 9) & 1) << 5); R = (st >> 1) * 16 + swz / 64; C = (st & 1) * 32 + (swz % 64) / 2; }
__host__ __device__ __forceinline__ int perm32(int rho) { const int n = rho >> 4, i = rho & 15; return 8 * (i >> 2) + 4 * n + (i & 3); }

struct Unit { int pm, pn, pb; };
struct Gemm { const bf16_t* A; const bf16_t* Bt; int M, N, K; };

struct StaticOrder {
    int nM, nN, nwg, G, c;
    __host__ __device__ void init(int M, int N, int G_, int c_) { nM = M / BM; nN = N / BM; nwg = nM * nN; G = G_; c = c_; }
    __host__ __device__ bool next(int i, Unit& u) const {
        const long L = (long)i * G + c; if (L >= nwg) return false;
        int wgid = (int)L; { const int q = nwg / NXCD, r = nwg % NXCD, xcd = wgid % NXCD, off = wgid / NXCD; wgid = (xcd < r ? xcd * (q + 1) : r * (q + 1) + (xcd - r) * q) + off; }
        const int nig = WGM * nN, gid = wgid / nig, fm = gid * WGM, gsz = (nM - fm) < WGM ? (nM - fm) : WGM;
        u.pm = fm + ((wgid % nig) % gsz); u.pn = (wgid % nig) / gsz; u.pb = u.pn; return true;
    }
    __device__ __forceinline__ void a_ready(const Unit&) const {}
    __device__ __forceinline__ void done(const Unit&) const {}
};


__device__ __forceinline__ unsigned cvt_pk_bf16(float lo, float hi) { unsigned r; asm volatile("v_cvt_pk_bf16_f32 %0, %1, %2" : "=v"(r) : "v"(lo), "v"(hi)); return r; }

struct EpiBf16 {
    static constexpr bool PERM = true, AFTER_DRAIN = false;
    bf16_t* O; int ldc;
    __device__ __forceinline__ void operator()(const f32x4 (&acc)[2][2][4][2], const Unit& u, int wr, int wc, int fr, int fq) const {
        const int row0 = u.pm * BM + wr * 64 + fr; const int col0 = u.pn * BM + wc * 32 + 8 * fq;
#pragma unroll
        for (int ai = 0; ai < 2; ++ai)
#pragma unroll
            for (int m = 0; m < 4; ++m) { bf16_t* rowp = O + (size_t)(row0 + ai * HALF + m * 16) * ldc + col0;
#pragma unroll
                for (int bj = 0; bj < 2; ++bj) { const f32x4 v0 = acc[ai][bj][m][0], v1 = acc[ai][bj][m][1];
                    u32x4 w; w.x = cvt_pk_bf16(v0[0], v0[1]); w.y = cvt_pk_bf16(v0[2], v0[3]); w.z = cvt_pk_bf16(v1[0], v1[1]); w.w = cvt_pk_bf16(v1[2], v1[3]);
                    *(u32x4*)(rowp + bj * HALF) = w; } }
    }
};
struct EpiSwiGLU {
    static constexpr bool PERM = true, AFTER_DRAIN = false;
    bf16_t* O; int ldc;
    __device__ __forceinline__ void operator()(const f32x4 (&acc)[2][2][4][2], const Unit& u, int wr, int wc, int fr, int fq) const {
        const int row0 = u.pm * BM + wr * 64 + fr; const int col0 = u.pn * HALF + wc * 32 + 8 * fq;
#pragma unroll
        for (int ai = 0; ai < 2; ++ai)
#pragma unroll
            for (int m = 0; m < 4; ++m) { bf16_t* rowp = O + (size_t)(row0 + ai * HALF + m * 16) * ldc + col0;
                float o[8];
#pragma unroll
                for (int n = 0; n < 2; ++n)
#pragma unroll
                    for (int j = 0; j < 4; ++j) { const float a = acc[ai][0][m][n][j], b = acc[ai][1][m][n][j]; o[n * 4 + j] = a * __builtin_amdgcn_rcpf(1.0f + __expf(-a)) * b; }
                u32x4 w; w.x = cvt_pk_bf16(o[0], o[1]); w.y = cvt_pk_bf16(o[2], o[3]); w.z = cvt_pk_bf16(o[4], o[5]); w.w = cvt_pk_bf16(o[6], o[7]);
                *(u32x4*)rowp = w; }
    }
};
struct EpiResid {
    static constexpr bool PERM = false, AFTER_DRAIN = false;
    const float* xin_lat; const float* xin_ctx; float* xout_lat; float* xout_ctx; const float* gmod; int gstride; const float* rowscale; int rs_stride; int nlat, seq;
    __device__ __forceinline__ void operator()(const f32x4 (&acc)[2][2][4][2], const Unit& u, int wr, int wc, int fr, int fq) const {
        const int prow = u.pm * BM; const bool isctx = prow >= nlat;
        const float* xin = isctx ? xin_ctx - (size_t)nlat * 1024 : xin_lat; float* xout = isctx ? xout_ctx - (size_t)nlat * 1024 : xout_lat;
        const int modrow = isctx ? 8 : prow / seq;
        const int row0 = prow + wr * 64 + fr, col0 = u.pn * BM + wc * 32 + 4 * fq;
        f32x4 gv[2][2];
#pragma unroll
        for (int bj = 0; bj < 2; ++bj)
#pragma unroll
            for (int n = 0; n < 2; ++n) gv[bj][n] = *(const f32x4*)(gmod + (size_t)modrow * gstride + col0 + bj * HALF + n * 16);
#pragma unroll
        for (int ai = 0; ai < 2; ++ai)
#pragma unroll
            for (int m = 0; m < 4; ++m) { const int row = row0 + ai * HALF + m * 16; const size_t off = (size_t)row * 1024 + col0;
                const float rs = rowscale ? rowscale[(size_t)row * rs_stride] : 1.0f;
#pragma unroll
                for (int bj = 0; bj < 2; ++bj)
#pragma unroll
                    for (int n = 0; n < 2; ++n) { const f32x4 xi = *(const f32x4*)(xin + off + bj * HALF + n * 16);
                        *(f32x4*)(xout + off + bj * HALF + n * 16) = xi + gv[bj][n] * rs * acc[ai][bj][m][n]; } }
    }
};
template <class Epi, class Sched, bool ALIGN_EPI = false, bool SP2 = false>
__device__ __forceinline__ void gemm_phase(PG8_LAS unsigned char* lds, const Gemm g, const Sched& S, const Epi& E) {
    const int tid = threadIdx.x, wid = __builtin_amdgcn_readfirstlane(tid >> 6), lane = tid & 63, wr = wid >> 2, wc = wid & 3, fr = lane & 15, fq = lane >> 4;
    const int K = g.K, nt = K / BK;
    unsigned voffA[2], voffB[2];
#pragma unroll
    for (int i = 0; i < 2; ++i) { int R, C; stage_rc(tid * 16 + i * 8192, R, C); const int Rb = Epi::PERM ? ((R & ~31) + perm32(R & 31)) : R;
        voffA[i] = (unsigned)(R * K + C) * 2u; voffB[i] = (unsigned)(Rb * K + C) * 2u; }
    const size_t kstep = (size_t)(BK * 2);
    const size_t hstep = (size_t)HALF * K * 2;
    const size_t tstep = 2 * hstep;
    const unsigned ldsw = (unsigned)wid * 1024u;
    const int aoff = lds_byte(wr * 64 + fr, fq * 8), boff = lds_byte(wc * 32 + fr, fq * 8);
#define PG8_SA(b, h) (((b) * 2 + (h)) * HTB)
#define PG8_SB(b, h) ((4 + (b) * 2 + (h)) * HTB)
#define PG8_STAGE(bufoff, gbase, voff) do { _Pragma("unroll") for (int _i = 0; _i < 2; ++_i) \
        __builtin_amdgcn_global_load_lds((const unsigned*)((const char*)(gbase) + (voff)[_i]), (PG8_LAS unsigned*)(lds + (bufoff) + ldsw + _i * 8192), 16, 0, 0); } while (0)
#define PG8_LDA(dst, b, h) do { _Pragma("unroll") for (int m = 0; m < 4; ++m) _Pragma("unroll") for (int k = 0; k < 2; ++k) dst[m][k] = *(const PG8_LAS bf16x8*)(lds + PG8_SA(b, h) + aoff + m * 2048 + k * 1024); } while (0)
#define PG8_LDB(dst, b, h) do { _Pragma("unroll") for (int n = 0; n < 2; ++n) _Pragma("unroll") for (int k = 0; k < 2; ++k) dst[n][k] = *(const PG8_LAS bf16x8*)(lds + PG8_SB(b, h) + boff + n * 2048 + k * 1024); } while (0)
#define PG8_MMA(ai, bj, At, Bt) do { __builtin_amdgcn_s_setprio(1); _Pragma("unroll") for (int m = 0; m < 4; ++m) _Pragma("unroll") for (int n = 0; n < 2; ++n) _Pragma("unroll") for (int k = 0; k < 2; ++k) \
        acc[ai][bj][m][n] = __builtin_amdgcn_mfma_f32_16x16x32_bf16(Bt[n][k], At[m][k], acc[ai][bj][m][n], 0, 0, 0); __builtin_amdgcn_s_setprio(0); } while (0)
#define PG8_WAIT_V(n) asm volatile("s_waitcnt vmcnt(" #n ")" ::: "memory")
#define PG8_WAIT_L(n) asm volatile("s_waitcnt lgkmcnt(" #n ")" ::: "memory")
#define PG8_BAR __builtin_amdgcn_s_barrier()
#define PG8_SCHED __builtin_amdgcn_sched_barrier(0)
    Unit cur, nxt; int ui = 0;
    if (!S.next(0, cur)) return;
    f32x4 acc[2][2][4][2];
#pragma unroll
    for (int a = 0; a < 2; ++a)
#pragma unroll
        for (int b = 0; b < 2; ++b)
#pragma unroll
            for (int m = 0; m < 4; ++m)
#pragma unroll
                for (int n = 0; n < 2; ++n) acc[a][b][m][n] = (f32x4){0.f, 0.f, 0.f, 0.f};
    bf16x8 At[4][2], B0[2][2], B1[2][2];
    const char* cA = (const char*)g.A + (size_t)cur.pm * tstep; const char* cB = (const char*)g.Bt + (size_t)cur.pb * tstep;
    S.a_ready(cur);
    if constexpr (SP2) {
        PG8_STAGE(PG8_SB(0, 0), cB, voffB); PG8_STAGE(PG8_SB(0, 1), cB + hstep, voffB); PG8_STAGE(PG8_SA(0, 0), cA, voffA); PG8_STAGE(PG8_SA(0, 1), cA + hstep, voffA);
        if (wr == 1) PG8_BAR;
        PG8_WAIT_V(2); PG8_BAR;
        PG8_STAGE(PG8_SB(1, 0), cB + kstep, voffB); PG8_STAGE(PG8_SA(1, 0), cA + kstep, voffA); PG8_STAGE(PG8_SB(1, 1), cB + hstep + kstep, voffB);
        PG8_WAIT_V(6); PG8_BAR;
    } else {
        PG8_STAGE(PG8_SB(0, 0), cB, voffB); PG8_STAGE(PG8_SA(0, 0), cA, voffA); PG8_STAGE(PG8_SB(0, 1), cB + hstep, voffB); PG8_STAGE(PG8_SA(0, 1), cA + hstep, voffA);
        if (wr == 1) PG8_BAR;
        PG8_WAIT_V(4); PG8_BAR;
        PG8_STAGE(PG8_SB(1, 0), cB + kstep, voffB); PG8_STAGE(PG8_SA(1, 0), cA + kstep, voffA); PG8_STAGE(PG8_SB(1, 1), cB + hstep + kstep, voffB);
        PG8_WAIT_V(6); PG8_BAR;
    }
    for (;;) {
        const bool has_next = S.next(ui + 1, nxt);
        const char* nA = has_next ? (const char*)g.A + (size_t)nxt.pm * tstep : cA; const char* nB = has_next ? (const char*)g.Bt + (size_t)nxt.pb * tstep : cB;
        for (int t = 0; t < nt; t += 2) {
            const bool last = (t == nt - 2);
            const char* a1 = cA + (size_t)(t + 1) * kstep;
            const char* a2 = last ? nA : cA + (size_t)(t + 2) * kstep; const char* b2 = last ? nB : cB + (size_t)(t + 2) * kstep;
            const char* a3 = a2 + kstep; const char* b3 = b2 + kstep;
            if (last && has_next) S.a_ready(nxt);
            if constexpr (SP2) {
            PG8_LDB(B0, 0, 0); PG8_LDB(B1, 0, 1); PG8_SCHED; PG8_LDA(At, 0, 0); PG8_STAGE(PG8_SA(1, 1), a1 + hstep, voffA);
            PG8_WAIT_V(8); PG8_WAIT_L(0); PG8_BAR; PG8_MMA(0, 0, At, B0); PG8_MMA(0, 1, At, B1); PG8_BAR; PG8_SCHED;
            PG8_LDA(At, 0, 1); PG8_STAGE(PG8_SB(0, 0), b2, voffB); PG8_STAGE(PG8_SB(0, 1), b2 + hstep, voffB); PG8_STAGE(PG8_SA(0, 0), a2, voffA);
            PG8_WAIT_V(8); PG8_WAIT_L(0); PG8_BAR; PG8_MMA(1, 0, At, B0); PG8_MMA(1, 1, At, B1); PG8_BAR; PG8_SCHED;
            PG8_LDB(B0, 1, 0); PG8_LDB(B1, 1, 1); PG8_SCHED; PG8_LDA(At, 1, 0); PG8_STAGE(PG8_SA(0, 1), a2 + hstep, voffA);
            PG8_WAIT_V(8); PG8_WAIT_L(0); PG8_BAR; PG8_MMA(0, 0, At, B0); PG8_MMA(0, 1, At, B1); PG8_BAR; PG8_SCHED;
            PG8_LDA(At, 1, 1); PG8_STAGE(PG8_SB(1, 0), b3, voffB); PG8_STAGE(PG8_SB(1, 1), b3 + hstep, voffB); PG8_STAGE(PG8_SA(1, 0), a3, voffA);
            PG8_WAIT_V(8); PG8_WAIT_L(0); PG8_BAR; PG8_MMA(1, 0, At, B0); PG8_MMA(1, 1, At, B1); PG8_BAR; PG8_SCHED;
            } else {
            PG8_LDB(B0, 0, 0); PG8_SCHED; PG8_LDA(At, 0, 0); PG8_STAGE(PG8_SA(1, 1), a1 + hstep, voffA);
            PG8_WAIT_L(8); PG8_BAR; PG8_WAIT_L(0); PG8_MMA(0, 0, At, B0); PG8_BAR; PG8_SCHED;
            PG8_LDB(B1, 0, 1); PG8_STAGE(PG8_SB(0, 0), b2, voffB);
            PG8_BAR; PG8_WAIT_L(0); PG8_MMA(0, 1, At, B1); PG8_BAR;
            PG8_LDA(At, 0, 1); PG8_STAGE(PG8_SA(0, 0), a2, voffA);
            PG8_BAR; PG8_WAIT_L(0); PG8_MMA(1, 0, At, B0); PG8_BAR; PG8_SCHED;
            PG8_STAGE(PG8_SB(0, 1), b2 + hstep, voffB);
            PG8_WAIT_V(6); PG8_BAR; PG8_MMA(1, 1, At, B1); PG8_BAR;
            PG8_LDB(B0, 1, 0); PG8_SCHED; PG8_LDA(At, 1, 0); PG8_STAGE(PG8_SA(0, 1), a2 + hstep, voffA);
            PG8_WAIT_L(8); PG8_BAR; PG8_WAIT_L(0); PG8_MMA(0, 0, At, B0); PG8_BAR; PG8_SCHED;
            PG8_LDB(B1, 1, 1); PG8_STAGE(PG8_SB(1, 0), b3, voffB);
            PG8_BAR; PG8_WAIT_L(0); PG8_MMA(0, 1, At, B1); PG8_BAR;
            PG8_LDA(At, 1, 1); PG8_STAGE(PG8_SA(1, 0), a3, voffA);
            PG8_BAR; PG8_WAIT_L(0); PG8_MMA(1, 0, At, B0); PG8_BAR; PG8_SCHED;
            PG8_STAGE(PG8_SB(1, 1), b3 + hstep, voffB);
            PG8_WAIT_V(6); PG8_BAR; PG8_MMA(1, 1, At, B1); PG8_BAR;
            }
        }
        if constexpr (ALIGN_EPI) { if (wr == 0) PG8_BAR; }
        if constexpr (!Epi::AFTER_DRAIN) { E(acc, cur, wr, wc, fr, fq); S.done(cur); }
        if (!has_next) break;
#pragma unroll
        for (int a = 0; a < 2; ++a)
#pragma unroll
            for (int b = 0; b < 2; ++b)
#pragma unroll
                for (int m = 0; m < 4; ++m)
#pragma unroll
                    for (int n = 0; n < 2; ++n) acc[a][b][m][n] = (f32x4){0.f, 0.f, 0.f, 0.f};
        cur = nxt; cA = nA; cB = nB; ++ui;
        if constexpr (ALIGN_EPI) { if (wr == 1) PG8_BAR; }
    }
    PG8_WAIT_V(0);
    if constexpr (!ALIGN_EPI) { if (wr == 0) PG8_BAR; }
    PG8_BAR;
    if constexpr (Epi::AFTER_DRAIN) { E.fused(acc, cur, wr, wc, fr, fq, lds, wid, lane); S.done(cur); }
#undef PG8_SA
#undef PG8_SB
#undef PG8_STAGE
#undef PG8_LDA
#undef PG8_LDB
#undef PG8_MMA
#undef PG8_WAIT_V
#undef PG8_WAIT_L
#undef PG8_BAR
#undef PG8_SCHED
}
}
#define GAS __attribute__((address_space(1)))
#define LAS __attribute__((address_space(3)))
typedef unsigned short bf16;
typedef unsigned v4u __attribute__((ext_vector_type(4)));
typedef float f32x4 __attribute__((ext_vector_type(4)));
typedef short bf16x8 __attribute__((ext_vector_type(8)));
typedef GAS unsigned gu32;
typedef GAS unsigned long long gu64;
#define RLX_AGENT __ATOMIC_RELAXED, __HIP_MEMORY_SCOPE_AGENT
#define LDS_WAIT() asm volatile("s_waitcnt lgkmcnt(0)" ::: "memory")
#define VM_WAIT() asm volatile("s_waitcnt vmcnt(0)" ::: "memory")
__device__ __forceinline__ unsigned long long rt() { return __builtin_amdgcn_s_memrealtime(); }
__device__ __forceinline__ unsigned f2bf(float f) { unsigned u = __builtin_bit_cast(unsigned, f); return (u + 0x7fffu + ((u >> 16) & 1u)) >> 16; }
__device__ __forceinline__ unsigned pk2(float lo, float hi) { return f2bf(lo) | (f2bf(hi) << 16); }

#define XB_TMO      128
#define XB_XCNT(j)  (256  + 64 * (j))
#define XB_XSUB(j)  (1280 + 64 * (j))
#define XB_XGEN(j)  (2304 + 64 * (j))
#define XB_TOP      3328
#define XB_TOPGEN   3392
#define XCD_BAR_WORDS 3456
#define XB_SPIN_CAP (1u << 18)

__device__ __forceinline__ unsigned xb_ld(unsigned* p)              { return __hip_atomic_load(p, __ATOMIC_RELAXED, __HIP_MEMORY_SCOPE_AGENT); }
__device__ __forceinline__ unsigned xb_add(unsigned* p, unsigned v) { return __hip_atomic_fetch_add(p, v, __ATOMIC_RELAXED, __HIP_MEMORY_SCOPE_AGENT); }
__device__ __forceinline__ unsigned xb_xcc_id() { return (unsigned)__builtin_amdgcn_s_getreg((3 << 11) | 20) & 0xFu; }
#define XB_SPIN(cond, bar) do { unsigned _sp = 0; while (cond) { __builtin_amdgcn_s_sleep(1); \
    if ((++_sp & 255u) == 0u) { if (xb_ld(&(bar)[XB_TMO])) break; if (_sp > XB_SPIN_CAP) { atomicAdd(&(bar)[XB_TMO], 1u); break; } } } } while (0)

struct XcdBarrier {
    unsigned* bar; unsigned x;
    volatile LAS unsigned* st;
};

__device__ __forceinline__ XcdBarrier xcd_barrier_post(unsigned* bar, volatile LAS unsigned* st) {
    XcdBarrier b; b.bar = bar; b.x = xb_xcc_id(); b.st = st;
    if (threadIdx.x == 0) (void)xb_add(&bar[XB_XCNT(b.x)], 1u);
    return b;
}
__device__ __forceinline__ void xcd_barrier_complete(unsigned* bar, unsigned x, unsigned& nloc, unsigned& nx) {
    const unsigned G = gridDim.x * gridDim.y * gridDim.z;
    unsigned sum, cnt, mine, sp = 0u;
    for (;;) {
        sum = 0u; cnt = 0u; mine = 0u;
#pragma unroll
        for (unsigned j = 0; j < 16; ++j) { const unsigned c = xb_ld(&bar[XB_XCNT(j)]); sum += c; cnt += (c > 0u) ? 1u : 0u; mine = (j == x) ? c : mine; }
        if (sum == G) break;
        __builtin_amdgcn_s_sleep(1);
        if ((++sp & 255u) == 0u) { if (xb_ld(&bar[XB_TMO])) break; if (sp > XB_SPIN_CAP) { atomicAdd(&bar[XB_TMO], 1u); break; } }
    }
    nloc = mine > 0u ? mine : 1u; nx = cnt > 0u ? cnt : 1u;
}

__device__ __forceinline__ void xcd_barrier(const XcdBarrier& b) {
    asm volatile("s_waitcnt vmcnt(0)" ::: "memory");
    __syncthreads();
    if (threadIdx.x == 0) {
        unsigned* bar = b.bar;
        __builtin_amdgcn_s_waitcnt(0);
        unsigned nloc = b.st[0], nx = b.st[1];
        if (nloc == 0u) { xcd_barrier_complete(bar, b.x, nloc, nx); b.st[0] = nloc; b.st[1] = nx; }
        const unsigned old = xb_add(&bar[XB_XSUB(b.x)], 1u);
        const unsigned gen = old / nloc;
        if (old + 1u == (gen + 1u) * nloc) {
            __builtin_amdgcn_fence(__ATOMIC_RELEASE, "agent");
            asm volatile("s_waitcnt vmcnt(0)" ::: "memory");
            const unsigned og = xb_add(&bar[XB_TOP], 1u);
            const unsigned tg = og / nx;
            if (og + 1u == (tg + 1u) * nx) xb_add(&bar[XB_TOPGEN], 1u);
            else XB_SPIN(xb_ld(&bar[XB_TOPGEN]) == tg, bar);
            __builtin_amdgcn_fence(__ATOMIC_ACQUIRE, "agent");
            xb_add(&bar[XB_XGEN(b.x)], 1u);
            asm volatile("s_waitcnt vmcnt(0)" ::: "memory");
        } else {
            XB_SPIN(xb_ld(&bar[XB_XGEN(b.x)]) == gen, bar);
            __builtin_amdgcn_fence(__ATOMIC_ACQUIRE, "agent");
            asm volatile("s_waitcnt vmcnt(0)" ::: "memory");
        }
    }
    __syncthreads();
}


constexpr int NWAVES = 8, NT = NWAVES * 64;
constexpr int D = 1024, BATCH = 8, SEQ = 4096, DEPTH = 2, GRIDW = 64, CTXL = 256, GWID = 256, HD = 64, NHEAD = 4;
constexpr int INC = 2048, NEXP = 16, MHID = 512;
constexpr int NLAT = BATCH * SEQ, NCTX = BATCH * CTXL, NROW = NLAT + NCTX;
constexpr float EPS = 1e-6f;
constexpr int UC_AV = 0, UC_AB = 256, UC_AC = 512, UC_P = 768, UC_Q = 1024, UC_K = 1280, UC_V = 1536, UC_F = 1792;

constexpr size_t MiB = 1u << 20;
constexpr size_t WS_CTL = 0, CTL_ZERO_BYTES = 1 * MiB;
constexpr size_t WS_MOD  = 1 * MiB;
constexpr size_t WS_ROUTE = 2 * MiB;
constexpr size_t WS_WIN  = 6 * MiB;
constexpr size_t WS_WOUT = 14 * MiB;
constexpr size_t WS_W13  = 18 * MiB;
constexpr size_t WS_W2   = 82 * MiB;
constexpr size_t WS_XC   = 114 * MiB;
constexpr size_t WS_H    = 122 * MiB;
constexpr size_t WS_U    = 190 * MiB;
constexpr size_t WS_S    = 326 * MiB;
constexpr size_t WS_END  = 480 * MiB;
constexpr size_t WS_DVEC = WS_S;
constexpr size_t WS_Z    = WS_S + 40 * MiB;
constexpr size_t NZ = (size_t)BATCH * NHEAD * SEQ * HD;

constexpr int CW_BAR = 4096;

constexpr int RING_OFF = 0, RING_BYTES = 131072;
constexpr int LDSCTL_OFF = RING_BYTES, MISC_OFF = LDSCTL_OFF + 320;
constexpr int TAB_OFF = RING_BYTES + 1024;
constexpr int LDS_BYTES = 147456;

struct Frame {
    LAS unsigned char* lds;
    volatile LAS unsigned* MISC;
    gu32* ctl;
    int tid, lane, wave, G, bid;
    float* out; unsigned char* ws;
    __device__ __forceinline__ const float* inp(int i) const {
        const __attribute__((address_space(4))) char* ka = (const __attribute__((address_space(4))) char*)__builtin_amdgcn_kernarg_segment_ptr();
        asm volatile("" : "+s"(ka));
        return *(const float* const __attribute__((address_space(4)))*)(ka + 8 * i);
    }
};
enum { I_X = 0, I_C, I_CTX, I_CCTX, I_ADAW, I_ADAB, I_N1G, I_N2G, I_WIN, I_CONVW, I_POOLW, I_POOLS, I_RPB, I_WOUT, I_RW, I_RB, I_W1, I_W3, I_W2, I_FG };

__device__ __forceinline__ float wave_sum(float v) {
#pragma unroll
    for (int o = 1; o < 64; o <<= 1) v += __shfl_xor(v, o);
    return v;
}
__device__ __forceinline__ float bflo(unsigned w) { return __builtin_bit_cast(float, w << 16); }
__device__ __forceinline__ float bfhi(unsigned w) { return __builtin_bit_cast(float, w & 0xffff0000u); }
__device__ __forceinline__ float bf2f(bf16 b) { return __builtin_bit_cast(float, (unsigned)b << 16); }

__device__ __forceinline__ void tr_item(const float* W, int K, int N, bf16* WT, int k0, int n0, int drow0, LAS float* scr, int lane) {
#pragma unroll 8
    for (int i = 0; i < 32; ++i) { const int kk = 2 * i + (lane >> 5); scr[kk * 33 + (lane & 31)] = W[(size_t)(k0 + kk) * N + n0 + (lane & 31)]; }
    LDS_WAIT(); asm volatile("" ::: "memory");
    const int c = lane & 7;
#pragma unroll
    for (int j = 0; j < 4; ++j) { const int n = (lane >> 3) + 8 * j; const LAS float* s = scr + (8 * c) * 33 + n;
        v4u o; o.x = pk2(s[0 * 33], s[1 * 33]); o.y = pk2(s[2 * 33], s[3 * 33]); o.z = pk2(s[4 * 33], s[5 * 33]); o.w = pk2(s[6 * 33], s[7 * 33]);
        *(GAS v4u*)(WT + (size_t)(drow0 + n) * K + k0 + 8 * c) = o; }
    LDS_WAIT(); asm volatile("" ::: "memory");
}
__device__ __forceinline__ void pa_phase(Frame& F) {
    LAS float* scr = (LAS float*)(F.lds + RING_OFF + F.wave * 16384);
    const int gw = F.bid * NWAVES + F.wave, NGW = F.G * NWAVES;
    bf16* WIN = (bf16*)(F.ws + WS_WIN); bf16* WOUT = (bf16*)(F.ws + WS_WOUT); bf16* W13 = (bf16*)(F.ws + WS_W13); bf16* W2 = (bf16*)(F.ws + WS_W2);
    constexpr int I_IN = 2 * 16 * 64, I_OUT = 2 * 16 * 32, I_1 = 32 * 16 * 16, I_2 = 32 * 8 * 32;
    constexpr int NITEMS = I_IN + I_OUT + 2 * I_1 + I_2;
    for (int it = gw; it < NITEMS; it += NGW) {
        int r = it;
        if (r < I_IN) { const int l = r / 1024, q = r % 1024, kb = q / 64, nb = q % 64;
            tr_item(F.inp(I_WIN) + (size_t)l * D * INC, D, INC, WIN + (size_t)l * INC * D, 64 * kb, 32 * nb, 32 * nb, scr, F.lane); continue; } r -= I_IN;
        if (r < I_OUT) { const int l = r / 512, q = r % 512, kb = q / 32, nb = q % 32;
            tr_item(F.inp(I_WOUT) + (size_t)l * D * D, D, D, WOUT + (size_t)l * D * D, 64 * kb, 32 * nb, 32 * nb, scr, F.lane); continue; } r -= I_OUT;
        if (r < 2 * I_1) { const int which = r / I_1; const int q0 = r % I_1; const int le = q0 / 256, q = q0 % 256, kb = q / 16, nb = q % 16;
            const int n0 = 32 * nb; const int drow0 = 256 * (n0 / 128) + 128 * which + (n0 % 128);
            tr_item(F.inp(which ? I_W3 : I_W1) + (size_t)le * D * MHID, D, MHID, W13 + (size_t)le * 1024 * D, 64 * kb, n0, drow0, scr, F.lane); continue; } r -= 2 * I_1;
        { const int le = r / 256, q = r % 256, kb = q / 32, nb = q % 32;
            tr_item(F.inp(I_W2) + (size_t)le * MHID * D, MHID, D, W2 + (size_t)le * D * MHID, 64 * kb, 32 * nb, 32 * nb, scr, F.lane); }
    }
    __syncthreads();
    LAS float* sc = (LAS float*)(F.lds + RING_OFF);
    LAS float* part = (LAS float*)(F.lds + RING_OFF + 40960);
    float* MOD = (float*)(F.ws + WS_MOD);
    bool have_sc = false;
    for (int it = F.bid; it < 2 * 96; it += F.G) {
        if (!have_sc) { for (int i = F.tid; i < 9 * 1024; i += NT) { const float v = i < 8192 ? F.inp(I_C)[i] : F.inp(I_CCTX)[i - 8192]; sc[i] = v / (1.0f + __expf(-v)); } have_sc = true; }
        __syncthreads();
        const int l = it / 96, cb = it % 96, col = cb * 64 + F.lane;
        const float* aw = F.inp(I_ADAW) + (size_t)l * D * 6144 + col;
        float acc[9];
#pragma unroll
        for (int r = 0; r < 9; ++r) acc[r] = 0.f;
        for (int k = F.wave * 128; k < F.wave * 128 + 128; ++k) { const float wv = aw[(size_t)k * 6144];
#pragma unroll
            for (int r = 0; r < 9; ++r) acc[r] += sc[r * 1024 + k] * wv; }
#pragma unroll
        for (int r = 0; r < 9; ++r) part[(F.wave * 9 + r) * 64 + F.lane] = acc[r];
        __syncthreads();
        for (int i = F.tid; i < 9 * 64; i += NT) { const int r = i >> 6, ln = i & 63; float s = F.inp(I_ADAB)[(size_t)l * 6144 + cb * 64 + ln];
#pragma unroll
            for (int w = 0; w < 8; ++w) s += part[(w * 9 + r) * 64 + ln];
            MOD[((size_t)l * 9 + r) * 6144 + cb * 64 + ln] = s; }
        __syncthreads();
    }
}

template <int MODE>
__device__ __forceinline__ void norm_phase(Frame& F, const float* xlat, const float* xctx, int nrows, const float* g, const float* modl, int ch_sh, int ch_sc, bf16* dst, float* gate, float* fout) {
    const int gw = F.bid * NWAVES + F.wave, NGW = F.G * NWAVES;
    for (int r = gw; r < nrows; r += NGW) {
        const float* xr = r < NLAT ? xlat + (size_t)r * D : xctx + (size_t)(r - NLAT) * D;
        const int modrow = r < NLAT ? (r >> 12) : 8;
        f32x4 v[4]; float ss = 0.f;
#pragma unroll
        for (int j = 0; j < 4; ++j) { v[j] = ((const GAS f32x4*)xr)[F.lane + 64 * j]; ss += (v[j].x * v[j].x + v[j].y * v[j].y) + (v[j].z * v[j].z + v[j].w * v[j].w); }
        ss = wave_sum(ss);
        const float rstd = 1.0f / sqrtf(ss * (1.0f / D) + EPS);
        if (MODE == 2) {
#pragma unroll
            for (int j = 0; j < 4; ++j) { const int c = 4 * F.lane + 256 * j; const f32x4 gv = *(const GAS f32x4*)(g + c); *(GAS f32x4*)(fout + (size_t)r * D + c) = v[j] * rstd * gv; }
            continue;
        }
        const float* mrow = modl + (size_t)modrow * 6144;
#pragma unroll
        for (int j = 0; j < 4; ++j) { const int c = 4 * F.lane + 256 * j; const f32x4 gv = *(const GAS f32x4*)(g + c);
            const f32x4 scv = *(const GAS f32x4*)(mrow + ch_sc * 1024 + c), shv = *(const GAS f32x4*)(mrow + ch_sh * 1024 + c);
            v[j] = v[j] * rstd * gv * (scv + 1.0f) + shv;
            *(GAS unsigned long long*)(dst + (size_t)r * D + c) = (unsigned long long)pk2(v[j].x, v[j].y) | ((unsigned long long)pk2(v[j].z, v[j].w) << 32); }
        if (MODE == 1) {
            float s16[16];
#pragma unroll
            for (int e = 0; e < 16; ++e) s16[e] = 0.f;
#pragma unroll
            for (int j = 0; j < 4; ++j)
#pragma unroll
                for (int i = 0; i < 4; ++i) { const int k = 4 * F.lane + 256 * j + i; const float hv = v[j][i]; const GAS f32x4* rw = (const GAS f32x4*)(F.inp(I_RW) + (size_t)k * 16);
#pragma unroll
                    for (int q = 0; q < 4; ++q) { const f32x4 w4 = rw[q]; s16[4 * q + 0] += hv * w4.x; s16[4 * q + 1] += hv * w4.y; s16[4 * q + 2] += hv * w4.z; s16[4 * q + 3] += hv * w4.w; } }
            float bs[16];
#pragma unroll
            for (int e = 0; e < 16; ++e) { s16[e] = wave_sum(s16[e]); s16[e] = 1.0f / (1.0f + expf(-s16[e])); bs[e] = s16[e] + F.inp(I_RB)[e]; }
            float best = -3.0e38f; int bg = 0;
#pragma unroll
            for (int gq = 0; gq < 4; ++gq) { const float a0 = bs[4 * gq], a1 = bs[4 * gq + 1], a2 = bs[4 * gq + 2], a3 = bs[4 * gq + 3];
                const float gs = fmaxf(fmaxf(fmaxf(a0 + a1, a0 + a2), fmaxf(a0 + a3, a1 + a2)), fmaxf(a1 + a3, a2 + a3));
                if (gs > best) { best = gs; bg = gq; } }
            float cb[4], cs[4];
#pragma unroll
            for (int i = 0; i < 4; ++i) { cb[i] = 0.f; cs[i] = 0.f; }
#pragma unroll
            for (int gq = 0; gq < 4; ++gq)
#pragma unroll
                for (int i = 0; i < 4; ++i) { cb[i] = (gq == bg) ? bs[4 * gq + i] : cb[i]; cs[i] = (gq == bg) ? s16[4 * gq + i] : cs[i]; }
            int i1 = 0; float b1 = cb[0], s1 = cs[0];
#pragma unroll
            for (int i = 1; i < 4; ++i) if (cb[i] > b1) { b1 = cb[i]; s1 = cs[i]; i1 = i; }
            int i2 = -1; float b2 = -3.0e38f, s2 = 0.f;
#pragma unroll
            for (int i = 0; i < 4; ++i) if (i != i1 && cb[i] > b2) { b2 = cb[i]; s2 = cs[i]; i2 = i; }
            const float inv = 1.0f / (s1 + s2);
            const int e1 = 4 * bg + i1, e2 = 4 * bg + i2;
            if (F.lane < 16) gate[(size_t)r * 16 + F.lane] = (F.lane == e1) ? s1 * inv : ((F.lane == e2) ? s2 * inv : 0.f);
        }
    }
}

__device__ __forceinline__ void seq_info(int r, int& base, int& t, int& L) {
    if (r < NLAT) { base = r & ~(SEQ - 1); t = r & (SEQ - 1); L = SEQ; } else { const int j = r - NLAT; base = NLAT + (j & ~(CTXL - 1)); t = j & (CTXL - 1); L = CTXL; }
}
__device__ __forceinline__ void att_key(const float (&q)[64], float (&o)[64], float& m, float& l, const bf16* kp, const bf16* vp, float bias) {
    float s = 0.f;
#pragma unroll
    for (int c8 = 0; c8 < 8; ++c8) { const v4u w = *(const GAS v4u*)(kp + 8 * c8);
        s += q[8 * c8 + 0] * bflo(w.x) + q[8 * c8 + 1] * bfhi(w.x) + q[8 * c8 + 2] * bflo(w.y) + q[8 * c8 + 3] * bfhi(w.y)
           + q[8 * c8 + 4] * bflo(w.z) + q[8 * c8 + 5] * bfhi(w.z) + q[8 * c8 + 6] * bflo(w.w) + q[8 * c8 + 7] * bfhi(w.w); }
    s = s * 0.125f + bias;
    const float mn = fmaxf(m, s), alpha = __expf(m - mn), p = __expf(s - mn);
    l = l * alpha + p; m = mn;
#pragma unroll
    for (int c8 = 0; c8 < 8; ++c8) { const v4u w = *(const GAS v4u*)(vp + 8 * c8);
        o[8 * c8 + 0] = o[8 * c8 + 0] * alpha + p * bflo(w.x); o[8 * c8 + 1] = o[8 * c8 + 1] * alpha + p * bfhi(w.x);
        o[8 * c8 + 2] = o[8 * c8 + 2] * alpha + p * bflo(w.y); o[8 * c8 + 3] = o[8 * c8 + 3] * alpha + p * bfhi(w.y);
        o[8 * c8 + 4] = o[8 * c8 + 4] * alpha + p * bflo(w.z); o[8 * c8 + 5] = o[8 * c8 + 5] * alpha + p * bfhi(w.z);
        o[8 * c8 + 6] = o[8 * c8 + 6] * alpha + p * bflo(w.w); o[8 * c8 + 7] = o[8 * c8 + 7] * alpha + p * bfhi(w.w); }
}
__device__ __forceinline__ void mixa_phase(Frame& F, int l, bool with_ctx) {
    const bf16* U = (const bf16*)(F.ws + WS_U); bf16* Y = (bf16*)(F.ws + WS_H);
    float* DV = (float*)(F.ws + WS_DVEC); float* Z = (float*)(F.ws + WS_Z);
    const int nrows = with_ctx ? NROW : NLAT;
    const long gtid = (long)F.bid * NT + F.tid, NTH = (long)F.G * NT;
    const float* cw = F.inp(I_CONVW) + (size_t)l * 3 * GWID;
    for (long i = gtid; i < (long)nrows * GWID; i += NTH) {
        const int r = (int)(i >> 8), ch = (int)(i & 255); int base, t, L; seq_info(r, base, t, L);
        const bf16* ur = U + (size_t)r * INC;
        float acc = cw[GWID + ch] * bf2f(ur[UC_AC + ch]) * bf2f(ur[UC_AV + ch]);
        if (t > 0) acc += cw[ch] * bf2f(ur[UC_AC + ch - INC]) * bf2f(ur[UC_AV + ch - INC]);
        if (t < L - 1) acc += cw[2 * GWID + ch] * bf2f(ur[UC_AC + ch + INC]) * bf2f(ur[UC_AV + ch + INC]);
        Y[(size_t)r * D + ch] = (bf16)f2bf(bf2f(ur[UC_AB + ch]) * acc);
        const int gi = ch >> 6, hw = 1 << gi;
        const int lo = t - hw > 0 ? t - hw : 0, hi = t + hw < L ? t + hw : L;
        float s = 0.f;
        for (int tt = lo; tt < hi; ++tt) s += bf2f(U[(size_t)(base + tt) * INC + UC_P + ch]);
        DV[(size_t)r * GWID + ch] = s / (float)(hi - lo) - bf2f(ur[UC_P + ch]);
    }
    const int nq = NLAT * NHEAD + (with_ctx ? NCTX * NHEAD : 0);
    for (long i = gtid; i < nq; i += NTH) {
        int qrow, h, b; bool lat = i < (long)NLAT * NHEAD; int r = 0, c = 0;
        if (lat) { c = (int)(i & 63); r = (int)((i >> 6) & 63); h = (int)((i >> 12) & 3); b = (int)(i >> 14); qrow = b * SEQ + r * GRIDW + c; }
        else { const int j = (int)(i - (long)NLAT * NHEAD); const int lq = j & 255; h = (j >> 8) & 3; b = j >> 10; qrow = NLAT + b * CTXL + lq; }
        float q[64], o[64];
        { const bf16* qp = U + (size_t)qrow * INC + UC_Q + h * HD;
#pragma unroll
          for (int c8 = 0; c8 < 8; ++c8) { const v4u w = *(const GAS v4u*)(qp + 8 * c8);
              q[8 * c8 + 0] = bflo(w.x); q[8 * c8 + 1] = bfhi(w.x); q[8 * c8 + 2] = bflo(w.y); q[8 * c8 + 3] = bfhi(w.y);
              q[8 * c8 + 4] = bflo(w.z); q[8 * c8 + 5] = bfhi(w.z); q[8 * c8 + 6] = bflo(w.w); q[8 * c8 + 7] = bfhi(w.w); } }
#pragma unroll
        for (int d = 0; d < 64; ++d) o[d] = 0.f;
        float m = -1.0e30f, lsum = 0.f;
        if (lat) {
            const int r0 = r - 4 < 0 ? 0 : (r - 4 > 56 ? 56 : r - 4), c0 = c - 8 < 0 ? 0 : (c - 8 > 48 ? 48 : c - 8);
            const float* rp = F.inp(I_RPB) + (size_t)(l * NHEAD + h) * 15 * 31;
            for (int kr = 0; kr < 8; ++kr) for (int kc = 0; kc < 16; ++kc) { const int rr = r0 + kr, cc = c0 + kc; const bf16* kp = U + (size_t)(b * SEQ + rr * GRIDW + cc) * INC + h * HD;
                att_key(q, o, m, lsum, kp + UC_K, kp + UC_V, rp[(rr - r + 7) * 31 + (cc - c + 15)]); }
        }
        for (int j = 0; j < CTXL; ++j) { const bf16* kp = U + (size_t)(NLAT + b * CTXL + j) * INC + h * HD; att_key(q, o, m, lsum, kp + UC_K, kp + UC_V, 0.f); }
        const float inv = 1.0f / lsum; bf16* yp = Y + (size_t)qrow * D + 512 + h * HD;
#pragma unroll
        for (int c8 = 0; c8 < 8; ++c8) { v4u w; w.x = pk2(o[8 * c8] * inv, o[8 * c8 + 1] * inv); w.y = pk2(o[8 * c8 + 2] * inv, o[8 * c8 + 3] * inv); w.z = pk2(o[8 * c8 + 4] * inv, o[8 * c8 + 5] * inv); w.w = pk2(o[8 * c8 + 6] * inv, o[8 * c8 + 7] * inv);
            *(GAS v4u*)(yp + 8 * c8) = w; }
    }
    LAS float* cs = (LAS float*)(F.lds + TAB_OFF); LAS float* sn = cs + 64; LAS float* cs256 = cs + 128; LAS float* sn256 = cs + 384;
    if (F.tid < 64) { float s_, c_; sincospif((float)F.tid * (1.0f / 32.0f), &s_, &c_); cs[F.tid] = c_; sn[F.tid] = s_; }
    if (F.tid < 256) { float s_, c_; sincospif((float)F.tid * (1.0f / 128.0f), &s_, &c_); cs256[F.tid] = c_; sn256[F.tid] = s_; }
    __syncthreads();
    LAS float* T = (LAS float*)(F.lds + RING_OFF); LAS float* X1r = T + 64 * 65; LAS float* X1i = X1r + 64 * 65;
    for (int un = F.bid; un < BATCH * NHEAD * 64; un += F.G) {
        const int b = un >> 8, h = (un >> 6) & 3, n2 = un & 63;
        { const int n1 = F.tid >> 3, c8 = F.tid & 7; const v4u w = *(const GAS v4u*)(U + (size_t)(b * SEQ + 64 * n1 + n2) * INC + UC_F + h * HD + 8 * c8); LAS float* tp = T + n1 * 65 + 8 * c8;
          tp[0] = bflo(w.x); tp[1] = bfhi(w.x); tp[2] = bflo(w.y); tp[3] = bfhi(w.y); tp[4] = bflo(w.z); tp[5] = bfhi(w.z); tp[6] = bflo(w.w); tp[7] = bfhi(w.w); }
        __syncthreads();
        const int cp = F.tid & 63;
        for (int i = 0; i < 8; ++i) { const int n1 = (F.tid >> 6) + 8 * i; float xr = 0.f, xi = 0.f;
            for (int c = 0; c < 64; ++c) { const float tv = T[n1 * 65 + c]; const int idx = (c * cp) & 63; xr += tv * cs[idx]; xi -= tv * sn[idx]; }
            X1r[n1 * 65 + cp] = xr; X1i[n1 * 65 + cp] = xi; }
        __syncthreads();
        for (int i = 0; i < 8; ++i) { const int n1p = (F.tid >> 6) + 8 * i; float ar = 0.f, ai = 0.f;
            for (int n1 = 0; n1 < 64; ++n1) { const int idx = (n1 * n1p) & 63; const float cc = cs[idx], ss = sn[idx], xr = X1r[n1 * 65 + cp], xi = X1i[n1 * 65 + cp]; ar += cc * xr + ss * xi; ai += cc * xi - ss * xr; }
            float sw, cw_; sincospif((float)(n2 * n1p) * (1.0f / 2048.0f), &sw, &cw_);
            const size_t zi = ((((size_t)(b * NHEAD + h) * 64 + n1p) * 64 + n2) * 64) + cp;
            Z[zi] = ar * cw_ + ai * sw; Z[NZ + zi] = ai * cw_ - ar * sw; }
        __syncthreads();
    }
    if (with_ctx) {
        LAS float* C1r = (LAS float*)(F.lds + RING_OFF); LAS float* C1i = C1r + 256 * 64;
        for (int un = F.bid; un < BATCH * NHEAD; un += F.G) {
            const int b = un >> 2, h = un & 3, cp = F.tid & 63;
            for (int i = 0; i < 32; ++i) { const int n = (F.tid >> 6) + 8 * i; const bf16* fp = U + (size_t)(NLAT + b * CTXL + n) * INC + UC_F + h * HD; float xr = 0.f, xi = 0.f;
                for (int c = 0; c < 64; ++c) { const float tv = bf2f(fp[c]); const int idx = (c * cp) & 63; xr += tv * cs[idx]; xi -= tv * sn[idx]; }
                C1r[n * 64 + cp] = xr; C1i[n * 64 + cp] = xi; }
            __syncthreads();
            for (int i = 0; i < 32; ++i) { const int np = (F.tid >> 6) + 8 * i; float acc = 0.f;
                for (int n = 0; n < 256; ++n) { const int idx = (n * np) & 255; acc += cs256[idx] * C1r[n * 64 + cp] + sn256[idx] * C1i[n * 64 + cp]; }
                Y[(size_t)(NLAT + b * CTXL + np) * D + 768 + h * HD + cp] = (bf16)f2bf(acc * (1.0f / 128.0f)); }
            __syncthreads();
        }
    }
}
__device__ __forceinline__ void mixb_phase(Frame& F, int l, bool with_ctx) {
    bf16* Y = (bf16*)(F.ws + WS_H); const float* DV = (const float*)(F.ws + WS_DVEC); const float* Z = (const float*)(F.ws + WS_Z);
    const int nrows = with_ctx ? NROW : NLAT;
    const long gtid = (long)F.bid * NT + F.tid, NTH = (long)F.G * NT;
    const float* pw = F.inp(I_POOLW) + (size_t)l * 4 * 64 * 64; const float* ps = F.inp(I_POOLS) + (size_t)l * GWID;
    for (long i = gtid; i < (long)nrows * GWID; i += NTH) {
        const int r = (int)(i >> 8), oc = (int)(i & 255), gi = oc >> 6, dd = oc & 63; const float* dv = DV + (size_t)r * GWID + gi * 64; const float* w = pw + (size_t)gi * 4096 + dd;
        float acc = 0.f;
        for (int c = 0; c < 64; ++c) acc += dv[c] * w[c * 64];
        Y[(size_t)r * D + 256 + oc] = (bf16)f2bf(acc * ps[oc]);
    }
    LAS float* cs = (LAS float*)(F.lds + TAB_OFF); LAS float* sn = cs + 64;
    if (F.tid < 64) { float s_, c_; sincospif((float)F.tid * (1.0f / 32.0f), &s_, &c_); cs[F.tid] = c_; sn[F.tid] = s_; }
    __syncthreads();
    LAS float* Zr = (LAS float*)(F.lds + RING_OFF); LAS float* Zi = Zr + 4096;
    for (int un = F.bid; un < BATCH * NHEAD * 64; un += F.G) {
        const int b = un >> 8, h = (un >> 6) & 3, n1p = un & 63;
        const size_t z0 = (((size_t)(b * NHEAD + h) * 64 + n1p) * 64) * 64;
        for (int i = F.tid; i < 4096; i += NT) { Zr[i] = Z[z0 + i]; Zi[i] = Z[NZ + z0 + i]; }
        __syncthreads();
        const int cp = F.tid & 63;
        for (int i = 0; i < 8; ++i) { const int n2p = (F.tid >> 6) + 8 * i; float acc = 0.f;
            for (int n2 = 0; n2 < 64; ++n2) { const int idx = (n2 * n2p) & 63; acc += cs[idx] * Zr[n2 * 64 + cp] + sn[idx] * Zi[n2 * 64 + cp]; }
            Y[(size_t)(b * SEQ + n1p + 64 * n2p) * D + 768 + h * HD + cp] = (bf16)f2bf(acc * (1.0f / 512.0f)); }
        __syncthreads();
    }
}

struct WinOrder {
    int G, c, nctx_cols, ctx_pn0;
    __device__ __forceinline__ bool next(int i, pg8::Unit& u) const {
        const long L = (long)i * G + c; const int nlatu = 1024, total = nlatu + 8 * nctx_cols; if (L >= total) return false;
        if (L < nlatu) { int wgid = (int)L; { const int xcd = wgid % 8, off = wgid / 8; wgid = xcd * 128 + off; }
            const int gid = wgid / 64, fm = gid * 8; u.pm = fm + ((wgid % 64) % 8); u.pn = (wgid % 64) / 8; }
        else { const int j = (int)L - nlatu; u.pm = 128 + (j % 8); u.pn = ctx_pn0 + j / 8; }
        u.pb = u.pn; return true;
    }
    __device__ __forceinline__ void a_ready(const pg8::Unit&) const {}
    __device__ __forceinline__ void done(const pg8::Unit&) const {}
};

struct Args { const float* in[20]; float* out; unsigned char* ws; int l, e; };
#define FRAME_SETUP() \
    extern __shared__ __attribute__((aligned(16))) unsigned char lds[]; \
    Frame F; F.lds = (LAS unsigned char*)lds; F.MISC = (volatile LAS unsigned*)(F.lds + MISC_OFF); \
    F.tid = threadIdx.x; F.lane = F.tid & 63; F.wave = __builtin_amdgcn_readfirstlane(F.tid >> 6); F.G = gridDim.x; F.bid = blockIdx.x; \
    F.ws = args.ws; F.out = args.out; F.ctl = (gu32*)(args.ws + WS_CTL); \
    bf16* H = (bf16*)(F.ws + WS_H); bf16* U = (bf16*)(F.ws + WS_U); bf16* HE = (bf16*)(F.ws + WS_U); \
    float* MOD = (float*)(F.ws + WS_MOD); float* XC = (float*)(F.ws + WS_XC); float* GATE = (float*)(F.ws + WS_ROUTE); \
    const int l = args.l; const bool first = (l == 0); const int M = first ? NROW : NLAT; const float* modl = MOD + (size_t)l * 9 * 6144; \
    (void)H; (void)U; (void)HE; (void)XC; (void)GATE; (void)M; (void)modl;

__global__ void __launch_bounds__(NT, 2) k_pa(Args args) { FRAME_SETUP(); pa_phase(F); }
__global__ void __launch_bounds__(NT, 2) k_norm1(Args args) { FRAME_SETUP();
    norm_phase<0>(F, first ? F.inp(I_X) : F.out, first ? F.inp(I_CTX) : XC, NROW, F.inp(I_N1G) + (size_t)l * D, modl, 0, 1, H, nullptr, nullptr); }
__global__ void __launch_bounds__(NT, 2) k_final(Args args) { FRAME_SETUP(); norm_phase<2>(F, F.out, XC, NLAT, F.inp(I_FG), nullptr, 0, 0, nullptr, nullptr, F.out); }
__global__ void __launch_bounds__(NT, 2) k_norm2(Args args) { FRAME_SETUP(); norm_phase<1>(F, F.out, XC, M, F.inp(I_N2G) + (size_t)l * D, modl, 3, 4, H, GATE, nullptr); }
__global__ void __launch_bounds__(NT, 2) k_win(Args args) { FRAME_SETUP();
    pg8::Gemm g{H, (const bf16*)(F.ws + WS_WIN) + (size_t)l * INC * D, NROW, INC, D};
    WinOrder S{F.G, F.bid, first ? 8 : 2, first ? 0 : 5};
    pg8::EpiBf16 E{U, INC};
    pg8::gemm_phase<pg8::EpiBf16, WinOrder, true, true>(F.lds + RING_OFF, g, S, E); }
__global__ void __launch_bounds__(NT, 2) k_mixa(Args args) { FRAME_SETUP(); mixa_phase(F, l, first); }
__global__ void __launch_bounds__(NT, 2) k_mixb(Args args) { FRAME_SETUP(); mixb_phase(F, l, first); }
__global__ void __launch_bounds__(NT, 2) k_wout(Args args) { FRAME_SETUP();
    pg8::Gemm g{H, (const bf16*)(F.ws + WS_WOUT) + (size_t)l * D * D, M, D, D};
    pg8::StaticOrder S; S.init(M, D, F.G, F.bid);
    const float* xlat_in = first ? F.inp(I_X) : F.out; const float* xctx_in = first ? F.inp(I_CTX) : XC;
    pg8::EpiResid E{xlat_in, xctx_in, F.out, XC, modl + 2 * 1024, 6144, nullptr, 0, NLAT, SEQ};
    pg8::gemm_phase<pg8::EpiResid, pg8::StaticOrder, true, true>(F.lds + RING_OFF, g, S, E); }
__global__ void __launch_bounds__(NT, 2) k_moe1(Args args) { FRAME_SETUP(); const int e = args.e;
    pg8::Gemm g{H, (const bf16*)(F.ws + WS_W13) + (size_t)(l * NEXP + e) * 1024 * D, M, 1024, D};
    pg8::StaticOrder S; S.init(M, 1024, F.G, F.bid);
    pg8::EpiSwiGLU E{HE, MHID};
    pg8::gemm_phase<pg8::EpiSwiGLU, pg8::StaticOrder, true, true>(F.lds + RING_OFF, g, S, E); }
__global__ void __launch_bounds__(NT, 2) k_moe2(Args args) { FRAME_SETUP(); const int e = args.e;
    pg8::Gemm g{HE, (const bf16*)(F.ws + WS_W2) + (size_t)(l * NEXP + e) * D * MHID, M, D, MHID};
    pg8::StaticOrder S; S.init(M, D, F.G, F.bid);
    pg8::EpiResid E{F.out, XC, F.out, XC, modl + 5 * 1024, 6144, GATE + e, 16, NLAT, SEQ};
    pg8::gemm_phase<pg8::EpiResid, pg8::StaticOrder, true, true>(F.lds + RING_OFF, g, S, E); }

typedef void (*kern_t)(Args);
extern "C" void kernel_launch(void* const* d_in, const int* in_sizes, int n_in, void* d_out, int out_size, void* d_ws, size_t ws_size, hipStream_t stream) {
    static int grid = 0;
    const kern_t kerns[] = {k_pa, k_norm1, k_final, k_norm2, k_win, k_mixa, k_mixb, k_wout, k_moe1, k_moe2};
    if (grid == 0) {
        if (n_in != 20 || out_size != NLAT * D || ws_size < WS_END) { fprintf(stderr, "kernel_launch: unexpected shapes (n_in %d out %d ws %zu)\n", n_in, out_size, ws_size); grid = -1; return; }
        int dev = 0, cus = 0;
        if (hipGetDevice(&dev) != hipSuccess || hipDeviceGetAttribute(&cus, hipDeviceAttributeMultiprocessorCount, dev) != hipSuccess) { grid = -1; return; }
        for (kern_t k : kerns) if (hipFuncSetAttribute((const void*)k, hipFuncAttributeMaxDynamicSharedMemorySize, LDS_BYTES) != hipSuccess) { fprintf(stderr, "kernel_launch: hipFuncSetAttribute failed\n"); grid = -1; return; }
        grid = cus;
    }
    if (grid < 0) return;
    Args a{};
    for (int i = 0; i < 20; ++i) a.in[i] = (const float*)d_in[i];
    a.out = (float*)d_out; a.ws = (unsigned char*)d_ws;
#define LAUNCH(k, L, E) do { a.l = (L); a.e = (E); hipLaunchKernelGGL(k, dim3(grid), dim3(NT), LDS_BYTES, stream, a); } while (0)
    LAUNCH(k_pa, 0, 0);
    for (int l = 0; l < DEPTH; ++l) {
        LAUNCH(k_norm1, l, 0);
        LAUNCH(k_win, l, 0); LAUNCH(k_mixa, l, 0); LAUNCH(k_mixb, l, 0); LAUNCH(k_wout, l, 0); LAUNCH(k_norm2, l, 0);
        for (int e = 0; e < NEXP; ++e) { LAUNCH(k_moe1, l, e); LAUNCH(k_moe2, l, e); }
    }
    LAUNCH(k_final, 0, 0);
}
```

```cpp
#include <hip/hip_runtime.h>
#include <cstdio>
#include <cstdint>
namespace pg8 {
#define PG8_LAS __attribute__((address_space(3)))
typedef unsigned short bf16_t;
typedef short bf16x8 __attribute__((ext_vector_type(8)));
typedef float f32x4 __attribute__((ext_vector_type(4)));
typedef unsigned u32x4 __attribute__((ext_vector_type(4)));
constexpr int BM = 256, BK = 64, HALF = 128, HTB = HALF * BK * 2  , STAGE_BYTES = 8 * HTB, NXCD = 8, WGM = 8;

__host__ __device__ __forceinline__ int lds_byte(int r, int c) { const int st = (r >> 4) * 2 + (c >> 5), rr = r & 15, cc = c & 31, ob = rr * 64 + cc * 2; return st * 1024 + (ob ^ (((ob >> 9) & 1) << 5)); }
__host__ __device__ __forceinline__ void stage_rc(int b, int& R, int& C) { const int st = b / 1024, sb = b % 1024, swz = sb ^ (((sb >> 9) & 1) << 5); R = (st >> 1) * 16 + swz / 64; C = (st & 1) * 32 + (swz % 64) / 2; }
__host__ __device__ __forceinline__ int perm32(int rho) { const int n = rho >> 4, i = rho & 15; return 8 * (i >> 2) + 4 * n + (i & 3); }

struct Unit { int pm, pn, pb, lb, nv; };
struct Gemm { const bf16_t* A; const bf16_t* Bt; int M, N, K; };

struct StaticOrder {
    int nM, nN, nwg, G, c;
    __host__ __device__ void init(int M, int N, int G_, int c_) { nM = M / BM; nN = N / BM; nwg = nM * nN; G = G_; c = c_; }
    __host__ __device__ bool next(int i, Unit& u) const {
        const long L = (long)i * G + c; if (L >= nwg) return false;
        int wgid = (int)L; { const int q = nwg / NXCD, r = nwg % NXCD, xcd = wgid % NXCD, off = wgid / NXCD; wgid = (xcd < r ? xcd * (q + 1) : r * (q + 1) + (xcd - r) * q) + off; }
        const int nig = WGM * nN, gid = wgid / nig, fm = gid * WGM, gsz = (nM - fm) < WGM ? (nM - fm) : WGM;
        u.pm = fm + ((wgid % nig) % gsz); u.pn = (wgid % nig) / gsz; u.pb = u.pn; u.lb = 0; u.nv = BM; return true;
    }
    __device__ __forceinline__ void a_ready(const Unit&) const {}
    __device__ __forceinline__ int row_of(const Unit&, int i) const { return i; }
    __device__ __forceinline__ void done(const Unit&) const {}
};


__device__ __forceinline__ unsigned cvt_pk_bf16(float lo, float hi) { unsigned r; asm volatile("v_cvt_pk_bf16_f32 %0, %1, %2" : "=v"(r) : "v"(lo), "v"(hi)); return r; }

struct EpiBf16 {
    static constexpr bool PERM = true, AFTER_DRAIN = false;
    bf16_t* O; int ldc;
    __device__ __forceinline__ void operator()(const f32x4 (&acc)[2][2][4][2], const Unit& u, int wr, int wc, int fr, int fq) const {
        const int row0 = u.pm * BM + wr * 64 + fr; const int col0 = u.pn * BM + wc * 32 + 8 * fq;
#pragma unroll
        for (int ai = 0; ai < 2; ++ai)
#pragma unroll
            for (int m = 0; m < 4; ++m) { bf16_t* rowp = O + (size_t)(row0 + ai * HALF + m * 16) * ldc + col0;
#pragma unroll
                for (int bj = 0; bj < 2; ++bj) { const f32x4 v0 = acc[ai][bj][m][0], v1 = acc[ai][bj][m][1];
                    u32x4 w; w.x = cvt_pk_bf16(v0[0], v0[1]); w.y = cvt_pk_bf16(v0[2], v0[3]); w.z = cvt_pk_bf16(v1[0], v1[1]); w.w = cvt_pk_bf16(v1[2], v1[3]);
                    *(u32x4*)(rowp + bj * HALF) = w; } }
    }
};
struct EpiSwiGLU {
    static constexpr bool PERM = true, AFTER_DRAIN = false;
    bf16_t* O; int ldc;
    __device__ __forceinline__ void operator()(const f32x4 (&acc)[2][2][4][2], const Unit& u, int wr, int wc, int fr, int fq) const {
        const int row0 = u.pm * BM + wr * 64 + fr; const int col0 = u.pn * HALF + wc * 32 + 8 * fq;
#pragma unroll
        for (int ai = 0; ai < 2; ++ai)
#pragma unroll
            for (int m = 0; m < 4; ++m) { bf16_t* rowp = O + (size_t)(row0 + ai * HALF + m * 16) * ldc + col0;
                float o[8];
#pragma unroll
                for (int n = 0; n < 2; ++n)
#pragma unroll
                    for (int j = 0; j < 4; ++j) { const float a = acc[ai][0][m][n][j], b = acc[ai][1][m][n][j]; o[n * 4 + j] = a * __builtin_amdgcn_rcpf(1.0f + __expf(-a)) * b; }
                u32x4 w; w.x = cvt_pk_bf16(o[0], o[1]); w.y = cvt_pk_bf16(o[2], o[3]); w.z = cvt_pk_bf16(o[4], o[5]); w.w = cvt_pk_bf16(o[6], o[7]);
                *(u32x4*)rowp = w; }
    }
};
struct EpiResid {
    static constexpr bool PERM = false, AFTER_DRAIN = false;
    const float* xin_lat; const float* xin_ctx; float* xout_lat; float* xout_ctx; const float* gmod; int gstride; const float* rowscale; int rs_stride; int nlat, seq;
    __device__ __forceinline__ void operator()(const f32x4 (&acc)[2][2][4][2], const Unit& u, int wr, int wc, int fr, int fq) const {
        const int prow = u.pm * BM; const bool isctx = prow >= nlat;
        const float* xin = isctx ? xin_ctx - (size_t)nlat * 1024 : xin_lat; float* xout = isctx ? xout_ctx - (size_t)nlat * 1024 : xout_lat;
        const int modrow = isctx ? 8 : prow / seq;
        const int row0 = prow + wr * 64 + fr, col0 = u.pn * BM + wc * 32 + 4 * fq;
        f32x4 gv[2][2];
#pragma unroll
        for (int bj = 0; bj < 2; ++bj)
#pragma unroll
            for (int n = 0; n < 2; ++n) gv[bj][n] = *(const f32x4*)(gmod + (size_t)modrow * gstride + col0 + bj * HALF + n * 16);
#pragma unroll
        for (int ai = 0; ai < 2; ++ai)
#pragma unroll
            for (int m = 0; m < 4; ++m) { const int row = row0 + ai * HALF + m * 16; const size_t off = (size_t)row * 1024 + col0;
                const float rs = rowscale ? rowscale[(size_t)row * rs_stride] : 1.0f;
#pragma unroll
                for (int bj = 0; bj < 2; ++bj)
#pragma unroll
                    for (int n = 0; n < 2; ++n) { const f32x4 xi = *(const f32x4*)(xin + off + bj * HALF + n * 16);
                        *(f32x4*)(xout + off + bj * HALF + n * 16) = xi + gv[bj][n] * rs * acc[ai][bj][m][n]; } }
    }
};
struct EpiScatter {
    static constexpr bool PERM = true, AFTER_DRAIN = false;
    bf16_t* Y2; const uint2* info;
    __device__ __forceinline__ void operator()(const f32x4 (&acc)[2][2][4][2], const Unit& u, int wr, int wc, int fr, int fq) const {
        const int col0 = u.pn * BM + wc * 32 + 8 * fq;
#pragma unroll
        for (int ai = 0; ai < 2; ++ai)
#pragma unroll
            for (int m = 0; m < 4; ++m) { const int i = ai * HALF + wr * 64 + m * 16 + fr;
                if (i < u.nv) { const uint2 inf = info[u.lb + i]; const float w = __builtin_bit_cast(float, inf.y); bf16_t* rowp = Y2 + (size_t)inf.x * 1024 + col0;
#pragma unroll
                    for (int bj = 0; bj < 2; ++bj) { const f32x4 v0 = acc[ai][bj][m][0] * w, v1 = acc[ai][bj][m][1] * w;
                        u32x4 q; q.x = cvt_pk_bf16(v0[0], v0[1]); q.y = cvt_pk_bf16(v0[2], v0[3]); q.z = cvt_pk_bf16(v1[0], v1[1]); q.w = cvt_pk_bf16(v1[2], v1[3]);
                        *(u32x4*)(rowp + bj * HALF) = q; } } }
    }
};
struct MoeOrder {
    int G, c, cap; const PG8_LAS int* tab; const uint2* info;
    __device__ __forceinline__ bool next(int i, Unit& u) const {
        const int nwg = __builtin_amdgcn_readfirstlane(tab[16]) * 4; const long L = (long)i * G + c; if (L >= nwg) return false;
        int wgid = (int)L; { const int q = nwg / NXCD, r = nwg % NXCD, xcd = wgid % NXCD, off = wgid / NXCD; wgid = (xcd < r ? xcd * (q + 1) : r * (q + 1) + (xcd - r) * q) + off; }
        const int gp = wgid >> 2; int e = 0;
#pragma unroll
        for (int q = 1; q < 16; ++q) e += (gp >= tab[q]) ? 1 : 0;
        e = __builtin_amdgcn_readfirstlane(e);
        const int p = gp - __builtin_amdgcn_readfirstlane(tab[e]); const int ne = __builtin_amdgcn_readfirstlane(tab[17 + e]);
        u.pm = gp; u.pn = wgid & 3; u.pb = e * 4 + u.pn; u.lb = e * cap + 256 * p; u.nv = (ne - 256 * p) < 256 ? (ne - 256 * p) : 256; return true;
    }
    __device__ __forceinline__ void a_ready(const Unit&) const {}
    __device__ __forceinline__ void done(const Unit&) const {}
    __device__ __forceinline__ int row_of(const Unit& u, int i) const { return i < u.nv ? (int)(info[u.lb + i].x >> 1) : 0; }
};
template <class Epi, class Sched, bool GATHER = false>
__device__ __forceinline__ void gemm_phase(PG8_LAS unsigned char* lds, const Gemm g, const Sched& S, const Epi& E) {
    int tid_ = threadIdx.x; asm volatile("" : "+v"(tid_));
    const int tid = tid_, wid = __builtin_amdgcn_readfirstlane(tid >> 6), lane = tid & 63, wr = wid >> 2, wc = wid & 3, fr = lane & 15, fq = lane >> 4;
    const int K = g.K, nt = K / BK;
    unsigned voffB[2];
#pragma unroll
    for (int i = 0; i < 2; ++i) { int R, C; stage_rc(tid * 16 + i * 8192, R, C); const int Rb = Epi::PERM ? ((R & ~31) + perm32(R & 31)) : R; voffB[i] = (unsigned)(Rb * K + C) * 2u; }
    const size_t kstep = (size_t)(BK * 2);
    const size_t hstep = (size_t)HALF * K * 2;
    const size_t tstep = 2 * hstep;
    const unsigned ldsw = (unsigned)wid * 1024u;
    const int aoff = lds_byte(wr * 64 + fr, fq * 8), boff = lds_byte(wc * 32 + fr, fq * 8);
#define PG8_SA(b, h) (((b) * 2 + (h)) * HTB)
#define PG8_SB(b, h) ((4 + (b) * 2 + (h)) * HTB)
#define PG8_STAGE(bufoff, gbase, voff) do { _Pragma("unroll") for (int _i = 0; _i < 2; ++_i) \
        __builtin_amdgcn_global_load_lds((const unsigned*)((const char*)(gbase) + (voff)[_i]), (PG8_LAS unsigned*)(lds + (bufoff) + ldsw + _i * 8192), 16, 0, 0); } while (0)
#define PG8_LDA(dst, b, h) do { _Pragma("unroll") for (int m = 0; m < 4; ++m) _Pragma("unroll") for (int k = 0; k < 2; ++k) dst[m][k] = *(const PG8_LAS bf16x8*)(lds + PG8_SA(b, h) + aoff + m * 2048 + k * 1024); } while (0)
#define PG8_LDB(dst, b, h) do { _Pragma("unroll") for (int n = 0; n < 2; ++n) _Pragma("unroll") for (int k = 0; k < 2; ++k) dst[n][k] = *(const PG8_LAS bf16x8*)(lds + PG8_SB(b, h) + boff + n * 2048 + k * 1024); } while (0)
#define PG8_MMA(ai, bj, At, Bt) do { __builtin_amdgcn_s_setprio(1); _Pragma("unroll") for (int m = 0; m < 4; ++m) _Pragma("unroll") for (int n = 0; n < 2; ++n) _Pragma("unroll") for (int k = 0; k < 2; ++k) \
        acc[ai][bj][m][n] = __builtin_amdgcn_mfma_f32_16x16x32_bf16(Bt[n][k], At[m][k], acc[ai][bj][m][n], 0, 0, 0); __builtin_amdgcn_s_setprio(0); } while (0)
#define PG8_WAIT_V(n) asm volatile("s_waitcnt vmcnt(" #n ")" ::: "memory")
#define PG8_WAIT_L(n) asm volatile("s_waitcnt lgkmcnt(" #n ")" ::: "memory")
#define PG8_BAR __builtin_amdgcn_s_barrier()
#define PG8_SCHED __builtin_amdgcn_sched_barrier(0)
#define PG8_AOFFS(o, u) do { _Pragma("unroll") for (int _h = 0; _h < 2; ++_h) _Pragma("unroll") for (int _i = 0; _i < 2; ++_i) { int _R, _C; stage_rc(tid * 16 + _i * 8192, _R, _C); \
        const int _row = GATHER ? S.row_of((u), _h * HALF + _R) : (_h * HALF + _R); (o)[_h][_i] = (unsigned)(_row * K + _C) * 2u; } } while (0)
    Unit cur, nxt; int ui = 0;
    if (!S.next(0, cur)) return;
    f32x4 acc[2][2][4][2];
#pragma unroll
    for (int a = 0; a < 2; ++a)
#pragma unroll
        for (int b = 0; b < 2; ++b)
#pragma unroll
            for (int m = 0; m < 4; ++m)
#pragma unroll
                for (int n = 0; n < 2; ++n) acc[a][b][m][n] = (f32x4){0.f, 0.f, 0.f, 0.f};
    bf16x8 At[4][2], B0[2][2], B1[2][2];
    unsigned offA[2][2], noffA[2][2];
    const char* cA = (const char*)g.A + (GATHER ? (size_t)0 : (size_t)cur.pm * tstep); const char* cB = (const char*)g.Bt + (size_t)cur.pb * tstep;
    S.a_ready(cur);
    PG8_AOFFS(offA, cur);
    PG8_STAGE(PG8_SB(0, 0), cB, voffB); PG8_STAGE(PG8_SB(0, 1), cB + hstep, voffB); PG8_STAGE(PG8_SA(0, 0), cA, offA[0]); PG8_STAGE(PG8_SA(0, 1), cA, offA[1]);
    if (wr == 1) PG8_BAR;
    PG8_WAIT_V(2); PG8_BAR;
    PG8_STAGE(PG8_SB(1, 0), cB + kstep, voffB); PG8_STAGE(PG8_SA(1, 0), cA + kstep, offA[0]); PG8_STAGE(PG8_SB(1, 1), cB + hstep + kstep, voffB);
    PG8_WAIT_V(6); PG8_BAR;
    for (;;) {
        const bool has_next = S.next(ui + 1, nxt);
        const char* nA = has_next ? (const char*)g.A + (GATHER ? (size_t)0 : (size_t)nxt.pm * tstep) : cA; const char* nB = has_next ? (const char*)g.Bt + (size_t)nxt.pb * tstep : cB;
        for (int t = 0; t < nt; t += 2) {
            const bool last = (t == nt - 2);
            const char* a1 = cA + (size_t)(t + 1) * kstep;
            const char* a2 = last ? nA : cA + (size_t)(t + 2) * kstep; const char* b2 = last ? nB : cB + (size_t)(t + 2) * kstep;
            const char* a3 = a2 + kstep; const char* b3 = b2 + kstep;
            if (last && has_next) S.a_ready(nxt);
            unsigned o2[2][2];
            if constexpr (GATHER) {
                if (last) { if (has_next) { PG8_AOFFS(noffA, nxt); } else {
#pragma unroll
                        for (int h = 0; h < 2; ++h) { noffA[h][0] = offA[h][0]; noffA[h][1] = offA[h][1]; } } }
#pragma unroll
                for (int h = 0; h < 2; ++h) { o2[h][0] = last ? noffA[h][0] : offA[h][0]; o2[h][1] = last ? noffA[h][1] : offA[h][1]; }
            } else {
#pragma unroll
                for (int h = 0; h < 2; ++h) { o2[h][0] = offA[h][0]; o2[h][1] = offA[h][1]; }
            }
            PG8_LDB(B0, 0, 0); PG8_LDB(B1, 0, 1); PG8_SCHED; PG8_LDA(At, 0, 0); PG8_STAGE(PG8_SA(1, 1), a1, offA[1]);
            PG8_WAIT_V(8); PG8_WAIT_L(0); PG8_BAR; PG8_MMA(0, 0, At, B0); PG8_MMA(0, 1, At, B1); PG8_BAR; PG8_SCHED;
            PG8_LDA(At, 0, 1); PG8_STAGE(PG8_SB(0, 0), b2, voffB); PG8_STAGE(PG8_SB(0, 1), b2 + hstep, voffB); PG8_STAGE(PG8_SA(0, 0), a2, o2[0]);
            PG8_WAIT_V(8); PG8_WAIT_L(0); PG8_BAR; PG8_MMA(1, 0, At, B0); PG8_MMA(1, 1, At, B1); PG8_BAR; PG8_SCHED;
            PG8_LDB(B0, 1, 0); PG8_LDB(B1, 1, 1); PG8_SCHED; PG8_LDA(At, 1, 0); PG8_STAGE(PG8_SA(0, 1), a2, o2[1]);
            PG8_WAIT_V(8); PG8_WAIT_L(0); PG8_BAR; PG8_MMA(0, 0, At, B0); PG8_MMA(0, 1, At, B1); PG8_BAR; PG8_SCHED;
            PG8_LDA(At, 1, 1); PG8_STAGE(PG8_SB(1, 0), b3, voffB); PG8_STAGE(PG8_SB(1, 1), b3 + hstep, voffB); PG8_STAGE(PG8_SA(1, 0), a3, o2[0]);
            PG8_WAIT_V(8); PG8_WAIT_L(0); PG8_BAR; PG8_MMA(1, 0, At, B0); PG8_MMA(1, 1, At, B1); PG8_BAR; PG8_SCHED;
        }
        if (wr == 0) PG8_BAR;
        E(acc, cur, wr, wc, fr, fq); S.done(cur);
        if (!has_next) break;
#pragma unroll
        for (int a = 0; a < 2; ++a)
#pragma unroll
            for (int b = 0; b < 2; ++b)
#pragma unroll
                for (int m = 0; m < 4; ++m)
#pragma unroll
                    for (int n = 0; n < 2; ++n) acc[a][b][m][n] = (f32x4){0.f, 0.f, 0.f, 0.f};
        cur = nxt; cA = nA; cB = nB; ++ui;
        if constexpr (GATHER) {
#pragma unroll
            for (int h = 0; h < 2; ++h) { offA[h][0] = noffA[h][0]; offA[h][1] = noffA[h][1]; } }
        if (wr == 1) PG8_BAR;
    }
    PG8_WAIT_V(0);
    PG8_BAR;
#undef PG8_SA
#undef PG8_SB
#undef PG8_STAGE
#undef PG8_LDA
#undef PG8_LDB
#undef PG8_MMA
#undef PG8_WAIT_V
#undef PG8_WAIT_L
#undef PG8_BAR
#undef PG8_SCHED
#undef PG8_AOFFS
}
}
#define GAS __attribute__((address_space(1)))
#define LAS __attribute__((address_space(3)))
typedef unsigned short bf16;
typedef unsigned v4u __attribute__((ext_vector_type(4)));
typedef float f32x4 __attribute__((ext_vector_type(4)));
typedef short bf16x8 __attribute__((ext_vector_type(8)));
typedef GAS unsigned gu32;
typedef GAS unsigned long long gu64;
#define RLX_AGENT __ATOMIC_RELAXED, __HIP_MEMORY_SCOPE_AGENT
#define LDS_WAIT() asm volatile("s_waitcnt lgkmcnt(0)" ::: "memory")
#define VM_WAIT() asm volatile("s_waitcnt vmcnt(0)" ::: "memory")
__device__ __forceinline__ unsigned long long rt() { return __builtin_amdgcn_s_memrealtime(); }
__device__ __forceinline__ unsigned f2bf(float f) { unsigned u = __builtin_bit_cast(unsigned, f); return (u + 0x7fffu + ((u >> 16) & 1u)) >> 16; }
__device__ __forceinline__ unsigned pk2(float lo, float hi) { return f2bf(lo) | (f2bf(hi) << 16); }

#define XB_TMO      128
#define XB_XCNT(j)  (256  + 64 * (j))
#define XB_XSUB(j)  (1280 + 64 * (j))
#define XB_XGEN(j)  (2304 + 64 * (j))
#define XB_TOP      3328
#define XB_TOPGEN   3392
#define XCD_BAR_WORDS 3456
#define XB_SPIN_CAP (1u << 18)

__device__ __forceinline__ unsigned xb_ld(unsigned* p)              { return __hip_atomic_load(p, __ATOMIC_RELAXED, __HIP_MEMORY_SCOPE_AGENT); }
__device__ __forceinline__ unsigned xb_add(unsigned* p, unsigned v) { return __hip_atomic_fetch_add(p, v, __ATOMIC_RELAXED, __HIP_MEMORY_SCOPE_AGENT); }
__device__ __forceinline__ unsigned xb_xcc_id() { return (unsigned)__builtin_amdgcn_s_getreg((3 << 11) | 20) & 0xFu; }
#define XB_SPIN(cond, bar) do { unsigned _sp = 0; while (cond) { __builtin_amdgcn_s_sleep(1); \
    if ((++_sp & 255u) == 0u) { if (xb_ld(&(bar)[XB_TMO])) break; if (_sp > XB_SPIN_CAP) { atomicAdd(&(bar)[XB_TMO], 1u); break; } } } } while (0)

struct XcdBarrier {
    unsigned* bar; unsigned x;
    volatile LAS unsigned* st;
};

__device__ __forceinline__ XcdBarrier xcd_barrier_post(unsigned* bar, volatile LAS unsigned* st) {
    XcdBarrier b; b.bar = bar; b.x = xb_xcc_id(); b.st = st;
    if (threadIdx.x == 0) (void)xb_add(&bar[XB_XCNT(b.x)], 1u);
    return b;
}
__device__ __forceinline__ void xcd_barrier_complete(unsigned* bar, unsigned x, unsigned& nloc, unsigned& nx) {
    const unsigned G = gridDim.x * gridDim.y * gridDim.z;
    unsigned sum, cnt, mine, sp = 0u;
    for (;;) {
        sum = 0u; cnt = 0u; mine = 0u;
#pragma unroll
        for (unsigned j = 0; j < 16; ++j) { const unsigned c = xb_ld(&bar[XB_XCNT(j)]); sum += c; cnt += (c > 0u) ? 1u : 0u; mine = (j == x) ? c : mine; }
        if (sum == G) break;
        __builtin_amdgcn_s_sleep(1);
        if ((++sp & 255u) == 0u) { if (xb_ld(&bar[XB_TMO])) break; if (sp > XB_SPIN_CAP) { atomicAdd(&bar[XB_TMO], 1u); break; } }
    }
    nloc = mine > 0u ? mine : 1u; nx = cnt > 0u ? cnt : 1u;
}

__device__ __forceinline__ void xcd_barrier(const XcdBarrier& b) {
    asm volatile("s_waitcnt vmcnt(0)" ::: "memory");
    __syncthreads();
    if (threadIdx.x == 0) {
        unsigned* bar = b.bar;
        __builtin_amdgcn_s_waitcnt(0);
        unsigned nloc = b.st[0], nx = b.st[1];
        if (nloc == 0u) { xcd_barrier_complete(bar, b.x, nloc, nx); b.st[0] = nloc; b.st[1] = nx; }
        const unsigned old = xb_add(&bar[XB_XSUB(b.x)], 1u);
        const unsigned gen = old / nloc;
        if (old + 1u == (gen + 1u) * nloc) {
            __builtin_amdgcn_fence(__ATOMIC_RELEASE, "agent");
            asm volatile("s_waitcnt vmcnt(0)" ::: "memory");
            const unsigned og = xb_add(&bar[XB_TOP], 1u);
            const unsigned tg = og / nx;
            if (og + 1u == (tg + 1u) * nx) xb_add(&bar[XB_TOPGEN], 1u);
            else XB_SPIN(xb_ld(&bar[XB_TOPGEN]) == tg, bar);
            __builtin_amdgcn_fence(__ATOMIC_ACQUIRE, "agent");
            xb_add(&bar[XB_XGEN(b.x)], 1u);
            asm volatile("s_waitcnt vmcnt(0)" ::: "memory");
        } else {
            XB_SPIN(xb_ld(&bar[XB_XGEN(b.x)]) == gen, bar);
            __builtin_amdgcn_fence(__ATOMIC_ACQUIRE, "agent");
            asm volatile("s_waitcnt vmcnt(0)" ::: "memory");
        }
    }
    __syncthreads();
}


constexpr int NWAVES = 8, NT = NWAVES * 64;
constexpr int D = 1024, BATCH = 8, SEQ = 4096, DEPTH = 2, GRIDW = 64, CTXL = 256, GWID = 256, HD = 64, NHEAD = 4;
constexpr int INC = 2048, NEXP = 16, MHID = 512;
constexpr int NLAT = BATCH * SEQ, NCTX = BATCH * CTXL, NROW = NLAT + NCTX;
constexpr float EPS = 1e-6f;
constexpr int UC_AV = 0, UC_AB = 256, UC_AC = 512, UC_P = 768, UC_Q = 1024, UC_K = 1280, UC_V = 1536, UC_F = 1792;

constexpr size_t MiB = 1u << 20;
constexpr size_t WS_CTL = 0, CTL_ZERO_BYTES = 65536;
constexpr size_t WS_MOD  = 1 * MiB;
constexpr size_t WS_INFO = 2 * MiB;
constexpr size_t WS_WIN  = 8 * MiB;
constexpr size_t WS_WOUT = 16 * MiB;
constexpr size_t WS_W13  = 20 * MiB;
constexpr size_t WS_W2   = 84 * MiB;
constexpr size_t WS_XC   = 116 * MiB;
constexpr size_t WS_H    = 124 * MiB;
constexpr size_t WS_U    = 192 * MiB;
constexpr size_t WS_S    = 328 * MiB;
constexpr size_t WS_END  = 472 * MiB;
constexpr size_t WS_DVEC = WS_S;
constexpr size_t WS_Z    = WS_S + 40 * MiB;
constexpr size_t NZ = (size_t)BATCH * NHEAD * SEQ * HD;
constexpr int CAP = NROW;

constexpr int CW_CNT = 2048;
constexpr int CW_BAR = 4096;

constexpr int RING_OFF = 0, RING_BYTES = 131072;
constexpr int LDSCTL_OFF = RING_BYTES, MISC_OFF = LDSCTL_OFF + 320;
constexpr int TAB_OFF = RING_BYTES + 1024;
constexpr int LDS_BYTES = 147456;

struct Frame {
    LAS unsigned char* lds;
    volatile LAS unsigned* MISC;
    gu32* ctl;
    int tid, lane, wave, G, bid;
    float* out; unsigned char* ws;
    static __device__ __forceinline__ const void* karg(int off) {
        const __attribute__((address_space(4))) char* ka = (const __attribute__((address_space(4))) char*)__builtin_amdgcn_kernarg_segment_ptr();
        asm volatile("" : "+s"(ka));
        return *(const void* const __attribute__((address_space(4)))*)(ka + off);
    }
    __device__ __forceinline__ const float* inp(int i) const { return (const float*)karg(8 * i); }
};
extern __shared__ __attribute__((aligned(16))) unsigned char dyn_lds[];
__device__ __forceinline__ Frame mk_frame() {
    Frame F; int t_ = threadIdx.x; asm volatile("" : "+v"(t_));
    F.tid = t_; F.lane = F.tid & 63; F.wave = __builtin_amdgcn_readfirstlane(F.tid >> 6); F.G = gridDim.x; F.bid = blockIdx.x;
    F.lds = (LAS unsigned char*)dyn_lds; F.MISC = (volatile LAS unsigned*)(F.lds + MISC_OFF);
    F.out = (float*)Frame::karg(160); F.ws = (unsigned char*)Frame::karg(168); F.ctl = (gu32*)(F.ws + WS_CTL);
    return F;
}
enum { I_X = 0, I_C, I_CTX, I_CCTX, I_ADAW, I_ADAB, I_N1G, I_N2G, I_WIN, I_CONVW, I_POOLW, I_POOLS, I_RPB, I_WOUT, I_RW, I_RB, I_W1, I_W3, I_W2, I_FG };

__device__ __forceinline__ float wave_sum(float v) {
#pragma unroll
    for (int o = 1; o < 64; o <<= 1) v += __shfl_xor(v, o);
    return v;
}
__device__ __forceinline__ float bflo(unsigned w) { return __builtin_bit_cast(float, w << 16); }
__device__ __forceinline__ float bfhi(unsigned w) { return __builtin_bit_cast(float, w & 0xffff0000u); }
__device__ __forceinline__ float bf2f(bf16 b) { return __builtin_bit_cast(float, (unsigned)b << 16); }

__device__ __forceinline__ void tr_item(const float* W, int K, int N, bf16* WT, int k0, int n0, int drow0, LAS float* scr, int lane) {
#pragma unroll 8
    for (int i = 0; i < 32; ++i) { const int kk = 2 * i + (lane >> 5); scr[kk * 33 + (lane & 31)] = W[(size_t)(k0 + kk) * N + n0 + (lane & 31)]; }
    LDS_WAIT(); asm volatile("" ::: "memory");
    const int c = lane & 7;
#pragma unroll
    for (int j = 0; j < 4; ++j) { const int n = (lane >> 3) + 8 * j; const LAS float* s = scr + (8 * c) * 33 + n;
        v4u o; o.x = pk2(s[0 * 33], s[1 * 33]); o.y = pk2(s[2 * 33], s[3 * 33]); o.z = pk2(s[4 * 33], s[5 * 33]); o.w = pk2(s[6 * 33], s[7 * 33]);
        *(GAS v4u*)(WT + (size_t)(drow0 + n) * K + k0 + 8 * c) = o; }
    LDS_WAIT(); asm volatile("" ::: "memory");
}
__device__ __forceinline__ void pa_phase() { Frame F = mk_frame();
    LAS float* scr = (LAS float*)(F.lds + RING_OFF + F.wave * 16384);
    const int gw = F.bid * NWAVES + F.wave, NGW = F.G * NWAVES;
    bf16* WIN = (bf16*)(F.ws + WS_WIN); bf16* WOUT = (bf16*)(F.ws + WS_WOUT); bf16* W13 = (bf16*)(F.ws + WS_W13); bf16* W2 = (bf16*)(F.ws + WS_W2);
    constexpr int I_IN = 2 * 16 * 64, I_OUT = 2 * 16 * 32, I_1 = 32 * 16 * 16, I_2 = 32 * 8 * 32;
    constexpr int NITEMS = I_IN + I_OUT + 2 * I_1 + I_2;
    for (int it = gw; it < NITEMS; it += NGW) {
        int r = it;
        if (r < I_IN) { const int l = r / 1024, q = r % 1024, kb = q / 64, nb = q % 64;
            tr_item(F.inp(I_WIN) + (size_t)l * D * INC, D, INC, WIN + (size_t)l * INC * D, 64 * kb, 32 * nb, 32 * nb, scr, F.lane); continue; } r -= I_IN;
        if (r < I_OUT) { const int l = r / 512, q = r % 512, kb = q / 32, nb = q % 32;
            tr_item(F.inp(I_WOUT) + (size_t)l * D * D, D, D, WOUT + (size_t)l * D * D, 64 * kb, 32 * nb, 32 * nb, scr, F.lane); continue; } r -= I_OUT;
        if (r < 2 * I_1) { const int which = r / I_1; const int q0 = r % I_1; const int le = q0 / 256, q = q0 % 256, kb = q / 16, nb = q % 16;
            const int n0 = 32 * nb; const int drow0 = 256 * (n0 / 128) + 128 * which + (n0 % 128);
            tr_item(F.inp(which ? I_W3 : I_W1) + (size_t)le * D * MHID, D, MHID, W13 + (size_t)le * 1024 * D, 64 * kb, n0, drow0, scr, F.lane); continue; } r -= 2 * I_1;
        { const int le = r / 256, q = r % 256, kb = q / 32, nb = q % 32;
            tr_item(F.inp(I_W2) + (size_t)le * MHID * D, MHID, D, W2 + (size_t)le * D * MHID, 64 * kb, 32 * nb, 32 * nb, scr, F.lane); }
    }
    __syncthreads();
    LAS float* sc = (LAS float*)(F.lds + RING_OFF);
    LAS float* part = (LAS float*)(F.lds + RING_OFF + 40960);
    float* MOD = (float*)(F.ws + WS_MOD);
    bool have_sc = false;
    for (int it = F.bid; it < 2 * 96; it += F.G) {
        if (!have_sc) { for (int i = F.tid; i < 9 * 1024; i += NT) { const float v = i < 8192 ? F.inp(I_C)[i] : F.inp(I_CCTX)[i - 8192]; sc[i] = v / (1.0f + __expf(-v)); } have_sc = true; }
        __syncthreads();
        const int l = it / 96, cb = it % 96, col = cb * 64 + F.lane;
        const float* aw = F.inp(I_ADAW) + (size_t)l * D * 6144 + col;
        float acc[9];
#pragma unroll
        for (int r = 0; r < 9; ++r) acc[r] = 0.f;
        for (int k = F.wave * 128; k < F.wave * 128 + 128; ++k) { const float wv = aw[(size_t)k * 6144];
#pragma unroll
            for (int r = 0; r < 9; ++r) acc[r] += sc[r * 1024 + k] * wv; }
#pragma unroll
        for (int r = 0; r < 9; ++r) part[(F.wave * 9 + r) * 64 + F.lane] = acc[r];
        __syncthreads();
        for (int i = F.tid; i < 9 * 64; i += NT) { const int r = i >> 6, ln = i & 63; float s = F.inp(I_ADAB)[(size_t)l * 6144 + cb * 64 + ln];
#pragma unroll
            for (int w = 0; w < 8; ++w) s += part[(w * 9 + r) * 64 + ln];
            MOD[((size_t)l * 9 + r) * 6144 + cb * 64 + ln] = s; }
        __syncthreads();
    }
}

template <bool ADD, bool FINAL>
__device__ __forceinline__ void norm_row(Frame& F, int r, const float* xr, float* xw, const float* g, const float* modl, const float* modadd, int ch_sh, int ch_sc, bf16* dst, const bf16* Y2, float* fout, f32x4 (&v)[4]) {
    const int modrow = r < NLAT ? (r >> 12) : 8;
    const float* mrow = modl + (size_t)modrow * 6144; const float* arow = modadd + (size_t)modrow * 6144;
    float ss = 0.f;
#pragma unroll
    for (int j = 0; j < 4; ++j) { const int c = 4 * F.lane + 256 * j; v[j] = *(const GAS f32x4*)(xr + c);
        if (ADD) { const f32x4 g2 = *(const GAS f32x4*)(arow + 5 * 1024 + c);
            const unsigned long long a = *(const GAS unsigned long long*)(Y2 + (size_t)r * 2048 + c), b = *(const GAS unsigned long long*)(Y2 + (size_t)r * 2048 + 1024 + c);
            f32x4 ya, yb; ya.x = bflo((unsigned)a); ya.y = bfhi((unsigned)a); ya.z = bflo((unsigned)(a >> 32)); ya.w = bfhi((unsigned)(a >> 32));
            yb.x = bflo((unsigned)b); yb.y = bfhi((unsigned)b); yb.z = bflo((unsigned)(b >> 32)); yb.w = bfhi((unsigned)(b >> 32));
            v[j] = v[j] + g2 * (ya + yb);
            if (!FINAL) *(GAS f32x4*)(xw + c) = v[j]; }
        ss += (v[j].x * v[j].x + v[j].y * v[j].y) + (v[j].z * v[j].z + v[j].w * v[j].w); }
    ss = wave_sum(ss);
    const float rstd = 1.0f / sqrtf(ss * (1.0f / D) + EPS);
#pragma unroll
    for (int j = 0; j < 4; ++j) { const int c = 4 * F.lane + 256 * j; const f32x4 gv = *(const GAS f32x4*)(g + c);
        if (FINAL) { *(GAS f32x4*)(fout + c) = v[j] * rstd * gv; }
        else { const f32x4 scv = *(const GAS f32x4*)(mrow + ch_sc * 1024 + c), shv = *(const GAS f32x4*)(mrow + ch_sh * 1024 + c);
            v[j] = v[j] * rstd * gv * (scv + 1.0f) + shv;
            *(GAS unsigned long long*)(dst + c) = (unsigned long long)pk2(v[j].x, v[j].y) | ((unsigned long long)pk2(v[j].z, v[j].w) << 32); } }
}
template <bool ADD, bool FINAL>
__device__ __forceinline__ void norm_phase(Frame& F, const float* xlat, const float* xctx, float* wlat, float* wctx, int nrows, const float* g, const float* modl, const float* modadd, int ch_sh, int ch_sc, bf16* dst, const bf16* Y2, float* fout) {
    const int gw = F.bid * NWAVES + F.wave, NGW = F.G * NWAVES;
    for (int r = gw; r < nrows; r += NGW) {
        const float* xr = r < NLAT ? xlat + (size_t)r * D : xctx + (size_t)(r - NLAT) * D;
        float* xw = r < NLAT ? wlat + (size_t)r * D : wctx + (size_t)(r - NLAT) * D;
        f32x4 v[4];
        norm_row<ADD, FINAL>(F, r, xr, xw, g, modl, modadd, ch_sh, ch_sc, dst + (size_t)r * D, Y2, fout + (size_t)r * D, v);
    }
}
__device__ __forceinline__ void route_phase(Frame& F, int l, const float* xlat, const float* xctx, int nrows, const float* g, const float* modl, bf16* dst) {
    LAS int* lcnt = (LAS int*)(F.lds + RING_OFF); LAS int* lbase = lcnt + 16; LAS int* rec_e = lcnt + 32; LAS int* rec_p = rec_e + 512; LAS float* rec_w = (LAS float*)(rec_p + 512);
    uint2* info = (uint2*)(F.ws + WS_INFO); unsigned* cnt = (unsigned*)(F.ctl + CW_CNT + l * 16);
    const int rpb = (nrows + F.G - 1) / F.G;
    if (F.tid < 16) lcnt[F.tid] = 0;
    __syncthreads();
    const float* rwp = F.inp(I_RW); const float* rbp = F.inp(I_RB);
    for (int i = F.wave; i < rpb; i += NWAVES) {
        const int r = F.bid * rpb + i; if (r >= nrows) break;
        const float* xr = r < NLAT ? xlat + (size_t)r * D : xctx + (size_t)(r - NLAT) * D;
        f32x4 v[4];
        norm_row<false, false>(F, r, xr, nullptr, g, modl, modl, 3, 4, dst + (size_t)r * D, nullptr, nullptr, v);
        float s16[16];
#pragma unroll
        for (int e = 0; e < 16; ++e) s16[e] = 0.f;
#pragma unroll
        for (int j = 0; j < 4; ++j)
#pragma unroll
            for (int ii = 0; ii < 4; ++ii) { const int k = 4 * F.lane + 256 * j + ii; const float hv = v[j][ii]; const GAS f32x4* rw = (const GAS f32x4*)(rwp + (size_t)k * 16);
#pragma unroll
                for (int q = 0; q < 4; ++q) { const f32x4 w4 = rw[q]; s16[4 * q + 0] += hv * w4.x; s16[4 * q + 1] += hv * w4.y; s16[4 * q + 2] += hv * w4.z; s16[4 * q + 3] += hv * w4.w; } }
        float bs[16];
#pragma unroll
        for (int e = 0; e < 16; ++e) { s16[e] = wave_sum(s16[e]); s16[e] = 1.0f / (1.0f + expf(-s16[e])); bs[e] = s16[e] + rbp[e]; }
        float best = -3.0e38f; int bg = 0;
#pragma unroll
        for (int gq = 0; gq < 4; ++gq) { const float a0 = bs[4 * gq], a1 = bs[4 * gq + 1], a2 = bs[4 * gq + 2], a3 = bs[4 * gq + 3];
            const float gs = fmaxf(fmaxf(fmaxf(a0 + a1, a0 + a2), fmaxf(a0 + a3, a1 + a2)), fmaxf(a1 + a3, a2 + a3));
            if (gs > best) { best = gs; bg = gq; } }
        float cb[4], cs[4];
#pragma unroll
        for (int ii = 0; ii < 4; ++ii) { cb[ii] = 0.f; cs[ii] = 0.f; }
#pragma unroll
        for (int gq = 0; gq < 4; ++gq)
#pragma unroll
            for (int ii = 0; ii < 4; ++ii) { cb[ii] = (gq == bg) ? bs[4 * gq + ii] : cb[ii]; cs[ii] = (gq == bg) ? s16[4 * gq + ii] : cs[ii]; }
        int i1 = 0; float b1 = cb[0], s1 = cs[0];
#pragma unroll
        for (int ii = 1; ii < 4; ++ii) if (cb[ii] > b1) { b1 = cb[ii]; s1 = cs[ii]; i1 = ii; }
        int i2 = -1; float b2 = -3.0e38f, s2 = 0.f;
#pragma unroll
        for (int ii = 0; ii < 4; ++ii) if (ii != i1 && cb[ii] > b2) { b2 = cb[ii]; s2 = cs[ii]; i2 = ii; }
        const float inv = 1.0f / (s1 + s2);
        const int e1 = 4 * bg + i1, e2 = 4 * bg + i2;
        if (F.lane == 0) { rec_e[2 * i] = e1; rec_p[2 * i] = atomicAdd((int*)&lcnt[e1], 1); rec_w[2 * i] = s1 * inv;
                           rec_e[2 * i + 1] = e2; rec_p[2 * i + 1] = atomicAdd((int*)&lcnt[e2], 1); rec_w[2 * i + 1] = s2 * inv; }
    }
    __syncthreads();
    if (F.tid < 16) lbase[F.tid] = (int)__hip_atomic_fetch_add(cnt + F.tid, (unsigned)lcnt[F.tid], __ATOMIC_RELAXED, __HIP_MEMORY_SCOPE_AGENT);
    __syncthreads();
    for (int j = F.tid; j < 2 * rpb; j += NT) { const int r = F.bid * rpb + (j >> 1); if (r < nrows) { const int e = rec_e[j];
        info[(size_t)e * CAP + lbase[e] + rec_p[j]] = make_uint2((unsigned)(r * 2 + (j & 1)), __builtin_bit_cast(unsigned, rec_w[j])); } }
}
__device__ __forceinline__ void moe_table(Frame& F, int l) {
    LAS int* tab = (LAS int*)(F.lds + TAB_OFF);
    if (F.tid == 0) { int acc = 0; const unsigned* cnt = (const unsigned*)(F.ctl + CW_CNT + l * 16);
        for (int e = 0; e < 16; ++e) { const int n = (int)__hip_atomic_load(cnt + e, __ATOMIC_RELAXED, __HIP_MEMORY_SCOPE_AGENT); tab[e] = acc; tab[17 + e] = n; acc += (n + 255) >> 8; }
        tab[16] = acc; }
    __syncthreads();
}

__device__ __forceinline__ void seq_info(int r, int& base, int& t, int& L) {
    if (r < NLAT) { base = r & ~(SEQ - 1); t = r & (SEQ - 1); L = SEQ; } else { const int j = r - NLAT; base = NLAT + (j & ~(CTXL - 1)); t = j & (CTXL - 1); L = CTXL; }
}
__device__ __forceinline__ void att_key(const float (&q)[64], float (&o)[64], float& m, float& l, const bf16* kp, const bf16* vp, float bias) {
    float s = 0.f;
#pragma unroll
    for (int c8 = 0; c8 < 8; ++c8) { const v4u w = *(const GAS v4u*)(kp + 8 * c8);
        s += q[8 * c8 + 0] * bflo(w.x) + q[8 * c8 + 1] * bfhi(w.x) + q[8 * c8 + 2] * bflo(w.y) + q[8 * c8 + 3] * bfhi(w.y)
           + q[8 * c8 + 4] * bflo(w.z) + q[8 * c8 + 5] * bfhi(w.z) + q[8 * c8 + 6] * bflo(w.w) + q[8 * c8 + 7] * bfhi(w.w); }
    s = s * 0.125f + bias;
    const float mn = fmaxf(m, s), alpha = __expf(m - mn), p = __expf(s - mn);
    l = l * alpha + p; m = mn;
#pragma unroll
    for (int c8 = 0; c8 < 8; ++c8) { const v4u w = *(const GAS v4u*)(vp + 8 * c8);
        o[8 * c8 + 0] = o[8 * c8 + 0] * alpha + p * bflo(w.x); o[8 * c8 + 1] = o[8 * c8 + 1] * alpha + p * bfhi(w.x);
        o[8 * c8 + 2] = o[8 * c8 + 2] * alpha + p * bflo(w.y); o[8 * c8 + 3] = o[8 * c8 + 3] * alpha + p * bfhi(w.y);
        o[8 * c8 + 4] = o[8 * c8 + 4] * alpha + p * bflo(w.z); o[8 * c8 + 5] = o[8 * c8 + 5] * alpha + p * bfhi(w.z);
        o[8 * c8 + 6] = o[8 * c8 + 6] * alpha + p * bflo(w.w); o[8 * c8 + 7] = o[8 * c8 + 7] * alpha + p * bfhi(w.w); }
}
__device__ __forceinline__ void mixa_phase(int l, bool with_ctx) { Frame F = mk_frame();
    const bf16* U = (const bf16*)(F.ws + WS_U); bf16* Y = (bf16*)(F.ws + WS_H);
    float* DV = (float*)(F.ws + WS_DVEC); float* Z = (float*)(F.ws + WS_Z);
    const int nrows = with_ctx ? NROW : NLAT;
    const long gtid = (long)F.bid * NT + F.tid, NTH = (long)F.G * NT;
    const float* cw = F.inp(I_CONVW) + (size_t)l * 3 * GWID;
    for (long i = gtid; i < (long)nrows * GWID; i += NTH) {
        const int r = (int)(i >> 8), ch = (int)(i & 255); int base, t, L; seq_info(r, base, t, L);
        const bf16* ur = U + (size_t)r * INC;
        float acc = cw[GWID + ch] * bf2f(ur[UC_AC + ch]) * bf2f(ur[UC_AV + ch]);
        if (t > 0) acc += cw[ch] * bf2f(ur[UC_AC + ch - INC]) * bf2f(ur[UC_AV + ch - INC]);
        if (t < L - 1) acc += cw[2 * GWID + ch] * bf2f(ur[UC_AC + ch + INC]) * bf2f(ur[UC_AV + ch + INC]);
        Y[(size_t)r * D + ch] = (bf16)f2bf(bf2f(ur[UC_AB + ch]) * acc);
        const int gi = ch >> 6, hw = 1 << gi;
        const int lo = t - hw > 0 ? t - hw : 0, hi = t + hw < L ? t + hw : L;
        float s = 0.f;
        for (int tt = lo; tt < hi; ++tt) s += bf2f(U[(size_t)(base + tt) * INC + UC_P + ch]);
        DV[(size_t)r * GWID + ch] = s / (float)(hi - lo) - bf2f(ur[UC_P + ch]);
    }
    const int nq = NLAT * NHEAD + (with_ctx ? NCTX * NHEAD : 0);
    for (long i = gtid; i < nq; i += NTH) {
        int qrow, h, b; bool lat = i < (long)NLAT * NHEAD; int r = 0, c = 0;
        if (lat) { c = (int)(i & 63); r = (int)((i >> 6) & 63); h = (int)((i >> 12) & 3); b = (int)(i >> 14); qrow = b * SEQ + r * GRIDW + c; }
        else { const int j = (int)(i - (long)NLAT * NHEAD); const int lq = j & 255; h = (j >> 8) & 3; b = j >> 10; qrow = NLAT + b * CTXL + lq; }
        float q[64], o[64];
        { const bf16* qp = U + (size_t)qrow * INC + UC_Q + h * HD;
#pragma unroll
          for (int c8 = 0; c8 < 8; ++c8) { const v4u w = *(const GAS v4u*)(qp + 8 * c8);
              q[8 * c8 + 0] = bflo(w.x); q[8 * c8 + 1] = bfhi(w.x); q[8 * c8 + 2] = bflo(w.y); q[8 * c8 + 3] = bfhi(w.y);
              q[8 * c8 + 4] = bflo(w.z); q[8 * c8 + 5] = bfhi(w.z); q[8 * c8 + 6] = bflo(w.w); q[8 * c8 + 7] = bfhi(w.w); } }
#pragma unroll
        for (int d = 0; d < 64; ++d) o[d] = 0.f;
        float m = -1.0e30f, lsum = 0.f;
        if (lat) {
            const int r0 = r - 4 < 0 ? 0 : (r - 4 > 56 ? 56 : r - 4), c0 = c - 8 < 0 ? 0 : (c - 8 > 48 ? 48 : c - 8);
            const float* rp = F.inp(I_RPB) + (size_t)(l * NHEAD + h) * 15 * 31;
            for (int kr = 0; kr < 8; ++kr) for (int kc = 0; kc < 16; ++kc) { const int rr = r0 + kr, cc = c0 + kc; const bf16* kp = U + (size_t)(b * SEQ + rr * GRIDW + cc) * INC + h * HD;
                att_key(q, o, m, lsum, kp + UC_K, kp + UC_V, rp[(rr - r + 7) * 31 + (cc - c + 15)]); }
        }
        for (int j = 0; j < CTXL; ++j) { const bf16* kp = U + (size_t)(NLAT + b * CTXL + j) * INC + h * HD; att_key(q, o, m, lsum, kp + UC_K, kp + UC_V, 0.f); }
        const float inv = 1.0f / lsum; bf16* yp = Y + (size_t)qrow * D + 512 + h * HD;
#pragma unroll
        for (int c8 = 0; c8 < 8; ++c8) { v4u w; w.x = pk2(o[8 * c8] * inv, o[8 * c8 + 1] * inv); w.y = pk2(o[8 * c8 + 2] * inv, o[8 * c8 + 3] * inv); w.z = pk2(o[8 * c8 + 4] * inv, o[8 * c8 + 5] * inv); w.w = pk2(o[8 * c8 + 6] * inv, o[8 * c8 + 7] * inv);
            *(GAS v4u*)(yp + 8 * c8) = w; }
    }
    LAS float* cs = (LAS float*)(F.lds + TAB_OFF); LAS float* sn = cs + 64; LAS float* cs256 = cs + 128; LAS float* sn256 = cs + 384;
    if (F.tid < 64) { float s_, c_; sincospif((float)F.tid * (1.0f / 32.0f), &s_, &c_); cs[F.tid] = c_; sn[F.tid] = s_; }
    if (F.tid < 256) { float s_, c_; sincospif((float)F.tid * (1.0f / 128.0f), &s_, &c_); cs256[F.tid] = c_; sn256[F.tid] = s_; }
    __syncthreads();
    LAS float* T = (LAS float*)(F.lds + RING_OFF); LAS float* X1r = T + 64 * 65; LAS float* X1i = X1r + 64 * 65;
    for (int un = F.bid; un < BATCH * NHEAD * 64; un += F.G) {
        const int b = un >> 8, h = (un >> 6) & 3, n2 = un & 63;
        { const int n1 = F.tid >> 3, c8 = F.tid & 7; const v4u w = *(const GAS v4u*)(U + (size_t)(b * SEQ + 64 * n1 + n2) * INC + UC_F + h * HD + 8 * c8); LAS float* tp = T + n1 * 65 + 8 * c8;
          tp[0] = bflo(w.x); tp[1] = bfhi(w.x); tp[2] = bflo(w.y); tp[3] = bfhi(w.y); tp[4] = bflo(w.z); tp[5] = bfhi(w.z); tp[6] = bflo(w.w); tp[7] = bfhi(w.w); }
        __syncthreads();
        const int cp = F.tid & 63;
        for (int i = 0; i < 8; ++i) { const int n1 = (F.tid >> 6) + 8 * i; float xr = 0.f, xi = 0.f;
            for (int c = 0; c < 64; ++c) { const float tv = T[n1 * 65 + c]; const int idx = (c * cp) & 63; xr += tv * cs[idx]; xi -= tv * sn[idx]; }
            X1r[n1 * 65 + cp] = xr; X1i[n1 * 65 + cp] = xi; }
        __syncthreads();
        for (int i = 0; i < 8; ++i) { const int n1p = (F.tid >> 6) + 8 * i; float ar = 0.f, ai = 0.f;
            for (int n1 = 0; n1 < 64; ++n1) { const int idx = (n1 * n1p) & 63; const float cc = cs[idx], ss = sn[idx], xr = X1r[n1 * 65 + cp], xi = X1i[n1 * 65 + cp]; ar += cc * xr + ss * xi; ai += cc * xi - ss * xr; }
            float sw, cw_; sincospif((float)(n2 * n1p) * (1.0f / 2048.0f), &sw, &cw_);
            const size_t zi = ((((size_t)(b * NHEAD + h) * 64 + n1p) * 64 + n2) * 64) + cp;
            Z[zi] = ar * cw_ + ai * sw; Z[NZ + zi] = ai * cw_ - ar * sw; }
        __syncthreads();
    }
    if (with_ctx) {
        LAS float* C1r = (LAS float*)(F.lds + RING_OFF); LAS float* C1i = C1r + 256 * 64;
        for (int un = F.bid; un < BATCH * NHEAD; un += F.G) {
            const int b = un >> 2, h = un & 3, cp = F.tid & 63;
            for (int i = 0; i < 32; ++i) { const int n = (F.tid >> 6) + 8 * i; const bf16* fp = U + (size_t)(NLAT + b * CTXL + n) * INC + UC_F + h * HD; float xr = 0.f, xi = 0.f;
                for (int c = 0; c < 64; ++c) { const float tv = bf2f(fp[c]); const int idx = (c * cp) & 63; xr += tv * cs[idx]; xi -= tv * sn[idx]; }
                C1r[n * 64 + cp] = xr; C1i[n * 64 + cp] = xi; }
            __syncthreads();
            for (int i = 0; i < 32; ++i) { const int np = (F.tid >> 6) + 8 * i; float acc = 0.f;
                for (int n = 0; n < 256; ++n) { const int idx = (n * np) & 255; acc += cs256[idx] * C1r[n * 64 + cp] + sn256[idx] * C1i[n * 64 + cp]; }
                Y[(size_t)(NLAT + b * CTXL + np) * D + 768 + h * HD + cp] = (bf16)f2bf(acc * (1.0f / 128.0f)); }
            __syncthreads();
        }
    }
}
__device__ __forceinline__ void mixb_phase(int l, bool with_ctx) { Frame F = mk_frame();
    bf16* Y = (bf16*)(F.ws + WS_H); const float* DV = (const float*)(F.ws + WS_DVEC); const float* Z = (const float*)(F.ws + WS_Z);
    const int nrows = with_ctx ? NROW : NLAT;
    const long gtid = (long)F.bid * NT + F.tid, NTH = (long)F.G * NT;
    const float* pw = F.inp(I_POOLW) + (size_t)l * 4 * 64 * 64; const float* ps = F.inp(I_POOLS) + (size_t)l * GWID;
    for (long i = gtid; i < (long)nrows * GWID; i += NTH) {
        const int r = (int)(i >> 8), oc = (int)(i & 255), gi = oc >> 6, dd = oc & 63; const float* dv = DV + (size_t)r * GWID + gi * 64; const float* w = pw + (size_t)gi * 4096 + dd;
        float acc = 0.f;
        for (int c = 0; c < 64; ++c) acc += dv[c] * w[c * 64];
        Y[(size_t)r * D + 256 + oc] = (bf16)f2bf(acc * ps[oc]);
    }
    LAS float* cs = (LAS float*)(F.lds + TAB_OFF); LAS float* sn = cs + 64;
    if (F.tid < 64) { float s_, c_; sincospif((float)F.tid * (1.0f / 32.0f), &s_, &c_); cs[F.tid] = c_; sn[F.tid] = s_; }
    __syncthreads();
    LAS float* Zr = (LAS float*)(F.lds + RING_OFF); LAS float* Zi = Zr + 4096;
    for (int un = F.bid; un < BATCH * NHEAD * 64; un += F.G) {
        const int b = un >> 8, h = (un >> 6) & 3, n1p = un & 63;
        const size_t z0 = (((size_t)(b * NHEAD + h) * 64 + n1p) * 64) * 64;
        for (int i = F.tid; i < 4096; i += NT) { Zr[i] = Z[z0 + i]; Zi[i] = Z[NZ + z0 + i]; }
        __syncthreads();
        const int cp = F.tid & 63;
        for (int i = 0; i < 8; ++i) { const int n2p = (F.tid >> 6) + 8 * i; float acc = 0.f;
            for (int n2 = 0; n2 < 64; ++n2) { const int idx = (n2 * n2p) & 63; acc += cs[idx] * Zr[n2 * 64 + cp] + sn[idx] * Zi[n2 * 64 + cp]; }
            Y[(size_t)(b * SEQ + n1p + 64 * n2p) * D + 768 + h * HD + cp] = (bf16)f2bf(acc * (1.0f / 512.0f)); }
        __syncthreads();
    }
}

struct WinOrder {
    int G, c, nctx_cols, ctx_pn0;
    __device__ __forceinline__ bool next(int i, pg8::Unit& u) const {
        const long L = (long)i * G + c; const int nlatu = 1024, total = nlatu + 8 * nctx_cols; if (L >= total) return false;
        if (L < nlatu) { int wgid = (int)L; { const int xcd = wgid % 8, off = wgid / 8; wgid = xcd * 128 + off; }
            const int gid = wgid / 64, fm = gid * 8; u.pm = fm + ((wgid % 64) % 8); u.pn = (wgid % 64) / 8; }
        else { const int j = (int)L - nlatu; u.pm = 128 + (j % 8); u.pn = ctx_pn0 + j / 8; }
        u.pb = u.pn; u.lb = 0; u.nv = 256; return true;
    }
    __device__ __forceinline__ void a_ready(const pg8::Unit&) const {}
    __device__ __forceinline__ void done(const pg8::Unit&) const {}
    __device__ __forceinline__ int row_of(const pg8::Unit&, int i) const { return i; }
};

struct Args { const float* in[20]; float* out; unsigned char* ws; int l, e; };
#define PH_PTRS() \
    bf16* H = (bf16*)(F.ws + WS_H); bf16* U = (bf16*)(F.ws + WS_U); bf16* HE = (bf16*)(F.ws + WS_U); bf16* Y2 = (bf16*)(F.ws + WS_S); \
    float* MOD = (float*)(F.ws + WS_MOD); float* XC = (float*)(F.ws + WS_XC); const uint2* INFO = (const uint2*)(F.ws + WS_INFO); \
    const bool first = (l == 0); const int M = first ? NROW : NLAT; const float* modl = MOD + (size_t)l * 9 * 6144; \
    (void)H; (void)U; (void)HE; (void)XC; (void)Y2; (void)INFO; (void)M; (void)modl;

__device__ __forceinline__ void ph_norm1(int l) { Frame F = mk_frame(); PH_PTRS();
    norm_phase<false, false>(F, F.inp(I_X), F.inp(I_CTX), nullptr, nullptr, NROW, F.inp(I_N1G), modl, modl, 0, 1, H, nullptr, nullptr); }
__device__ __forceinline__ void ph_next(int l) { Frame F = mk_frame(); PH_PTRS();
    if (first) norm_phase<true, false>(F, F.out, XC, F.out, XC, NROW, F.inp(I_N1G) + D, MOD + (size_t)9 * 6144, modl, 0, 1, H, Y2, nullptr);
    else norm_phase<true, true>(F, F.out, XC, F.out, XC, NLAT, F.inp(I_FG), modl, modl, 0, 0, nullptr, Y2, F.out); }
__device__ __forceinline__ void ph_route(int l) { Frame F = mk_frame(); PH_PTRS(); route_phase(F, l, F.out, XC, M, F.inp(I_N2G) + (size_t)l * D, modl, H); }
__device__ __forceinline__ void ph_win(int l) { Frame F = mk_frame(); PH_PTRS();
    pg8::Gemm g{H, (const bf16*)(F.ws + WS_WIN) + (size_t)l * INC * D, NROW, INC, D};
    WinOrder S{F.G, F.bid, first ? 8 : 2, first ? 0 : 5};
    pg8::EpiBf16 E{U, INC};
    pg8::gemm_phase<pg8::EpiBf16, WinOrder>(F.lds + RING_OFF, g, S, E); }
__device__ __forceinline__ void ph_wout(int l) { Frame F = mk_frame(); PH_PTRS();
    pg8::Gemm g{H, (const bf16*)(F.ws + WS_WOUT) + (size_t)l * D * D, M, D, D};
    pg8::StaticOrder S; S.init(M, D, F.G, F.bid);
    const float* xlat_in = first ? F.inp(I_X) : F.out; const float* xctx_in = first ? F.inp(I_CTX) : XC;
    pg8::EpiResid E{xlat_in, xctx_in, F.out, XC, modl + 2 * 1024, 6144, nullptr, 0, NLAT, SEQ};
    pg8::gemm_phase<pg8::EpiResid, pg8::StaticOrder>(F.lds + RING_OFF, g, S, E); }
__device__ __forceinline__ void ph_moe1(int l) { Frame F = mk_frame(); PH_PTRS(); moe_table(F, l);
    pg8::Gemm g{H, (const bf16*)(F.ws + WS_W13) + (size_t)l * NEXP * 1024 * D, M, 1024, D};
    pg8::MoeOrder S{F.G, F.bid, CAP, (const LAS int*)(F.lds + TAB_OFF), INFO};
    pg8::EpiSwiGLU E{HE, MHID};
    pg8::gemm_phase<pg8::EpiSwiGLU, pg8::MoeOrder, true>(F.lds + RING_OFF, g, S, E); }
__device__ __forceinline__ void ph_moe2(int l) { Frame F = mk_frame(); PH_PTRS(); moe_table(F, l);
    pg8::Gemm g{HE, (const bf16*)(F.ws + WS_W2) + (size_t)l * NEXP * D * MHID, M, D, MHID};
    pg8::MoeOrder S{F.G, F.bid, CAP, (const LAS int*)(F.lds + TAB_OFF), INFO};
    pg8::EpiScatter E{Y2, INFO};
    pg8::gemm_phase<pg8::EpiScatter, pg8::MoeOrder, false>(F.lds + RING_OFF, g, S, E); }

__device__ __forceinline__ void grid_bar() {
    Frame F = mk_frame(); XcdBarrier b; b.bar = (unsigned*)(F.ctl + CW_BAR); b.x = xb_xcc_id(); b.st = F.MISC + 8; xcd_barrier(b);
}
#ifndef SINGLE_LAUNCH
#define SINGLE_LAUNCH 1
#endif
#if !SINGLE_LAUNCH
__global__ void __launch_bounds__(NT, 2) k_pa(Args args) { pa_phase(); }
__global__ void __launch_bounds__(NT, 2) k_norm1(Args args) { ph_norm1(args.l); }
__global__ void __launch_bounds__(NT, 2) k_next(Args args) { ph_next(args.l); }
__global__ void __launch_bounds__(NT, 2) k_route(Args args) { ph_route(args.l); }
__global__ void __launch_bounds__(NT, 2) k_win(Args args) { ph_win(args.l); }
__global__ void __launch_bounds__(NT, 2) k_mixa(Args args) { mixa_phase(args.l, args.l == 0); }
__global__ void __launch_bounds__(NT, 2) k_mixb(Args args) { mixb_phase(args.l, args.l == 0); }
__global__ void __launch_bounds__(NT, 2) k_wout(Args args) { ph_wout(args.l); }
__global__ void __launch_bounds__(NT, 2) k_moe1(Args args) { ph_moe1(args.l); }
__global__ void __launch_bounds__(NT, 2) k_moe2(Args args) { ph_moe2(args.l); }
#else
#define PMARK(name) asm volatile("; PHASE_MARK " name ::: "memory")
template <int L> __device__ __forceinline__ void layer_phases() {
    PMARK("win"); ph_win(L); grid_bar();
    PMARK("mixa"); mixa_phase(L, L == 0); grid_bar();
    PMARK("mixb"); mixb_phase(L, L == 0); grid_bar();
    PMARK("wout"); ph_wout(L); grid_bar();
    PMARK("route"); ph_route(L); grid_bar();
    PMARK("moe1"); ph_moe1(L); grid_bar();
    PMARK("moe2"); ph_moe2(L); grid_bar();
    PMARK("next"); ph_next(L);
}
__global__ void __launch_bounds__(NT, 2) fwd_all(Args args) {
    { Frame F = mk_frame();
      for (int u = F.tid; u < (LDS_BYTES - LDSCTL_OFF) / 4; u += NT) ((LAS unsigned*)(F.lds + LDSCTL_OFF))[u] = 0u;
      __syncthreads();
      (void)xcd_barrier_post((unsigned*)(F.ctl + CW_BAR), F.MISC + 8); }
    PMARK("pa"); pa_phase(); grid_bar();
    PMARK("norm1"); ph_norm1(0); grid_bar();
    layer_phases<0>(); grid_bar();
    layer_phases<1>();
}
#endif

typedef void (*kern_t)(Args);
extern "C" void kernel_launch(void* const* d_in, const int* in_sizes, int n_in, void* d_out, int out_size, void* d_ws, size_t ws_size, hipStream_t stream) {
    static int grid = 0;
#if SINGLE_LAUNCH
    const kern_t kerns[] = {fwd_all};
#else
    const kern_t kerns[] = {k_pa, k_norm1, k_next, k_route, k_win, k_mixa, k_mixb, k_wout, k_moe1, k_moe2};
#endif
    if (grid == 0) {
        if (n_in != 20 || out_size != NLAT * D || ws_size < WS_END) { fprintf(stderr, "kernel_launch: unexpected shapes (n_in %d out %d ws %zu)\n", n_in, out_size, ws_size); grid = -1; return; }
        int dev = 0, cus = 0;
        if (hipGetDevice(&dev) != hipSuccess || hipDeviceGetAttribute(&cus, hipDeviceAttributeMultiprocessorCount, dev) != hipSuccess) { grid = -1; return; }
        for (kern_t k : kerns) if (hipFuncSetAttribute((const void*)k, hipFuncAttributeMaxDynamicSharedMemorySize, LDS_BYTES) != hipSuccess) { fprintf(stderr, "kernel_launch: hipFuncSetAttribute failed\n"); grid = -1; return; }
        int per_cu = 0; (void)hipOccupancyMaxActiveBlocksPerMultiprocessor(&per_cu, (const void*)kerns[0], NT, LDS_BYTES); (void)hipGetLastError();
        grid = cus;
    }
    if (grid < 0) return;
    (void)hipMemsetAsync((char*)d_ws + WS_CTL, 0, CTL_ZERO_BYTES, stream);
    Args a{};
    for (int i = 0; i < 20; ++i) a.in[i] = (const float*)d_in[i];
    a.out = (float*)d_out; a.ws = (unsigned char*)d_ws;
#if SINGLE_LAUNCH
    hipLaunchKernelGGL(fwd_all, dim3(grid), dim3(NT), LDS_BYTES, stream, a);
#else
#define LAUNCH(k, L, E) do { a.l = (L); a.e = (E); hipLaunchKernelGGL(k, dim3(grid), dim3(NT), LDS_BYTES, stream, a); } while (0)
    LAUNCH(k_pa, 0, 0);
    LAUNCH(k_norm1, 0, 0);
    for (int l = 0; l < DEPTH; ++l) {
        LAUNCH(k_win, l, 0); LAUNCH(k_mixa, l, 0); LAUNCH(k_mixb, l, 0); LAUNCH(k_wout, l, 0); LAUNCH(k_route, l, 0);
        LAUNCH(k_moe1, l, 0); LAUNCH(k_moe2, l, 0); LAUNCH(k_next, l, 0);
    }
#endif
}
```

```cpp
#include <hip/hip_runtime.h>
#include <cstdio>
#include <cstdint>
namespace pg8 {
#define PG8_LAS __attribute__((address_space(3)))
typedef unsigned short bf16_t;
typedef short bf16x8 __attribute__((ext_vector_type(8)));
typedef float f32x4 __attribute__((ext_vector_type(4)));
typedef unsigned u32x4 __attribute__((ext_vector_type(4)));
constexpr int BM = 256, BK = 64, HALF = 128, HTB = HALF * BK * 2  , STAGE_BYTES = 8 * HTB, NXCD = 8, WGM = 8;

__host__ __device__ __forceinline__ int lds_byte(int r, int c) { const int st = (r >> 4) * 2 + (c >> 5), rr = r & 15, cc = c & 31, ob = rr * 64 + cc * 2; return st * 1024 + (ob ^ (((ob >> 9) & 1) << 5)); }
__host__ __device__ __forceinline__ void stage_rc(int b, int& R, int& C) { const int st = b / 1024, sb = b % 1024, swz = sb ^ (((sb >> 9) & 1) << 5); R = (st >> 1) * 16 + swz / 64; C = (st & 1) * 32 + (swz % 64) / 2; }
__host__ __device__ __forceinline__ int perm32(int rho) { const int n = rho >> 4, i = rho & 15; return 8 * (i >> 2) + 4 * n + (i & 3); }

struct Unit { int pm, pn, pb, lb, nv; };
struct Gemm { const bf16_t* A; const bf16_t* Bt; int M, N, K; };

struct StaticOrder {
    int nM, nN, nwg, G, c;
    __host__ __device__ void init(int M, int N, int G_, int c_) { nM = M / BM; nN = N / BM; nwg = nM * nN; G = G_; c = c_; }
    __host__ __device__ bool next(int i, Unit& u) const {
        const long L = (long)i * G + c; if (L >= nwg) return false;
        int wgid = (int)L; { const int q = nwg / NXCD, r = nwg % NXCD, xcd = wgid % NXCD, off = wgid / NXCD; wgid = (xcd < r ? xcd * (q + 1) : r * (q + 1) + (xcd - r) * q) + off; }
        const int nig = WGM * nN, gid = wgid / nig, fm = gid * WGM, gsz = (nM - fm) < WGM ? (nM - fm) : WGM;
        u.pm = fm + ((wgid % nig) % gsz); u.pn = (wgid % nig) / gsz; u.pb = u.pn; u.lb = 0; u.nv = BM; return true;
    }
    __device__ __forceinline__ void a_ready(const Unit&) const {}
    __device__ __forceinline__ int row_of(const Unit&, int i) const { return i; }
    __device__ __forceinline__ void done(const Unit&) const {}
};


__device__ __forceinline__ unsigned cvt_pk_bf16(float lo, float hi) { unsigned r; asm volatile("v_cvt_pk_bf16_f32 %0, %1, %2" : "=v"(r) : "v"(lo), "v"(hi)); return r; }

struct EpiBf16 {
    static constexpr bool PERM = true, AFTER_DRAIN = false;
    bf16_t* O; int ldc;
    __device__ __forceinline__ void operator()(const f32x4 (&acc)[2][2][4][2], const Unit& u, int wr, int wc, int fr, int fq) const {
        const int row0 = u.pm * BM + wr * 64 + fr; const int col0 = u.pn * BM + wc * 32 + 8 * fq;
#pragma unroll
        for (int ai = 0; ai < 2; ++ai)
#pragma unroll
            for (int m = 0; m < 4; ++m) { bf16_t* rowp = O + (size_t)(row0 + ai * HALF + m * 16) * ldc + col0;
#pragma unroll
                for (int bj = 0; bj < 2; ++bj) { const f32x4 v0 = acc[ai][bj][m][0], v1 = acc[ai][bj][m][1];
                    u32x4 w; w.x = cvt_pk_bf16(v0[0], v0[1]); w.y = cvt_pk_bf16(v0[2], v0[3]); w.z = cvt_pk_bf16(v1[0], v1[1]); w.w = cvt_pk_bf16(v1[2], v1[3]);
                    *(u32x4*)(rowp + bj * HALF) = w; } }
    }
};
struct EpiSwiGLU {
    static constexpr bool PERM = true, AFTER_DRAIN = false;
    bf16_t* O; int ldc;
    __device__ __forceinline__ void operator()(const f32x4 (&acc)[2][2][4][2], const Unit& u, int wr, int wc, int fr, int fq) const {
        const int row0 = u.pm * BM + wr * 64 + fr; const int col0 = u.pn * HALF + wc * 32 + 8 * fq;
#pragma unroll
        for (int ai = 0; ai < 2; ++ai)
#pragma unroll
            for (int m = 0; m < 4; ++m) { bf16_t* rowp = O + (size_t)(row0 + ai * HALF + m * 16) * ldc + col0;
                float o[8];
#pragma unroll
                for (int n = 0; n < 2; ++n)
#pragma unroll
                    for (int j = 0; j < 4; ++j) { const float a = acc[ai][0][m][n][j], b = acc[ai][1][m][n][j]; o[n * 4 + j] = a * __builtin_amdgcn_rcpf(1.0f + __expf(-a)) * b; }
                u32x4 w; w.x = cvt_pk_bf16(o[0], o[1]); w.y = cvt_pk_bf16(o[2], o[3]); w.z = cvt_pk_bf16(o[4], o[5]); w.w = cvt_pk_bf16(o[6], o[7]);
                *(u32x4*)rowp = w; }
    }
};
struct EpiResid {
    static constexpr bool PERM = false, AFTER_DRAIN = false;
    const float* xin_lat; const float* xin_ctx; float* xout_lat; float* xout_ctx; const float* gmod; int gstride; const float* rowscale; int rs_stride; int nlat, seq;
    __device__ __forceinline__ void operator()(const f32x4 (&acc)[2][2][4][2], const Unit& u, int wr, int wc, int fr, int fq) const {
        const int prow = u.pm * BM; const bool isctx = prow >= nlat;
        const float* xin = isctx ? xin_ctx - (size_t)nlat * 1024 : xin_lat; float* xout = isctx ? xout_ctx - (size_t)nlat * 1024 : xout_lat;
        const int modrow = isctx ? 8 : prow / seq;
        const int row0 = prow + wr * 64 + fr, col0 = u.pn * BM + wc * 32 + 4 * fq;
        f32x4 gv[2][2];
#pragma unroll
        for (int bj = 0; bj < 2; ++bj)
#pragma unroll
            for (int n = 0; n < 2; ++n) gv[bj][n] = *(const f32x4*)(gmod + (size_t)modrow * gstride + col0 + bj * HALF + n * 16);
#pragma unroll
        for (int ai = 0; ai < 2; ++ai)
#pragma unroll
            for (int m = 0; m < 4; ++m) { const int row = row0 + ai * HALF + m * 16; const size_t off = (size_t)row * 1024 + col0;
                const float rs = rowscale ? rowscale[(size_t)row * rs_stride] : 1.0f;
#pragma unroll
                for (int bj = 0; bj < 2; ++bj)
#pragma unroll
                    for (int n = 0; n < 2; ++n) { const f32x4 xi = *(const f32x4*)(xin + off + bj * HALF + n * 16);
                        *(f32x4*)(xout + off + bj * HALF + n * 16) = xi + gv[bj][n] * rs * acc[ai][bj][m][n]; } }
    }
};
struct EpiScatter {
    static constexpr bool PERM = true, AFTER_DRAIN = false;
    bf16_t* Y2; const uint2* info;
    __device__ __forceinline__ void operator()(const f32x4 (&acc)[2][2][4][2], const Unit& u, int wr, int wc, int fr, int fq) const {
        const int col0 = u.pn * BM + wc * 32 + 8 * fq;
#pragma unroll
        for (int ai = 0; ai < 2; ++ai)
#pragma unroll
            for (int m = 0; m < 4; ++m) { const int i = ai * HALF + wr * 64 + m * 16 + fr;
                if (i < u.nv) { const uint2 inf = info[u.lb + i]; const float w = __builtin_bit_cast(float, inf.y); bf16_t* rowp = Y2 + (size_t)inf.x * 1024 + col0;
#pragma unroll
                    for (int bj = 0; bj < 2; ++bj) { const f32x4 v0 = acc[ai][bj][m][0] * w, v1 = acc[ai][bj][m][1] * w;
                        u32x4 q; q.x = cvt_pk_bf16(v0[0], v0[1]); q.y = cvt_pk_bf16(v0[2], v0[3]); q.z = cvt_pk_bf16(v1[0], v1[1]); q.w = cvt_pk_bf16(v1[2], v1[3]);
                        *(u32x4*)(rowp + bj * HALF) = q; } } }
    }
};
struct MoeOrder {
    int G, c, cap; const PG8_LAS int* tab; const uint2* info;
    __device__ __forceinline__ bool next(int i, Unit& u) const {
        const int nwg = __builtin_amdgcn_readfirstlane(tab[16]) * 4; const long L = (long)i * G + c; if (L >= nwg) return false;
        int wgid = (int)L; { const int q = nwg / NXCD, r = nwg % NXCD, xcd = wgid % NXCD, off = wgid / NXCD; wgid = (xcd < r ? xcd * (q + 1) : r * (q + 1) + (xcd - r) * q) + off; }
        const int gp = wgid >> 2; int e = 0;
#pragma unroll
        for (int q = 1; q < 16; ++q) e += (gp >= tab[q]) ? 1 : 0;
        e = __builtin_amdgcn_readfirstlane(e);
        const int p = gp - __builtin_amdgcn_readfirstlane(tab[e]); const int ne = __builtin_amdgcn_readfirstlane(tab[17 + e]);
        u.pm = gp; u.pn = wgid & 3; u.pb = e * 4 + u.pn; u.lb = e * cap + 256 * p; u.nv = (ne - 256 * p) < 256 ? (ne - 256 * p) : 256; return true;
    }
    __device__ __forceinline__ void a_ready(const Unit&) const {}
    __device__ __forceinline__ void done(const Unit&) const {}
    __device__ __forceinline__ int row_of(const Unit& u, int i) const { return i < u.nv ? (int)(info[u.lb + i].x >> 1) : 0; }
};
template <class Epi, class Sched, bool GATHER = false>
__device__ __forceinline__ void gemm_phase(PG8_LAS unsigned char* lds, const Gemm g, const Sched& S, const Epi& E) {
    int tid_ = threadIdx.x; asm volatile("" : "+v"(tid_));
    const int tid = tid_, wid = __builtin_amdgcn_readfirstlane(tid >> 6), lane = tid & 63, wr = wid >> 2, wc = wid & 3, fr = lane & 15, fq = lane >> 4;
    const int K = g.K, nt = K / BK;
    unsigned voffB[2];
#pragma unroll
    for (int i = 0; i < 2; ++i) { int R, C; stage_rc(tid * 16 + i * 8192, R, C); const int Rb = Epi::PERM ? ((R & ~31) + perm32(R & 31)) : R; voffB[i] = (unsigned)(Rb * K + C) * 2u; }
    const size_t kstep = (size_t)(BK * 2);
    const size_t hstep = (size_t)HALF * K * 2;
    const size_t tstep = 2 * hstep;
    const unsigned ldsw = (unsigned)wid * 1024u;
    const int aoff = lds_byte(wr * 64 + fr, fq * 8), boff = lds_byte(wc * 32 + fr, fq * 8);
#define PG8_SA(b, h) (((b) * 2 + (h)) * HTB)
#define PG8_SB(b, h) ((4 + (b) * 2 + (h)) * HTB)
#define PG8_STAGE(bufoff, gbase, voff) do { _Pragma("unroll") for (int _i = 0; _i < 2; ++_i) \
        __builtin_amdgcn_global_load_lds((const unsigned*)((const char*)(gbase) + (voff)[_i]), (PG8_LAS unsigned*)(lds + (bufoff) + ldsw + _i * 8192), 16, 0, 0); } while (0)
#define PG8_LDA(dst, b, h) do { _Pragma("unroll") for (int m = 0; m < 4; ++m) _Pragma("unroll") for (int k = 0; k < 2; ++k) dst[m][k] = *(const PG8_LAS bf16x8*)(lds + PG8_SA(b, h) + aoff + m * 2048 + k * 1024); } while (0)
#define PG8_LDB(dst, b, h) do { _Pragma("unroll") for (int n = 0; n < 2; ++n) _Pragma("unroll") for (int k = 0; k < 2; ++k) dst[n][k] = *(const PG8_LAS bf16x8*)(lds + PG8_SB(b, h) + boff + n * 2048 + k * 1024); } while (0)
#define PG8_MMA(ai, bj, At, Bt) do { __builtin_amdgcn_s_setprio(1); _Pragma("unroll") for (int m = 0; m < 4; ++m) _Pragma("unroll") for (int n = 0; n < 2; ++n) _Pragma("unroll") for (int k = 0; k < 2; ++k) \
        acc[ai][bj][m][n] = __builtin_amdgcn_mfma_f32_16x16x32_bf16(Bt[n][k], At[m][k], acc[ai][bj][m][n], 0, 0, 0); __builtin_amdgcn_s_setprio(0); } while (0)
#define PG8_WAIT_V(n) asm volatile("s_waitcnt vmcnt(" #n ")" ::: "memory")
#define PG8_WAIT_L(n) asm volatile("s_waitcnt lgkmcnt(" #n ")" ::: "memory")
#define PG8_BAR __builtin_amdgcn_s_barrier()
#define PG8_SCHED __builtin_amdgcn_sched_barrier(0)
#define PG8_AOFFS(o, u) do { _Pragma("unroll") for (int _h = 0; _h < 2; ++_h) _Pragma("unroll") for (int _i = 0; _i < 2; ++_i) { int _R, _C; stage_rc(tid * 16 + _i * 8192, _R, _C); \
        const int _row = GATHER ? S.row_of((u), _h * HALF + _R) : (_h * HALF + _R); (o)[_h][_i] = (unsigned)(_row * K + _C) * 2u; } } while (0)
    Unit cur, nxt; int ui = 0;
    if (!S.next(0, cur)) return;
    f32x4 acc[2][2][4][2];
#pragma unroll
    for (int a = 0; a < 2; ++a)
#pragma unroll
        for (int b = 0; b < 2; ++b)
#pragma unroll
            for (int m = 0; m < 4; ++m)
#pragma unroll
                for (int n = 0; n < 2; ++n) acc[a][b][m][n] = (f32x4){0.f, 0.f, 0.f, 0.f};
    bf16x8 At[4][2], B0[2][2], B1[2][2];
    unsigned offA[2][2], noffA[2][2];
    const char* cA = (const char*)g.A + (GATHER ? (size_t)0 : (size_t)cur.pm * tstep); const char* cB = (const char*)g.Bt + (size_t)cur.pb * tstep;
    S.a_ready(cur);
    PG8_AOFFS(offA, cur);
    PG8_STAGE(PG8_SB(0, 0), cB, voffB); PG8_STAGE(PG8_SB(0, 1), cB + hstep, voffB); PG8_STAGE(PG8_SA(0, 0), cA, offA[0]); PG8_STAGE(PG8_SA(0, 1), cA, offA[1]);
    if (wr == 1) PG8_BAR;
    PG8_WAIT_V(2); PG8_BAR;
    PG8_STAGE(PG8_SB(1, 0), cB + kstep, voffB); PG8_STAGE(PG8_SA(1, 0), cA + kstep, offA[0]); PG8_STAGE(PG8_SB(1, 1), cB + hstep + kstep, voffB);
    PG8_WAIT_V(6); PG8_BAR;
    for (;;) {
        const bool has_next = S.next(ui + 1, nxt);
        const char* nA = has_next ? (const char*)g.A + (GATHER ? (size_t)0 : (size_t)nxt.pm * tstep) : cA; const char* nB = has_next ? (const char*)g.Bt + (size_t)nxt.pb * tstep : cB;
        for (int t = 0; t < nt; t += 2) {
            const bool last = (t == nt - 2);
            const char* a1 = cA + (size_t)(t + 1) * kstep;
            const char* a2 = last ? nA : cA + (size_t)(t + 2) * kstep; const char* b2 = last ? nB : cB + (size_t)(t + 2) * kstep;
            const char* a3 = a2 + kstep; const char* b3 = b2 + kstep;
            if (last && has_next) S.a_ready(nxt);
            unsigned o2[2][2];
            if constexpr (GATHER) {
                if (last) { if (has_next) { PG8_AOFFS(noffA, nxt); } else {
#pragma unroll
                        for (int h = 0; h < 2; ++h) { noffA[h][0] = offA[h][0]; noffA[h][1] = offA[h][1]; } } }
#pragma unroll
                for (int h = 0; h < 2; ++h) { o2[h][0] = last ? noffA[h][0] : offA[h][0]; o2[h][1] = last ? noffA[h][1] : offA[h][1]; }
            } else {
#pragma unroll
                for (int h = 0; h < 2; ++h) { o2[h][0] = offA[h][0]; o2[h][1] = offA[h][1]; }
            }
            PG8_LDB(B0, 0, 0); PG8_LDB(B1, 0, 1); PG8_SCHED; PG8_LDA(At, 0, 0); PG8_STAGE(PG8_SA(1, 1), a1, offA[1]);
            PG8_WAIT_V(8); PG8_WAIT_L(0); PG8_BAR; PG8_MMA(0, 0, At, B0); PG8_MMA(0, 1, At, B1); PG8_BAR; PG8_SCHED;
            PG8_LDA(At, 0, 1); PG8_STAGE(PG8_SB(0, 0), b2, voffB); PG8_STAGE(PG8_SB(0, 1), b2 + hstep, voffB); PG8_STAGE(PG8_SA(0, 0), a2, o2[0]);
            PG8_WAIT_V(8); PG8_WAIT_L(0); PG8_BAR; PG8_MMA(1, 0, At, B0); PG8_MMA(1, 1, At, B1); PG8_BAR; PG8_SCHED;
            PG8_LDB(B0, 1, 0); PG8_LDB(B1, 1, 1); PG8_SCHED; PG8_LDA(At, 1, 0); PG8_STAGE(PG8_SA(0, 1), a2, o2[1]);
            PG8_WAIT_V(8); PG8_WAIT_L(0); PG8_BAR; PG8_MMA(0, 0, At, B0); PG8_MMA(0, 1, At, B1); PG8_BAR; PG8_SCHED;
            PG8_LDA(At, 1, 1); PG8_STAGE(PG8_SB(1, 0), b3, voffB); PG8_STAGE(PG8_SB(1, 1), b3 + hstep, voffB); PG8_STAGE(PG8_SA(1, 0), a3, o2[0]);
            PG8_WAIT_V(8); PG8_WAIT_L(0); PG8_BAR; PG8_MMA(1, 0, At, B0); PG8_MMA(1, 1, At, B1); PG8_BAR; PG8_SCHED;
        }
        if (wr == 0) PG8_BAR;
        E(acc, cur, wr, wc, fr, fq); S.done(cur);
        if (!has_next) break;
#pragma unroll
        for (int a = 0; a < 2; ++a)
#pragma unroll
            for (int b = 0; b < 2; ++b)
#pragma unroll
                for (int m = 0; m < 4; ++m)
#pragma unroll
                    for (int n = 0; n < 2; ++n) acc[a][b][m][n] = (f32x4){0.f, 0.f, 0.f, 0.f};
        cur = nxt; cA = nA; cB = nB; ++ui;
        if constexpr (GATHER) {
#pragma unroll
            for (int h = 0; h < 2; ++h) { offA[h][0] = noffA[h][0]; offA[h][1] = noffA[h][1]; } }
        if (wr == 1) PG8_BAR;
    }
    PG8_WAIT_V(0);
    PG8_BAR;
#undef PG8_SA
#undef PG8_SB
#undef PG8_STAGE
#undef PG8_LDA
#undef PG8_LDB
#undef PG8_MMA
#undef PG8_WAIT_V
#undef PG8_WAIT_L
#undef PG8_BAR
#undef PG8_SCHED
#undef PG8_AOFFS
}
}
#define GAS __attribute__((address_space(1)))
#define LAS __attribute__((address_space(3)))
typedef unsigned short bf16;
typedef unsigned v4u __attribute__((ext_vector_type(4)));
typedef float f32x4 __attribute__((ext_vector_type(4)));
typedef short bf16x8 __attribute__((ext_vector_type(8)));
typedef GAS unsigned gu32;
typedef GAS unsigned long long gu64;
#define RLX_AGENT __ATOMIC_RELAXED, __HIP_MEMORY_SCOPE_AGENT
#define LDS_WAIT() asm volatile("s_waitcnt lgkmcnt(0)" ::: "memory")
#define VM_WAIT() asm volatile("s_waitcnt vmcnt(0)" ::: "memory")
__device__ __forceinline__ unsigned long long rt() { return __builtin_amdgcn_s_memrealtime(); }
__device__ __forceinline__ unsigned f2bf(float f) { unsigned u = __builtin_bit_cast(unsigned, f); return (u + 0x7fffu + ((u >> 16) & 1u)) >> 16; }
__device__ __forceinline__ unsigned pk2(float lo, float hi) { return f2bf(lo) | (f2bf(hi) << 16); }

#define XB_TMO      128
#define XB_XCNT(j)  (256  + 64 * (j))
#define XB_XSUB(j)  (1280 + 64 * (j))
#define XB_XGEN(j)  (2304 + 64 * (j))
#define XB_TOP      3328
#define XB_TOPGEN   3392
#define XCD_BAR_WORDS 3456
#define XB_SPIN_CAP (1u << 18)

__device__ __forceinline__ unsigned xb_ld(unsigned* p)              { return __hip_atomic_load(p, __ATOMIC_RELAXED, __HIP_MEMORY_SCOPE_AGENT); }
__device__ __forceinline__ unsigned xb_add(unsigned* p, unsigned v) { return __hip_atomic_fetch_add(p, v, __ATOMIC_RELAXED, __HIP_MEMORY_SCOPE_AGENT); }
__device__ __forceinline__ unsigned xb_xcc_id() { return (unsigned)__builtin_amdgcn_s_getreg((3 << 11) | 20) & 0xFu; }
#define XB_SPIN(cond, bar) do { unsigned _sp = 0; while (cond) { __builtin_amdgcn_s_sleep(1); \
    if ((++_sp & 255u) == 0u) { if (xb_ld(&(bar)[XB_TMO])) break; if (_sp > XB_SPIN_CAP) { atomicAdd(&(bar)[XB_TMO], 1u); break; } } } } while (0)

struct XcdBarrier {
    unsigned* bar; unsigned x;
    volatile LAS unsigned* st;
};

__device__ __forceinline__ XcdBarrier xcd_barrier_post(unsigned* bar, volatile LAS unsigned* st) {
    XcdBarrier b; b.bar = bar; b.x = xb_xcc_id(); b.st = st;
    if (threadIdx.x == 0) (void)xb_add(&bar[XB_XCNT(b.x)], 1u);
    return b;
}
__device__ __forceinline__ void xcd_barrier_complete(unsigned* bar, unsigned x, unsigned& nloc, unsigned& nx) {
    const unsigned G = gridDim.x * gridDim.y * gridDim.z;
    unsigned sum, cnt, mine, sp = 0u;
    for (;;) {
        sum = 0u; cnt = 0u; mine = 0u;
#pragma unroll
        for (unsigned j = 0; j < 16; ++j) { const unsigned c = xb_ld(&bar[XB_XCNT(j)]); sum += c; cnt += (c > 0u) ? 1u : 0u; mine = (j == x) ? c : mine; }
        if (sum == G) break;
        __builtin_amdgcn_s_sleep(1);
        if ((++sp & 255u) == 0u) { if (xb_ld(&bar[XB_TMO])) break; if (sp > XB_SPIN_CAP) { atomicAdd(&bar[XB_TMO], 1u); break; } }
    }
    nloc = mine > 0u ? mine : 1u; nx = cnt > 0u ? cnt : 1u;
}

__device__ __forceinline__ void xcd_barrier(const XcdBarrier& b) {
    asm volatile("s_waitcnt vmcnt(0)" ::: "memory");
    __syncthreads();
    if (threadIdx.x == 0) {
        unsigned* bar = b.bar;
        __builtin_amdgcn_s_waitcnt(0);
        unsigned nloc = b.st[0], nx = b.st[1];
        if (nloc == 0u) { xcd_barrier_complete(bar, b.x, nloc, nx); b.st[0] = nloc; b.st[1] = nx; }
        const unsigned old = xb_add(&bar[XB_XSUB(b.x)], 1u);
        const unsigned gen = old / nloc;
        if (old + 1u == (gen + 1u) * nloc) {
            __builtin_amdgcn_fence(__ATOMIC_RELEASE, "agent");
            asm volatile("s_waitcnt vmcnt(0)" ::: "memory");
            const unsigned og = xb_add(&bar[XB_TOP], 1u);
            const unsigned tg = og / nx;
            if (og + 1u == (tg + 1u) * nx) xb_add(&bar[XB_TOPGEN], 1u);
            else XB_SPIN(xb_ld(&bar[XB_TOPGEN]) == tg, bar);
            __builtin_amdgcn_fence(__ATOMIC_ACQUIRE, "agent");
            xb_add(&bar[XB_XGEN(b.x)], 1u);
            asm volatile("s_waitcnt vmcnt(0)" ::: "memory");
        } else {
            XB_SPIN(xb_ld(&bar[XB_XGEN(b.x)]) == gen, bar);
            __builtin_amdgcn_fence(__ATOMIC_ACQUIRE, "agent");
            asm volatile("s_waitcnt vmcnt(0)" ::: "memory");
        }
    }
    __syncthreads();
}


constexpr int NWAVES = 8, NT = NWAVES * 64;
constexpr int D = 1024, BATCH = 8, SEQ = 4096, DEPTH = 2, GRIDW = 64, CTXL = 256, GWID = 256, HD = 64, NHEAD = 4;
constexpr int INC = 2048, NEXP = 16, MHID = 512;
constexpr int NLAT = BATCH * SEQ, NCTX = BATCH * CTXL, NROW = NLAT + NCTX;
constexpr float EPS = 1e-6f;
constexpr int UC_AV = 0, UC_AB = 256, UC_AC = 512, UC_P = 768, UC_Q = 1024, UC_K = 1280, UC_V = 1536, UC_F = 1792;

constexpr size_t MiB = 1u << 20;
constexpr size_t WS_CTL = 0, CTL_ZERO_BYTES = 65536;
constexpr size_t WS_MOD  = 1 * MiB;
constexpr size_t WS_PWT  = 1 * MiB + 768 * 1024;
constexpr size_t WS_INFO = 2 * MiB;
constexpr size_t WS_WIN  = 8 * MiB;
constexpr size_t WS_WOUT = 16 * MiB;
constexpr size_t WS_W13  = 20 * MiB;
constexpr size_t WS_W2   = 84 * MiB;
constexpr size_t WS_XC   = 116 * MiB;
constexpr size_t WS_H    = 124 * MiB;
constexpr size_t WS_U    = 192 * MiB;
constexpr size_t WS_S    = 328 * MiB;
constexpr size_t WS_END  = 472 * MiB;
constexpr size_t WS_VT   = WS_S;
constexpr size_t WS_VTC  = WS_S + 16 * MiB;
constexpr size_t WS_DVEC = WS_S + 104 * MiB;
constexpr size_t WS_Z    = WS_S + 40 * MiB;
constexpr size_t NZ = (size_t)BATCH * NHEAD * SEQ * HD;
constexpr size_t NZC = (size_t)BATCH * NHEAD * CTXL * HD;
constexpr int CAP = NROW;

constexpr int CW_CNT = 2048;
constexpr int CW_BAR = 4096;

constexpr int RING_OFF = 0, RING_BYTES = 131072;
constexpr int LDSCTL_OFF = RING_BYTES, MISC_OFF = LDSCTL_OFF + 320;
constexpr int TAB_OFF = RING_BYTES + 1024;
constexpr int LDS_BYTES = 147456;

struct Frame {
    LAS unsigned char* lds;
    volatile LAS unsigned* MISC;
    gu32* ctl;
    int tid, lane, wave, G, bid;
    float* out; unsigned char* ws;
    static __device__ __forceinline__ const void* karg(int off) {
        const __attribute__((address_space(4))) char* ka = (const __attribute__((address_space(4))) char*)__builtin_amdgcn_kernarg_segment_ptr();
        asm volatile("" : "+s"(ka));
        return *(const void* const __attribute__((address_space(4)))*)(ka + off);
    }
    __device__ __forceinline__ const float* inp(int i) const { return (const float*)karg(8 * i); }
};
extern __shared__ __attribute__((aligned(16))) unsigned char dyn_lds[];
__device__ __forceinline__ Frame mk_frame() {
    Frame F; int t_ = threadIdx.x; asm volatile("" : "+v"(t_));
    F.tid = t_; F.lane = F.tid & 63; F.wave = __builtin_amdgcn_readfirstlane(F.tid >> 6); F.G = gridDim.x; F.bid = blockIdx.x;
    F.lds = (LAS unsigned char*)dyn_lds; F.MISC = (volatile LAS unsigned*)(F.lds + MISC_OFF);
    F.out = (float*)Frame::karg(160); F.ws = (unsigned char*)Frame::karg(168); F.ctl = (gu32*)(F.ws + WS_CTL);
    return F;
}
enum { I_X = 0, I_C, I_CTX, I_CCTX, I_ADAW, I_ADAB, I_N1G, I_N2G, I_WIN, I_CONVW, I_POOLW, I_POOLS, I_RPB, I_WOUT, I_RW, I_RB, I_W1, I_W3, I_W2, I_FG };

__device__ __forceinline__ float wave_sum(float v) {
#pragma unroll
    for (int o = 1; o < 64; o <<= 1) v += __shfl_xor(v, o);
    return v;
}
__device__ __forceinline__ float bflo(unsigned w) { return __builtin_bit_cast(float, w << 16); }
__device__ __forceinline__ float bfhi(unsigned w) { return __builtin_bit_cast(float, w & 0xffff0000u); }
__device__ __forceinline__ float bf2f(bf16 b) { return __builtin_bit_cast(float, (unsigned)b << 16); }

__device__ __forceinline__ void tr_item(const float* W, int K, int N, bf16* WT, int k0, int n0, int drow0, LAS float* scr, int lane) {
#pragma unroll 8
    for (int i = 0; i < 32; ++i) { const int kk = 2 * i + (lane >> 5); scr[kk * 33 + (lane & 31)] = W[(size_t)(k0 + kk) * N + n0 + (lane & 31)]; }
    LDS_WAIT(); asm volatile("" ::: "memory");
    const int c = lane & 7;
#pragma unroll
    for (int j = 0; j < 4; ++j) { const int n = (lane >> 3) + 8 * j; const LAS float* s = scr + (8 * c) * 33 + n;
        v4u o; o.x = pk2(s[0 * 33], s[1 * 33]); o.y = pk2(s[2 * 33], s[3 * 33]); o.z = pk2(s[4 * 33], s[5 * 33]); o.w = pk2(s[6 * 33], s[7 * 33]);
        *(GAS v4u*)(WT + (size_t)(drow0 + n) * K + k0 + 8 * c) = o; }
    LDS_WAIT(); asm volatile("" ::: "memory");
}
__device__ __forceinline__ void pa_phase() { Frame F = mk_frame();
    LAS float* scr = (LAS float*)(F.lds + RING_OFF + F.wave * 16384);
    const int gw = F.bid * NWAVES + F.wave, NGW = F.G * NWAVES;
    bf16* WIN = (bf16*)(F.ws + WS_WIN); bf16* WOUT = (bf16*)(F.ws + WS_WOUT); bf16* W13 = (bf16*)(F.ws + WS_W13); bf16* W2 = (bf16*)(F.ws + WS_W2);
    constexpr int I_IN = 2 * 16 * 64, I_OUT = 2 * 16 * 32, I_1 = 32 * 16 * 16, I_2 = 32 * 8 * 32;
    constexpr int NITEMS = I_IN + I_OUT + 2 * I_1 + I_2;
    for (int it = gw; it < NITEMS; it += NGW) {
        int r = it;
        if (r < I_IN) { const int l = r / 1024, q = r % 1024, kb = q / 64, nb = q % 64;
            tr_item(F.inp(I_WIN) + (size_t)l * D * INC, D, INC, WIN + (size_t)l * INC * D, 64 * kb, 32 * nb, 32 * nb, scr, F.lane); continue; } r -= I_IN;
        if (r < I_OUT) { const int l = r / 512, q = r % 512, kb = q / 32, nb = q % 32;
            tr_item(F.inp(I_WOUT) + (size_t)l * D * D, D, D, WOUT + (size_t)l * D * D, 64 * kb, 32 * nb, 32 * nb, scr, F.lane); continue; } r -= I_OUT;
        if (r < 2 * I_1) { const int which = r / I_1; const int q0 = r % I_1; const int le = q0 / 256, q = q0 % 256, kb = q / 16, nb = q % 16;
            const int n0 = 32 * nb; const int drow0 = 256 * (n0 / 128) + 128 * which + (n0 % 128);
            tr_item(F.inp(which ? I_W3 : I_W1) + (size_t)le * D * MHID, D, MHID, W13 + (size_t)le * 1024 * D, 64 * kb, n0, drow0, scr, F.lane); continue; } r -= 2 * I_1;
        { const int le = r / 256, q = r % 256, kb = q / 32, nb = q % 32;
            tr_item(F.inp(I_W2) + (size_t)le * MHID * D, MHID, D, W2 + (size_t)le * D * MHID, 64 * kb, 32 * nb, 32 * nb, scr, F.lane); }
    }
    { bf16* PWT = (bf16*)(F.ws + WS_PWT); const float* pw = F.inp(I_POOLW);
      for (int i = F.bid * NT + F.tid; i < 2 * 4 * 64 * 64; i += F.G * NT) { const int c = i & 63, dd = (i >> 6) & 63, lg = i >> 12; PWT[i] = (bf16)f2bf(pw[((size_t)lg * 64 + c) * 64 + dd]); } }
    __syncthreads();
    LAS float* sc = (LAS float*)(F.lds + RING_OFF);
    LAS float* part = (LAS float*)(F.lds + RING_OFF + 40960);
    float* MOD = (float*)(F.ws + WS_MOD);
    bool have_sc = false;
    for (int it = F.bid; it < 2 * 96; it += F.G) {
        if (!have_sc) { for (int i = F.tid; i < 9 * 1024; i += NT) { const float v = i < 8192 ? F.inp(I_C)[i] : F.inp(I_CCTX)[i - 8192]; sc[i] = v / (1.0f + __expf(-v)); } have_sc = true; }
        __syncthreads();
        const int l = it / 96, cb = it % 96, col = cb * 64 + F.lane;
        const float* aw = F.inp(I_ADAW) + (size_t)l * D * 6144 + col;
        float acc[9];
#pragma unroll
        for (int r = 0; r < 9; ++r) acc[r] = 0.f;
        for (int k = F.wave * 128; k < F.wave * 128 + 128; ++k) { const float wv = aw[(size_t)k * 6144];
#pragma unroll
            for (int r = 0; r < 9; ++r) acc[r] += sc[r * 1024 + k] * wv; }
#pragma unroll
        for (int r = 0; r < 9; ++r) part[(F.wave * 9 + r) * 64 + F.lane] = acc[r];
        __syncthreads();
        for (int i = F.tid; i < 9 * 64; i += NT) { const int r = i >> 6, ln = i & 63; float s = F.inp(I_ADAB)[(size_t)l * 6144 + cb * 64 + ln];
#pragma unroll
            for (int w = 0; w < 8; ++w) s += part[(w * 9 + r) * 64 + ln];
            MOD[((size_t)l * 9 + r) * 6144 + cb * 64 + ln] = s; }
        __syncthreads();
    }
}

template <bool ADD, bool FINAL>
__device__ __forceinline__ void norm_row(Frame& F, int r, const float* xr, float* xw, const float* g, const float* modl, const float* modadd, int ch_sh, int ch_sc, bf16* dst, const bf16* Y2, float* fout, f32x4 (&v)[4]) {
    const int modrow = r < NLAT ? (r >> 12) : 8;
    const float* mrow = modl + (size_t)modrow * 6144; const float* arow = modadd + (size_t)modrow * 6144;
    float ss = 0.f;
#pragma unroll
    for (int j = 0; j < 4; ++j) { const int c = 4 * F.lane + 256 * j; v[j] = *(const GAS f32x4*)(xr + c);
        if (ADD) { const f32x4 g2 = *(const GAS f32x4*)(arow + 5 * 1024 + c);
            const unsigned long long a = *(const GAS unsigned long long*)(Y2 + (size_t)r * 2048 + c), b = *(const GAS unsigned long long*)(Y2 + (size_t)r * 2048 + 1024 + c);
            f32x4 ya, yb; ya.x = bflo((unsigned)a); ya.y = bfhi((unsigned)a); ya.z = bflo((unsigned)(a >> 32)); ya.w = bfhi((unsigned)(a >> 32));
            yb.x = bflo((unsigned)b); yb.y = bfhi((unsigned)b); yb.z = bflo((unsigned)(b >> 32)); yb.w = bfhi((unsigned)(b >> 32));
            v[j] = v[j] + g2 * (ya + yb);
            if (!FINAL) *(GAS f32x4*)(xw + c) = v[j]; }
        ss += (v[j].x * v[j].x + v[j].y * v[j].y) + (v[j].z * v[j].z + v[j].w * v[j].w); }
    ss = wave_sum(ss);
    const float rstd = 1.0f / sqrtf(ss * (1.0f / D) + EPS);
#pragma unroll
    for (int j = 0; j < 4; ++j) { const int c = 4 * F.lane + 256 * j; const f32x4 gv = *(const GAS f32x4*)(g + c);
        if (FINAL) { *(GAS f32x4*)(fout + c) = v[j] * rstd * gv; }
        else { const f32x4 scv = *(const GAS f32x4*)(mrow + ch_sc * 1024 + c), shv = *(const GAS f32x4*)(mrow + ch_sh * 1024 + c);
            v[j] = v[j] * rstd * gv * (scv + 1.0f) + shv;
            *(GAS unsigned long long*)(dst + c) = (unsigned long long)pk2(v[j].x, v[j].y) | ((unsigned long long)pk2(v[j].z, v[j].w) << 32); } }
}
template <bool ADD, bool FINAL>
__device__ __forceinline__ void norm_phase(Frame& F, const float* xlat, const float* xctx, float* wlat, float* wctx, int nrows, const float* g, const float* modl, const float* modadd, int ch_sh, int ch_sc, bf16* dst, const bf16* Y2, float* fout) {
    const int gw = F.bid * NWAVES + F.wave, NGW = F.G * NWAVES;
    for (int r = gw; r < nrows; r += NGW) {
        const float* xr = r < NLAT ? xlat + (size_t)r * D : xctx + (size_t)(r - NLAT) * D;
        float* xw = r < NLAT ? wlat + (size_t)r * D : wctx + (size_t)(r - NLAT) * D;
        f32x4 v[4];
        norm_row<ADD, FINAL>(F, r, xr, xw, g, modl, modadd, ch_sh, ch_sc, dst + (size_t)r * D, Y2, fout + (size_t)r * D, v);
    }
}
__device__ __forceinline__ void route_phase(Frame& F, int l, const float* xlat, const float* xctx, int nrows, const float* g, const float* modl, bf16* dst) {
    LAS int* lcnt = (LAS int*)(F.lds + RING_OFF); LAS int* lbase = lcnt + 16; LAS int* rec_e = lcnt + 32; LAS int* rec_p = rec_e + 512; LAS float* rec_w = (LAS float*)(rec_p + 512);
    uint2* info = (uint2*)(F.ws + WS_INFO); unsigned* cnt = (unsigned*)(F.ctl + CW_CNT + l * 16);
    const int rpb = (nrows + F.G - 1) / F.G;
    if (F.tid < 16) lcnt[F.tid] = 0;
    __syncthreads();
    const float* rwp = F.inp(I_RW); const float* rbp = F.inp(I_RB);
    for (int i = F.wave; i < rpb; i += NWAVES) {
        const int r = F.bid * rpb + i; if (r >= nrows) break;
        const float* xr = r < NLAT ? xlat + (size_t)r * D : xctx + (size_t)(r - NLAT) * D;
        f32x4 v[4];
        norm_row<false, false>(F, r, xr, nullptr, g, modl, modl, 3, 4, dst + (size_t)r * D, nullptr, nullptr, v);
        float s16[16];
#pragma unroll
        for (int e = 0; e < 16; ++e) s16[e] = 0.f;
#pragma unroll
        for (int j = 0; j < 4; ++j)
#pragma unroll
            for (int ii = 0; ii < 4; ++ii) { const int k = 4 * F.lane + 256 * j + ii; const float hv = v[j][ii]; const GAS f32x4* rw = (const GAS f32x4*)(rwp + (size_t)k * 16);
#pragma unroll
                for (int q = 0; q < 4; ++q) { const f32x4 w4 = rw[q]; s16[4 * q + 0] += hv * w4.x; s16[4 * q + 1] += hv * w4.y; s16[4 * q + 2] += hv * w4.z; s16[4 * q + 3] += hv * w4.w; } }
        float bs[16];
#pragma unroll
        for (int e = 0; e < 16; ++e) { s16[e] = wave_sum(s16[e]); s16[e] = 1.0f / (1.0f + expf(-s16[e])); bs[e] = s16[e] + rbp[e]; }
        float best = -3.0e38f; int bg = 0;
#pragma unroll
        for (int gq = 0; gq < 4; ++gq) { const float a0 = bs[4 * gq], a1 = bs[4 * gq + 1], a2 = bs[4 * gq + 2], a3 = bs[4 * gq + 3];
            const float gs = fmaxf(fmaxf(fmaxf(a0 + a1, a0 + a2), fmaxf(a0 + a3, a1 + a2)), fmaxf(a1 + a3, a2 + a3));
            if (gs > best) { best = gs; bg = gq; } }
        float cb[4], cs[4];
#pragma unroll
        for (int ii = 0; ii < 4; ++ii) { cb[ii] = 0.f; cs[ii] = 0.f; }
#pragma unroll
        for (int gq = 0; gq < 4; ++gq)
#pragma unroll
            for (int ii = 0; ii < 4; ++ii) { cb[ii] = (gq == bg) ? bs[4 * gq + ii] : cb[ii]; cs[ii] = (gq == bg) ? s16[4 * gq + ii] : cs[ii]; }
        int i1 = 0; float b1 = cb[0], s1 = cs[0];
#pragma unroll
        for (int ii = 1; ii < 4; ++ii) if (cb[ii] > b1) { b1 = cb[ii]; s1 = cs[ii]; i1 = ii; }
        int i2 = -1; float b2 = -3.0e38f, s2 = 0.f;
#pragma unroll
        for (int ii = 0; ii < 4; ++ii) if (ii != i1 && cb[ii] > b2) { b2 = cb[ii]; s2 = cs[ii]; i2 = ii; }
        const float inv = 1.0f / (s1 + s2);
        const int e1 = 4 * bg + i1, e2 = 4 * bg + i2;
        if (F.lane == 0) { rec_e[2 * i] = e1; rec_p[2 * i] = atomicAdd((int*)&lcnt[e1], 1); rec_w[2 * i] = s1 * inv;
                           rec_e[2 * i + 1] = e2; rec_p[2 * i + 1] = atomicAdd((int*)&lcnt[e2], 1); rec_w[2 * i + 1] = s2 * inv; }
    }
    __syncthreads();
    if (F.tid < 16) lbase[F.tid] = (int)__hip_atomic_fetch_add(cnt + F.tid, (unsigned)lcnt[F.tid], __ATOMIC_RELAXED, __HIP_MEMORY_SCOPE_AGENT);
    __syncthreads();
    for (int j = F.tid; j < 2 * rpb; j += NT) { const int r = F.bid * rpb + (j >> 1); if (r < nrows) { const int e = rec_e[j];
        info[(size_t)e * CAP + lbase[e] + rec_p[j]] = make_uint2((unsigned)(r * 2 + (j & 1)), __builtin_bit_cast(unsigned, rec_w[j])); } }
}
__device__ __forceinline__ void moe_table(Frame& F, int l) {
    LAS int* tab = (LAS int*)(F.lds + TAB_OFF);
    if (F.tid == 0) { int acc = 0; const unsigned* cnt = (const unsigned*)(F.ctl + CW_CNT + l * 16);
        for (int e = 0; e < 16; ++e) { const int n = (int)__hip_atomic_load(cnt + e, __ATOMIC_RELAXED, __HIP_MEMORY_SCOPE_AGENT); tab[e] = acc; tab[17 + e] = n; acc += (n + 255) >> 8; }
        tab[16] = acc; }
    __syncthreads();
}

__device__ __forceinline__ void seq_info(int r, int& base, int& t, int& L) {
    if (r < NLAT) { base = r & ~(SEQ - 1); t = r & (SEQ - 1); L = SEQ; } else { const int j = r - NLAT; base = NLAT + (j & ~(CTXL - 1)); t = j & (CTXL - 1); L = CTXL; }
}
typedef unsigned v2u __attribute__((ext_vector_type(2)));
__device__ __forceinline__ unsigned cvtpk(float lo, float hi) { unsigned r; asm volatile("v_cvt_pk_bf16_f32 %0, %1, %2" : "=v"(r) : "v"(lo), "v"(hi)); return r; }
__device__ __forceinline__ bf16x8 mk8(v2u a, v2u b) { v4u w; w.x = a.x; w.y = a.y; w.z = b.x; w.w = b.y; return __builtin_bit_cast(bf16x8, w); }
__device__ __forceinline__ void vt_prepass(Frame& F) {
    const bf16* U = (const bf16*)(F.ws + WS_U); bf16* VT = (bf16*)(F.ws + WS_VT); bf16* VTC = (bf16*)(F.ws + WS_VTC);
    LAS unsigned short* T = (LAS unsigned short*)(F.lds + RING_OFF + F.wave * 16384);
    const int gw = F.bid * NWAVES + F.wave, NGW = F.G * NWAVES;
    for (int idx = gw; idx < 2048 + 128; idx += NGW) {
        int bh, urow0, dstride; bf16* dst;
        if (idx < 2048) { bh = idx >> 6; const int tt = idx & 63; urow0 = (bh >> 2) * SEQ + tt * 64; dst = VT + (size_t)bh * 64 * SEQ + tt * 64; dstride = SEQ; }
        else { const int j = idx - 2048; bh = j >> 2; const int tt = j & 3; urow0 = NLAT + (bh >> 2) * CTXL + tt * 64; dst = VTC + (size_t)bh * 64 * CTXL + tt * 64; dstride = CTXL; }
        const bf16* src = U + (size_t)(urow0 + F.lane) * INC + UC_V + (bh & 3) * HD;
#pragma unroll
        for (int p = 0; p < 8; ++p) { const v4u w = *(const GAS v4u*)(src + 8 * p); LAS unsigned short* tp = T + (8 * p) * 72 + F.lane;
            tp[0 * 72] = (unsigned short)w.x; tp[1 * 72] = (unsigned short)(w.x >> 16); tp[2 * 72] = (unsigned short)w.y; tp[3 * 72] = (unsigned short)(w.y >> 16);
            tp[4 * 72] = (unsigned short)w.z; tp[5 * 72] = (unsigned short)(w.z >> 16); tp[6 * 72] = (unsigned short)w.w; tp[7 * 72] = (unsigned short)(w.w >> 16); }
        LDS_WAIT(); asm volatile("" ::: "memory");
#pragma unroll
        for (int i = 0; i < 8; ++i) { const int d = 8 * i + (F.lane >> 3), t8 = F.lane & 7; const v4u o = *(const LAS v4u*)(T + d * 72 + t8 * 8); *(GAS v4u*)(dst + (size_t)d * dstride + t8 * 8) = o; }
        LDS_WAIT(); asm volatile("" ::: "memory");
    }
}
template <bool LAT>
__device__ __forceinline__ void attn_unit(Frame& F, int l, int b, int h, int r, int cb, const LAS float* rpbs) {
    const bf16* U = (const bf16*)(F.ws + WS_U); bf16* Y = (bf16*)(F.ws + WS_H);
    const bf16* VT = (const bf16*)(F.ws + WS_VT); const bf16* VTC = (const bf16*)(F.ws + WS_VTC);
    const int q = F.lane & 15, g = F.lane >> 4;
    constexpr int NT_ = LAT ? 32 : 16, NB = LAT ? 16 : 0;
    const int qrow = LAT ? (b * SEQ + r * GRIDW + cb * 16 + q) : (NLAT + b * CTXL + cb * 16 + q);
    const int r0 = r - 4 < 0 ? 0 : (r - 4 > 56 ? 56 : r - 4);
    const int wb = cb * 16 - 8 < 0 ? 0 : (cb * 16 - 8 > 32 ? 32 : cb * 16 - 8);
    bf16x8 qf[2];
#pragma unroll
    for (int ks = 0; ks < 2; ++ks) qf[ks] = *(const GAS bf16x8*)(U + (size_t)qrow * INC + UC_Q + h * HD + 32 * ks + 8 * g);
    f32x4 s[NT_];
#pragma unroll
    for (int t = 0; t < NT_; ++t) {
        int krow;
        if (t < NB) { const int kr = t >> 1, seg = t & 1; krow = b * SEQ + (r0 + kr) * GRIDW + wb + seg * 16 + q; } else krow = NLAT + b * CTXL + (t - NB) * 16 + q;
        const bf16* kp = U + (size_t)krow * INC + UC_K + h * HD + 8 * g;
        const bf16x8 k0 = *(const GAS bf16x8*)kp, k1 = *(const GAS bf16x8*)(kp + 32);
        f32x4 a = (f32x4){0.f, 0.f, 0.f, 0.f};
        a = __builtin_amdgcn_mfma_f32_16x16x32_bf16(k0, qf[0], a, 0, 0, 0);
        s[t] = __builtin_amdgcn_mfma_f32_16x16x32_bf16(k1, qf[1], a, 0, 0, 0);
    }
    float m = -3.0e38f;
    if (LAT) {
        const int cq = cb * 16 + q; const int c0 = cq - 8 < 0 ? 0 : (cq - 8 > 48 ? 48 : cq - 8);
        const LAS float* rp = rpbs + h * 15 * 31;
#pragma unroll
        for (int t = 0; t < NB; ++t) { const int kr = t >> 1, seg = t & 1; const int rrel = r0 + kr - r + 7;
#pragma unroll
            for (int i = 0; i < 4; ++i) { const int cc = wb + seg * 16 + 4 * g + i; const bool ok = (cc >= c0) && (cc < c0 + 16);
                int ci = cc - cq + 15; ci = ci < 0 ? 0 : (ci > 30 ? 30 : ci);
                const float v = ok ? s[t][i] * 0.125f + rp[rrel * 31 + ci] : -3.0e38f; s[t][i] = v; m = fmaxf(m, v); } }
    }
#pragma unroll
    for (int t = NB; t < NT_; ++t)
#pragma unroll
        for (int i = 0; i < 4; ++i) { const float v = s[t][i] * 0.125f; s[t][i] = v; m = fmaxf(m, v); }
    m = fmaxf(m, __shfl_xor(m, 16)); m = fmaxf(m, __shfl_xor(m, 32));
    float sum = 0.f;
#pragma unroll
    for (int t = 0; t < NT_; ++t)
#pragma unroll
        for (int i = 0; i < 4; ++i) { const float p = __expf(s[t][i] - m); s[t][i] = p; sum += p; }
    sum += __shfl_xor(sum, 16); sum += __shfl_xor(sum, 32);
    f32x4 o[4];
#pragma unroll
    for (int dt = 0; dt < 4; ++dt) o[dt] = (f32x4){0.f, 0.f, 0.f, 0.f};
    const size_t bh = (size_t)(b * NHEAD + h);
#pragma unroll
    for (int kk = 0; kk < NT_ / 2; ++kk) {
        v4u pw; pw.x = cvtpk(s[2 * kk][0], s[2 * kk][1]); pw.y = cvtpk(s[2 * kk][2], s[2 * kk][3]); pw.z = cvtpk(s[2 * kk + 1][0], s[2 * kk + 1][1]); pw.w = cvtpk(s[2 * kk + 1][2], s[2 * kk + 1][3]);
        const bf16x8 pf = __builtin_bit_cast(bf16x8, pw);
        const bf16* vbase; int vstride;
        if (2 * kk < NB) { vbase = VT + bh * 64 * SEQ + (r0 + kk) * GRIDW + wb + 4 * g; vstride = SEQ; } else { vbase = VTC + bh * 64 * CTXL + (kk - NB / 2) * 32 + 4 * g; vstride = CTXL; }
#pragma unroll
        for (int dt = 0; dt < 4; ++dt) { const bf16* vp = vbase + (size_t)(dt * 16 + q) * vstride;
            const v2u v0 = *(const GAS v2u*)vp, v1 = *(const GAS v2u*)(vp + 16);
            o[dt] = __builtin_amdgcn_mfma_f32_16x16x32_bf16(mk8(v0, v1), pf, o[dt], 0, 0, 0); }
    }
    const float inv = 1.0f / sum; bf16* yp = Y + (size_t)qrow * D + 512 + h * HD + 4 * g;
#pragma unroll
    for (int dt = 0; dt < 4; ++dt) { v2u w; w.x = cvtpk(o[dt][0] * inv, o[dt][1] * inv); w.y = cvtpk(o[dt][2] * inv, o[dt][3] * inv); *(GAS v2u*)(yp + dt * 16) = w; }
}
__device__ __forceinline__ void attn_phase(Frame& F, int l, bool with_ctx) {
    LAS float* rpbs = (LAS float*)(F.lds + TAB_OFF);
    { const float* rp = F.inp(I_RPB) + (size_t)l * NHEAD * 15 * 31; for (int i = F.tid; i < NHEAD * 15 * 31; i += NT) rpbs[i] = rp[i]; }
    __syncthreads();
    const int gw = F.bid * NWAVES + F.wave, NGW = F.G * NWAVES;
    for (int uid = gw; uid < BATCH * NHEAD * 64 * 4; uid += NGW) { const int cb = uid & 3, r = (uid >> 2) & 63, h = (uid >> 8) & 3, b = uid >> 10; attn_unit<true>(F, l, b, h, r, cb, rpbs); }
    if (with_ctx) for (int uid = gw; uid < BATCH * NHEAD * 16; uid += NGW) { const int cb = uid & 15, h = (uid >> 4) & 3, b = uid >> 6; attn_unit<false>(F, l, b, h, 0, cb, rpbs); }
}
__device__ __forceinline__ void dft64_tables(Frame& F, int off) {
    LAS unsigned short* CT = (LAS unsigned short*)(F.lds + off); LAS unsigned short* ST = CT + 64 * 72;
    for (int i = F.tid; i < 4096; i += NT) { const int j = i >> 6, k = i & 63; float s_, c_; sincospif((float)((j * k) & 63) * (1.0f / 32.0f), &s_, &c_); CT[j * 72 + k] = (unsigned short)f2bf(c_); ST[j * 72 + k] = (unsigned short)f2bf(s_); }
}
__device__ __forceinline__ void fourier_a(Frame& F) {
    const bf16* U = (const bf16*)(F.ws + WS_U); bf16* Zr = (bf16*)(F.ws + WS_Z); bf16* Zi = Zr + NZ;
    constexpr int O_CT = 0, O_TWC = 18432, O_TWS = O_TWC + 16384;
    dft64_tables(F, O_CT);
    { LAS float* twc = (LAS float*)(F.lds + O_TWC); LAS float* tws = (LAS float*)(F.lds + O_TWS);
      for (int i = F.tid; i < 4096; i += NT) { float s_, c_; sincospif((float)i * (1.0f / 2048.0f), &s_, &c_); twc[i] = c_; tws[i] = s_; } }
    __syncthreads();
    const LAS unsigned short* CT = (const LAS unsigned short*)(F.lds + O_CT); const LAS unsigned short* ST = CT + 64 * 72;
    const LAS float* twc = (const LAS float*)(F.lds + O_TWC); const LAS float* tws = (const LAS float*)(F.lds + O_TWS);
    const int q = F.lane & 15, g = F.lane >> 4;
    const int gw = F.bid * NWAVES + F.wave, NGW = F.G * NWAVES;
    for (int un = gw; un < BATCH * NHEAD * 64; un += NGW) {
        const int b = un >> 8, h = (un >> 6) & 3, n2 = un & 63;
        f32x4 xr[4][4], xw[4][4];
#pragma unroll
        for (int mt = 0; mt < 4; ++mt)
#pragma unroll
            for (int ct = 0; ct < 4; ++ct) { xr[mt][ct] = (f32x4){0.f, 0.f, 0.f, 0.f}; xw[mt][ct] = (f32x4){0.f, 0.f, 0.f, 0.f}; }
#pragma unroll
        for (int ks = 0; ks < 2; ++ks) {
            bf16x8 tf[4], cf[4], sf[4];
#pragma unroll
            for (int mt = 0; mt < 4; ++mt) tf[mt] = *(const GAS bf16x8*)(U + (size_t)(b * SEQ + 64 * (16 * mt + q) + n2) * INC + UC_F + h * HD + 32 * ks + 8 * g);
#pragma unroll
            for (int ct = 0; ct < 4; ++ct) { cf[ct] = *(const LAS bf16x8*)(CT + (16 * ct + q) * 72 + 32 * ks + 8 * g); sf[ct] = *(const LAS bf16x8*)(ST + (16 * ct + q) * 72 + 32 * ks + 8 * g); }
#pragma unroll
            for (int mt = 0; mt < 4; ++mt)
#pragma unroll
                for (int ct = 0; ct < 4; ++ct) { xr[mt][ct] = __builtin_amdgcn_mfma_f32_16x16x32_bf16(tf[mt], cf[ct], xr[mt][ct], 0, 0, 0); xw[mt][ct] = __builtin_amdgcn_mfma_f32_16x16x32_bf16(tf[mt], sf[ct], xw[mt][ct], 0, 0, 0); }
        }
        v4u ar[4][2], awn[4][2];
#pragma unroll
        for (int ct = 0; ct < 4; ++ct)
#pragma unroll
            for (int kb = 0; kb < 2; ++kb) {
                ar[ct][kb].x = cvtpk(xr[2 * kb][ct][0], xr[2 * kb][ct][1]); ar[ct][kb].y = cvtpk(xr[2 * kb][ct][2], xr[2 * kb][ct][3]);
                ar[ct][kb].z = cvtpk(xr[2 * kb + 1][ct][0], xr[2 * kb + 1][ct][1]); ar[ct][kb].w = cvtpk(xr[2 * kb + 1][ct][2], xr[2 * kb + 1][ct][3]);
                awn[ct][kb].x = cvtpk(-xw[2 * kb][ct][0], -xw[2 * kb][ct][1]); awn[ct][kb].y = cvtpk(-xw[2 * kb][ct][2], -xw[2 * kb][ct][3]);
                awn[ct][kb].z = cvtpk(-xw[2 * kb + 1][ct][0], -xw[2 * kb + 1][ct][1]); awn[ct][kb].w = cvtpk(-xw[2 * kb + 1][ct][2], -xw[2 * kb + 1][ct][3]); }
#pragma unroll
        for (int rt = 0; rt < 4; ++rt) {
            const int n1p = 16 * rt + q;
            bf16x8 cb_[2], sb_[2];
#pragma unroll
            for (int kb = 0; kb < 2; ++kb) { const LAS unsigned short* cp = CT + n1p * 72 + 32 * kb + 4 * g; const LAS unsigned short* sp = ST + n1p * 72 + 32 * kb + 4 * g;
                cb_[kb] = mk8(*(const LAS v2u*)cp, *(const LAS v2u*)(cp + 16)); sb_[kb] = mk8(*(const LAS v2u*)sp, *(const LAS v2u*)(sp + 16)); }
            const int tix = n2 * n1p; const float cw = twc[tix], sw = tws[tix];
            const size_t zbase = ((((size_t)(b * NHEAD + h) * 64 + n1p) * 64 + n2) * 64) + 4 * g;
#pragma unroll
            for (int ct = 0; ct < 4; ++ct) {
                f32x4 yr = (f32x4){0.f, 0.f, 0.f, 0.f}, yi = (f32x4){0.f, 0.f, 0.f, 0.f};
#pragma unroll
                for (int kb = 0; kb < 2; ++kb) {
                    const bf16x8 a_r = __builtin_bit_cast(bf16x8, ar[ct][kb]), a_wn = __builtin_bit_cast(bf16x8, awn[ct][kb]);
                    v4u nr = ar[ct][kb]; nr.x ^= 0x80008000u; nr.y ^= 0x80008000u; nr.z ^= 0x80008000u; nr.w ^= 0x80008000u; const bf16x8 a_rn = __builtin_bit_cast(bf16x8, nr);
                    yr = __builtin_amdgcn_mfma_f32_16x16x32_bf16(a_r, cb_[kb], yr, 0, 0, 0); yr = __builtin_amdgcn_mfma_f32_16x16x32_bf16(a_wn, sb_[kb], yr, 0, 0, 0);
                    yi = __builtin_amdgcn_mfma_f32_16x16x32_bf16(a_wn, cb_[kb], yi, 0, 0, 0); yi = __builtin_amdgcn_mfma_f32_16x16x32_bf16(a_rn, sb_[kb], yi, 0, 0, 0); }
                v2u wr_, wi_;
                wr_.x = cvtpk(yr[0] * cw + yi[0] * sw, yr[1] * cw + yi[1] * sw); wr_.y = cvtpk(yr[2] * cw + yi[2] * sw, yr[3] * cw + yi[3] * sw);
                wi_.x = cvtpk(yi[0] * cw - yr[0] * sw, yi[1] * cw - yr[1] * sw); wi_.y = cvtpk(yi[2] * cw - yr[2] * sw, yi[3] * cw - yr[3] * sw);
                *(GAS v2u*)(Zr + zbase + 16 * ct) = wr_; *(GAS v2u*)(Zi + zbase + 16 * ct) = wi_;
            }
        }
    }
}
__device__ __forceinline__ void fourier_b(Frame& F, bool with_ctx) {
    bf16* Y = (bf16*)(F.ws + WS_H); const bf16* Zr = (const bf16*)(F.ws + WS_Z);
    dft64_tables(F, 0);
    __syncthreads();
    const LAS unsigned short* CT = (const LAS unsigned short*)(F.lds); const LAS unsigned short* ST = CT + 64 * 72;
    LAS unsigned short* ZT = (LAS unsigned short*)(F.lds + 18432 + F.wave * 9216);
    const int q = F.lane & 15, g = F.lane >> 4;
    const int gw = F.bid * NWAVES + F.wave, NGW = F.G * NWAVES;
    const int nun = BATCH * NHEAD * 64 + (with_ctx ? BATCH * NHEAD * 4 : 0);
    for (int un = gw; un < nun; un += NGW) {
        const bool lat = un < BATCH * NHEAD * 64; const int uc = un - BATCH * NHEAD * 64;
        const int b = lat ? (un >> 8) : (uc >> 4), h = lat ? ((un >> 6) & 3) : ((uc >> 2) & 3), n1p = lat ? (un & 63) : (uc & 3);
        const size_t z0 = lat ? (((size_t)(b * NHEAD + h) * 64 + n1p) * 64) * 64 : 2 * NZ + (((size_t)(b * NHEAD + h) * 4 + n1p) * 64) * 64;
        const size_t zim = lat ? NZ : NZC;
        const int tok0 = lat ? (b * SEQ + n1p) : (NLAT + b * CTXL + n1p), tstride = lat ? 64 : 4; const float oscale = lat ? (1.0f / 512.0f) : (1.0f / 128.0f);
        f32x4 acc[4][4];
#pragma unroll
        for (int ct = 0; ct < 4; ++ct)
#pragma unroll
            for (int nt = 0; nt < 4; ++nt) acc[ct][nt] = (f32x4){0.f, 0.f, 0.f, 0.f};
#pragma unroll
        for (int comp = 0; comp < 2; ++comp) {
            const bf16* zp = Zr + z0 + (comp ? zim : 0); const LAS unsigned short* FT = comp ? ST : CT;
#pragma unroll
            for (int i = 0; i < 8; ++i) { const int p = F.lane + 64 * i, n2 = p >> 3, c8 = p & 7; const v4u w = *(const GAS v4u*)(zp + (size_t)n2 * 64 + 8 * c8); LAS unsigned short* tp = ZT + (8 * c8) * 72 + n2;
                tp[0 * 72] = (unsigned short)w.x; tp[1 * 72] = (unsigned short)(w.x >> 16); tp[2 * 72] = (unsigned short)w.y; tp[3 * 72] = (unsigned short)(w.y >> 16);
                tp[4 * 72] = (unsigned short)w.z; tp[5 * 72] = (unsigned short)(w.z >> 16); tp[6 * 72] = (unsigned short)w.w; tp[7 * 72] = (unsigned short)(w.w >> 16); }
            LDS_WAIT(); asm volatile("" ::: "memory");
#pragma unroll
            for (int ks = 0; ks < 2; ++ks) {
                bf16x8 af[4], bf_[4];
#pragma unroll
                for (int ct = 0; ct < 4; ++ct) af[ct] = *(const LAS bf16x8*)(ZT + (16 * ct + q) * 72 + 32 * ks + 8 * g);
#pragma unroll
                for (int nt = 0; nt < 4; ++nt) bf_[nt] = *(const LAS bf16x8*)(FT + (16 * nt + q) * 72 + 32 * ks + 8 * g);
#pragma unroll
                for (int ct = 0; ct < 4; ++ct)
#pragma unroll
                    for (int nt = 0; nt < 4; ++nt) acc[ct][nt] = __builtin_amdgcn_mfma_f32_16x16x32_bf16(af[ct], bf_[nt], acc[ct][nt], 0, 0, 0);
            }
            LDS_WAIT(); asm volatile("" ::: "memory");
        }
#pragma unroll
        for (int nt = 0; nt < 4; ++nt) { bf16* yp = Y + (size_t)(tok0 + tstride * (16 * nt + q)) * D + 768 + h * HD + 4 * g;
#pragma unroll
            for (int ct = 0; ct < 4; ++ct) { v2u w; w.x = cvtpk(acc[ct][nt][0] * oscale, acc[ct][nt][1] * oscale); w.y = cvtpk(acc[ct][nt][2] * oscale, acc[ct][nt][3] * oscale); *(GAS v2u*)(yp + 16 * ct) = w; } }
    }
}
__device__ __forceinline__ v4u mul_bf8(v4u a, v4u b) { v4u r; r.x = cvtpk(bflo(a.x) * bflo(b.x), bfhi(a.x) * bfhi(b.x)); r.y = cvtpk(bflo(a.y) * bflo(b.y), bfhi(a.y) * bfhi(b.y)); r.z = cvtpk(bflo(a.z) * bflo(b.z), bfhi(a.z) * bfhi(b.z)); r.w = cvtpk(bflo(a.w) * bflo(b.w), bfhi(a.w) * bfhi(b.w)); return r; }
__device__ __forceinline__ void convpool_phase(Frame& F, int l, int nrows) {
    const bf16* U = (const bf16*)(F.ws + WS_U); bf16* Y = (bf16*)(F.ws + WS_H);
    const bf16* PWT = (const bf16*)(F.ws + WS_PWT) + (size_t)l * 4 * 64 * 64;
    const float* cw = F.inp(I_CONVW) + (size_t)l * 3 * GWID; const float* ps = F.inp(I_POOLS) + (size_t)l * GWID;
    LAS unsigned* PX = (LAS unsigned*)(F.lds + RING_OFF);
    LAS unsigned* DT = (LAS unsigned*)(F.lds + RING_OFF + 40960);
    const int q = F.lane & 15, g = F.lane >> 4;
    for (int tile = F.bid; tile < nrows / 64; tile += F.G) {
        const int r0 = tile * 64; int base, t0, L; seq_info(r0, base, t0, L);
#pragma unroll
        for (int i = 0; i < 4; ++i) { const int p = F.tid + NT * i, tr = p >> 5, c8 = p & 31, t = t0 + tr; const bf16* ur = U + (size_t)(r0 + tr) * INC + 8 * c8;
            const v4u zc = mul_bf8(*(const GAS v4u*)(ur + UC_AC), *(const GAS v4u*)(ur + UC_AV));
            v4u zp = (v4u){0u, 0u, 0u, 0u}, zn = (v4u){0u, 0u, 0u, 0u};
            if (t > 0) zp = mul_bf8(*(const GAS v4u*)(ur + UC_AC - INC), *(const GAS v4u*)(ur + UC_AV - INC));
            if (t < L - 1) zn = mul_bf8(*(const GAS v4u*)(ur + UC_AC + INC), *(const GAS v4u*)(ur + UC_AV + INC));
            const v4u ab = *(const GAS v4u*)(ur + UC_AB);
            const f32x4 w0a = *(const GAS f32x4*)(cw + 8 * c8), w0b = *(const GAS f32x4*)(cw + 8 * c8 + 4), w1a = *(const GAS f32x4*)(cw + GWID + 8 * c8), w1b = *(const GAS f32x4*)(cw + GWID + 8 * c8 + 4),
                        w2a = *(const GAS f32x4*)(cw + 2 * GWID + 8 * c8), w2b = *(const GAS f32x4*)(cw + 2 * GWID + 8 * c8 + 4);
            v4u o;
            o.x = cvtpk(bflo(ab.x) * (w0a.x * bflo(zp.x) + w1a.x * bflo(zc.x) + w2a.x * bflo(zn.x)), bfhi(ab.x) * (w0a.y * bfhi(zp.x) + w1a.y * bfhi(zc.x) + w2a.y * bfhi(zn.x)));
            o.y = cvtpk(bflo(ab.y) * (w0a.z * bflo(zp.y) + w1a.z * bflo(zc.y) + w2a.z * bflo(zn.y)), bfhi(ab.y) * (w0a.w * bfhi(zp.y) + w1a.w * bfhi(zc.y) + w2a.w * bfhi(zn.y)));
            o.z = cvtpk(bflo(ab.z) * (w0b.x * bflo(zp.z) + w1b.x * bflo(zc.z) + w2b.x * bflo(zn.z)), bfhi(ab.z) * (w0b.y * bfhi(zp.z) + w1b.y * bfhi(zc.z) + w2b.y * bfhi(zn.z)));
            o.w = cvtpk(bflo(ab.w) * (w0b.z * bflo(zp.w) + w1b.z * bflo(zc.w) + w2b.z * bflo(zn.w)), bfhi(ab.w) * (w0b.w * bfhi(zp.w) + w1b.w * bfhi(zc.w) + w2b.w * bfhi(zn.w)));
            *(GAS v4u*)(Y + (size_t)(r0 + tr) * D + 8 * c8) = o; }
#pragma unroll
        for (int i = 0; i < 5; ++i) { const int p = F.tid + NT * i, rr = p >> 5, c8 = p & 31, t = t0 - 8 + rr; v4u w = (v4u){0u, 0u, 0u, 0u};
            if (t >= 0 && t < L) w = *(const GAS v4u*)(U + (size_t)(base + t) * INC + UC_P + 8 * c8);
            *(LAS v4u*)(PX + rr * 128 + 4 * c8) = w; }
        __syncthreads();
        { const int c2 = F.tid & 127, tq = F.tid >> 7, hw = 1 << (c2 >> 5);
          float s0 = 0.f, s1 = 0.f;
          for (int k = -hw; k < hw; ++k) { const unsigned w = PX[(16 * tq + 8 + k) * 128 + c2]; s0 += bflo(w); s1 += bfhi(w); }
          for (int i = 0; i < 16; ++i) { const int tl = 16 * tq + i, t = t0 + tl;
              const int lo = t - hw > 0 ? t - hw : 0, hi = t + hw < L ? t + hw : L; const float rc = 1.0f / (float)(hi - lo);
              const unsigned xc = PX[(tl + 8) * 128 + c2];
              DT[tl * 132 + c2] = cvtpk(s0 * rc - bflo(xc), s1 * rc - bfhi(xc));
              const unsigned wa = PX[(tl + 8 + hw) * 128 + c2], wsb = PX[(tl + 8 - hw) * 128 + c2];
              s0 += bflo(wa) - bflo(wsb); s1 += bfhi(wa) - bfhi(wsb); } }
        __syncthreads();
        { const int gi = F.wave & 3;
          bf16x8 wf[4][2];
#pragma unroll
          for (int dt = 0; dt < 4; ++dt)
#pragma unroll
              for (int ks = 0; ks < 2; ++ks) wf[dt][ks] = *(const GAS bf16x8*)(PWT + ((size_t)gi * 64 + 16 * dt + q) * 64 + 32 * ks + 8 * g);
#pragma unroll
          for (int tj = 0; tj < 2; ++tj) { const int tt = 2 * (F.wave >> 2) + tj;
              bf16x8 df[2];
#pragma unroll
              for (int ks = 0; ks < 2; ++ks) df[ks] = *(const LAS bf16x8*)(DT + (16 * tt + q) * 132 + gi * 32 + 16 * ks + 4 * g);
#pragma unroll
              for (int dt = 0; dt < 4; ++dt) { f32x4 a = (f32x4){0.f, 0.f, 0.f, 0.f};
                  a = __builtin_amdgcn_mfma_f32_16x16x32_bf16(wf[dt][0], df[0], a, 0, 0, 0); a = __builtin_amdgcn_mfma_f32_16x16x32_bf16(wf[dt][1], df[1], a, 0, 0, 0);
                  const int oc = gi * 64 + 16 * dt + 4 * g; const f32x4 sc = *(const GAS f32x4*)(ps + oc);
                  v2u w; w.x = cvtpk(a[0] * sc.x, a[1] * sc.y); w.y = cvtpk(a[2] * sc.z, a[3] * sc.w);
                  *(GAS v2u*)(Y + (size_t)(r0 + 16 * tt + q) * D + 256 + oc) = w; } } }
        __syncthreads();
    }
}

__device__ __forceinline__ void fourier_ctx_a(Frame& F) {
    const bf16* U = (const bf16*)(F.ws + WS_U); bf16* Zc = (bf16*)(F.ws + WS_Z) + 2 * NZ;
    LAS float* cs = (LAS float*)(F.lds + TAB_OFF); LAS float* sn = cs + 64; LAS float* cs256 = cs + 128; LAS float* sn256 = cs + 384;
    if (F.tid < 64) { float s_, c_; sincospif((float)F.tid * (1.0f / 32.0f), &s_, &c_); cs[F.tid] = c_; sn[F.tid] = s_; }
    if (F.tid < 256) { float s_, c_; sincospif((float)F.tid * (1.0f / 128.0f), &s_, &c_); cs256[F.tid] = c_; sn256[F.tid] = s_; }
    __syncthreads();
    for (int item = F.bid * NT + F.tid; item < BATCH * NHEAD * 64 * 64; item += F.G * NT) {
        const int cp = item & 63, n2 = (item >> 6) & 63, h = (item >> 12) & 3, b = item >> 14;
        float xr[4], xi[4];
#pragma unroll
        for (int n1 = 0; n1 < 4; ++n1) { xr[n1] = 0.f; xi[n1] = 0.f; }
        for (int c8 = 0; c8 < 8; ++c8) {
            float cc[8], ss[8];
#pragma unroll
            for (int e = 0; e < 8; ++e) { const int idx = ((8 * c8 + e) * cp) & 63; cc[e] = cs[idx]; ss[e] = sn[idx]; }
#pragma unroll
            for (int n1 = 0; n1 < 4; ++n1) { const v4u w = *(const GAS v4u*)(U + (size_t)(NLAT + b * CTXL + 64 * n1 + n2) * INC + UC_F + h * HD + 8 * c8);
                const float f0 = bflo(w.x), f1 = bfhi(w.x), f2 = bflo(w.y), f3 = bfhi(w.y), f4 = bflo(w.z), f5 = bfhi(w.z), f6 = bflo(w.w), f7 = bfhi(w.w);
                xr[n1] += f0 * cc[0] + f1 * cc[1] + f2 * cc[2] + f3 * cc[3] + f4 * cc[4] + f5 * cc[5] + f6 * cc[6] + f7 * cc[7];
                xi[n1] -= f0 * ss[0] + f1 * ss[1] + f2 * ss[2] + f3 * ss[3] + f4 * ss[4] + f5 * ss[5] + f6 * ss[6] + f7 * ss[7]; }
        }
        float yr[4], yi[4];
        yr[0] = xr[0] + xr[1] + xr[2] + xr[3];           yi[0] = xi[0] + xi[1] + xi[2] + xi[3];
        yr[1] = xr[0] + xi[1] - xr[2] - xi[3];           yi[1] = xi[0] - xr[1] - xi[2] + xr[3];
        yr[2] = xr[0] - xr[1] + xr[2] - xr[3];           yi[2] = xi[0] - xi[1] + xi[2] - xi[3];
        yr[3] = xr[0] - xi[1] - xr[2] + xi[3];           yi[3] = xi[0] + xr[1] - xi[2] - xr[3];
#pragma unroll
        for (int k = 0; k < 4; ++k) { const int tix = (n2 * k) & 255; const float cw = cs256[tix], sw = sn256[tix];
            const size_t zi = ((((size_t)(b * NHEAD + h) * 4 + k) * 64 + n2) * 64) + cp;
            Zc[zi] = (bf16)f2bf(yr[k] * cw + yi[k] * sw); Zc[NZC + zi] = (bf16)f2bf(yi[k] * cw - yr[k] * sw); }
    }
}

__device__ __forceinline__ void mixa_phase(int l, bool with_ctx) { Frame F = mk_frame();
    const int nrows = with_ctx ? NROW : NLAT;
    convpool_phase(F, l, nrows);
    vt_prepass(F);
    __syncthreads();
    fourier_a(F);
    __syncthreads();
    if (with_ctx) fourier_ctx_a(F);
}
__device__ __forceinline__ void mixb_phase(int l, bool with_ctx) { Frame F = mk_frame();
    attn_phase(F, l, with_ctx);
    __syncthreads();
    bf16* Y = (bf16*)(F.ws + WS_H); const float* DV = (const float*)(F.ws + WS_DVEC); const float* Z = (const float*)(F.ws + WS_Z);
    const int nrows = with_ctx ? NROW : NLAT;
    const long gtid = (long)F.bid * NT + F.tid, NTH = (long)F.G * NT;
    __syncthreads();
    fourier_b(F, with_ctx);
}

struct WinOrder {
    int G, c, nctx_cols, ctx_pn0;
    __device__ __forceinline__ bool next(int i, pg8::Unit& u) const {
        const long L = (long)i * G + c; const int nlatu = 1024, total = nlatu + 8 * nctx_cols; if (L >= total) return false;
        if (L < nlatu) { int wgid = (int)L; { const int xcd = wgid % 8, off = wgid / 8; wgid = xcd * 128 + off; }
            const int gid = wgid / 64, fm = gid * 8; u.pm = fm + ((wgid % 64) % 8); u.pn = (wgid % 64) / 8; }
        else { const int j = (int)L - nlatu; u.pm = 128 + (j % 8); u.pn = ctx_pn0 + j / 8; }
        u.pb = u.pn; u.lb = 0; u.nv = 256; return true;
    }
    __device__ __forceinline__ void a_ready(const pg8::Unit&) const {}
    __device__ __forceinline__ void done(const pg8::Unit&) const {}
    __device__ __forceinline__ int row_of(const pg8::Unit&, int i) const { return i; }
};

struct Args { const float* in[20]; float* out; unsigned char* ws; int l, e; };
#define PH_PTRS() \
    bf16* H = (bf16*)(F.ws + WS_H); bf16* U = (bf16*)(F.ws + WS_U); bf16* HE = (bf16*)(F.ws + WS_U); bf16* Y2 = (bf16*)(F.ws + WS_S); \
    float* MOD = (float*)(F.ws + WS_MOD); float* XC = (float*)(F.ws + WS_XC); const uint2* INFO = (const uint2*)(F.ws + WS_INFO); \
    const bool first = (l == 0); const int M = first ? NROW : NLAT; const float* modl = MOD + (size_t)l * 9 * 6144; \
    (void)H; (void)U; (void)HE; (void)XC; (void)Y2; (void)INFO; (void)M; (void)modl;

__device__ __forceinline__ void ph_norm1(int l) { Frame F = mk_frame(); PH_PTRS();
    norm_phase<false, false>(F, F.inp(I_X), F.inp(I_CTX), nullptr, nullptr, NROW, F.inp(I_N1G), modl, modl, 0, 1, H, nullptr, nullptr); }
__device__ __forceinline__ void ph_next(int l) { Frame F = mk_frame(); PH_PTRS();
    if (first) norm_phase<true, false>(F, F.out, XC, F.out, XC, NROW, F.inp(I_N1G) + D, MOD + (size_t)9 * 6144, modl, 0, 1, H, Y2, nullptr);
    else norm_phase<true, true>(F, F.out, XC, F.out, XC, NLAT, F.inp(I_FG), modl, modl, 0, 0, nullptr, Y2, F.out); }
__device__ __forceinline__ void ph_route(int l) { Frame F = mk_frame(); PH_PTRS(); route_phase(F, l, F.out, XC, M, F.inp(I_N2G) + (size_t)l * D, modl, H); }
__device__ __forceinline__ void ph_win(int l) { Frame F = mk_frame(); PH_PTRS();
    pg8::Gemm g{H, (const bf16*)(F.ws + WS_WIN) + (size_t)l * INC * D, NROW, INC, D};
    WinOrder S{F.G, F.bid, first ? 8 : 2, first ? 0 : 5};
    pg8::EpiBf16 E{U, INC};
    pg8::gemm_phase<pg8::EpiBf16, WinOrder>(F.lds + RING_OFF, g, S, E); }
__device__ __forceinline__ void ph_wout(int l) { Frame F = mk_frame(); PH_PTRS();
    pg8::Gemm g{H, (const bf16*)(F.ws + WS_WOUT) + (size_t)l * D * D, M, D, D};
    pg8::StaticOrder S; S.init(M, D, F.G, F.bid);
    const float* xlat_in = first ? F.inp(I_X) : F.out; const float* xctx_in = first ? F.inp(I_CTX) : XC;
    pg8::EpiResid E{xlat_in, xctx_in, F.out, XC, modl + 2 * 1024, 6144, nullptr, 0, NLAT, SEQ};
    pg8::gemm_phase<pg8::EpiResid, pg8::StaticOrder>(F.lds + RING_OFF, g, S, E); }
__device__ __forceinline__ void ph_moe1(int l) { Frame F = mk_frame(); PH_PTRS(); moe_table(F, l);
    pg8::Gemm g{H, (const bf16*)(F.ws + WS_W13) + (size_t)l * NEXP * 1024 * D, M, 1024, D};
    pg8::MoeOrder S{F.G, F.bid, CAP, (const LAS int*)(F.lds + TAB_OFF), INFO};
    pg8::EpiSwiGLU E{HE, MHID};
    pg8::gemm_phase<pg8::EpiSwiGLU, pg8::MoeOrder, true>(F.lds + RING_OFF, g, S, E); }
__device__ __forceinline__ void ph_moe2(int l) { Frame F = mk_frame(); PH_PTRS(); moe_table(F, l);
    pg8::Gemm g{HE, (const bf16*)(F.ws + WS_W2) + (size_t)l * NEXP * D * MHID, M, D, MHID};
    pg8::MoeOrder S{F.G, F.bid, CAP, (const LAS int*)(F.lds + TAB_OFF), INFO};
    pg8::EpiScatter E{Y2, INFO};
    pg8::gemm_phase<pg8::EpiScatter, pg8::MoeOrder, false>(F.lds + RING_OFF, g, S, E); }

__device__ __forceinline__ void grid_bar() {
    Frame F = mk_frame(); XcdBarrier b; b.bar = (unsigned*)(F.ctl + CW_BAR); b.x = xb_xcc_id(); b.st = F.MISC + 8; xcd_barrier(b);
}
#ifndef SINGLE_LAUNCH
#define SINGLE_LAUNCH 1
#endif
#if !SINGLE_LAUNCH
__global__ void __launch_bounds__(NT, 2) k_pa(Args args) { pa_phase(); }
__global__ void __launch_bounds__(NT, 2) k_norm1(Args args) { ph_norm1(args.l); }
__global__ void __launch_bounds__(NT, 2) k_next(Args args) { ph_next(args.l); }
__global__ void __launch_bounds__(NT, 2) k_route(Args args) { ph_route(args.l); }
__global__ void __launch_bounds__(NT, 2) k_win(Args args) { ph_win(args.l); }
__global__ void __launch_bounds__(NT, 2) k_mixa(Args args) { mixa_phase(args.l, args.l == 0); }
__global__ void __launch_bounds__(NT, 2) k_mixb(Args args) { mixb_phase(args.l, args.l == 0); }
__global__ void __launch_bounds__(NT, 2) k_wout(Args args) { ph_wout(args.l); }
__global__ void __launch_bounds__(NT, 2) k_moe1(Args args) { ph_moe1(args.l); }
__global__ void __launch_bounds__(NT, 2) k_moe2(Args args) { ph_moe2(args.l); }
#else
#define PMARK(name) asm volatile("; PHASE_MARK " name ::: "memory")
template <int L> __device__ __forceinline__ void layer_phases() {
    PMARK("win"); ph_win(L); grid_bar();
    PMARK("mixa"); mixa_phase(L, L == 0); grid_bar();
    PMARK("mixb"); mixb_phase(L, L == 0); grid_bar();
    PMARK("wout"); ph_wout(L); grid_bar();
    PMARK("route"); ph_route(L); grid_bar();
    PMARK("moe1"); ph_moe1(L); grid_bar();
    PMARK("moe2"); ph_moe2(L); grid_bar();
    PMARK("next"); ph_next(L);
}
__global__ void __launch_bounds__(NT, 2) fwd_all(Args args) {
    { Frame F = mk_frame();
      for (int u = F.tid; u < (LDS_BYTES - LDSCTL_OFF) / 4; u += NT) ((LAS unsigned*)(F.lds + LDSCTL_OFF))[u] = 0u;
      __syncthreads();
      (void)xcd_barrier_post((unsigned*)(F.ctl + CW_BAR), F.MISC + 8); }
    PMARK("pa"); pa_phase(); grid_bar();
    PMARK("norm1"); ph_norm1(0); grid_bar();
    layer_phases<0>(); grid_bar();
    layer_phases<1>();
}
#endif

typedef void (*kern_t)(Args);
extern "C" void kernel_launch(void* const* d_in, const int* in_sizes, int n_in, void* d_out, int out_size, void* d_ws, size_t ws_size, hipStream_t stream) {
    static int grid = 0;
#if SINGLE_LAUNCH
    const kern_t kerns[] = {fwd_all};
#else
    const kern_t kerns[] = {k_pa, k_norm1, k_next, k_route, k_win, k_mixa, k_mixb, k_wout, k_moe1, k_moe2};
#endif
    if (grid == 0) {
        if (n_in != 20 || out_size != NLAT * D || ws_size < WS_END) { fprintf(stderr, "kernel_launch: unexpected shapes (n_in %d out %d ws %zu)\n", n_in, out_size, ws_size); grid = -1; return; }
        int dev = 0, cus = 0;
        if (hipGetDevice(&dev) != hipSuccess || hipDeviceGetAttribute(&cus, hipDeviceAttributeMultiprocessorCount, dev) != hipSuccess) { grid = -1; return; }
        for (kern_t k : kerns) if (hipFuncSetAttribute((const void*)k, hipFuncAttributeMaxDynamicSharedMemorySize, LDS_BYTES) != hipSuccess) { fprintf(stderr, "kernel_launch: hipFuncSetAttribute failed\n"); grid = -1; return; }
        int per_cu = 0; (void)hipOccupancyMaxActiveBlocksPerMultiprocessor(&per_cu, (const void*)kerns[0], NT, LDS_BYTES); (void)hipGetLastError();
        grid = cus;
    }
    if (grid < 0) return;
    (void)hipMemsetAsync((char*)d_ws + WS_CTL, 0, CTL_ZERO_BYTES, stream);
    Args a{};
    for (int i = 0; i < 20; ++i) a.in[i] = (const float*)d_in[i];
    a.out = (float*)d_out; a.ws = (unsigned char*)d_ws;
#if SINGLE_LAUNCH
    hipLaunchKernelGGL(fwd_all, dim3(grid), dim3(NT), LDS_BYTES, stream, a);
#else
#define LAUNCH(k, L, E) do { a.l = (L); a.e = (E); hipLaunchKernelGGL(k, dim3(grid), dim3(NT), LDS_BYTES, stream, a); } while (0)
    LAUNCH(k_pa, 0, 0);
    LAUNCH(k_norm1, 0, 0);
    for (int l = 0; l < DEPTH; ++l) {
        LAUNCH(k_win, l, 0); LAUNCH(k_mixa, l, 0); LAUNCH(k_mixb, l, 0); LAUNCH(k_wout, l, 0); LAUNCH(k_route, l, 0);
        LAUNCH(k_moe1, l, 0); LAUNCH(k_moe2, l, 0); LAUNCH(k_next, l, 0);
    }
#endif
}
```

```cpp
#include <hip/hip_runtime.h>
#include <cstdio>
#include <cstdint>
namespace pg8 {
#define PG8_LAS __attribute__((address_space(3)))
typedef unsigned short bf16_t;
typedef short bf16x8 __attribute__((ext_vector_type(8)));
typedef float f32x4 __attribute__((ext_vector_type(4)));
typedef unsigned u32x4 __attribute__((ext_vector_type(4)));
constexpr int BM = 256, BK = 64, HALF = 128, HTB = HALF * BK * 2  , STAGE_BYTES = 8 * HTB, NXCD = 8, WGM = 8;

__host__ __device__ __forceinline__ int lds_byte(int r, int c) { const int st = (r >> 4) * 2 + (c >> 5), rr = r & 15, cc = c & 31, ob = rr * 64 + cc * 2; return st * 1024 + (ob ^ (((ob >> 9) & 1) << 5)); }
__host__ __device__ __forceinline__ void stage_rc(int b, int& R, int& C) { const int st = b / 1024, sb = b % 1024, swz = sb ^ (((sb >> 9) & 1) << 5); R = (st >> 1) * 16 + swz / 64; C = (st & 1) * 32 + (swz % 64) / 2; }
__host__ __device__ __forceinline__ int perm32(int rho) { const int n = rho >> 4, i = rho & 15; return 8 * (i >> 2) + 4 * n + (i & 3); }

struct Unit { int pm, pn, pb, lb, nv; };
struct Gemm { const bf16_t* A; const bf16_t* Bt; int M, N, K; };

struct StaticOrder {
    int nM, nN, nwg, G, c;
    __host__ __device__ void init(int M, int N, int G_, int c_) { nM = M / BM; nN = N / BM; nwg = nM * nN; G = G_; c = c_; }
    __host__ __device__ bool next(int i, Unit& u) const {
        const long L = (long)i * G + c; if (L >= nwg) return false;
        int wgid = (int)L; { const int q = nwg / NXCD, r = nwg % NXCD, xcd = wgid % NXCD, off = wgid / NXCD; wgid = (xcd < r ? xcd * (q + 1) : r * (q + 1) + (xcd - r) * q) + off; }
        const int nig = WGM * nN, gid = wgid / nig, fm = gid * WGM, gsz = (nM - fm) < WGM ? (nM - fm) : WGM;
        u.pm = fm + ((wgid % nig) % gsz); u.pn = (wgid % nig) / gsz; u.pb = u.pn; u.lb = 0; u.nv = BM; return true;
    }
    __device__ __forceinline__ void a_ready(const Unit&) const {}
    __device__ __forceinline__ int row_of(const Unit&, int i) const { return i; }
    __device__ __forceinline__ void done(const Unit&) const {}
};


__device__ __forceinline__ unsigned cvt_pk_bf16(float lo, float hi) { unsigned r; asm volatile("v_cvt_pk_bf16_f32 %0, %1, %2" : "=v"(r) : "v"(lo), "v"(hi)); return r; }

struct EpiBf16 {
    static constexpr bool PERM = true, AFTER_DRAIN = false;
    bf16_t* O; int ldc;
    __device__ __forceinline__ void operator()(const f32x4 (&acc)[2][2][4][2], const Unit& u, int wr, int wc, int fr, int fq) const {
        const int row0 = u.pm * BM + wr * 64 + fr; const int col0 = u.pn * BM + wc * 32 + 8 * fq;
#pragma unroll
        for (int ai = 0; ai < 2; ++ai)
#pragma unroll
            for (int m = 0; m < 4; ++m) { bf16_t* rowp = O + (size_t)(row0 + ai * HALF + m * 16) * ldc + col0;
#pragma unroll
                for (int bj = 0; bj < 2; ++bj) { const f32x4 v0 = acc[ai][bj][m][0], v1 = acc[ai][bj][m][1];
                    u32x4 w; w.x = cvt_pk_bf16(v0[0], v0[1]); w.y = cvt_pk_bf16(v0[2], v0[3]); w.z = cvt_pk_bf16(v1[0], v1[1]); w.w = cvt_pk_bf16(v1[2], v1[3]);
                    *(u32x4*)(rowp + bj * HALF) = w; } }
    }
};
struct EpiSwiGLU {
    static constexpr bool PERM = true, AFTER_DRAIN = false;
    bf16_t* O; int ldc;
    __device__ __forceinline__ void operator()(const f32x4 (&acc)[2][2][4][2], const Unit& u, int wr, int wc, int fr, int fq) const {
        const int row0 = u.pm * BM + wr * 64 + fr; const int col0 = u.pn * HALF + wc * 32 + 8 * fq;
#pragma unroll
        for (int ai = 0; ai < 2; ++ai)
#pragma unroll
            for (int m = 0; m < 4; ++m) { bf16_t* rowp = O + (size_t)(row0 + ai * HALF + m * 16) * ldc + col0;
                float o[8];
#pragma unroll
                for (int n = 0; n < 2; ++n)
#pragma unroll
                    for (int j = 0; j < 4; ++j) { const float a = acc[ai][0][m][n][j], b = acc[ai][1][m][n][j]; o[n * 4 + j] = a * __builtin_amdgcn_rcpf(1.0f + __expf(-a)) * b; }
                u32x4 w; w.x = cvt_pk_bf16(o[0], o[1]); w.y = cvt_pk_bf16(o[2], o[3]); w.z = cvt_pk_bf16(o[4], o[5]); w.w = cvt_pk_bf16(o[6], o[7]);
                *(u32x4*)rowp = w; }
    }
};
struct EpiResid {
    static constexpr bool PERM = false, AFTER_DRAIN = false;
    const float* xin_lat; const float* xin_ctx; float* xout_lat; float* xout_ctx; const float* gmod; int gstride; const float* rowscale; int rs_stride; int nlat, seq;
    __device__ __forceinline__ void operator()(const f32x4 (&acc)[2][2][4][2], const Unit& u, int wr, int wc, int fr, int fq) const {
        const int prow = u.pm * BM; const bool isctx = prow >= nlat;
        const float* xin = isctx ? xin_ctx - (size_t)nlat * 1024 : xin_lat; float* xout = isctx ? xout_ctx - (size_t)nlat * 1024 : xout_lat;
        const int modrow = isctx ? 8 : prow / seq;
        const int row0 = prow + wr * 64 + fr, col0 = u.pn * BM + wc * 32 + 4 * fq;
        f32x4 gv[2][2];
#pragma unroll
        for (int bj = 0; bj < 2; ++bj)
#pragma unroll
            for (int n = 0; n < 2; ++n) gv[bj][n] = *(const f32x4*)(gmod + (size_t)modrow * gstride + col0 + bj * HALF + n * 16);
#pragma unroll
        for (int ai = 0; ai < 2; ++ai)
#pragma unroll
            for (int m = 0; m < 4; ++m) { const int row = row0 + ai * HALF + m * 16; const size_t off = (size_t)row * 1024 + col0;
                const float rs = rowscale ? rowscale[(size_t)row * rs_stride] : 1.0f;
#pragma unroll
                for (int bj = 0; bj < 2; ++bj)
#pragma unroll
                    for (int n = 0; n < 2; ++n) { const f32x4 xi = *(const f32x4*)(xin + off + bj * HALF + n * 16);
                        *(f32x4*)(xout + off + bj * HALF + n * 16) = xi + gv[bj][n] * rs * acc[ai][bj][m][n]; } }
    }
};
struct EpiScatter {
    static constexpr bool PERM = true, AFTER_DRAIN = false;
    bf16_t* Y2; const uint2* info;
    __device__ __forceinline__ void operator()(const f32x4 (&acc)[2][2][4][2], const Unit& u, int wr, int wc, int fr, int fq) const {
        const int col0 = u.pn * BM + wc * 32 + 8 * fq;
#pragma unroll
        for (int ai = 0; ai < 2; ++ai)
#pragma unroll
            for (int m = 0; m < 4; ++m) { const int i = ai * HALF + wr * 64 + m * 16 + fr;
                if (i < u.nv) { const uint2 inf = info[u.lb + i]; const float w = __builtin_bit_cast(float, inf.y); bf16_t* rowp = Y2 + (size_t)inf.x * 1024 + col0;
#pragma unroll
                    for (int bj = 0; bj < 2; ++bj) { const f32x4 v0 = acc[ai][bj][m][0] * w, v1 = acc[ai][bj][m][1] * w;
                        u32x4 q; q.x = cvt_pk_bf16(v0[0], v0[1]); q.y = cvt_pk_bf16(v0[2], v0[3]); q.z = cvt_pk_bf16(v1[0], v1[1]); q.w = cvt_pk_bf16(v1[2], v1[3]);
                        *(u32x4*)(rowp + bj * HALF) = q; } } }
    }
};
struct MoeOrder {
    int G, c, cap; const PG8_LAS int* tab; const uint2* info;
    __device__ __forceinline__ bool next(int i, Unit& u) const {
        const int nwg = __builtin_amdgcn_readfirstlane(tab[16]) * 4; const long L = (long)i * G + c; if (L >= nwg) return false;
        int wgid = (int)L; { const int q = nwg / NXCD, r = nwg % NXCD, xcd = wgid % NXCD, off = wgid / NXCD; wgid = (xcd < r ? xcd * (q + 1) : r * (q + 1) + (xcd - r) * q) + off; }
        const int gp = wgid >> 2; int e = 0;
#pragma unroll
        for (int q = 1; q < 16; ++q) e += (gp >= tab[q]) ? 1 : 0;
        e = __builtin_amdgcn_readfirstlane(e);
        const int p = gp - __builtin_amdgcn_readfirstlane(tab[e]); const int ne = __builtin_amdgcn_readfirstlane(tab[17 + e]);
        u.pm = gp; u.pn = wgid & 3; u.pb = e * 4 + u.pn; u.lb = e * cap + 256 * p; u.nv = (ne - 256 * p) < 256 ? (ne - 256 * p) : 256; return true;
    }
    __device__ __forceinline__ void a_ready(const Unit&) const {}
    __device__ __forceinline__ void done(const Unit&) const {}
    __device__ __forceinline__ int row_of(const Unit& u, int i) const { return i < u.nv ? (int)(info[u.lb + i].x >> 1) : 0; }
};
template <class Epi, class Sched, bool GATHER = false>
__device__ __forceinline__ void gemm_phase(PG8_LAS unsigned char* lds, const Gemm g, const Sched& S, const Epi& E) {
    int tid_ = threadIdx.x; asm volatile("" : "+v"(tid_));
    const int tid = tid_, wid = __builtin_amdgcn_readfirstlane(tid >> 6), lane = tid & 63, wr = wid >> 2, wc = wid & 3, fr = lane & 15, fq = lane >> 4;
    const int K = g.K, nt = K / BK;
    unsigned voffB[2];
#pragma unroll
    for (int i = 0; i < 2; ++i) { int R, C; stage_rc(tid * 16 + i * 8192, R, C); const int Rb = Epi::PERM ? ((R & ~31) + perm32(R & 31)) : R; voffB[i] = (unsigned)(Rb * K + C) * 2u; }
    const size_t kstep = (size_t)(BK * 2);
    const size_t hstep = (size_t)HALF * K * 2;
    const size_t tstep = 2 * hstep;
    const unsigned ldsw = (unsigned)wid * 1024u;
    const int aoff = lds_byte(wr * 64 + fr, fq * 8), boff = lds_byte(wc * 32 + fr, fq * 8);
#define PG8_SA(b, h) (((b) * 2 + (h)) * HTB)
#define PG8_SB(b, h) ((4 + (b) * 2 + (h)) * HTB)
#define PG8_STAGE(bufoff, gbase, voff) do { _Pragma("unroll") for (int _i = 0; _i < 2; ++_i) \
        __builtin_amdgcn_global_load_lds((const unsigned*)((const char*)(gbase) + (voff)[_i]), (PG8_LAS unsigned*)(lds + (bufoff) + ldsw + _i * 8192), 16, 0, 0); } while (0)
#define PG8_LDA(dst, b, h) do { _Pragma("unroll") for (int m = 0; m < 4; ++m) _Pragma("unroll") for (int k = 0; k < 2; ++k) dst[m][k] = *(const PG8_LAS bf16x8*)(lds + PG8_SA(b, h) + aoff + m * 2048 + k * 1024); } while (0)
#define PG8_LDB(dst, b, h) do { _Pragma("unroll") for (int n = 0; n < 2; ++n) _Pragma("unroll") for (int k = 0; k < 2; ++k) dst[n][k] = *(const PG8_LAS bf16x8*)(lds + PG8_SB(b, h) + boff + n * 2048 + k * 1024); } while (0)
#define PG8_MMA(ai, bj, At, Bt) do { __builtin_amdgcn_s_setprio(1); _Pragma("unroll") for (int m = 0; m < 4; ++m) _Pragma("unroll") for (int n = 0; n < 2; ++n) _Pragma("unroll") for (int k = 0; k < 2; ++k) \
        acc[ai][bj][m][n] = __builtin_amdgcn_mfma_f32_16x16x32_bf16(Bt[n][k], At[m][k], acc[ai][bj][m][n], 0, 0, 0); __builtin_amdgcn_s_setprio(0); } while (0)
#define PG8_WAIT_V(n) asm volatile("s_waitcnt vmcnt(" #n ")" ::: "memory")
#define PG8_WAIT_L(n) asm volatile("s_waitcnt lgkmcnt(" #n ")" ::: "memory")
#define PG8_BAR __builtin_amdgcn_s_barrier()
#define PG8_SCHED __builtin_amdgcn_sched_barrier(0)
#define PG8_AOFFS(o, u) do { _Pragma("unroll") for (int _h = 0; _h < 2; ++_h) _Pragma("unroll") for (int _i = 0; _i < 2; ++_i) { int _R, _C; stage_rc(tid * 16 + _i * 8192, _R, _C); \
        const int _row = GATHER ? S.row_of((u), _h * HALF + _R) : (_h * HALF + _R); (o)[_h][_i] = (unsigned)(_row * K + _C) * 2u; } } while (0)
    Unit cur, nxt; int ui = 0;
    if (!S.next(0, cur)) return;
    f32x4 acc[2][2][4][2];
#pragma unroll
    for (int a = 0; a < 2; ++a)
#pragma unroll
        for (int b = 0; b < 2; ++b)
#pragma unroll
            for (int m = 0; m < 4; ++m)
#pragma unroll
                for (int n = 0; n < 2; ++n) acc[a][b][m][n] = (f32x4){0.f, 0.f, 0.f, 0.f};
    bf16x8 At[4][2], B0[2][2], B1[2][2];
    unsigned offA[2][2], noffA[2][2];
    const char* cA = (const char*)g.A + (GATHER ? (size_t)0 : (size_t)cur.pm * tstep); const char* cB = (const char*)g.Bt + (size_t)cur.pb * tstep;
    S.a_ready(cur);
    PG8_AOFFS(offA, cur);
    PG8_STAGE(PG8_SB(0, 0), cB, voffB); PG8_STAGE(PG8_SB(0, 1), cB + hstep, voffB); PG8_STAGE(PG8_SA(0, 0), cA, offA[0]); PG8_STAGE(PG8_SA(0, 1), cA, offA[1]);
    if (wr == 1) PG8_BAR;
    PG8_WAIT_V(2); PG8_BAR;
    PG8_STAGE(PG8_SB(1, 0), cB + kstep, voffB); PG8_STAGE(PG8_SA(1, 0), cA + kstep, offA[0]); PG8_STAGE(PG8_SB(1, 1), cB + hstep + kstep, voffB);
    PG8_WAIT_V(6); PG8_BAR;
    for (;;) {
        const bool has_next = S.next(ui + 1, nxt);
        const char* nA = has_next ? (const char*)g.A + (GATHER ? (size_t)0 : (size_t)nxt.pm * tstep) : cA; const char* nB = has_next ? (const char*)g.Bt + (size_t)nxt.pb * tstep : cB;
        for (int t = 0; t < nt; t += 2) {
            const bool last = (t == nt - 2);
            const char* a1 = cA + (size_t)(t + 1) * kstep;
            const char* a2 = last ? nA : cA + (size_t)(t + 2) * kstep; const char* b2 = last ? nB : cB + (size_t)(t + 2) * kstep;
            const char* a3 = a2 + kstep; const char* b3 = b2 + kstep;
            if (last && has_next) S.a_ready(nxt);
            unsigned o2[2][2];
            if constexpr (GATHER) {
                if (last) { if (has_next) { PG8_AOFFS(noffA, nxt); } else {
#pragma unroll
                        for (int h = 0; h < 2; ++h) { noffA[h][0] = offA[h][0]; noffA[h][1] = offA[h][1]; } } }
#pragma unroll
                for (int h = 0; h < 2; ++h) { o2[h][0] = last ? noffA[h][0] : offA[h][0]; o2[h][1] = last ? noffA[h][1] : offA[h][1]; }
            } else {
#pragma unroll
                for (int h = 0; h < 2; ++h) { o2[h][0] = offA[h][0]; o2[h][1] = offA[h][1]; }
            }
            PG8_LDB(B0, 0, 0); PG8_LDB(B1, 0, 1); PG8_SCHED; PG8_LDA(At, 0, 0); PG8_STAGE(PG8_SA(1, 1), a1, offA[1]);
            PG8_WAIT_V(8); PG8_WAIT_L(0); PG8_BAR; PG8_MMA(0, 0, At, B0); PG8_MMA(0, 1, At, B1); PG8_BAR; PG8_SCHED;
            PG8_LDA(At, 0, 1); PG8_STAGE(PG8_SB(0, 0), b2, voffB); PG8_STAGE(PG8_SB(0, 1), b2 + hstep, voffB); PG8_STAGE(PG8_SA(0, 0), a2, o2[0]);
            PG8_WAIT_V(8); PG8_WAIT_L(0); PG8_BAR; PG8_MMA(1, 0, At, B0); PG8_MMA(1, 1, At, B1); PG8_BAR; PG8_SCHED;
            PG8_LDB(B0, 1, 0); PG8_LDB(B1, 1, 1); PG8_SCHED; PG8_LDA(At, 1, 0); PG8_STAGE(PG8_SA(0, 1), a2, o2[1]);
            PG8_WAIT_V(8); PG8_WAIT_L(0); PG8_BAR; PG8_MMA(0, 0, At, B0); PG8_MMA(0, 1, At, B1); PG8_BAR; PG8_SCHED;
            PG8_LDA(At, 1, 1); PG8_STAGE(PG8_SB(1, 0), b3, voffB); PG8_STAGE(PG8_SB(1, 1), b3 + hstep, voffB); PG8_STAGE(PG8_SA(1, 0), a3, o2[0]);
            PG8_WAIT_V(8); PG8_WAIT_L(0); PG8_BAR; PG8_MMA(1, 0, At, B0); PG8_MMA(1, 1, At, B1); PG8_BAR; PG8_SCHED;
        }
        if (wr == 0) PG8_BAR;
        E(acc, cur, wr, wc, fr, fq); S.done(cur);
        if (!has_next) break;
#pragma unroll
        for (int a = 0; a < 2; ++a)
#pragma unroll
            for (int b = 0; b < 2; ++b)
#pragma unroll
                for (int m = 0; m < 4; ++m)
#pragma unroll
                    for (int n = 0; n < 2; ++n) acc[a][b][m][n] = (f32x4){0.f, 0.f, 0.f, 0.f};
        cur = nxt; cA = nA; cB = nB; ++ui;
        if constexpr (GATHER) {
#pragma unroll
            for (int h = 0; h < 2; ++h) { offA[h][0] = noffA[h][0]; offA[h][1] = noffA[h][1]; } }
        if (wr == 1) PG8_BAR;
    }
    PG8_WAIT_V(0);
    PG8_BAR;
#undef PG8_SA
#undef PG8_SB
#undef PG8_STAGE
#undef PG8_LDA
#undef PG8_LDB
#undef PG8_MMA
#undef PG8_WAIT_V
#undef PG8_WAIT_L
#undef PG8_BAR
#undef PG8_SCHED
#undef PG8_AOFFS
}
}
#define GAS __attribute__((address_space(1)))
#define LAS __attribute__((address_space(3)))
typedef unsigned short bf16;
typedef unsigned v4u __attribute__((ext_vector_type(4)));
typedef float f32x4 __attribute__((ext_vector_type(4)));
typedef short bf16x8 __attribute__((ext_vector_type(8)));
typedef GAS unsigned gu32;
typedef GAS unsigned long long gu64;
#define RLX_AGENT __ATOMIC_RELAXED, __HIP_MEMORY_SCOPE_AGENT
#define LDS_WAIT() asm volatile("s_waitcnt lgkmcnt(0)" ::: "memory")
#define VM_WAIT() asm volatile("s_waitcnt vmcnt(0)" ::: "memory")
__device__ __forceinline__ unsigned long long rt() { return __builtin_amdgcn_s_memrealtime(); }
__device__ __forceinline__ unsigned f2bf(float f) { unsigned u = __builtin_bit_cast(unsigned, f); return (u + 0x7fffu + ((u >> 16) & 1u)) >> 16; }
__device__ __forceinline__ unsigned pk2(float lo, float hi) { return f2bf(lo) | (f2bf(hi) << 16); }

#define XB_TMO      128
#define XB_XCNT(j)  (256  + 64 * (j))
#define XB_XSUB(j)  (1280 + 64 * (j))
#define XB_XGEN(j)  (2304 + 64 * (j))
#define XB_TOP      3328
#define XB_TOPGEN   3392
#define XCD_BAR_WORDS 3456
#define XB_SPIN_CAP (1u << 18)

__device__ __forceinline__ unsigned xb_ld(unsigned* p)              { return __hip_atomic_load(p, __ATOMIC_RELAXED, __HIP_MEMORY_SCOPE_AGENT); }
__device__ __forceinline__ unsigned xb_add(unsigned* p, unsigned v) { return __hip_atomic_fetch_add(p, v, __ATOMIC_RELAXED, __HIP_MEMORY_SCOPE_AGENT); }
__device__ __forceinline__ unsigned xb_xcc_id() { return (unsigned)__builtin_amdgcn_s_getreg((3 << 11) | 20) & 0xFu; }
#define XB_SPIN(cond, bar) do { unsigned _sp = 0; while (cond) { __builtin_amdgcn_s_sleep(1); \
    if ((++_sp & 255u) == 0u) { if (xb_ld(&(bar)[XB_TMO])) break; if (_sp > XB_SPIN_CAP) { atomicAdd(&(bar)[XB_TMO], 1u); break; } } } } while (0)

struct XcdBarrier {
    unsigned* bar; unsigned x;
    volatile LAS unsigned* st;
};

__device__ __forceinline__ XcdBarrier xcd_barrier_post(unsigned* bar, volatile LAS unsigned* st) {
    XcdBarrier b; b.bar = bar; b.x = xb_xcc_id(); b.st = st;
    if (threadIdx.x == 0) (void)xb_add(&bar[XB_XCNT(b.x)], 1u);
    return b;
}
__device__ __forceinline__ void xcd_barrier_complete(unsigned* bar, unsigned x, unsigned& nloc, unsigned& nx) {
    const unsigned G = gridDim.x * gridDim.y * gridDim.z;
    unsigned sum, cnt, mine, sp = 0u;
    for (;;) {
        sum = 0u; cnt = 0u; mine = 0u;
#pragma unroll
        for (unsigned j = 0; j < 16; ++j) { const unsigned c = xb_ld(&bar[XB_XCNT(j)]); sum += c; cnt += (c > 0u) ? 1u : 0u; mine = (j == x) ? c : mine; }
        if (sum == G) break;
        __builtin_amdgcn_s_sleep(1);
        if ((++sp & 255u) == 0u) { if (xb_ld(&bar[XB_TMO])) break; if (sp > XB_SPIN_CAP) { atomicAdd(&bar[XB_TMO], 1u); break; } }
    }
    nloc = mine > 0u ? mine : 1u; nx = cnt > 0u ? cnt : 1u;
}

__device__ __forceinline__ void xcd_barrier(const XcdBarrier& b) {
    asm volatile("s_waitcnt vmcnt(0)" ::: "memory");
    __syncthreads();
    if (threadIdx.x == 0) {
        unsigned* bar = b.bar;
        __builtin_amdgcn_s_waitcnt(0);
        unsigned nloc = b.st[0], nx = b.st[1];
        if (nloc == 0u) { xcd_barrier_complete(bar, b.x, nloc, nx); b.st[0] = nloc; b.st[1] = nx; }
        const unsigned old = xb_add(&bar[XB_XSUB(b.x)], 1u);
        const unsigned gen = old / nloc;
        if (old + 1u == (gen + 1u) * nloc) {
            __builtin_amdgcn_fence(__ATOMIC_RELEASE, "agent");
            asm volatile("s_waitcnt vmcnt(0)" ::: "memory");
            const unsigned og = xb_add(&bar[XB_TOP], 1u);
            const unsigned tg = og / nx;
            if (og + 1u == (tg + 1u) * nx) xb_add(&bar[XB_TOPGEN], 1u);
            else XB_SPIN(xb_ld(&bar[XB_TOPGEN]) == tg, bar);
            __builtin_amdgcn_fence(__ATOMIC_ACQUIRE, "agent");
            xb_add(&bar[XB_XGEN(b.x)], 1u);
            asm volatile("s_waitcnt vmcnt(0)" ::: "memory");
        } else {
            XB_SPIN(xb_ld(&bar[XB_XGEN(b.x)]) == gen, bar);
            __builtin_amdgcn_fence(__ATOMIC_ACQUIRE, "agent");
            asm volatile("s_waitcnt vmcnt(0)" ::: "memory");
        }
    }
    __syncthreads();
}


constexpr int NWAVES = 8, NT = NWAVES * 64;
constexpr int D = 1024, BATCH = 8, SEQ = 4096, DEPTH = 2, GRIDW = 64, CTXL = 256, GWID = 256, HD = 64, NHEAD = 4;
constexpr int INC = 2048, NEXP = 16, MHID = 512;
constexpr int NLAT = BATCH * SEQ, NCTX = BATCH * CTXL, NROW = NLAT + NCTX;
constexpr float EPS = 1e-6f;
constexpr int UC_AV = 0, UC_AB = 256, UC_AC = 512, UC_P = 768, UC_Q = 1024, UC_K = 1280, UC_V = 1536, UC_F = 1792;

constexpr size_t MiB = 1u << 20;
constexpr size_t WS_CTL = 0, CTL_ZERO_BYTES = 65536;
constexpr size_t WS_MOD  = 1 * MiB;
constexpr size_t WS_PWT  = 1 * MiB + 768 * 1024;
constexpr size_t WS_INFO = 2 * MiB;
constexpr size_t WS_WIN  = 8 * MiB;
constexpr size_t WS_WOUT = 16 * MiB;
constexpr size_t WS_W13  = 20 * MiB;
constexpr size_t WS_W2   = 84 * MiB;
constexpr size_t WS_XC   = 116 * MiB;
constexpr size_t WS_H    = 124 * MiB;
constexpr size_t WS_U    = 192 * MiB;
constexpr size_t WS_S    = 328 * MiB;
constexpr size_t WS_END  = 472 * MiB;
constexpr size_t WS_KF   = WS_S;
constexpr size_t WS_VF   = WS_S + 28 * MiB;
constexpr size_t WS_KFC  = WS_S + 60 * MiB;
constexpr size_t WS_VFC  = WS_S + 61 * MiB;
constexpr size_t WS_Z    = WS_S + 64 * MiB;
constexpr size_t NZ = (size_t)BATCH * NHEAD * SEQ * HD;
constexpr size_t NZC = (size_t)BATCH * NHEAD * CTXL * HD;
constexpr int CAP = NROW;

constexpr int CW_CNT = 2048;
constexpr int CW_BAR = 4096;

constexpr int RING_OFF = 0, RING_BYTES = 131072;
constexpr int LDSCTL_OFF = RING_BYTES, MISC_OFF = LDSCTL_OFF + 320;
constexpr int TAB_OFF = RING_BYTES + 1024;
constexpr int LDS_BYTES = 147456;

struct Frame {
    LAS unsigned char* lds;
    volatile LAS unsigned* MISC;
    gu32* ctl;
    int tid, lane, wave, G, bid;
    float* out; unsigned char* ws;
    static __device__ __forceinline__ const void* karg(int off) {
        const __attribute__((address_space(4))) char* ka = (const __attribute__((address_space(4))) char*)__builtin_amdgcn_kernarg_segment_ptr();
        asm volatile("" : "+s"(ka));
        return *(const void* const __attribute__((address_space(4)))*)(ka + off);
    }
    __device__ __forceinline__ const float* inp(int i) const { return (const float*)karg(8 * i); }
};
extern __shared__ __attribute__((aligned(16))) unsigned char dyn_lds[];
__device__ __forceinline__ Frame mk_frame() {
    Frame F; int t_ = threadIdx.x; asm volatile("" : "+v"(t_));
    F.tid = t_; F.lane = F.tid & 63; F.wave = __builtin_amdgcn_readfirstlane(F.tid >> 6); F.G = gridDim.x; F.bid = blockIdx.x;
    F.lds = (LAS unsigned char*)dyn_lds; F.MISC = (volatile LAS unsigned*)(F.lds + MISC_OFF);
    F.out = (float*)Frame::karg(160); F.ws = (unsigned char*)Frame::karg(168); F.ctl = (gu32*)(F.ws + WS_CTL);
    return F;
}
enum { I_X = 0, I_C, I_CTX, I_CCTX, I_ADAW, I_ADAB, I_N1G, I_N2G, I_WIN, I_CONVW, I_POOLW, I_POOLS, I_RPB, I_WOUT, I_RW, I_RB, I_W1, I_W3, I_W2, I_FG };

__device__ __forceinline__ float wave_sum(float v) {
#pragma unroll
    for (int o = 1; o < 64; o <<= 1) v += __shfl_xor(v, o);
    return v;
}
__device__ __forceinline__ float bflo(unsigned w) { return __builtin_bit_cast(float, w << 16); }
__device__ __forceinline__ float bfhi(unsigned w) { return __builtin_bit_cast(float, w & 0xffff0000u); }
__device__ __forceinline__ float bf2f(bf16 b) { return __builtin_bit_cast(float, (unsigned)b << 16); }

__device__ __forceinline__ void tr_item(const float* W, int K, int N, bf16* WT, int k0, int n0, int drow0, LAS float* scr, int lane) {
#pragma unroll 8
    for (int i = 0; i < 32; ++i) { const int kk = 2 * i + (lane >> 5); scr[kk * 33 + (lane & 31)] = W[(size_t)(k0 + kk) * N + n0 + (lane & 31)]; }
    LDS_WAIT(); asm volatile("" ::: "memory");
    const int c = lane & 7;
#pragma unroll
    for (int j = 0; j < 4; ++j) { const int n = (lane >> 3) + 8 * j; const LAS float* s = scr + (8 * c) * 33 + n;
        v4u o; o.x = pk2(s[0 * 33], s[1 * 33]); o.y = pk2(s[2 * 33], s[3 * 33]); o.z = pk2(s[4 * 33], s[5 * 33]); o.w = pk2(s[6 * 33], s[7 * 33]);
        *(GAS v4u*)(WT + (size_t)(drow0 + n) * K + k0 + 8 * c) = o; }
    LDS_WAIT(); asm volatile("" ::: "memory");
}
__device__ __forceinline__ void pa_phase() { Frame F = mk_frame();
    LAS float* scr = (LAS float*)(F.lds + RING_OFF + F.wave * 16384);
    const int gw = F.bid * NWAVES + F.wave, NGW = F.G * NWAVES;
    bf16* WIN = (bf16*)(F.ws + WS_WIN); bf16* WOUT = (bf16*)(F.ws + WS_WOUT); bf16* W13 = (bf16*)(F.ws + WS_W13); bf16* W2 = (bf16*)(F.ws + WS_W2);
    constexpr int I_IN = 2 * 16 * 64, I_OUT = 2 * 16 * 32, I_1 = 32 * 16 * 16, I_2 = 32 * 8 * 32;
    constexpr int NITEMS = I_IN + I_OUT + 2 * I_1 + I_2;
    for (int it = gw; it < NITEMS; it += NGW) {
        int r = it;
        if (r < I_IN) { const int l = r / 1024, q = r % 1024, kb = q / 64, nb = q % 64;
            tr_item(F.inp(I_WIN) + (size_t)l * D * INC, D, INC, WIN + (size_t)l * INC * D, 64 * kb, 32 * nb, 32 * nb, scr, F.lane); continue; } r -= I_IN;
        if (r < I_OUT) { const int l = r / 512, q = r % 512, kb = q / 32, nb = q % 32;
            tr_item(F.inp(I_WOUT) + (size_t)l * D * D, D, D, WOUT + (size_t)l * D * D, 64 * kb, 32 * nb, 32 * nb, scr, F.lane); continue; } r -= I_OUT;
        if (r < 2 * I_1) { const int which = r / I_1; const int q0 = r % I_1; const int le = q0 / 256, q = q0 % 256, kb = q / 16, nb = q % 16;
            const int n0 = 32 * nb; const int drow0 = 256 * (n0 / 128) + 128 * which + (n0 % 128);
            tr_item(F.inp(which ? I_W3 : I_W1) + (size_t)le * D * MHID, D, MHID, W13 + (size_t)le * 1024 * D, 64 * kb, n0, drow0, scr, F.lane); continue; } r -= 2 * I_1;
        { const int le = r / 256, q = r % 256, kb = q / 32, nb = q % 32;
            tr_item(F.inp(I_W2) + (size_t)le * MHID * D, MHID, D, W2 + (size_t)le * D * MHID, 64 * kb, 32 * nb, 32 * nb, scr, F.lane); }
    }
    { bf16* PWT = (bf16*)(F.ws + WS_PWT); const float* pw = F.inp(I_POOLW);
      for (int i = F.bid * NT + F.tid; i < 2 * 4 * 64 * 64; i += F.G * NT) { const int c = i & 63, dd = (i >> 6) & 63, lg = i >> 12; PWT[i] = (bf16)f2bf(pw[((size_t)lg * 64 + c) * 64 + dd]); } }
    __syncthreads();
    LAS float* sc = (LAS float*)(F.lds + RING_OFF);
    LAS float* part = (LAS float*)(F.lds + RING_OFF + 40960);
    float* MOD = (float*)(F.ws + WS_MOD);
    bool have_sc = false;
    for (int it = F.bid; it < 2 * 96; it += F.G) {
        if (!have_sc) { for (int i = F.tid; i < 9 * 1024; i += NT) { const float v = i < 8192 ? F.inp(I_C)[i] : F.inp(I_CCTX)[i - 8192]; sc[i] = v / (1.0f + __expf(-v)); } have_sc = true; }
        __syncthreads();
        const int l = it / 96, cb = it % 96, col = cb * 64 + F.lane;
        const float* aw = F.inp(I_ADAW) + (size_t)l * D * 6144 + col;
        float acc[9];
#pragma unroll
        for (int r = 0; r < 9; ++r) acc[r] = 0.f;
        for (int k = F.wave * 128; k < F.wave * 128 + 128; ++k) { const float wv = aw[(size_t)k * 6144];
#pragma unroll
            for (int r = 0; r < 9; ++r) acc[r] += sc[r * 1024 + k] * wv; }
#pragma unroll
        for (int r = 0; r < 9; ++r) part[(F.wave * 9 + r) * 64 + F.lane] = acc[r];
        __syncthreads();
        for (int i = F.tid; i < 9 * 64; i += NT) { const int r = i >> 6, ln = i & 63; float s = F.inp(I_ADAB)[(size_t)l * 6144 + cb * 64 + ln];
#pragma unroll
            for (int w = 0; w < 8; ++w) s += part[(w * 9 + r) * 64 + ln];
            MOD[((size_t)l * 9 + r) * 6144 + cb * 64 + ln] = s; }
        __syncthreads();
    }
}

struct RowIn { f32x4 x[4]; unsigned long long ya[4], yb[4]; };
template <bool ADD>
__device__ __forceinline__ void row_load(Frame& F, int r, const float* xr, const bf16* Y2, RowIn& in) {
#pragma unroll
    for (int j = 0; j < 4; ++j) { const int c = 4 * F.lane + 256 * j; in.x[j] = *(const GAS f32x4*)(xr + c);
        if (ADD) { in.ya[j] = *(const GAS unsigned long long*)(Y2 + (size_t)r * 2048 + c); in.yb[j] = *(const GAS unsigned long long*)(Y2 + (size_t)r * 2048 + 1024 + c); } }
}
template <bool ADD, bool FINAL>
__device__ __forceinline__ void row_finish(Frame& F, int r, const RowIn& in, float* xw, const float* g, const float* modl, const float* modadd, int ch_sh, int ch_sc, bf16* dst, float* fout, f32x4 (&v)[4]) {
    const int modrow = r < NLAT ? (r >> 12) : 8;
    const float* mrow = modl + (size_t)modrow * 6144; const float* arow = modadd + (size_t)modrow * 6144;
    float ss = 0.f;
#pragma unroll
    for (int j = 0; j < 4; ++j) { const int c = 4 * F.lane + 256 * j; v[j] = in.x[j];
        if (ADD) { const f32x4 g2 = *(const GAS f32x4*)(arow + 5 * 1024 + c); const unsigned long long a = in.ya[j], b = in.yb[j];
            f32x4 ya, yb; ya.x = bflo((unsigned)a); ya.y = bfhi((unsigned)a); ya.z = bflo((unsigned)(a >> 32)); ya.w = bfhi((unsigned)(a >> 32));
            yb.x = bflo((unsigned)b); yb.y = bfhi((unsigned)b); yb.z = bflo((unsigned)(b >> 32)); yb.w = bfhi((unsigned)(b >> 32));
            v[j] = v[j] + g2 * (ya + yb);
            if (!FINAL) *(GAS f32x4*)(xw + c) = v[j]; }
        ss += (v[j].x * v[j].x + v[j].y * v[j].y) + (v[j].z * v[j].z + v[j].w * v[j].w); }
    ss = wave_sum(ss);
    const float rstd = 1.0f / sqrtf(ss * (1.0f / D) + EPS);
#pragma unroll
    for (int j = 0; j < 4; ++j) { const int c = 4 * F.lane + 256 * j; const f32x4 gv = *(const GAS f32x4*)(g + c);
        if (FINAL) { *(GAS f32x4*)(fout + c) = v[j] * rstd * gv; }
        else { const f32x4 scv = *(const GAS f32x4*)(mrow + ch_sc * 1024 + c), shv = *(const GAS f32x4*)(mrow + ch_sh * 1024 + c);
            v[j] = v[j] * rstd * gv * (scv + 1.0f) + shv;
            *(GAS unsigned long long*)(dst + c) = (unsigned long long)pk2(v[j].x, v[j].y) | ((unsigned long long)pk2(v[j].z, v[j].w) << 32); } }
}
template <bool ADD, bool FINAL>
__device__ __forceinline__ void norm_phase(Frame& F, const float* xlat, const float* xctx, float* wlat, float* wctx, int nrows, const float* g, const float* modl, const float* modadd, int ch_sh, int ch_sc, bf16* dst, const bf16* Y2, float* fout) {
    const int gw = F.bid * NWAVES + F.wave, NGW = F.G * NWAVES;
    int r = gw; if (r >= nrows) return;
    RowIn cur; row_load<ADD>(F, r, r < NLAT ? xlat + (size_t)r * D : xctx + (size_t)(r - NLAT) * D, Y2, cur);
    for (;;) {
        const int rn = r + NGW; const bool more = rn < nrows;
        RowIn nxt;
        if (more) row_load<ADD>(F, rn, rn < NLAT ? xlat + (size_t)rn * D : xctx + (size_t)(rn - NLAT) * D, Y2, nxt);
        float* xw = r < NLAT ? wlat + (size_t)r * D : wctx + (size_t)(r - NLAT) * D;
        f32x4 v[4];
        row_finish<ADD, FINAL>(F, r, cur, xw, g, modl, modadd, ch_sh, ch_sc, dst + (size_t)r * D, fout + (size_t)r * D, v);
        if (!more) break;
        cur = nxt; r = rn;
    }
}
__device__ __forceinline__ void route_phase(Frame& F, int l, const float* xlat, const float* xctx, int nrows, const float* g, const float* modl, bf16* dst, uint2* info, unsigned* cnt) {
    LAS int* lcnt = (LAS int*)(F.lds + RING_OFF); LAS int* lbase = lcnt + 16; LAS int* rec_e = lcnt + 32; LAS int* rec_p = rec_e + 512; LAS float* rec_w = (LAS float*)(rec_p + 512);
    const int rpb = (nrows + F.G - 1) / F.G;
    if (F.tid < 16) lcnt[F.tid] = 0;
    LAS float* WT = (LAS float*)(F.lds + RING_OFF + 16384);
    { const float* rwp = F.inp(I_RW); for (int i = F.tid; i < 1024 * 16; i += NT) { const int k = i >> 4, e = i & 15; WT[e * 1024 + k] = rwp[i]; } }
    __syncthreads();
    const float* rbp = F.inp(I_RB);
    RowIn cur; bool have = (F.wave < rpb) && (F.bid * rpb + F.wave < nrows);
    if (have) { const int r = F.bid * rpb + F.wave; row_load<false>(F, r, r < NLAT ? xlat + (size_t)r * D : xctx + (size_t)(r - NLAT) * D, nullptr, cur); }
    for (int i = F.wave; have; i += NWAVES) {
        const int r = F.bid * rpb + i;
        const int in_ = i + NWAVES, rn = F.bid * rpb + in_; const bool more = (in_ < rpb) && (rn < nrows);
        RowIn nxt;
        if (more) row_load<false>(F, rn, rn < NLAT ? xlat + (size_t)rn * D : xctx + (size_t)(rn - NLAT) * D, nullptr, nxt);
        f32x4 v[4];
        row_finish<false, false>(F, r, cur, nullptr, g, modl, modl, 3, 4, dst + (size_t)r * D, nullptr, v);
        float s16[16];
#pragma unroll
        for (int e = 0; e < 16; ++e) s16[e] = 0.f;
#pragma unroll
        for (int j = 0; j < 4; ++j)
#pragma unroll
            for (int e = 0; e < 16; ++e) { const f32x4 w4 = *(const LAS f32x4*)(WT + e * 1024 + 4 * F.lane + 256 * j); s16[e] += (v[j].x * w4.x + v[j].y * w4.y) + (v[j].z * w4.z + v[j].w * w4.w); }
        float bs[16];
#pragma unroll
        for (int e = 0; e < 16; ++e) { s16[e] = wave_sum(s16[e]); s16[e] = 1.0f / (1.0f + expf(-s16[e])); bs[e] = s16[e] + rbp[e]; }
        float best = -3.0e38f; int bg = 0;
#pragma unroll
        for (int gq = 0; gq < 4; ++gq) { const float a0 = bs[4 * gq], a1 = bs[4 * gq + 1], a2 = bs[4 * gq + 2], a3 = bs[4 * gq + 3];
            const float gs = fmaxf(fmaxf(fmaxf(a0 + a1, a0 + a2), fmaxf(a0 + a3, a1 + a2)), fmaxf(a1 + a3, a2 + a3));
            if (gs > best) { best = gs; bg = gq; } }
        float cb[4], cs[4];
#pragma unroll
        for (int ii = 0; ii < 4; ++ii) { cb[ii] = 0.f; cs[ii] = 0.f; }
#pragma unroll
        for (int gq = 0; gq < 4; ++gq)
#pragma unroll
            for (int ii = 0; ii < 4; ++ii) { cb[ii] = (gq == bg) ? bs[4 * gq + ii] : cb[ii]; cs[ii] = (gq == bg) ? s16[4 * gq + ii] : cs[ii]; }
        int i1 = 0; float b1 = cb[0], s1 = cs[0];
#pragma unroll
        for (int ii = 1; ii < 4; ++ii) if (cb[ii] > b1) { b1 = cb[ii]; s1 = cs[ii]; i1 = ii; }
        int i2 = -1; float b2 = -3.0e38f, s2 = 0.f;
#pragma unroll
        for (int ii = 0; ii < 4; ++ii) if (ii != i1 && cb[ii] > b2) { b2 = cb[ii]; s2 = cs[ii]; i2 = ii; }
        const float inv = 1.0f / (s1 + s2);
        const int e1 = 4 * bg + i1, e2 = 4 * bg + i2;
        if (F.lane == 0) { rec_e[2 * i] = e1; rec_p[2 * i] = atomicAdd((int*)&lcnt[e1], 1); rec_w[2 * i] = s1 * inv;
                           rec_e[2 * i + 1] = e2; rec_p[2 * i + 1] = atomicAdd((int*)&lcnt[e2], 1); rec_w[2 * i + 1] = s2 * inv; }
        have = more; cur = nxt;
    }
    __syncthreads();
    if (F.tid < 16) lbase[F.tid] = (int)__hip_atomic_fetch_add(cnt + F.tid, (unsigned)lcnt[F.tid], __ATOMIC_RELAXED, __HIP_MEMORY_SCOPE_AGENT);
    __syncthreads();
    for (int j = F.tid; j < 2 * rpb; j += NT) { const int r = F.bid * rpb + (j >> 1); if (r < nrows) { const int e = rec_e[j];
        info[(size_t)e * CAP + lbase[e] + rec_p[j]] = make_uint2((unsigned)(r * 2 + (j & 1)), __builtin_bit_cast(unsigned, rec_w[j])); } }
}
__device__ __forceinline__ void moe_table(Frame& F, int l) {
    LAS int* tab = (LAS int*)(F.lds + TAB_OFF);
    if (F.tid == 0) { int acc = 0; const unsigned* cnt = (const unsigned*)(F.ctl + CW_CNT + l * 16);
        for (int e = 0; e < 16; ++e) { const int n = (int)__hip_atomic_load(cnt + e, __ATOMIC_RELAXED, __HIP_MEMORY_SCOPE_AGENT); tab[e] = acc; tab[17 + e] = n; acc += (n + 255) >> 8; }
        tab[16] = acc; }
    __syncthreads();
}

__device__ __forceinline__ void seq_info(int r, int& base, int& t, int& L) {
    if (r < NLAT) { base = r & ~(SEQ - 1); t = r & (SEQ - 1); L = SEQ; } else { const int j = r - NLAT; base = NLAT + (j & ~(CTXL - 1)); t = j & (CTXL - 1); L = CTXL; }
}
typedef unsigned v2u __attribute__((ext_vector_type(2)));
__device__ __forceinline__ unsigned cvtpk(float lo, float hi) { unsigned r; asm volatile("v_cvt_pk_bf16_f32 %0, %1, %2" : "=v"(r) : "v"(lo), "v"(hi)); return r; }
__device__ __forceinline__ bf16x8 mk8(v2u a, v2u b) { v4u w; w.x = a.x; w.y = a.y; w.z = b.x; w.w = b.y; return __builtin_bit_cast(bf16x8, w); }
template <bool LAT>
__device__ __forceinline__ void kv_unit(Frame& F, int bh, int rq, LAS unsigned short* T) {
    const bf16* U = (const bf16*)(F.ws + WS_U);
    const int q = F.lane & 15, g = F.lane >> 4, h = bh & 3;
    const int urow0 = LAT ? ((bh >> 2) * SEQ + rq * 64) : (NLAT + (bh >> 2) * CTXL + rq * 64);
    bf16* kdst = LAT ? (bf16*)(F.ws + WS_KF) + ((size_t)(bh * 64 + rq) * 14) * 512 : (bf16*)(F.ws + WS_KFC) + ((size_t)(bh * 16 + rq * 4) * 2) * 512;
    bf16* vdst = LAT ? (bf16*)(F.ws + WS_VF) + ((size_t)(bh * 64 + rq) * 16) * 512 : (bf16*)(F.ws + WS_VFC) + ((size_t)(bh * 8 + rq * 2) * 4) * 512;
    { const bf16* src = U + (size_t)(urow0 + F.lane) * INC + UC_V + h * HD;
#pragma unroll
      for (int p = 0; p < 8; ++p) { const v4u w = *(const GAS v4u*)(src + 8 * p); LAS unsigned short* tp = T + (8 * p) * 72 + F.lane;
          tp[0 * 72] = (unsigned short)w.x; tp[1 * 72] = (unsigned short)(w.x >> 16); tp[2 * 72] = (unsigned short)w.y; tp[3 * 72] = (unsigned short)(w.y >> 16);
          tp[4 * 72] = (unsigned short)w.z; tp[5 * 72] = (unsigned short)(w.z >> 16); tp[6 * 72] = (unsigned short)w.w; tp[7 * 72] = (unsigned short)(w.w >> 16); } }
    constexpr int NK = LAT ? 7 : 4, KST = LAT ? 8 : 16;
#pragma unroll
    for (int sidx = 0; sidx < NK; ++sidx)
#pragma unroll
        for (int ks = 0; ks < 2; ++ks) { const v4u w = *(const GAS v4u*)(U + (size_t)(urow0 + KST * sidx + q) * INC + UC_K + h * HD + 32 * ks + 8 * g); *(GAS v4u*)(kdst + (size_t)(sidx * 2 + ks) * 512 + F.lane * 8) = w; }
    LDS_WAIT(); asm volatile("" ::: "memory");
    constexpr int NV = LAT ? 4 : 2;
#pragma unroll
    for (int w = 0; w < NV; ++w) { const int vst = LAT ? (w == 0 ? 0 : (w == 1 ? 8 : (w == 2 ? 24 : 32))) : 32 * w;
#pragma unroll
        for (int dt = 0; dt < 4; ++dt) { const LAS unsigned short* tp = T + (16 * dt + q) * 72 + vst + 4 * g; const v2u lo = *(const LAS v2u*)tp, hi = *(const LAS v2u*)(tp + 16);
            v4u o; o.x = lo.x; o.y = lo.y; o.z = hi.x; o.w = hi.y; *(GAS v4u*)(vdst + (size_t)(w * 4 + dt) * 512 + F.lane * 8) = o; } }
    LDS_WAIT(); asm volatile("" ::: "memory");
}
__device__ __forceinline__ void kv_prepass(Frame& F) {
    LAS unsigned short* T = (LAS unsigned short*)(F.lds + RING_OFF + F.wave * 16384);
    const int gw = F.bid * NWAVES + F.wave, NGW = F.G * NWAVES;
#pragma unroll 1
    for (int idx = gw; idx < 2048; idx += NGW) kv_unit<true>(F, idx >> 6, idx & 63, T);
#pragma unroll 1
    for (int idx = gw; idx < 128; idx += NGW) kv_unit<false>(F, idx >> 2, idx & 3, T);
}
template <bool LAT>
__device__ __forceinline__ void attn_unit(Frame& F, int l, int b, int h, int r, int cb, const LAS float* rpbs) {
    const bf16* U = (const bf16*)(F.ws + WS_U); bf16* Y = (bf16*)(F.ws + WS_H);
    const bf16* KF = (const bf16*)(F.ws + WS_KF); const bf16* VF = (const bf16*)(F.ws + WS_VF); const bf16* KFC = (const bf16*)(F.ws + WS_KFC); const bf16* VFC = (const bf16*)(F.ws + WS_VFC);
    const size_t bh = (size_t)(b * NHEAD + h);
    const int q = F.lane & 15, g = F.lane >> 4;
    constexpr int NT_ = LAT ? 32 : 16, NB = LAT ? 16 : 0;
    const int qrow = LAT ? (b * SEQ + r * GRIDW + cb * 16 + q) : (NLAT + b * CTXL + cb * 16 + q);
    const int r0 = r - 4 < 0 ? 0 : (r - 4 > 56 ? 56 : r - 4);
    const int wb = cb * 16 - 8 < 0 ? 0 : (cb * 16 - 8 > 32 ? 32 : cb * 16 - 8);
    bf16x8 qf[2];
#pragma unroll
    for (int ks = 0; ks < 2; ++ks) qf[ks] = *(const GAS bf16x8*)(U + (size_t)qrow * INC + UC_Q + h * HD + 32 * ks + 8 * g);
    f32x4 s[NT_];
#pragma unroll
    for (int t = 0; t < NT_; ++t) {
        const bf16* kp;
        if (t < NB) { const int kr = t >> 1, seg = t & 1; kp = KF + (((bh * 64 + (r0 + kr)) * 7 + ((wb >> 3) + 2 * seg)) * 2) * 512 + F.lane * 8; } else kp = KFC + ((bh * 16 + (t - NB)) * 2) * 512 + F.lane * 8;
        const bf16x8 k0 = *(const GAS bf16x8*)kp, k1 = *(const GAS bf16x8*)(kp + 512);
        f32x4 a = (f32x4){0.f, 0.f, 0.f, 0.f};
        a = __builtin_amdgcn_mfma_f32_16x16x32_bf16(k0, qf[0], a, 0, 0, 0);
        s[t] = __builtin_amdgcn_mfma_f32_16x16x32_bf16(k1, qf[1], a, 0, 0, 0);
    }
    float m = -3.0e38f;
    if (LAT) {
        const int cq = cb * 16 + q; const int c0 = cq - 8 < 0 ? 0 : (cq - 8 > 48 ? 48 : cq - 8);
        const LAS float* rp = rpbs + h * 15 * 31;
#pragma unroll
        for (int t = 0; t < NB; ++t) { const int kr = t >> 1, seg = t & 1; const int rrel = r0 + kr - r + 7;
#pragma unroll
            for (int i = 0; i < 4; ++i) { const int cc = wb + seg * 16 + 4 * g + i; const bool ok = (cc >= c0) && (cc < c0 + 16);
                int ci = cc - cq + 15; ci = ci < 0 ? 0 : (ci > 30 ? 30 : ci);
                const float bias = rp[rrel * 31 + ci];
                float v = s[t][i] * 0.125f + bias; v = ok ? v : -3.0e38f; s[t][i] = v; m = fmaxf(m, v); } }
    }
#pragma unroll
    for (int t = NB; t < NT_; ++t)
#pragma unroll
        for (int i = 0; i < 4; ++i) { const float v = s[t][i] * 0.125f; s[t][i] = v; m = fmaxf(m, v); }
    m = fmaxf(m, __shfl_xor(m, 16)); m = fmaxf(m, __shfl_xor(m, 32));
    float sum = 0.f;
#pragma unroll
    for (int t = 0; t < NT_; ++t)
#pragma unroll
        for (int i = 0; i < 4; ++i) { const float p = __expf(s[t][i] - m); s[t][i] = p; sum += p; }
    sum += __shfl_xor(sum, 16); sum += __shfl_xor(sum, 32);
    f32x4 o[4];
#pragma unroll
    for (int dt = 0; dt < 4; ++dt) o[dt] = (f32x4){0.f, 0.f, 0.f, 0.f};
#pragma unroll
    for (int kk = 0; kk < NT_ / 2; ++kk) {
        v4u pw; pw.x = cvtpk(s[2 * kk][0], s[2 * kk][1]); pw.y = cvtpk(s[2 * kk][2], s[2 * kk][3]); pw.z = cvtpk(s[2 * kk + 1][0], s[2 * kk + 1][1]); pw.w = cvtpk(s[2 * kk + 1][2], s[2 * kk + 1][3]);
        const bf16x8 pf = __builtin_bit_cast(bf16x8, pw);
        const bf16* vbase;
        if (2 * kk < NB) vbase = VF + (((bh * 64 + (r0 + kk)) * 4 + cb) * 4) * 512 + F.lane * 8; else vbase = VFC + ((bh * 8 + (kk - NB / 2)) * 4) * 512 + F.lane * 8;
#pragma unroll
        for (int dt = 0; dt < 4; ++dt) { const bf16x8 vf = *(const GAS bf16x8*)(vbase + dt * 512);
            o[dt] = __builtin_amdgcn_mfma_f32_16x16x32_bf16(vf, pf, o[dt], 0, 0, 0); }
    }
    const float inv = 1.0f / sum; bf16* yp = Y + (size_t)qrow * D + 512 + h * HD + 4 * g;
#pragma unroll
    for (int dt = 0; dt < 4; ++dt) { v2u w; w.x = cvtpk(o[dt][0] * inv, o[dt][1] * inv); w.y = cvtpk(o[dt][2] * inv, o[dt][3] * inv); *(GAS v2u*)(yp + dt * 16) = w; }
}
__device__ __forceinline__ void attn_phase(Frame& F, int l, bool with_ctx) {
    LAS float* rpbs = (LAS float*)(F.lds + TAB_OFF);
    { const float* rp = F.inp(I_RPB) + (size_t)l * NHEAD * 15 * 31; for (int i = F.tid; i < NHEAD * 15 * 31; i += NT) rpbs[i] = rp[i]; }
    __syncthreads();
    const int gw = F.bid * NWAVES + F.wave, NGW = F.G * NWAVES;
    {
        const int x = F.bid & 7, lb = F.bid >> 3, nlb = (F.G - x + 7) >> 3;
#pragma unroll 1
        for (int uu = lb * NWAVES + F.wave; uu < 1024; uu += nlb * NWAVES) { const int bh = 4 * x + (uu >> 8), u = uu & 255; attn_unit<true>(F, l, bh >> 2, bh & 3, u >> 2, u & 3, rpbs); } }
    if (with_ctx) for (int uid = gw; uid < BATCH * NHEAD * 16; uid += NGW) { const int cb = uid & 15, h = (uid >> 4) & 3, b = uid >> 6; attn_unit<false>(F, l, b, h, 0, cb, rpbs); }
}
__device__ __forceinline__ void dft64_tables(Frame& F, int off) {
    LAS unsigned short* CT = (LAS unsigned short*)(F.lds + off); LAS unsigned short* ST = CT + 64 * 72;
    for (int i = F.tid; i < 4096; i += NT) { const int j = i >> 6, k = i & 63; float s_, c_; sincospif((float)((j * k) & 63) * (1.0f / 32.0f), &s_, &c_); CT[j * 72 + k] = (unsigned short)f2bf(c_); ST[j * 72 + k] = (unsigned short)f2bf(s_); }
}
__device__ __forceinline__ void fourier_a(Frame& F) {
    const bf16* U = (const bf16*)(F.ws + WS_U); bf16* Zr = (bf16*)(F.ws + WS_Z); bf16* Zi = Zr + NZ;
    constexpr int O_CT = 0, O_TWC = 18432, O_TWS = O_TWC + 16384;
    dft64_tables(F, O_CT);
    { LAS float* twc = (LAS float*)(F.lds + O_TWC); LAS float* tws = (LAS float*)(F.lds + O_TWS);
      for (int i = F.tid; i < 4096; i += NT) { float s_, c_; sincospif((float)i * (1.0f / 2048.0f), &s_, &c_); twc[i] = c_; tws[i] = s_; } }
    __syncthreads();
    const LAS unsigned short* CT = (const LAS unsigned short*)(F.lds + O_CT); const LAS unsigned short* ST = CT + 64 * 72;
    const LAS float* twc = (const LAS float*)(F.lds + O_TWC); const LAS float* tws = (const LAS float*)(F.lds + O_TWS);
    const int q = F.lane & 15, g = F.lane >> 4;
    const int gw = F.bid * NWAVES + F.wave, NGW = F.G * NWAVES;
    for (int un = gw; un < BATCH * NHEAD * 64; un += NGW) {
        const int b = un >> 8, h = (un >> 6) & 3, n2 = un & 63;
        f32x4 xr[4][4], xw[4][4];
#pragma unroll
        for (int mt = 0; mt < 4; ++mt)
#pragma unroll
            for (int ct = 0; ct < 4; ++ct) { xr[mt][ct] = (f32x4){0.f, 0.f, 0.f, 0.f}; xw[mt][ct] = (f32x4){0.f, 0.f, 0.f, 0.f}; }
#pragma unroll
        for (int ks = 0; ks < 2; ++ks) {
            bf16x8 tf[4], cf[4], sf[4];
#pragma unroll
            for (int mt = 0; mt < 4; ++mt) tf[mt] = *(const GAS bf16x8*)(U + (size_t)(b * SEQ + 64 * (16 * mt + q) + n2) * INC + UC_F + h * HD + 32 * ks + 8 * g);
#pragma unroll
            for (int ct = 0; ct < 4; ++ct) { cf[ct] = *(const LAS bf16x8*)(CT + (16 * ct + q) * 72 + 32 * ks + 8 * g); sf[ct] = *(const LAS bf16x8*)(ST + (16 * ct + q) * 72 + 32 * ks + 8 * g); }
#pragma unroll
            for (int mt = 0; mt < 4; ++mt)
#pragma unroll
                for (int ct = 0; ct < 4; ++ct) { xr[mt][ct] = __builtin_amdgcn_mfma_f32_16x16x32_bf16(tf[mt], cf[ct], xr[mt][ct], 0, 0, 0); xw[mt][ct] = __builtin_amdgcn_mfma_f32_16x16x32_bf16(tf[mt], sf[ct], xw[mt][ct], 0, 0, 0); }
        }
        v4u ar[4][2], awn[4][2];
#pragma unroll
        for (int ct = 0; ct < 4; ++ct)
#pragma unroll
            for (int kb = 0; kb < 2; ++kb) {
                ar[ct][kb].x = cvtpk(xr[2 * kb][ct][0], xr[2 * kb][ct][1]); ar[ct][kb].y = cvtpk(xr[2 * kb][ct][2], xr[2 * kb][ct][3]);
                ar[ct][kb].z = cvtpk(xr[2 * kb + 1][ct][0], xr[2 * kb + 1][ct][1]); ar[ct][kb].w = cvtpk(xr[2 * kb + 1][ct][2], xr[2 * kb + 1][ct][3]);
                awn[ct][kb].x = cvtpk(-xw[2 * kb][ct][0], -xw[2 * kb][ct][1]); awn[ct][kb].y = cvtpk(-xw[2 * kb][ct][2], -xw[2 * kb][ct][3]);
                awn[ct][kb].z = cvtpk(-xw[2 * kb + 1][ct][0], -xw[2 * kb + 1][ct][1]); awn[ct][kb].w = cvtpk(-xw[2 * kb + 1][ct][2], -xw[2 * kb + 1][ct][3]); }
#pragma unroll
        for (int rt = 0; rt < 4; ++rt) {
            const int n1p = 16 * rt + q;
            bf16x8 cb_[2], sb_[2];
#pragma unroll
            for (int kb = 0; kb < 2; ++kb) { const LAS unsigned short* cp = CT + n1p * 72 + 32 * kb + 4 * g; const LAS unsigned short* sp = ST + n1p * 72 + 32 * kb + 4 * g;
                cb_[kb] = mk8(*(const LAS v2u*)cp, *(const LAS v2u*)(cp + 16)); sb_[kb] = mk8(*(const LAS v2u*)sp, *(const LAS v2u*)(sp + 16)); }
            const int tix = n2 * n1p; const float cw = twc[tix], sw = tws[tix];
            const size_t zbase = ((((size_t)(b * NHEAD + h) * 64 + n1p) * 64 + n2) * 64) + 4 * g;
#pragma unroll
            for (int ct = 0; ct < 4; ++ct) {
                f32x4 yr = (f32x4){0.f, 0.f, 0.f, 0.f}, yi = (f32x4){0.f, 0.f, 0.f, 0.f};
#pragma unroll
                for (int kb = 0; kb < 2; ++kb) {
                    const bf16x8 a_r = __builtin_bit_cast(bf16x8, ar[ct][kb]), a_wn = __builtin_bit_cast(bf16x8, awn[ct][kb]);
                    v4u nr = ar[ct][kb]; nr.x ^= 0x80008000u; nr.y ^= 0x80008000u; nr.z ^= 0x80008000u; nr.w ^= 0x80008000u; const bf16x8 a_rn = __builtin_bit_cast(bf16x8, nr);
                    yr = __builtin_amdgcn_mfma_f32_16x16x32_bf16(a_r, cb_[kb], yr, 0, 0, 0); yr = __builtin_amdgcn_mfma_f32_16x16x32_bf16(a_wn, sb_[kb], yr, 0, 0, 0);
                    yi = __builtin_amdgcn_mfma_f32_16x16x32_bf16(a_wn, cb_[kb], yi, 0, 0, 0); yi = __builtin_amdgcn_mfma_f32_16x16x32_bf16(a_rn, sb_[kb], yi, 0, 0, 0); }
                v2u wr_, wi_;
                wr_.x = cvtpk(yr[0] * cw + yi[0] * sw, yr[1] * cw + yi[1] * sw); wr_.y = cvtpk(yr[2] * cw + yi[2] * sw, yr[3] * cw + yi[3] * sw);
                wi_.x = cvtpk(yi[0] * cw - yr[0] * sw, yi[1] * cw - yr[1] * sw); wi_.y = cvtpk(yi[2] * cw - yr[2] * sw, yi[3] * cw - yr[3] * sw);
                *(GAS v2u*)(Zr + zbase + 16 * ct) = wr_; *(GAS v2u*)(Zi + zbase + 16 * ct) = wi_;
            }
        }
    }
}
__device__ __forceinline__ void fourier_b(Frame& F, bool with_ctx) {
    bf16* Y = (bf16*)(F.ws + WS_H); const bf16* Zr = (const bf16*)(F.ws + WS_Z);
    dft64_tables(F, 0);
    __syncthreads();
    const LAS unsigned short* CT = (const LAS unsigned short*)(F.lds); const LAS unsigned short* ST = CT + 64 * 72;
    LAS unsigned short* ZT = (LAS unsigned short*)(F.lds + 18432 + F.wave * 9216);
    const int q = F.lane & 15, g = F.lane >> 4;
    const int gw = F.bid * NWAVES + F.wave, NGW = F.G * NWAVES;
    const int nun = BATCH * NHEAD * 64 + (with_ctx ? BATCH * NHEAD * 4 : 0);
    for (int un = gw; un < nun; un += NGW) {
        const bool lat = un < BATCH * NHEAD * 64; const int uc = un - BATCH * NHEAD * 64;
        const int b = lat ? (un >> 8) : (uc >> 4), h = lat ? ((un >> 6) & 3) : ((uc >> 2) & 3), n1p = lat ? (un & 63) : (uc & 3);
        const size_t z0 = lat ? (((size_t)(b * NHEAD + h) * 64 + n1p) * 64) * 64 : 2 * NZ + (((size_t)(b * NHEAD + h) * 4 + n1p) * 64) * 64;
        const size_t zim = lat ? NZ : NZC;
        const int tok0 = lat ? (b * SEQ + n1p) : (NLAT + b * CTXL + n1p), tstride = lat ? 64 : 4; const float oscale = lat ? (1.0f / 512.0f) : (1.0f / 128.0f);
        f32x4 acc[4][4];
#pragma unroll
        for (int ct = 0; ct < 4; ++ct)
#pragma unroll
            for (int nt = 0; nt < 4; ++nt) acc[ct][nt] = (f32x4){0.f, 0.f, 0.f, 0.f};
#pragma unroll
        for (int comp = 0; comp < 2; ++comp) {
            const bf16* zp = Zr + z0 + (comp ? zim : 0); const LAS unsigned short* FT = comp ? ST : CT;
#pragma unroll
            for (int i = 0; i < 8; ++i) { const int p = F.lane + 64 * i, n2 = p >> 3, c8 = p & 7; const v4u w = *(const GAS v4u*)(zp + (size_t)n2 * 64 + 8 * c8); LAS unsigned short* tp = ZT + (8 * c8) * 72 + n2;
                tp[0 * 72] = (unsigned short)w.x; tp[1 * 72] = (unsigned short)(w.x >> 16); tp[2 * 72] = (unsigned short)w.y; tp[3 * 72] = (unsigned short)(w.y >> 16);
                tp[4 * 72] = (unsigned short)w.z; tp[5 * 72] = (unsigned short)(w.z >> 16); tp[6 * 72] = (unsigned short)w.w; tp[7 * 72] = (unsigned short)(w.w >> 16); }
            LDS_WAIT(); asm volatile("" ::: "memory");
#pragma unroll
            for (int ks = 0; ks < 2; ++ks) {
                bf16x8 af[4], bf_[4];
#pragma unroll
                for (int ct = 0; ct < 4; ++ct) af[ct] = *(const LAS bf16x8*)(ZT + (16 * ct + q) * 72 + 32 * ks + 8 * g);
#pragma unroll
                for (int nt = 0; nt < 4; ++nt) bf_[nt] = *(const LAS bf16x8*)(FT + (16 * nt + q) * 72 + 32 * ks + 8 * g);
#pragma unroll
                for (int ct = 0; ct < 4; ++ct)
#pragma unroll
                    for (int nt = 0; nt < 4; ++nt) acc[ct][nt] = __builtin_amdgcn_mfma_f32_16x16x32_bf16(af[ct], bf_[nt], acc[ct][nt], 0, 0, 0);
            }
            LDS_WAIT(); asm volatile("" ::: "memory");
        }
#pragma unroll
        for (int nt = 0; nt < 4; ++nt) { bf16* yp = Y + (size_t)(tok0 + tstride * (16 * nt + q)) * D + 768 + h * HD + 4 * g;
#pragma unroll
            for (int ct = 0; ct < 4; ++ct) { v2u w; w.x = cvtpk(acc[ct][nt][0] * oscale, acc[ct][nt][1] * oscale); w.y = cvtpk(acc[ct][nt][2] * oscale, acc[ct][nt][3] * oscale); *(GAS v2u*)(yp + 16 * ct) = w; } }
    }
}
__device__ __forceinline__ v4u mul_bf8(v4u a, v4u b) { v4u r; r.x = cvtpk(bflo(a.x) * bflo(b.x), bfhi(a.x) * bfhi(b.x)); r.y = cvtpk(bflo(a.y) * bflo(b.y), bfhi(a.y) * bfhi(b.y)); r.z = cvtpk(bflo(a.z) * bflo(b.z), bfhi(a.z) * bfhi(b.z)); r.w = cvtpk(bflo(a.w) * bflo(b.w), bfhi(a.w) * bfhi(b.w)); return r; }
__device__ __forceinline__ void convpool_phase(Frame& F, int l, int nrows) {
    const bf16* U = (const bf16*)(F.ws + WS_U); bf16* Y = (bf16*)(F.ws + WS_H);
    const bf16* PWT = (const bf16*)(F.ws + WS_PWT) + (size_t)l * 4 * 64 * 64;
    const float* cw = F.inp(I_CONVW) + (size_t)l * 3 * GWID; const float* ps = F.inp(I_POOLS) + (size_t)l * GWID;
    LAS unsigned* PX = (LAS unsigned*)(F.lds + RING_OFF);
    LAS unsigned* DT = (LAS unsigned*)(F.lds + RING_OFF + 40960);
    const int q = F.lane & 15, g = F.lane >> 4;
    for (int tile = F.bid; tile < nrows / 64; tile += F.G) {
        const int r0 = tile * 64; int base, t0, L; seq_info(r0, base, t0, L);
#pragma unroll
        for (int i = 0; i < 4; ++i) { const int p = F.tid + NT * i, tr = p >> 5, c8 = p & 31, t = t0 + tr; const bf16* ur = U + (size_t)(r0 + tr) * INC + 8 * c8;
            const v4u zc = mul_bf8(*(const GAS v4u*)(ur + UC_AC), *(const GAS v4u*)(ur + UC_AV));
            v4u zp = (v4u){0u, 0u, 0u, 0u}, zn = (v4u){0u, 0u, 0u, 0u};
            if (t > 0) zp = mul_bf8(*(const GAS v4u*)(ur + UC_AC - INC), *(const GAS v4u*)(ur + UC_AV - INC));
            if (t < L - 1) zn = mul_bf8(*(const GAS v4u*)(ur + UC_AC + INC), *(const GAS v4u*)(ur + UC_AV + INC));
            const v4u ab = *(const GAS v4u*)(ur + UC_AB);
            const f32x4 w0a = *(const GAS f32x4*)(cw + 8 * c8), w0b = *(const GAS f32x4*)(cw + 8 * c8 + 4), w1a = *(const GAS f32x4*)(cw + GWID + 8 * c8), w1b = *(const GAS f32x4*)(cw + GWID + 8 * c8 + 4),
                        w2a = *(const GAS f32x4*)(cw + 2 * GWID + 8 * c8), w2b = *(const GAS f32x4*)(cw + 2 * GWID + 8 * c8 + 4);
            v4u o;
            o.x = cvtpk(bflo(ab.x) * (w0a.x * bflo(zp.x) + w1a.x * bflo(zc.x) + w2a.x * bflo(zn.x)), bfhi(ab.x) * (w0a.y * bfhi(zp.x) + w1a.y * bfhi(zc.x) + w2a.y * bfhi(zn.x)));
            o.y = cvtpk(bflo(ab.y) * (w0a.z * bflo(zp.y) + w1a.z * bflo(zc.y) + w2a.z * bflo(zn.y)), bfhi(ab.y) * (w0a.w * bfhi(zp.y) + w1a.w * bfhi(zc.y) + w2a.w * bfhi(zn.y)));
            o.z = cvtpk(bflo(ab.z) * (w0b.x * bflo(zp.z) + w1b.x * bflo(zc.z) + w2b.x * bflo(zn.z)), bfhi(ab.z) * (w0b.y * bfhi(zp.z) + w1b.y * bfhi(zc.z) + w2b.y * bfhi(zn.z)));
            o.w = cvtpk(bflo(ab.w) * (w0b.z * bflo(zp.w) + w1b.z * bflo(zc.w) + w2b.z * bflo(zn.w)), bfhi(ab.w) * (w0b.w * bfhi(zp.w) + w1b.w * bfhi(zc.w) + w2b.w * bfhi(zn.w)));
            *(GAS v4u*)(Y + (size_t)(r0 + tr) * D + 8 * c8) = o; }
#pragma unroll
        for (int i = 0; i < 5; ++i) { const int p = F.tid + NT * i, rr = p >> 5, c8 = p & 31, t = t0 - 8 + rr; v4u w = (v4u){0u, 0u, 0u, 0u};
            if (t >= 0 && t < L) w = *(const GAS v4u*)(U + (size_t)(base + t) * INC + UC_P + 8 * c8);
            *(LAS v4u*)(PX + rr * 128 + 4 * c8) = w; }
        __syncthreads();
        { const int c2 = F.tid & 127, tq = F.tid >> 7, hw = 1 << (c2 >> 5);
          float s0 = 0.f, s1 = 0.f;
          for (int k = -hw; k < hw; ++k) { const unsigned w = PX[(16 * tq + 8 + k) * 128 + c2]; s0 += bflo(w); s1 += bfhi(w); }
          for (int i = 0; i < 16; ++i) { const int tl = 16 * tq + i, t = t0 + tl;
              const int lo = t - hw > 0 ? t - hw : 0, hi = t + hw < L ? t + hw : L; const float rc = 1.0f / (float)(hi - lo);
              const unsigned xc = PX[(tl + 8) * 128 + c2];
              DT[tl * 132 + c2] = cvtpk(s0 * rc - bflo(xc), s1 * rc - bfhi(xc));
              const unsigned wa = PX[(tl + 8 + hw) * 128 + c2], wsb = PX[(tl + 8 - hw) * 128 + c2];
              s0 += bflo(wa) - bflo(wsb); s1 += bfhi(wa) - bfhi(wsb); } }
        __syncthreads();
        { const int gi = F.wave & 3;
          bf16x8 wf[4][2];
#pragma unroll
          for (int dt = 0; dt < 4; ++dt)
#pragma unroll
              for (int ks = 0; ks < 2; ++ks) wf[dt][ks] = *(const GAS bf16x8*)(PWT + ((size_t)gi * 64 + 16 * dt + q) * 64 + 32 * ks + 8 * g);
#pragma unroll
          for (int tj = 0; tj < 2; ++tj) { const int tt = 2 * (F.wave >> 2) + tj;
              bf16x8 df[2];
#pragma unroll
              for (int ks = 0; ks < 2; ++ks) df[ks] = *(const LAS bf16x8*)(DT + (16 * tt + q) * 132 + gi * 32 + 16 * ks + 4 * g);
#pragma unroll
              for (int dt = 0; dt < 4; ++dt) { f32x4 a = (f32x4){0.f, 0.f, 0.f, 0.f};
                  a = __builtin_amdgcn_mfma_f32_16x16x32_bf16(wf[dt][0], df[0], a, 0, 0, 0); a = __builtin_amdgcn_mfma_f32_16x16x32_bf16(wf[dt][1], df[1], a, 0, 0, 0);
                  const int oc = gi * 64 + 16 * dt + 4 * g; const f32x4 sc = *(const GAS f32x4*)(ps + oc);
                  v2u w; w.x = cvtpk(a[0] * sc.x, a[1] * sc.y); w.y = cvtpk(a[2] * sc.z, a[3] * sc.w);
                  *(GAS v2u*)(Y + (size_t)(r0 + 16 * tt + q) * D + 256 + oc) = w; } } }
        __syncthreads();
    }
}

__device__ __forceinline__ void fourier_ctx_a(Frame& F) {
    const bf16* U = (const bf16*)(F.ws + WS_U); bf16* Zc = (bf16*)(F.ws + WS_Z) + 2 * NZ;
    LAS float* cs = (LAS float*)(F.lds + TAB_OFF); LAS float* sn = cs + 64; LAS float* cs256 = cs + 128; LAS float* sn256 = cs + 384;
    if (F.tid < 64) { float s_, c_; sincospif((float)F.tid * (1.0f / 32.0f), &s_, &c_); cs[F.tid] = c_; sn[F.tid] = s_; }
    if (F.tid < 256) { float s_, c_; sincospif((float)F.tid * (1.0f / 128.0f), &s_, &c_); cs256[F.tid] = c_; sn256[F.tid] = s_; }
    __syncthreads();
    for (int item = F.bid * NT + F.tid; item < BATCH * NHEAD * 64 * 64; item += F.G * NT) {
        const int cp = item & 63, n2 = (item >> 6) & 63, h = (item >> 12) & 3, b = item >> 14;
        float xr[4], xi[4];
#pragma unroll
        for (int n1 = 0; n1 < 4; ++n1) { xr[n1] = 0.f; xi[n1] = 0.f; }
        for (int c8 = 0; c8 < 8; ++c8) {
            float cc[8], ss[8];
#pragma unroll
            for (int e = 0; e < 8; ++e) { const int idx = ((8 * c8 + e) * cp) & 63; cc[e] = cs[idx]; ss[e] = sn[idx]; }
#pragma unroll
            for (int n1 = 0; n1 < 4; ++n1) { const v4u w = *(const GAS v4u*)(U + (size_t)(NLAT + b * CTXL + 64 * n1 + n2) * INC + UC_F + h * HD + 8 * c8);
                const float f0 = bflo(w.x), f1 = bfhi(w.x), f2 = bflo(w.y), f3 = bfhi(w.y), f4 = bflo(w.z), f5 = bfhi(w.z), f6 = bflo(w.w), f7 = bfhi(w.w);
                xr[n1] += f0 * cc[0] + f1 * cc[1] + f2 * cc[2] + f3 * cc[3] + f4 * cc[4] + f5 * cc[5] + f6 * cc[6] + f7 * cc[7];
                xi[n1] -= f0 * ss[0] + f1 * ss[1] + f2 * ss[2] + f3 * ss[3] + f4 * ss[4] + f5 * ss[5] + f6 * ss[6] + f7 * ss[7]; }
        }
        float yr[4], yi[4];
        yr[0] = xr[0] + xr[1] + xr[2] + xr[3];           yi[0] = xi[0] + xi[1] + xi[2] + xi[3];
        yr[1] = xr[0] + xi[1] - xr[2] - xi[3];           yi[1] = xi[0] - xr[1] - xi[2] + xr[3];
        yr[2] = xr[0] - xr[1] + xr[2] - xr[3];           yi[2] = xi[0] - xi[1] + xi[2] - xi[3];
        yr[3] = xr[0] - xi[1] - xr[2] + xi[3];           yi[3] = xi[0] + xr[1] - xi[2] - xr[3];
#pragma unroll
        for (int k = 0; k < 4; ++k) { const int tix = (n2 * k) & 255; const float cw = cs256[tix], sw = sn256[tix];
            const size_t zi = ((((size_t)(b * NHEAD + h) * 4 + k) * 64 + n2) * 64) + cp;
            Zc[zi] = (bf16)f2bf(yr[k] * cw + yi[k] * sw); Zc[NZC + zi] = (bf16)f2bf(yi[k] * cw - yr[k] * sw); }
    }
}

#ifndef REP_ATT
#define REP_ATT 1
#endif
#ifndef REP_FB
#define REP_FB 1
#endif
__device__ __forceinline__ void mixa_phase(int l, bool with_ctx) { Frame F = mk_frame();
    const int nrows = with_ctx ? NROW : NLAT;
    convpool_phase(F, l, nrows);
    kv_prepass(F);
    __syncthreads();
    fourier_a(F);
    __syncthreads();
    if (with_ctx) fourier_ctx_a(F);
}
__device__ __forceinline__ void mixb_phase(int l, bool with_ctx) { Frame F = mk_frame();
    attn_phase(F, l, with_ctx);
    __syncthreads();
#if REP_ATT > 1
    attn_phase(F, l, with_ctx);
    __syncthreads();
#endif
    fourier_b(F, with_ctx);
#if REP_FB > 1
    __syncthreads();
    fourier_b(F, with_ctx);
#endif
}

struct WinOrder {
    int G, c, nctx_cols, ctx_pn0;
    __device__ __forceinline__ bool next(int i, pg8::Unit& u) const {
        const long L = (long)i * G + c; const int nlatu = 1024, total = nlatu + 8 * nctx_cols; if (L >= total) return false;
        if (L < nlatu) { int wgid = (int)L; { const int xcd = wgid % 8, off = wgid / 8; wgid = xcd * 128 + off; }
            const int gid = wgid / 64, fm = gid * 8; u.pm = fm + ((wgid % 64) % 8); u.pn = (wgid % 64) / 8; }
        else { const int j = (int)L - nlatu; u.pm = 128 + (j % 8); u.pn = ctx_pn0 + j / 8; }
        u.pb = u.pn; u.lb = 0; u.nv = 256; return true;
    }
    __device__ __forceinline__ void a_ready(const pg8::Unit&) const {}
    __device__ __forceinline__ void done(const pg8::Unit&) const {}
    __device__ __forceinline__ int row_of(const pg8::Unit&, int i) const { return i; }
};

struct Args { const float* in[20]; float* out; unsigned char* ws; int l, e; };
#define PH_PTRS() \
    bf16* H = (bf16*)(F.ws + WS_H); bf16* U = (bf16*)(F.ws + WS_U); bf16* HE = (bf16*)(F.ws + WS_U); bf16* Y2 = (bf16*)(F.ws + WS_S); \
    float* MOD = (float*)(F.ws + WS_MOD); float* XC = (float*)(F.ws + WS_XC); const uint2* INFO = (const uint2*)(F.ws + WS_INFO); \
    const bool first = (l == 0); const int M = first ? NROW : NLAT; const float* modl = MOD + (size_t)l * 9 * 6144; \
    (void)H; (void)U; (void)HE; (void)XC; (void)Y2; (void)INFO; (void)M; (void)modl;

__device__ __forceinline__ void ph_norm1(int l) { Frame F = mk_frame(); PH_PTRS();
    norm_phase<false, false>(F, F.inp(I_X), F.inp(I_CTX), nullptr, nullptr, NROW, F.inp(I_N1G), modl, modl, 0, 1, H, nullptr, nullptr); }
__device__ __forceinline__ void ph_next(int l, bool probe = false) { Frame F = mk_frame(); PH_PTRS();
    if (first) norm_phase<true, false>(F, F.out, XC, probe ? (float*)(F.ws + WS_U) : F.out, probe ? (float*)(F.ws + WS_U) + (size_t)NLAT * D : XC, NROW, F.inp(I_N1G) + D, MOD + (size_t)9 * 6144, modl, 0, 1, H, Y2, nullptr);
    else norm_phase<true, true>(F, F.out, XC, F.out, XC, NLAT, F.inp(I_FG), modl, modl, 0, 0, nullptr, Y2, F.out); }
__device__ __forceinline__ void ph_route(int l, bool probe = false) { Frame F = mk_frame(); PH_PTRS();
    route_phase(F, l, F.out, XC, M, F.inp(I_N2G) + (size_t)l * D, modl, H, probe ? (uint2*)(F.ws + WS_U) : (uint2*)(F.ws + WS_INFO), (unsigned*)(F.ctl + CW_CNT + (probe ? 32 : 0) + l * 16)); }
__device__ __forceinline__ void ph_win(int l) { Frame F = mk_frame(); PH_PTRS();
    pg8::Gemm g{H, (const bf16*)(F.ws + WS_WIN) + (size_t)l * INC * D, NROW, INC, D};
    WinOrder S{F.G, F.bid, first ? 8 : 2, first ? 0 : 5};
    pg8::EpiBf16 E{U, INC};
    pg8::gemm_phase<pg8::EpiBf16, WinOrder>(F.lds + RING_OFF, g, S, E); }
__device__ __forceinline__ void ph_wout(int l) { Frame F = mk_frame(); PH_PTRS();
    pg8::Gemm g{H, (const bf16*)(F.ws + WS_WOUT) + (size_t)l * D * D, M, D, D};
    pg8::StaticOrder S; S.init(M, D, F.G, F.bid);
    const float* xlat_in = first ? F.inp(I_X) : F.out; const float* xctx_in = first ? F.inp(I_CTX) : XC;
    pg8::EpiResid E{xlat_in, xctx_in, F.out, XC, modl + 2 * 1024, 6144, nullptr, 0, NLAT, SEQ};
    pg8::gemm_phase<pg8::EpiResid, pg8::StaticOrder>(F.lds + RING_OFF, g, S, E); }
__device__ __forceinline__ void ph_moe1(int l) { Frame F = mk_frame(); PH_PTRS(); moe_table(F, l);
    pg8::Gemm g{H, (const bf16*)(F.ws + WS_W13) + (size_t)l * NEXP * 1024 * D, M, 1024, D};
    pg8::MoeOrder S{F.G, F.bid, CAP, (const LAS int*)(F.lds + TAB_OFF), INFO};
    pg8::EpiSwiGLU E{HE, MHID};
    pg8::gemm_phase<pg8::EpiSwiGLU, pg8::MoeOrder, true>(F.lds + RING_OFF, g, S, E); }
__device__ __forceinline__ void ph_moe2(int l) { Frame F = mk_frame(); PH_PTRS(); moe_table(F, l);
    pg8::Gemm g{HE, (const bf16*)(F.ws + WS_W2) + (size_t)l * NEXP * D * MHID, M, D, MHID};
    pg8::MoeOrder S{F.G, F.bid, CAP, (const LAS int*)(F.lds + TAB_OFF), INFO};
    pg8::EpiScatter E{Y2, INFO};
    pg8::gemm_phase<pg8::EpiScatter, pg8::MoeOrder, false>(F.lds + RING_OFF, g, S, E); }

__device__ __forceinline__ void grid_bar() {
    Frame F = mk_frame(); XcdBarrier b; b.bar = (unsigned*)(F.ctl + CW_BAR); b.x = xb_xcc_id(); b.st = F.MISC + 8; xcd_barrier(b);
}
#ifndef SINGLE_LAUNCH
#define SINGLE_LAUNCH 1
#endif
#if !SINGLE_LAUNCH
__global__ void __launch_bounds__(NT, 2) k_pa(Args args) { pa_phase(); }
__global__ void __launch_bounds__(NT, 2) k_norm1(Args args) { ph_norm1(args.l); }
__global__ void __launch_bounds__(NT, 2) k_next(Args args) { ph_next(args.l); }
__global__ void __launch_bounds__(NT, 2) k_route(Args args) { ph_route(args.l); }
__global__ void __launch_bounds__(NT, 2) k_win(Args args) { ph_win(args.l); }
__global__ void __launch_bounds__(NT, 2) k_mixa(Args args) { mixa_phase(args.l, args.l == 0); }
__global__ void __launch_bounds__(NT, 2) k_mixb(Args args) { mixb_phase(args.l, args.l == 0); }
__global__ void __launch_bounds__(NT, 2) k_wout(Args args) { ph_wout(args.l); }
__global__ void __launch_bounds__(NT, 2) k_moe1(Args args) { ph_moe1(args.l); }
__global__ void __launch_bounds__(NT, 2) k_moe2(Args args) { ph_moe2(args.l); }
#else
#define PMARK(name) asm volatile("; PHASE_MARK " name ::: "memory")
#ifndef REP_ROUTE
#define REP_ROUTE 1
#endif
#ifndef REP_NEXT
#define REP_NEXT 1
#endif
#ifndef REP_PA
#define REP_PA 1
#endif
#ifndef REP_WIN
#define REP_WIN 1
#endif
#ifndef REP_MIXA
#define REP_MIXA 1
#endif
#ifndef REP_MIXB
#define REP_MIXB 1
#endif
#ifndef REP_MOE1
#define REP_MOE1 1
#endif
#ifndef REP_MOE2
#define REP_MOE2 1
#endif
template <int L> __device__ __forceinline__ void layer_phases() {
    PMARK("win"); ph_win(L); grid_bar();
#if REP_WIN > 1
    ph_win(L); grid_bar();
#endif
    PMARK("mixa"); mixa_phase(L, L == 0); grid_bar();
#if REP_MIXA > 1
    mixa_phase(L, L == 0); grid_bar();
#endif
    PMARK("mixb"); mixb_phase(L, L == 0); grid_bar();
#if REP_MIXB > 1
    mixb_phase(L, L == 0); grid_bar();
#endif
    PMARK("wout"); ph_wout(L); grid_bar();
#if REP_ROUTE > 1
    ph_route(L, true); grid_bar();
#endif
    PMARK("route"); ph_route(L); grid_bar();
    PMARK("moe1"); ph_moe1(L); grid_bar();
#if REP_MOE1 > 1
    ph_moe1(L); grid_bar();
#endif
    PMARK("moe2"); ph_moe2(L); grid_bar();
#if REP_MOE2 > 1
    ph_moe2(L); grid_bar();
#endif
#if REP_NEXT > 1
    if (L == 0) { ph_next(L, true); grid_bar(); }
#endif
    PMARK("next"); ph_next(L);
}
__global__ void __launch_bounds__(NT, 2) fwd_all(Args args) {
    { Frame F = mk_frame();
      for (int u = F.tid; u < (LDS_BYTES - LDSCTL_OFF) / 4; u += NT) ((LAS unsigned*)(F.lds + LDSCTL_OFF))[u] = 0u;
      __syncthreads();
      (void)xcd_barrier_post((unsigned*)(F.ctl + CW_BAR), F.MISC + 8); }
    PMARK("pa"); pa_phase(); grid_bar();
#if REP_PA > 1
    pa_phase(); grid_bar();
#endif
    PMARK("norm1"); ph_norm1(0); grid_bar();
    layer_phases<0>(); grid_bar();
    layer_phases<1>();
}
#endif

typedef void (*kern_t)(Args);
extern "C" void kernel_launch(void* const* d_in, const int* in_sizes, int n_in, void* d_out, int out_size, void* d_ws, size_t ws_size, hipStream_t stream) {
    static int grid = 0;
#if SINGLE_LAUNCH
    const kern_t kerns[] = {fwd_all};
#else
    const kern_t kerns[] = {k_pa, k_norm1, k_next, k_route, k_win, k_mixa, k_mixb, k_wout, k_moe1, k_moe2};
#endif
    if (grid == 0) {
        if (n_in != 20 || out_size != NLAT * D || ws_size < WS_END) { fprintf(stderr, "kernel_launch: unexpected shapes (n_in %d out %d ws %zu)\n", n_in, out_size, ws_size); grid = -1; return; }
        int dev = 0, cus = 0;
        if (hipGetDevice(&dev) != hipSuccess || hipDeviceGetAttribute(&cus, hipDeviceAttributeMultiprocessorCount, dev) != hipSuccess) { grid = -1; return; }
        for (kern_t k : kerns) if (hipFuncSetAttribute((const void*)k, hipFuncAttributeMaxDynamicSharedMemorySize, LDS_BYTES) != hipSuccess) { fprintf(stderr, "kernel_launch: hipFuncSetAttribute failed\n"); grid = -1; return; }
        int per_cu = 0; (void)hipOccupancyMaxActiveBlocksPerMultiprocessor(&per_cu, (const void*)kerns[0], NT, LDS_BYTES); (void)hipGetLastError();
        grid = cus;
    }
    if (grid < 0) return;
    (void)hipMemsetAsync((char*)d_ws + WS_CTL, 0, CTL_ZERO_BYTES, stream);
    Args a{};
    for (int i = 0; i < 20; ++i) a.in[i] = (const float*)d_in[i];
    a.out = (float*)d_out; a.ws = (unsigned char*)d_ws;
#if SINGLE_LAUNCH
    hipLaunchKernelGGL(fwd_all, dim3(grid), dim3(NT), LDS_BYTES, stream, a);
#else
#define LAUNCH(k, L, E) do { a.l = (L); a.e = (E); hipLaunchKernelGGL(k, dim3(grid), dim3(NT), LDS_BYTES, stream, a); } while (0)
    LAUNCH(k_pa, 0, 0);
    LAUNCH(k_norm1, 0, 0);
    for (int l = 0; l < DEPTH; ++l) {
        LAUNCH(k_win, l, 0); LAUNCH(k_mixa, l, 0); LAUNCH(k_mixb, l, 0); LAUNCH(k_wout, l, 0); LAUNCH(k_route, l, 0);
        LAUNCH(k_moe1, l, 0); LAUNCH(k_moe2, l, 0); LAUNCH(k_next, l, 0);
    }
#endif
}
```

```cpp
#include <hip/hip_runtime.h>
#include <cstdio>
#include <cstdint>
namespace pg8 {
#define PG8_LAS __attribute__((address_space(3)))
typedef unsigned short bf16_t;
typedef short bf16x8 __attribute__((ext_vector_type(8)));
typedef float f32x4 __attribute__((ext_vector_type(4)));
typedef unsigned u32x4 __attribute__((ext_vector_type(4)));
constexpr int BM = 256, BK = 64, HALF = 128, HTB = HALF * BK * 2  , STAGE_BYTES = 8 * HTB, NXCD = 8, WGM = 8;

__host__ __device__ __forceinline__ int lds_byte(int r, int c) { const int st = (r >> 4) * 2 + (c >> 5), rr = r & 15, cc = c & 31, ob = rr * 64 + cc * 2; return st * 1024 + (ob ^ (((ob >> 9) & 1) << 5)); }
__host__ __device__ __forceinline__ void stage_rc(int b, int& R, int& C) { const int st = b / 1024, sb = b % 1024, swz = sb ^ (((sb >> 9) & 1) << 5); R = (st >> 1) * 16 + swz / 64; C = (st & 1) * 32 + (swz % 64) / 2; }
__host__ __device__ __forceinline__ int perm32(int rho) { const int n = rho >> 4, i = rho & 15; return 8 * (i >> 2) + 4 * n + (i & 3); }

struct Unit { int pm, pn, pb, lb, nv; };
struct Gemm { const bf16_t* A; const bf16_t* Bt; int M, N, K; };

struct StaticOrder {
    int nM, nN, nwg, G, c;
    __host__ __device__ void init(int M, int N, int G_, int c_) { nM = M / BM; nN = N / BM; nwg = nM * nN; G = G_; c = c_; }
    __host__ __device__ bool next(int i, Unit& u) const {
        const long L = (long)i * G + c; if (L >= nwg) return false;
        int wgid = (int)L; { const int q = nwg / NXCD, r = nwg % NXCD, xcd = wgid % NXCD, off = wgid / NXCD; wgid = (xcd < r ? xcd * (q + 1) : r * (q + 1) + (xcd - r) * q) + off; }
        const int nig = WGM * nN, gid = wgid / nig, fm = gid * WGM, gsz = (nM - fm) < WGM ? (nM - fm) : WGM;
        u.pm = fm + ((wgid % nig) % gsz); u.pn = (wgid % nig) / gsz; u.pb = u.pn; u.lb = 0; u.nv = BM; return true;
    }
    __device__ __forceinline__ void a_ready(const Unit&) const {}
    __device__ __forceinline__ int row_of(const Unit&, int i) const { return i; }
    __device__ __forceinline__ void done(const Unit&) const {}
};


__device__ __forceinline__ unsigned cvt_pk_bf16(float lo, float hi) { unsigned r; asm volatile("v_cvt_pk_bf16_f32 %0, %1, %2" : "=v"(r) : "v"(lo), "v"(hi)); return r; }

struct EpiBf16 {
    static constexpr bool PERM = true, AFTER_DRAIN = false;
    bf16_t* O; int ldc;
    __device__ __forceinline__ void operator()(const f32x4 (&acc)[2][2][4][2], const Unit& u, int wr, int wc, int fr, int fq) const {
        const int row0 = u.pm * BM + wr * 64 + fr; const int col0 = u.pn * BM + wc * 32 + 8 * fq;
#pragma unroll
        for (int ai = 0; ai < 2; ++ai)
#pragma unroll
            for (int m = 0; m < 4; ++m) { bf16_t* rowp = O + (size_t)(row0 + ai * HALF + m * 16) * ldc + col0;
#pragma unroll
                for (int bj = 0; bj < 2; ++bj) { const f32x4 v0 = acc[ai][bj][m][0], v1 = acc[ai][bj][m][1];
                    u32x4 w; w.x = cvt_pk_bf16(v0[0], v0[1]); w.y = cvt_pk_bf16(v0[2], v0[3]); w.z = cvt_pk_bf16(v1[0], v1[1]); w.w = cvt_pk_bf16(v1[2], v1[3]);
                    *(u32x4*)(rowp + bj * HALF) = w; } }
    }
};
struct EpiSwiGLU {
    static constexpr bool PERM = true, AFTER_DRAIN = false;
    bf16_t* O; int ldc;
    __device__ __forceinline__ void operator()(const f32x4 (&acc)[2][2][4][2], const Unit& u, int wr, int wc, int fr, int fq) const {
        const int row0 = u.pm * BM + wr * 64 + fr; const int col0 = u.pn * HALF + wc * 32 + 8 * fq;
#pragma unroll
        for (int ai = 0; ai < 2; ++ai)
#pragma unroll
            for (int m = 0; m < 4; ++m) { bf16_t* rowp = O + (size_t)(row0 + ai * HALF + m * 16) * ldc + col0;
                float o[8];
#pragma unroll
                for (int n = 0; n < 2; ++n)
#pragma unroll
                    for (int j = 0; j < 4; ++j) { const float a = acc[ai][0][m][n][j], b = acc[ai][1][m][n][j]; o[n * 4 + j] = a * __builtin_amdgcn_rcpf(1.0f + __expf(-a)) * b; }
                u32x4 w; w.x = cvt_pk_bf16(o[0], o[1]); w.y = cvt_pk_bf16(o[2], o[3]); w.z = cvt_pk_bf16(o[4], o[5]); w.w = cvt_pk_bf16(o[6], o[7]);
                *(u32x4*)rowp = w; }
    }
};
struct EpiResid {
    static constexpr bool PERM = false, AFTER_DRAIN = false;
    const float* xin_lat; const float* xin_ctx; float* xout_lat; float* xout_ctx; const float* gmod; int gstride; const float* rowscale; int rs_stride; int nlat, seq;
    __device__ __forceinline__ void operator()(const f32x4 (&acc)[2][2][4][2], const Unit& u, int wr, int wc, int fr, int fq) const {
        const int prow = u.pm * BM; const bool isctx = prow >= nlat;
        const float* xin = isctx ? xin_ctx - (size_t)nlat * 1024 : xin_lat; float* xout = isctx ? xout_ctx - (size_t)nlat * 1024 : xout_lat;
        const int modrow = isctx ? 8 : prow / seq;
        const int row0 = prow + wr * 64 + fr, col0 = u.pn * BM + wc * 32 + 4 * fq;
        f32x4 gv[2][2];
#pragma unroll
        for (int bj = 0; bj < 2; ++bj)
#pragma unroll
            for (int n = 0; n < 2; ++n) gv[bj][n] = *(const f32x4*)(gmod + (size_t)modrow * gstride + col0 + bj * HALF + n * 16);
#pragma unroll
        for (int ai = 0; ai < 2; ++ai)
#pragma unroll
            for (int m = 0; m < 4; ++m) { const int row = row0 + ai * HALF + m * 16; const size_t off = (size_t)row * 1024 + col0;
                const float rs = rowscale ? rowscale[(size_t)row * rs_stride] : 1.0f;
#pragma unroll
                for (int bj = 0; bj < 2; ++bj)
#pragma unroll
                    for (int n = 0; n < 2; ++n) { const f32x4 xi = *(const f32x4*)(xin + off + bj * HALF + n * 16);
                        *(f32x4*)(xout + off + bj * HALF + n * 16) = xi + gv[bj][n] * rs * acc[ai][bj][m][n]; } }
    }
};
struct EpiScatter {
    static constexpr bool PERM = true, AFTER_DRAIN = false;
    bf16_t* Y2; const uint2* info;
    __device__ __forceinline__ void operator()(const f32x4 (&acc)[2][2][4][2], const Unit& u, int wr, int wc, int fr, int fq) const {
        const int col0 = u.pn * BM + wc * 32 + 8 * fq;
#pragma unroll
        for (int ai = 0; ai < 2; ++ai)
#pragma unroll
            for (int m = 0; m < 4; ++m) { const int i = ai * HALF + wr * 64 + m * 16 + fr;
                if (i < u.nv) { const uint2 inf = info[u.lb + i]; const float w = __builtin_bit_cast(float, inf.y); bf16_t* rowp = Y2 + (size_t)inf.x * 1024 + col0;
#pragma unroll
                    for (int bj = 0; bj < 2; ++bj) { const f32x4 v0 = acc[ai][bj][m][0] * w, v1 = acc[ai][bj][m][1] * w;
                        u32x4 q; q.x = cvt_pk_bf16(v0[0], v0[1]); q.y = cvt_pk_bf16(v0[2], v0[3]); q.z = cvt_pk_bf16(v1[0], v1[1]); q.w = cvt_pk_bf16(v1[2], v1[3]);
                        *(u32x4*)(rowp + bj * HALF) = q; } } }
    }
};
struct MoeOrder {
    int G, c, cap; const PG8_LAS int* tab; const uint2* info;
    __device__ __forceinline__ bool next(int i, Unit& u) const {
        const int nwg = __builtin_amdgcn_readfirstlane(tab[16]) * 4; const long L = (long)i * G + c; if (L >= nwg) return false;
        int wgid = (int)L; { const int q = nwg / NXCD, r = nwg % NXCD, xcd = wgid % NXCD, off = wgid / NXCD; wgid = (xcd < r ? xcd * (q + 1) : r * (q + 1) + (xcd - r) * q) + off; }
        const int gp = wgid >> 2; int e = 0;
#pragma unroll
        for (int q = 1; q < 16; ++q) e += (gp >= tab[q]) ? 1 : 0;
        e = __builtin_amdgcn_readfirstlane(e);
        const int p = gp - __builtin_amdgcn_readfirstlane(tab[e]); const int ne = __builtin_amdgcn_readfirstlane(tab[17 + e]);
        u.pm = gp; u.pn = wgid & 3; u.pb = e * 4 + u.pn; u.lb = e * cap + 256 * p; u.nv = (ne - 256 * p) < 256 ? (ne - 256 * p) : 256; return true;
    }
    __device__ __forceinline__ void a_ready(const Unit&) const {}
    __device__ __forceinline__ void done(const Unit&) const {}
    __device__ __forceinline__ int row_of(const Unit& u, int i) const { return i < u.nv ? (int)(info[u.lb + i].x >> 1) : 0; }
};
template <class Epi, class Sched, bool GATHER = false>
__device__ __forceinline__ void gemm_phase(PG8_LAS unsigned char* lds, const Gemm g, const Sched& S, const Epi& E) {
    int tid_ = threadIdx.x; asm volatile("" : "+v"(tid_));
    const int tid = tid_, wid = __builtin_amdgcn_readfirstlane(tid >> 6), lane = tid & 63, wr = wid >> 2, wc = wid & 3, fr = lane & 15, fq = lane >> 4;
    const int K = g.K, nt = K / BK;
    unsigned voffB[2];
#pragma unroll
    for (int i = 0; i < 2; ++i) { int R, C; stage_rc(tid * 16 + i * 8192, R, C); const int Rb = Epi::PERM ? ((R & ~31) + perm32(R & 31)) : R; voffB[i] = (unsigned)(Rb * K + C) * 2u; }
    const size_t kstep = (size_t)(BK * 2);
    const size_t hstep = (size_t)HALF * K * 2;
    const size_t tstep = 2 * hstep;
    const unsigned ldsw = (unsigned)wid * 1024u;
    const int aoff = lds_byte(wr * 64 + fr, fq * 8), boff = lds_byte(wc * 32 + fr, fq * 8);
#define PG8_SA(b, h) (((b) * 2 + (h)) * HTB)
#define PG8_SB(b, h) ((4 + (b) * 2 + (h)) * HTB)
#define PG8_STAGE(bufoff, gbase, voff) do { _Pragma("unroll") for (int _i = 0; _i < 2; ++_i) \
        __builtin_amdgcn_global_load_lds((const unsigned*)((const char*)(gbase) + (voff)[_i]), (PG8_LAS unsigned*)(lds + (bufoff) + ldsw + _i * 8192), 16, 0, 0); } while (0)
#define PG8_LDA(dst, b, h) do { _Pragma("unroll") for (int m = 0; m < 4; ++m) _Pragma("unroll") for (int k = 0; k < 2; ++k) dst[m][k] = *(const PG8_LAS bf16x8*)(lds + PG8_SA(b, h) + aoff + m * 2048 + k * 1024); } while (0)
#define PG8_LDB(dst, b, h) do { _Pragma("unroll") for (int n = 0; n < 2; ++n) _Pragma("unroll") for (int k = 0; k < 2; ++k) dst[n][k] = *(const PG8_LAS bf16x8*)(lds + PG8_SB(b, h) + boff + n * 2048 + k * 1024); } while (0)
#define PG8_MMA(ai, bj, At, Bt) do { __builtin_amdgcn_s_setprio(1); _Pragma("unroll") for (int m = 0; m < 4; ++m) _Pragma("unroll") for (int n = 0; n < 2; ++n) _Pragma("unroll") for (int k = 0; k < 2; ++k) \
        acc[ai][bj][m][n] = __builtin_amdgcn_mfma_f32_16x16x32_bf16(Bt[n][k], At[m][k], acc[ai][bj][m][n], 0, 0, 0); __builtin_amdgcn_s_setprio(0); } while (0)
#define PG8_WAIT_V(n) asm volatile("s_waitcnt vmcnt(" #n ")" ::: "memory")
#define PG8_WAIT_L(n) asm volatile("s_waitcnt lgkmcnt(" #n ")" ::: "memory")
#define PG8_BAR __builtin_amdgcn_s_barrier()
#define PG8_SCHED __builtin_amdgcn_sched_barrier(0)
#define PG8_AOFFS(o, u) do { _Pragma("unroll") for (int _h = 0; _h < 2; ++_h) _Pragma("unroll") for (int _i = 0; _i < 2; ++_i) { int _R, _C; stage_rc(tid * 16 + _i * 8192, _R, _C); \
        const int _row = GATHER ? S.row_of((u), _h * HALF + _R) : (_h * HALF + _R); (o)[_h][_i] = (unsigned)(_row * K + _C) * 2u; } } while (0)
    Unit cur, nxt; int ui = 0;
    if (!S.next(0, cur)) return;
    f32x4 acc[2][2][4][2];
#pragma unroll
    for (int a = 0; a < 2; ++a)
#pragma unroll
        for (int b = 0; b < 2; ++b)
#pragma unroll
            for (int m = 0; m < 4; ++m)
#pragma unroll
                for (int n = 0; n < 2; ++n) acc[a][b][m][n] = (f32x4){0.f, 0.f, 0.f, 0.f};
    bf16x8 At[4][2], B0[2][2], B1[2][2];
    unsigned offA[2][2], noffA[2][2];
    const char* cA = (const char*)g.A + (GATHER ? (size_t)0 : (size_t)cur.pm * tstep); const char* cB = (const char*)g.Bt + (size_t)cur.pb * tstep;
    S.a_ready(cur);
    PG8_AOFFS(offA, cur);
    PG8_STAGE(PG8_SB(0, 0), cB, voffB); PG8_STAGE(PG8_SB(0, 1), cB + hstep, voffB); PG8_STAGE(PG8_SA(0, 0), cA, offA[0]); PG8_STAGE(PG8_SA(0, 1), cA, offA[1]);
    if (wr == 1) PG8_BAR;
    PG8_WAIT_V(2); PG8_BAR;
    PG8_STAGE(PG8_SB(1, 0), cB + kstep, voffB); PG8_STAGE(PG8_SA(1, 0), cA + kstep, offA[0]); PG8_STAGE(PG8_SB(1, 1), cB + hstep + kstep, voffB);
    PG8_WAIT_V(6); PG8_BAR;
    for (;;) {
        const bool has_next = S.next(ui + 1, nxt);
        const char* nA = has_next ? (const char*)g.A + (GATHER ? (size_t)0 : (size_t)nxt.pm * tstep) : cA; const char* nB = has_next ? (const char*)g.Bt + (size_t)nxt.pb * tstep : cB;
        for (int t = 0; t < nt; t += 2) {
            const bool last = (t == nt - 2);
            const char* a1 = cA + (size_t)(t + 1) * kstep;
            const char* a2 = last ? nA : cA + (size_t)(t + 2) * kstep; const char* b2 = last ? nB : cB + (size_t)(t + 2) * kstep;
            const char* a3 = a2 + kstep; const char* b3 = b2 + kstep;
            if (last && has_next) S.a_ready(nxt);
            unsigned o2[2][2];
            if constexpr (GATHER) {
                if (last) { if (has_next) { PG8_AOFFS(noffA, nxt); } else {
#pragma unroll
                        for (int h = 0; h < 2; ++h) { noffA[h][0] = offA[h][0]; noffA[h][1] = offA[h][1]; } } }
#pragma unroll
                for (int h = 0; h < 2; ++h) { o2[h][0] = last ? noffA[h][0] : offA[h][0]; o2[h][1] = last ? noffA[h][1] : offA[h][1]; }
            } else {
#pragma unroll
                for (int h = 0; h < 2; ++h) { o2[h][0] = offA[h][0]; o2[h][1] = offA[h][1]; }
            }
            PG8_LDB(B0, 0, 0); PG8_LDB(B1, 0, 1); PG8_SCHED; PG8_LDA(At, 0, 0); PG8_STAGE(PG8_SA(1, 1), a1, offA[1]);
            PG8_WAIT_V(8); PG8_WAIT_L(0); PG8_BAR; PG8_MMA(0, 0, At, B0); PG8_MMA(0, 1, At, B1); PG8_BAR; PG8_SCHED;
            PG8_LDA(At, 0, 1); PG8_STAGE(PG8_SB(0, 0), b2, voffB); PG8_STAGE(PG8_SB(0, 1), b2 + hstep, voffB); PG8_STAGE(PG8_SA(0, 0), a2, o2[0]);
            PG8_WAIT_V(8); PG8_WAIT_L(0); PG8_BAR; PG8_MMA(1, 0, At, B0); PG8_MMA(1, 1, At, B1); PG8_BAR; PG8_SCHED;
            PG8_LDB(B0, 1, 0); PG8_LDB(B1, 1, 1); PG8_SCHED; PG8_LDA(At, 1, 0); PG8_STAGE(PG8_SA(0, 1), a2, o2[1]);
            PG8_WAIT_V(8); PG8_WAIT_L(0); PG8_BAR; PG8_MMA(0, 0, At, B0); PG8_MMA(0, 1, At, B1); PG8_BAR; PG8_SCHED;
            PG8_LDA(At, 1, 1); PG8_STAGE(PG8_SB(1, 0), b3, voffB); PG8_STAGE(PG8_SB(1, 1), b3 + hstep, voffB); PG8_STAGE(PG8_SA(1, 0), a3, o2[0]);
            PG8_WAIT_V(8); PG8_WAIT_L(0); PG8_BAR; PG8_MMA(1, 0, At, B0); PG8_MMA(1, 1, At, B1); PG8_BAR; PG8_SCHED;
        }
        if (wr == 0) PG8_BAR;
        E(acc, cur, wr, wc, fr, fq); S.done(cur);
        if (!has_next) break;
#pragma unroll
        for (int a = 0; a < 2; ++a)
#pragma unroll
            for (int b = 0; b < 2; ++b)
#pragma unroll
                for (int m = 0; m < 4; ++m)
#pragma unroll
                    for (int n = 0; n < 2; ++n) acc[a][b][m][n] = (f32x4){0.f, 0.f, 0.f, 0.f};
        cur = nxt; cA = nA; cB = nB; ++ui;
        if constexpr (GATHER) {
#pragma unroll
            for (int h = 0; h < 2; ++h) { offA[h][0] = noffA[h][0]; offA[h][1] = noffA[h][1]; } }
        if (wr == 1) PG8_BAR;
    }
    PG8_WAIT_V(0);
    PG8_BAR;
#undef PG8_SA
#undef PG8_SB
#undef PG8_STAGE
#undef PG8_LDA
#undef PG8_LDB
#undef PG8_MMA
#undef PG8_WAIT_V
#undef PG8_WAIT_L
#undef PG8_BAR
#undef PG8_SCHED
#undef PG8_AOFFS
}
}
#define GAS __attribute__((address_space(1)))
#define LAS __attribute__((address_space(3)))
typedef unsigned short bf16;
typedef unsigned v4u __attribute__((ext_vector_type(4)));
typedef float f32x4 __attribute__((ext_vector_type(4)));
typedef short bf16x8 __attribute__((ext_vector_type(8)));
typedef GAS unsigned gu32;
typedef GAS unsigned long long gu64;
#define RLX_AGENT __ATOMIC_RELAXED, __HIP_MEMORY_SCOPE_AGENT
#define LDS_WAIT() asm volatile("s_waitcnt lgkmcnt(0)" ::: "memory")
#define VM_WAIT() asm volatile("s_waitcnt vmcnt(0)" ::: "memory")
__device__ __forceinline__ unsigned long long rt() { return __builtin_amdgcn_s_memrealtime(); }
__device__ __forceinline__ unsigned f2bf(float f) { unsigned u = __builtin_bit_cast(unsigned, f); return (u + 0x7fffu + ((u >> 16) & 1u)) >> 16; }
__device__ __forceinline__ unsigned pk2(float lo, float hi) { return f2bf(lo) | (f2bf(hi) << 16); }

#define XB_TMO      128
#define XB_XCNT(j)  (256  + 64 * (j))
#define XB_XSUB(j)  (1280 + 64 * (j))
#define XB_XGEN(j)  (2304 + 64 * (j))
#define XB_TOP      3328
#define XB_TOPGEN   3392
#define XCD_BAR_WORDS 3456
#define XB_SPIN_CAP (1u << 18)

__device__ __forceinline__ unsigned xb_ld(unsigned* p)              { return __hip_atomic_load(p, __ATOMIC_RELAXED, __HIP_MEMORY_SCOPE_AGENT); }
__device__ __forceinline__ unsigned xb_add(unsigned* p, unsigned v) { return __hip_atomic_fetch_add(p, v, __ATOMIC_RELAXED, __HIP_MEMORY_SCOPE_AGENT); }
__device__ __forceinline__ unsigned xb_xcc_id() { return (unsigned)__builtin_amdgcn_s_getreg((3 << 11) | 20) & 0xFu; }
#define XB_SPIN(cond, bar) do { unsigned _sp = 0; while (cond) { __builtin_amdgcn_s_sleep(1); \
    if ((++_sp & 255u) == 0u) { if (xb_ld(&(bar)[XB_TMO])) break; if (_sp > XB_SPIN_CAP) { atomicAdd(&(bar)[XB_TMO], 1u); break; } } } } while (0)

struct XcdBarrier {
    unsigned* bar; unsigned x;
    volatile LAS unsigned* st;
};

__device__ __forceinline__ XcdBarrier xcd_barrier_post(unsigned* bar, volatile LAS unsigned* st) {
    XcdBarrier b; b.bar = bar; b.x = xb_xcc_id(); b.st = st;
    if (threadIdx.x == 0) (void)xb_add(&bar[XB_XCNT(b.x)], 1u);
    return b;
}
__device__ __forceinline__ void xcd_barrier_complete(unsigned* bar, unsigned x, unsigned& nloc, unsigned& nx) {
    const unsigned G = gridDim.x * gridDim.y * gridDim.z;
    unsigned sum, cnt, mine, sp = 0u;
    for (;;) {
        sum = 0u; cnt = 0u; mine = 0u;
#pragma unroll
        for (unsigned j = 0; j < 16; ++j) { const unsigned c = xb_ld(&bar[XB_XCNT(j)]); sum += c; cnt += (c > 0u) ? 1u : 0u; mine = (j == x) ? c : mine; }
        if (sum == G) break;
        __builtin_amdgcn_s_sleep(1);
        if ((++sp & 255u) == 0u) { if (xb_ld(&bar[XB_TMO])) break; if (sp > XB_SPIN_CAP) { atomicAdd(&bar[XB_TMO], 1u); break; } }
    }
    nloc = mine > 0u ? mine : 1u; nx = cnt > 0u ? cnt : 1u;
}

__device__ __forceinline__ void xcd_barrier(const XcdBarrier& b) {
    asm volatile("s_waitcnt vmcnt(0)" ::: "memory");
    __syncthreads();
    if (threadIdx.x == 0) {
        unsigned* bar = b.bar;
        __builtin_amdgcn_s_waitcnt(0);
        unsigned nloc = b.st[0], nx = b.st[1];
        if (nloc == 0u) { xcd_barrier_complete(bar, b.x, nloc, nx); b.st[0] = nloc; b.st[1] = nx; }
        const unsigned old = xb_add(&bar[XB_XSUB(b.x)], 1u);
        const unsigned gen = old / nloc;
        if (old + 1u == (gen + 1u) * nloc) {
            __builtin_amdgcn_fence(__ATOMIC_RELEASE, "agent");
            asm volatile("s_waitcnt vmcnt(0)" ::: "memory");
            const unsigned og = xb_add(&bar[XB_TOP], 1u);
            const unsigned tg = og / nx;
            if (og + 1u == (tg + 1u) * nx) xb_add(&bar[XB_TOPGEN], 1u);
            else XB_SPIN(xb_ld(&bar[XB_TOPGEN]) == tg, bar);
            __builtin_amdgcn_fence(__ATOMIC_ACQUIRE, "agent");
            xb_add(&bar[XB_XGEN(b.x)], 1u);
            asm volatile("s_waitcnt vmcnt(0)" ::: "memory");
        } else {
            XB_SPIN(xb_ld(&bar[XB_XGEN(b.x)]) == gen, bar);
            __builtin_amdgcn_fence(__ATOMIC_ACQUIRE, "agent");
            asm volatile("s_waitcnt vmcnt(0)" ::: "memory");
        }
    }
    __syncthreads();
}


constexpr int NWAVES = 8, NT = NWAVES * 64;
constexpr int D = 1024, BATCH = 8, SEQ = 4096, DEPTH = 2, GRIDW = 64, CTXL = 256, GWID = 256, HD = 64, NHEAD = 4;
constexpr int INC = 2048, NEXP = 16, MHID = 512;
constexpr int NLAT = BATCH * SEQ, NCTX = BATCH * CTXL, NROW = NLAT + NCTX;
constexpr float EPS = 1e-6f;
constexpr int UC_AV = 0, UC_AB = 256, UC_AC = 512, UC_P = 768, UC_Q = 1024, UC_K = 1280, UC_V = 1536, UC_F = 1792;

constexpr size_t MiB = 1u << 20;
constexpr size_t WS_CTL = 0, CTL_ZERO_BYTES = 65536;
constexpr size_t WS_MOD  = 1 * MiB;
constexpr size_t WS_PWT  = 1 * MiB + 768 * 1024;
constexpr size_t WS_INFO = 2 * MiB;
constexpr size_t WS_WIN  = 8 * MiB;
constexpr size_t WS_WOUT = 16 * MiB;
constexpr size_t WS_W13  = 20 * MiB;
constexpr size_t WS_W2   = 84 * MiB;
constexpr size_t WS_XC   = 116 * MiB;
constexpr size_t WS_H    = 124 * MiB;
constexpr size_t WS_U    = 192 * MiB;
constexpr size_t WS_S    = 328 * MiB;
constexpr size_t WS_END  = 472 * MiB;
constexpr size_t WS_KF   = WS_S;
constexpr size_t WS_VF   = WS_S + 28 * MiB;
constexpr size_t WS_KFC  = WS_S + 60 * MiB;
constexpr size_t WS_VFC  = WS_S + 61 * MiB;
constexpr size_t WS_Z    = WS_S + 64 * MiB;
constexpr size_t NZ = (size_t)BATCH * NHEAD * SEQ * HD;
constexpr size_t NZC = (size_t)BATCH * NHEAD * CTXL * HD;
constexpr int CAP = NROW;

constexpr int CW_CNT = 2048;
constexpr int CW_BAR = 4096;

constexpr int RING_OFF = 0, RING_BYTES = 131072;
constexpr int LDSCTL_OFF = RING_BYTES, MISC_OFF = LDSCTL_OFF + 320;
constexpr int TAB_OFF = RING_BYTES + 1024;
constexpr int LDS_BYTES = 147456;

struct Frame {
    LAS unsigned char* lds;
    volatile LAS unsigned* MISC;
    gu32* ctl;
    int tid, lane, wave, G, bid;
    float* out; unsigned char* ws;
    static __device__ __forceinline__ const void* karg(int off) {
        const __attribute__((address_space(4))) char* ka = (const __attribute__((address_space(4))) char*)__builtin_amdgcn_kernarg_segment_ptr();
        asm volatile("" : "+s"(ka));
        return *(const void* const __attribute__((address_space(4)))*)(ka + off);
    }
    __device__ __forceinline__ const float* inp(int i) const { return (const float*)karg(8 * i); }
};
extern __shared__ __attribute__((aligned(16))) unsigned char dyn_lds[];
__device__ __forceinline__ Frame mk_frame() {
    Frame F; int t_ = threadIdx.x; asm volatile("" : "+v"(t_));
    F.tid = t_; F.lane = F.tid & 63; F.wave = __builtin_amdgcn_readfirstlane(F.tid >> 6); F.G = gridDim.x; F.bid = blockIdx.x;
    F.lds = (LAS unsigned char*)dyn_lds; F.MISC = (volatile LAS unsigned*)(F.lds + MISC_OFF);
    F.out = (float*)Frame::karg(160); F.ws = (unsigned char*)Frame::karg(168); F.ctl = (gu32*)(F.ws + WS_CTL);
    return F;
}
enum { I_X = 0, I_C, I_CTX, I_CCTX, I_ADAW, I_ADAB, I_N1G, I_N2G, I_WIN, I_CONVW, I_POOLW, I_POOLS, I_RPB, I_WOUT, I_RW, I_RB, I_W1, I_W3, I_W2, I_FG };

__device__ __forceinline__ float wave_sum(float v) {
#pragma unroll
    for (int o = 1; o < 64; o <<= 1) v += __shfl_xor(v, o);
    return v;
}
__device__ __forceinline__ float bflo(unsigned w) { return __builtin_bit_cast(float, w << 16); }
__device__ __forceinline__ float bfhi(unsigned w) { return __builtin_bit_cast(float, w & 0xffff0000u); }
__device__ __forceinline__ float bf2f(bf16 b) { return __builtin_bit_cast(float, (unsigned)b << 16); }

__device__ __forceinline__ void tr_item(const float* W, int K, int N, bf16* WT, int k0, int n0, int drow0, LAS float* scr, int lane) {
#pragma unroll 8
    for (int i = 0; i < 32; ++i) { const int kk = 2 * i + (lane >> 5); scr[kk * 33 + (lane & 31)] = W[(size_t)(k0 + kk) * N + n0 + (lane & 31)]; }
    LDS_WAIT(); asm volatile("" ::: "memory");
    const int c = lane & 7;
#pragma unroll
    for (int j = 0; j < 4; ++j) { const int n = (lane >> 3) + 8 * j; const LAS float* s = scr + (8 * c) * 33 + n;
        v4u o; o.x = pk2(s[0 * 33], s[1 * 33]); o.y = pk2(s[2 * 33], s[3 * 33]); o.z = pk2(s[4 * 33], s[5 * 33]); o.w = pk2(s[6 * 33], s[7 * 33]);
        *(GAS v4u*)(WT + (size_t)(drow0 + n) * K + k0 + 8 * c) = o; }
    LDS_WAIT(); asm volatile("" ::: "memory");
}
__device__ __forceinline__ void pa_phase() { Frame F = mk_frame();
    LAS float* scr = (LAS float*)(F.lds + RING_OFF + F.wave * 16384);
    const int gw = F.bid * NWAVES + F.wave, NGW = F.G * NWAVES;
    bf16* WIN = (bf16*)(F.ws + WS_WIN); bf16* WOUT = (bf16*)(F.ws + WS_WOUT); bf16* W13 = (bf16*)(F.ws + WS_W13); bf16* W2 = (bf16*)(F.ws + WS_W2);
    constexpr int I_IN = 2 * 16 * 64, I_OUT = 2 * 16 * 32, I_1 = 32 * 16 * 16, I_2 = 32 * 8 * 32;
    constexpr int NITEMS = I_IN + I_OUT + 2 * I_1 + I_2;
    for (int it = gw; it < NITEMS; it += NGW) {
        int r = it;
        if (r < I_IN) { const int l = r / 1024, q = r % 1024, kb = q / 64, nb = q % 64;
            tr_item(F.inp(I_WIN) + (size_t)l * D * INC, D, INC, WIN + (size_t)l * INC * D, 64 * kb, 32 * nb, 32 * nb, scr, F.lane); continue; } r -= I_IN;
        if (r < I_OUT) { const int l = r / 512, q = r % 512, kb = q / 32, nb = q % 32;
            tr_item(F.inp(I_WOUT) + (size_t)l * D * D, D, D, WOUT + (size_t)l * D * D, 64 * kb, 32 * nb, 32 * nb, scr, F.lane); continue; } r -= I_OUT;
        if (r < 2 * I_1) { const int which = r / I_1; const int q0 = r % I_1; const int le = q0 / 256, q = q0 % 256, kb = q / 16, nb = q % 16;
            const int n0 = 32 * nb; const int drow0 = 256 * (n0 / 128) + 128 * which + (n0 % 128);
            tr_item(F.inp(which ? I_W3 : I_W1) + (size_t)le * D * MHID, D, MHID, W13 + (size_t)le * 1024 * D, 64 * kb, n0, drow0, scr, F.lane); continue; } r -= 2 * I_1;
        { const int le = r / 256, q = r % 256, kb = q / 32, nb = q % 32;
            tr_item(F.inp(I_W2) + (size_t)le * MHID * D, MHID, D, W2 + (size_t)le * D * MHID, 64 * kb, 32 * nb, 32 * nb, scr, F.lane); }
    }
    { bf16* PWT = (bf16*)(F.ws + WS_PWT); const float* pw = F.inp(I_POOLW);
      for (int i = F.bid * NT + F.tid; i < 2 * 4 * 64 * 64; i += F.G * NT) { const int c = i & 63, dd = (i >> 6) & 63, lg = i >> 12; PWT[i] = (bf16)f2bf(pw[((size_t)lg * 64 + c) * 64 + dd]); } }
    __syncthreads();
    LAS float* sc = (LAS float*)(F.lds + RING_OFF);
    LAS float* part = (LAS float*)(F.lds + RING_OFF + 40960);
    float* MOD = (float*)(F.ws + WS_MOD);
    bool have_sc = false;
    for (int it = F.bid; it < 2 * 96; it += F.G) {
        if (!have_sc) { for (int i = F.tid; i < 9 * 1024; i += NT) { const float v = i < 8192 ? F.inp(I_C)[i] : F.inp(I_CCTX)[i - 8192]; sc[i] = v / (1.0f + __expf(-v)); } have_sc = true; }
        __syncthreads();
        const int l = it / 96, cb = it % 96, col = cb * 64 + F.lane;
        const float* aw = F.inp(I_ADAW) + (size_t)l * D * 6144 + col;
        float acc[9];
#pragma unroll
        for (int r = 0; r < 9; ++r) acc[r] = 0.f;
        for (int k = F.wave * 128; k < F.wave * 128 + 128; ++k) { const float wv = aw[(size_t)k * 6144];
#pragma unroll
            for (int r = 0; r < 9; ++r) acc[r] += sc[r * 1024 + k] * wv; }
#pragma unroll
        for (int r = 0; r < 9; ++r) part[(F.wave * 9 + r) * 64 + F.lane] = acc[r];
        __syncthreads();
        for (int i = F.tid; i < 9 * 64; i += NT) { const int r = i >> 6, ln = i & 63; float s = F.inp(I_ADAB)[(size_t)l * 6144 + cb * 64 + ln];
#pragma unroll
            for (int w = 0; w < 8; ++w) s += part[(w * 9 + r) * 64 + ln];
            MOD[((size_t)l * 9 + r) * 6144 + cb * 64 + ln] = s; }
        __syncthreads();
    }
}

typedef unsigned v2u_ __attribute__((ext_vector_type(2)));
__device__ __forceinline__ unsigned cvt_pk_bf(float lo, float hi) { unsigned r; asm volatile("v_cvt_pk_bf16_f32 %0, %1, %2" : "=v"(r) : "v"(lo), "v"(hi)); return r; }
struct RowIn { f32x4 x[4]; unsigned long long ya[4], yb[4]; };
template <int ADD>
__device__ __forceinline__ void row_load(Frame& F, int r, const float* xr, const bf16* Y2, RowIn& in) {
#pragma unroll
    for (int j = 0; j < 4; ++j) { const int c = 4 * F.lane + 256 * j; in.x[j] = *(const GAS f32x4*)(xr + c);
        if (ADD == 1) { in.ya[j] = *(const GAS unsigned long long*)(Y2 + (size_t)r * 2048 + c); in.yb[j] = *(const GAS unsigned long long*)(Y2 + (size_t)r * 2048 + 1024 + c); }
        if (ADD == 2) { in.ya[j] = *(const GAS unsigned long long*)(Y2 + (size_t)r * 1024 + c); } }
}
struct RowPar { f32x4 a[4], b[4], gt[4]; int modrow; };
template <int ADD, bool FINAL>
__device__ __forceinline__ void row_params(Frame& F, int modrow, const float* g, const float* modl, const float* modadd, int ch_sh, int ch_sc, RowPar& P) {
    P.modrow = modrow;
#pragma unroll
    for (int j = 0; j < 4; ++j) { const int c = 4 * F.lane + 256 * j; const f32x4 gv = *(const GAS f32x4*)(g + c);
        if (FINAL) { P.a[j] = gv; P.b[j] = (f32x4){0.f, 0.f, 0.f, 0.f}; }
        else { const float* mrow = modl + (size_t)modrow * 6144; P.a[j] = gv * (*(const GAS f32x4*)(mrow + ch_sc * 1024 + c) + 1.0f); P.b[j] = *(const GAS f32x4*)(mrow + ch_sh * 1024 + c); }
        if (ADD) P.gt[j] = *(const GAS f32x4*)(modadd + (size_t)modrow * 6144 + (ADD == 1 ? 5 : 2) * 1024 + c); else P.gt[j] = (f32x4){0.f, 0.f, 0.f, 0.f}; }
}
template <int ADD, bool FINAL>
__device__ __forceinline__ void row_finish(Frame& F, const RowIn& in, const RowPar& P, float* xw, bf16* dst, float* fout, f32x4 (&v)[4]) {
    float ss = 0.f;
#pragma unroll
    for (int j = 0; j < 4; ++j) { const int c = 4 * F.lane + 256 * j; v[j] = in.x[j];
        if (ADD) { const unsigned long long a = in.ya[j];
            f32x4 ya; ya.x = bflo((unsigned)a); ya.y = bfhi((unsigned)a); ya.z = bflo((unsigned)(a >> 32)); ya.w = bfhi((unsigned)(a >> 32));
            if (ADD == 1) { const unsigned long long b = in.yb[j]; f32x4 yb; yb.x = bflo((unsigned)b); yb.y = bfhi((unsigned)b); yb.z = bflo((unsigned)(b >> 32)); yb.w = bfhi((unsigned)(b >> 32)); ya = ya + yb; }
            v[j] = v[j] + P.gt[j] * ya;
            if (!FINAL) *(GAS f32x4*)(xw + c) = v[j]; }
        ss += (v[j].x * v[j].x + v[j].y * v[j].y) + (v[j].z * v[j].z + v[j].w * v[j].w); }
    ss = wave_sum(ss);
    const float rstd = 1.0f / sqrtf(ss * (1.0f / D) + EPS);
#pragma unroll
    for (int j = 0; j < 4; ++j) { const int c = 4 * F.lane + 256 * j;
        if (FINAL) { *(GAS f32x4*)(fout + c) = v[j] * rstd * P.a[j]; }
        else { v[j] = v[j] * rstd * P.a[j] + P.b[j];
            *(GAS v2u_*)(dst + c) = (v2u_){cvt_pk_bf(v[j].x, v[j].y), cvt_pk_bf(v[j].z, v[j].w)}; } }
}
template <int ADD, bool FINAL>
__device__ __forceinline__ void norm_phase(Frame& F, const float* xlat, const float* xctx, float* wlat, float* wctx, int nrows, const float* g, const float* modl, const float* modadd, int ch_sh, int ch_sc, bf16* dst, const bf16* Y2, float* fout) {
    const int rpb = (nrows + F.G - 1) / F.G;
    int i = F.wave; int r = F.bid * rpb + i; if (i >= rpb || r >= nrows) return;
    RowIn cur; row_load<ADD>(F, r, r < NLAT ? xlat + (size_t)r * D : xctx + (size_t)(r - NLAT) * D, Y2, cur);
    RowPar P; P.modrow = -1;
    for (;;) {
        const int in_ = i + NWAVES, rn = F.bid * rpb + in_; const bool more = (in_ < rpb) && (rn < nrows);
        RowIn nxt;
        if (more) row_load<ADD>(F, rn, rn < NLAT ? xlat + (size_t)rn * D : xctx + (size_t)(rn - NLAT) * D, Y2, nxt);
        const int modrow = r < NLAT ? (r >> 12) : 8;
        if (modrow != P.modrow) row_params<ADD, FINAL>(F, modrow, g, modl, modadd, ch_sh, ch_sc, P);
        float* xw = r < NLAT ? wlat + (size_t)r * D : wctx + (size_t)(r - NLAT) * D;
        f32x4 v[4];
        row_finish<ADD, FINAL>(F, cur, P, xw, dst + (size_t)r * D, fout + (size_t)r * D, v);
        if (!more) break;
        cur = nxt; r = rn; i = in_;
    }
}
__device__ __forceinline__ void route_phase(Frame& F, int l, const float* xlat, const float* xctx, float* wlat, float* wctx, const bf16* O, int nrows, const float* g, const float* modl, bf16* dst, uint2* info, unsigned* cnt) {
    LAS int* lcnt = (LAS int*)(F.lds + RING_OFF); LAS int* lbase = lcnt + 16; LAS int* rec_e = lcnt + 32; LAS int* rec_p = rec_e + 512; LAS float* rec_w = (LAS float*)(rec_p + 512);
    const int rpb = (nrows + F.G - 1) / F.G;
    if (F.tid < 16) lcnt[F.tid] = 0;
    LAS float* WT = (LAS float*)(F.lds + RING_OFF + 32768);
    LAS float* LG = (LAS float*)(F.lds + RING_OFF + 8192);
    { const float* rwp = F.inp(I_RW); for (int i = F.tid; i < 1024 * 16; i += NT) { const int k = i >> 4, e = i & 15; WT[e * 1024 + k] = rwp[i]; } }
    __syncthreads();
    const float* rbp = F.inp(I_RB);
    RowPar P; P.modrow = -1;
    RowIn cur; bool have = (F.wave < rpb) && (F.bid * rpb + F.wave < nrows);
    if (have) { const int r = F.bid * rpb + F.wave; row_load<2>(F, r, r < NLAT ? xlat + (size_t)r * D : xctx + (size_t)(r - NLAT) * D, O, cur); }
    for (int i = F.wave; have; i += NWAVES) {
        const int r = F.bid * rpb + i;
        const int in_ = i + NWAVES, rn = F.bid * rpb + in_; const bool more = (in_ < rpb) && (rn < nrows);
        RowIn nxt;
        if (more) row_load<2>(F, rn, rn < NLAT ? xlat + (size_t)rn * D : xctx + (size_t)(rn - NLAT) * D, O, nxt);
        f32x4 v[4];
        { const int modrow = r < NLAT ? (r >> 12) : 8; if (modrow != P.modrow) row_params<2, false>(F, modrow, g, modl, modl, 3, 4, P); }
        row_finish<2, false>(F, cur, P, r < NLAT ? wlat + (size_t)r * D : wctx + (size_t)(r - NLAT) * D, dst + (size_t)r * D, nullptr, v);
        typedef float f32x2 __attribute__((ext_vector_type(2)));
        f32x2 s2[16];
#pragma unroll
        for (int e = 0; e < 16; ++e) s2[e] = (f32x2){0.f, 0.f};
#pragma unroll
        for (int j = 0; j < 4; ++j) { const f32x2 vlo = (f32x2){v[j].x, v[j].y}, vhi = (f32x2){v[j].z, v[j].w};
#pragma unroll
            for (int e = 0; e < 16; ++e) { const f32x4 w4 = *(const LAS f32x4*)(WT + e * 1024 + 4 * F.lane + 256 * j); s2[e] += vlo * (f32x2){w4.x, w4.y}; s2[e] += vhi * (f32x2){w4.z, w4.w}; } }
        float s16[16];
#pragma unroll
        for (int e = 0; e < 16; ++e) s16[e] = s2[e].x + s2[e].y;
        { float a8[8], a4[4], a2[2]; const bool h5 = F.lane & 32, h4 = F.lane & 16, h3 = F.lane & 8, h2 = F.lane & 4;
#pragma unroll
          for (int k = 0; k < 8; ++k) { const float send = h5 ? s16[k] : s16[k + 8], keep = h5 ? s16[k + 8] : s16[k]; a8[k] = keep + __shfl_xor(send, 32); }
#pragma unroll
          for (int k = 0; k < 4; ++k) { const float send = h4 ? a8[k] : a8[k + 4], keep = h4 ? a8[k + 4] : a8[k]; a4[k] = keep + __shfl_xor(send, 16); }
#pragma unroll
          for (int k = 0; k < 2; ++k) { const float send = h3 ? a4[k] : a4[k + 2], keep = h3 ? a4[k + 2] : a4[k]; a2[k] = keep + __shfl_xor(send, 8); }
          const float send = h2 ? a2[0] : a2[1], keep = h2 ? a2[1] : a2[0]; float a1 = keep + __shfl_xor(send, 4);
          a1 += __shfl_xor(a1, 1); a1 += __shfl_xor(a1, 2);
          if ((F.lane & 3) == 0) LG[i * 17 + 8 * ((F.lane >> 5) & 1) + 4 * ((F.lane >> 4) & 1) + 2 * ((F.lane >> 3) & 1) + ((F.lane >> 2) & 1)] = a1; }
        have = more; cur = nxt;
    }
    __syncthreads();
    for (int i = F.tid; i < rpb; i += NT) { if (F.bid * rpb + i >= nrows) break;
        float s16[16], bs[16];
#pragma unroll
        for (int e = 0; e < 16; ++e) { s16[e] = 1.0f / (1.0f + expf(-LG[i * 17 + e])); bs[e] = s16[e] + rbp[e]; }
        float best = -3.0e38f; int bg = 0;
#pragma unroll
        for (int gq = 0; gq < 4; ++gq) { const float a0 = bs[4 * gq], a1 = bs[4 * gq + 1], a2 = bs[4 * gq + 2], a3 = bs[4 * gq + 3];
            const float gs = fmaxf(fmaxf(fmaxf(a0 + a1, a0 + a2), fmaxf(a0 + a3, a1 + a2)), fmaxf(a1 + a3, a2 + a3));
            if (gs > best) { best = gs; bg = gq; } }
        float cb[4], cs[4];
#pragma unroll
        for (int ii = 0; ii < 4; ++ii) { cb[ii] = 0.f; cs[ii] = 0.f; }
#pragma unroll
        for (int gq = 0; gq < 4; ++gq)
#pragma unroll
            for (int ii = 0; ii < 4; ++ii) { cb[ii] = (gq == bg) ? bs[4 * gq + ii] : cb[ii]; cs[ii] = (gq == bg) ? s16[4 * gq + ii] : cs[ii]; }
        int i1 = 0; float b1 = cb[0], s1 = cs[0];
#pragma unroll
        for (int ii = 1; ii < 4; ++ii) if (cb[ii] > b1) { b1 = cb[ii]; s1 = cs[ii]; i1 = ii; }
        int i2 = -1; float b2 = -3.0e38f, s2 = 0.f;
#pragma unroll
        for (int ii = 0; ii < 4; ++ii) if (ii != i1 && cb[ii] > b2) { b2 = cb[ii]; s2 = cs[ii]; i2 = ii; }
        const float inv = 1.0f / (s1 + s2);
        const int e1 = 4 * bg + i1, e2 = 4 * bg + i2;
        rec_e[2 * i] = e1; rec_p[2 * i] = atomicAdd((int*)&lcnt[e1], 1); rec_w[2 * i] = s1 * inv;
        rec_e[2 * i + 1] = e2; rec_p[2 * i + 1] = atomicAdd((int*)&lcnt[e2], 1); rec_w[2 * i + 1] = s2 * inv;
    }
    __syncthreads();
    if (F.tid < 16) lbase[F.tid] = (int)__hip_atomic_fetch_add(cnt + F.tid, (unsigned)lcnt[F.tid], __ATOMIC_RELAXED, __HIP_MEMORY_SCOPE_AGENT);
    __syncthreads();
    for (int j = F.tid; j < 2 * rpb; j += NT) { const int r = F.bid * rpb + (j >> 1); if (r < nrows) { const int e = rec_e[j];
        info[(size_t)e * CAP + lbase[e] + rec_p[j]] = make_uint2((unsigned)(r * 2 + (j & 1)), __builtin_bit_cast(unsigned, rec_w[j])); } }
}
__device__ __forceinline__ void moe_table(Frame& F, int l) {
    LAS int* tab = (LAS int*)(F.lds + TAB_OFF);
    if (F.tid == 0) { int acc = 0; const unsigned* cnt = (const unsigned*)(F.ctl + CW_CNT + l * 16);
        for (int e = 0; e < 16; ++e) { const int n = (int)__hip_atomic_load(cnt + e, __ATOMIC_RELAXED, __HIP_MEMORY_SCOPE_AGENT); tab[e] = acc; tab[17 + e] = n; acc += (n + 255) >> 8; }
        tab[16] = acc; }
    __syncthreads();
}

__device__ __forceinline__ void seq_info(int r, int& base, int& t, int& L) {
    if (r < NLAT) { base = r & ~(SEQ - 1); t = r & (SEQ - 1); L = SEQ; } else { const int j = r - NLAT; base = NLAT + (j & ~(CTXL - 1)); t = j & (CTXL - 1); L = CTXL; }
}
typedef unsigned v2u __attribute__((ext_vector_type(2)));
__device__ __forceinline__ unsigned cvtpk(float lo, float hi) { unsigned r; asm volatile("v_cvt_pk_bf16_f32 %0, %1, %2" : "=v"(r) : "v"(lo), "v"(hi)); return r; }
__device__ __forceinline__ bf16x8 mk8(v2u a, v2u b) { v4u w; w.x = a.x; w.y = a.y; w.z = b.x; w.w = b.y; return __builtin_bit_cast(bf16x8, w); }
template <bool LAT>
__device__ __forceinline__ void kv_unit(Frame& F, int bh, int rq, LAS unsigned short* T) {
    const bf16* U = (const bf16*)(F.ws + WS_U);
    const int q = F.lane & 15, g = F.lane >> 4, h = bh & 3;
    const int urow0 = LAT ? ((bh >> 2) * SEQ + rq * 64) : (NLAT + (bh >> 2) * CTXL + rq * 64);
    bf16* kdst = LAT ? (bf16*)(F.ws + WS_KF) + ((size_t)(bh * 64 + rq) * 14) * 512 : (bf16*)(F.ws + WS_KFC) + ((size_t)(bh * 16 + rq * 4) * 2) * 512;
    bf16* vdst = LAT ? (bf16*)(F.ws + WS_VF) + ((size_t)(bh * 64 + rq) * 16) * 512 : (bf16*)(F.ws + WS_VFC) + ((size_t)(bh * 8 + rq * 2) * 4) * 512;
    { const bf16* src = U + (size_t)(urow0 + F.lane) * INC + UC_V + h * HD;
#pragma unroll
      for (int p = 0; p < 8; ++p) { const v4u w = *(const GAS v4u*)(src + 8 * p); LAS unsigned short* tp = T + (8 * p) * 72 + F.lane;
          tp[0 * 72] = (unsigned short)w.x; tp[1 * 72] = (unsigned short)(w.x >> 16); tp[2 * 72] = (unsigned short)w.y; tp[3 * 72] = (unsigned short)(w.y >> 16);
          tp[4 * 72] = (unsigned short)w.z; tp[5 * 72] = (unsigned short)(w.z >> 16); tp[6 * 72] = (unsigned short)w.w; tp[7 * 72] = (unsigned short)(w.w >> 16); } }
    constexpr int NK = LAT ? 7 : 4, KST = LAT ? 8 : 16;
#pragma unroll
    for (int sidx = 0; sidx < NK; ++sidx)
#pragma unroll
        for (int ks = 0; ks < 2; ++ks) { const v4u w = *(const GAS v4u*)(U + (size_t)(urow0 + KST * sidx + q) * INC + UC_K + h * HD + 32 * ks + 8 * g); *(GAS v4u*)(kdst + (size_t)(sidx * 2 + ks) * 512 + F.lane * 8) = w; }
    LDS_WAIT(); asm volatile("" ::: "memory");
    constexpr int NV = LAT ? 4 : 2;
#pragma unroll
    for (int w = 0; w < NV; ++w) { const int vst = LAT ? (w == 0 ? 0 : (w == 1 ? 8 : (w == 2 ? 24 : 32))) : 32 * w;
#pragma unroll
        for (int dt = 0; dt < 4; ++dt) { const LAS unsigned short* tp = T + (16 * dt + q) * 72 + vst + 4 * g; const v2u lo = *(const LAS v2u*)tp, hi = *(const LAS v2u*)(tp + 16);
            v4u o; o.x = lo.x; o.y = lo.y; o.z = hi.x; o.w = hi.y; *(GAS v4u*)(vdst + (size_t)(w * 4 + dt) * 512 + F.lane * 8) = o; } }
    LDS_WAIT(); asm volatile("" ::: "memory");
}
__device__ __forceinline__ void kv_prepass(Frame& F) {
    LAS unsigned short* T = (LAS unsigned short*)(F.lds + RING_OFF + F.wave * 16384);
    const int gw = F.bid * NWAVES + F.wave, NGW = F.G * NWAVES;
#pragma unroll 1
    for (int idx = gw; idx < 2048; idx += NGW) kv_unit<true>(F, idx >> 6, idx & 63, T);
#pragma unroll 1
    for (int idx = gw; idx < 128; idx += NGW) kv_unit<false>(F, idx >> 2, idx & 3, T);
}
template <bool LAT>
__device__ __forceinline__ void attn_unit(Frame& F, int l, int b, int h, int r, int cb, const LAS float* rpbs) {
    const bf16* U = (const bf16*)(F.ws + WS_U); bf16* Y = (bf16*)(F.ws + WS_H);
    const bf16* KF = (const bf16*)(F.ws + WS_KF); const bf16* VF = (const bf16*)(F.ws + WS_VF); const bf16* KFC = (const bf16*)(F.ws + WS_KFC); const bf16* VFC = (const bf16*)(F.ws + WS_VFC);
    const size_t bh = (size_t)(b * NHEAD + h);
    const int q = F.lane & 15, g = F.lane >> 4;
    constexpr int NT_ = LAT ? 32 : 16, NB = LAT ? 16 : 0;
    const int qrow = LAT ? (b * SEQ + r * GRIDW + cb * 16 + q) : (NLAT + b * CTXL + cb * 16 + q);
    const int r0 = r - 4 < 0 ? 0 : (r - 4 > 56 ? 56 : r - 4);
    const int wb = cb * 16 - 8 < 0 ? 0 : (cb * 16 - 8 > 32 ? 32 : cb * 16 - 8);
    bf16x8 qf[2];
#pragma unroll
    for (int ks = 0; ks < 2; ++ks) qf[ks] = *(const GAS bf16x8*)(U + (size_t)qrow * INC + UC_Q + h * HD + 32 * ks + 8 * g);
    f32x4 s[NT_];
#pragma unroll
    for (int t = 0; t < NT_; ++t) {
        const bf16* kp;
        if (t < NB) { const int kr = t >> 1, seg = t & 1; kp = KF + (((bh * 64 + (r0 + kr)) * 7 + ((wb >> 3) + 2 * seg)) * 2) * 512 + F.lane * 8; } else kp = KFC + ((bh * 16 + (t - NB)) * 2) * 512 + F.lane * 8;
        const bf16x8 k0 = *(const GAS bf16x8*)kp, k1 = *(const GAS bf16x8*)(kp + 512);
        f32x4 a = (f32x4){0.f, 0.f, 0.f, 0.f};
        a = __builtin_amdgcn_mfma_f32_16x16x32_bf16(k0, qf[0], a, 0, 0, 0);
        s[t] = __builtin_amdgcn_mfma_f32_16x16x32_bf16(k1, qf[1], a, 0, 0, 0);
    }
    float m = -3.0e38f;
    if (LAT) {
        const int cq = cb * 16 + q; const int c0 = cq - 8 < 0 ? 0 : (cq - 8 > 48 ? 48 : cq - 8);
        const LAS float* rp = rpbs + h * 15 * 31;
#pragma unroll
        for (int t = 0; t < NB; ++t) { const int kr = t >> 1, seg = t & 1; const int rrel = r0 + kr - r + 7;
#pragma unroll
            for (int i = 0; i < 4; ++i) { const int cc = wb + seg * 16 + 4 * g + i; const bool ok = (cc >= c0) && (cc < c0 + 16);
                int ci = cc - cq + 15; ci = ci < 0 ? 0 : (ci > 30 ? 30 : ci);
                const float bias = rp[rrel * 31 + ci];
                float v = s[t][i] * 0.125f + bias; v = ok ? v : -3.0e38f; s[t][i] = v; m = fmaxf(m, v); } }
    }
#pragma unroll
    for (int t = NB; t < NT_; ++t)
#pragma unroll
        for (int i = 0; i < 4; ++i) { const float v = s[t][i] * 0.125f; s[t][i] = v; m = fmaxf(m, v); }
    m = fmaxf(m, __shfl_xor(m, 16)); m = fmaxf(m, __shfl_xor(m, 32));
    float sum = 0.f;
#pragma unroll
    for (int t = 0; t < NT_; ++t)
#pragma unroll
        for (int i = 0; i < 4; ++i) { const float p = __expf(s[t][i] - m); s[t][i] = p; sum += p; }
    sum += __shfl_xor(sum, 16); sum += __shfl_xor(sum, 32);
    f32x4 o[4];
#pragma unroll
    for (int dt = 0; dt < 4; ++dt) o[dt] = (f32x4){0.f, 0.f, 0.f, 0.f};
#pragma unroll
    for (int kk = 0; kk < NT_ / 2; ++kk) {
        v4u pw; pw.x = cvtpk(s[2 * kk][0], s[2 * kk][1]); pw.y = cvtpk(s[2 * kk][2], s[2 * kk][3]); pw.z = cvtpk(s[2 * kk + 1][0], s[2 * kk + 1][1]); pw.w = cvtpk(s[2 * kk + 1][2], s[2 * kk + 1][3]);
        const bf16x8 pf = __builtin_bit_cast(bf16x8, pw);
        const bf16* vbase;
        if (2 * kk < NB) vbase = VF + (((bh * 64 + (r0 + kk)) * 4 + cb) * 4) * 512 + F.lane * 8; else vbase = VFC + ((bh * 8 + (kk - NB / 2)) * 4) * 512 + F.lane * 8;
#pragma unroll
        for (int dt = 0; dt < 4; ++dt) { const bf16x8 vf = *(const GAS bf16x8*)(vbase + dt * 512);
            o[dt] = __builtin_amdgcn_mfma_f32_16x16x32_bf16(vf, pf, o[dt], 0, 0, 0); }
    }
    const float inv = 1.0f / sum; bf16* yp = Y + (size_t)qrow * D + 512 + h * HD + 4 * g;
#pragma unroll
    for (int dt = 0; dt < 4; ++dt) { v2u w; w.x = cvtpk(o[dt][0] * inv, o[dt][1] * inv); w.y = cvtpk(o[dt][2] * inv, o[dt][3] * inv); *(GAS v2u*)(yp + dt * 16) = w; }
}
__device__ __forceinline__ void attn_phase(Frame& F, int l, bool with_ctx) {
    LAS float* rpbs = (LAS float*)(F.lds + TAB_OFF);
    { const float* rp = F.inp(I_RPB) + (size_t)l * NHEAD * 15 * 31; for (int i = F.tid; i < NHEAD * 15 * 31; i += NT) rpbs[i] = rp[i]; }
    __syncthreads();
    const int gw = F.bid * NWAVES + F.wave, NGW = F.G * NWAVES;
    {
        const int x = F.bid & 7, lb = F.bid >> 3, nlb = (F.G - x + 7) >> 3;
#pragma unroll 1
        for (int uu = lb * NWAVES + F.wave; uu < 1024; uu += nlb * NWAVES) { const int bh = 4 * x + (uu >> 8), u = uu & 255; attn_unit<true>(F, l, bh >> 2, bh & 3, u >> 2, u & 3, rpbs); } }
    if (with_ctx) for (int uid = gw; uid < BATCH * NHEAD * 16; uid += NGW) { const int cb = uid & 15, h = (uid >> 4) & 3, b = uid >> 6; attn_unit<false>(F, l, b, h, 0, cb, rpbs); }
}
__device__ __forceinline__ void dft64_tables(Frame& F, int off) {
    LAS unsigned short* CT = (LAS unsigned short*)(F.lds + off); LAS unsigned short* ST = CT + 64 * 72;
    for (int i = F.tid; i < 4096; i += NT) { const int j = i >> 6, k = i & 63; float s_, c_; sincospif((float)((j * k) & 63) * (1.0f / 32.0f), &s_, &c_); CT[j * 72 + k] = (unsigned short)f2bf(c_); ST[j * 72 + k] = (unsigned short)f2bf(s_); }
}
__device__ __forceinline__ void fourier_a(Frame& F) {
    const bf16* U = (const bf16*)(F.ws + WS_U); bf16* Zr = (bf16*)(F.ws + WS_Z); bf16* Zi = Zr + NZ;
    constexpr int O_CT = 0, O_TWC = 18432, O_TWS = O_TWC + 16384;
    dft64_tables(F, O_CT);
    { LAS float* twc = (LAS float*)(F.lds + O_TWC); LAS float* tws = (LAS float*)(F.lds + O_TWS);
      for (int i = F.tid; i < 4096; i += NT) { float s_, c_; sincospif((float)i * (1.0f / 2048.0f), &s_, &c_); twc[i] = c_; tws[i] = s_; } }
    __syncthreads();
    const LAS unsigned short* CT = (const LAS unsigned short*)(F.lds + O_CT); const LAS unsigned short* ST = CT + 64 * 72;
    const LAS float* twc = (const LAS float*)(F.lds + O_TWC); const LAS float* tws = (const LAS float*)(F.lds + O_TWS);
    const int q = F.lane & 15, g = F.lane >> 4;
    const int gw = F.bid * NWAVES + F.wave, NGW = F.G * NWAVES;
    for (int un = gw; un < BATCH * NHEAD * 64; un += NGW) {
        const int b = un >> 8, h = (un >> 6) & 3, n2 = un & 63;
        f32x4 xr[4][4], xw[4][4];
#pragma unroll
        for (int mt = 0; mt < 4; ++mt)
#pragma unroll
            for (int ct = 0; ct < 4; ++ct) { xr[mt][ct] = (f32x4){0.f, 0.f, 0.f, 0.f}; xw[mt][ct] = (f32x4){0.f, 0.f, 0.f, 0.f}; }
#pragma unroll
        for (int ks = 0; ks < 2; ++ks) {
            bf16x8 tf[4], cf[4], sf[4];
#pragma unroll
            for (int mt = 0; mt < 4; ++mt) tf[mt] = *(const GAS bf16x8*)(U + (size_t)(b * SEQ + 64 * (16 * mt + q) + n2) * INC + UC_F + h * HD + 32 * ks + 8 * g);
#pragma unroll
            for (int ct = 0; ct < 4; ++ct) { cf[ct] = *(const LAS bf16x8*)(CT + (16 * ct + q) * 72 + 32 * ks + 8 * g); sf[ct] = *(const LAS bf16x8*)(ST + (16 * ct + q) * 72 + 32 * ks + 8 * g); }
#pragma unroll
            for (int mt = 0; mt < 4; ++mt)
#pragma unroll
                for (int ct = 0; ct < 4; ++ct) { xr[mt][ct] = __builtin_amdgcn_mfma_f32_16x16x32_bf16(tf[mt], cf[ct], xr[mt][ct], 0, 0, 0); xw[mt][ct] = __builtin_amdgcn_mfma_f32_16x16x32_bf16(tf[mt], sf[ct], xw[mt][ct], 0, 0, 0); }
        }
        v4u ar[4][2], awn[4][2];
#pragma unroll
        for (int ct = 0; ct < 4; ++ct)
#pragma unroll
            for (int kb = 0; kb < 2; ++kb) {
                ar[ct][kb].x = cvtpk(xr[2 * kb][ct][0], xr[2 * kb][ct][1]); ar[ct][kb].y = cvtpk(xr[2 * kb][ct][2], xr[2 * kb][ct][3]);
                ar[ct][kb].z = cvtpk(xr[2 * kb + 1][ct][0], xr[2 * kb + 1][ct][1]); ar[ct][kb].w = cvtpk(xr[2 * kb + 1][ct][2], xr[2 * kb + 1][ct][3]);
                awn[ct][kb].x = cvtpk(-xw[2 * kb][ct][0], -xw[2 * kb][ct][1]); awn[ct][kb].y = cvtpk(-xw[2 * kb][ct][2], -xw[2 * kb][ct][3]);
                awn[ct][kb].z = cvtpk(-xw[2 * kb + 1][ct][0], -xw[2 * kb + 1][ct][1]); awn[ct][kb].w = cvtpk(-xw[2 * kb + 1][ct][2], -xw[2 * kb + 1][ct][3]); }
#pragma unroll
        for (int rt = 0; rt < 4; ++rt) {
            const int n1p = 16 * rt + q;
            bf16x8 cb_[2], sb_[2];
#pragma unroll
            for (int kb = 0; kb < 2; ++kb) { const LAS unsigned short* cp = CT + n1p * 72 + 32 * kb + 4 * g; const LAS unsigned short* sp = ST + n1p * 72 + 32 * kb + 4 * g;
                cb_[kb] = mk8(*(const LAS v2u*)cp, *(const LAS v2u*)(cp + 16)); sb_[kb] = mk8(*(const LAS v2u*)sp, *(const LAS v2u*)(sp + 16)); }
            const int tix = n2 * n1p; const float cw = twc[tix], sw = tws[tix];
            const size_t zbase = ((((size_t)(b * NHEAD + h) * 64 + n1p) * 64 + n2) * 64) + 4 * g;
#pragma unroll
            for (int ct = 0; ct < 4; ++ct) {
                f32x4 yr = (f32x4){0.f, 0.f, 0.f, 0.f}, yi = (f32x4){0.f, 0.f, 0.f, 0.f};
#pragma unroll
                for (int kb = 0; kb < 2; ++kb) {
                    const bf16x8 a_r = __builtin_bit_cast(bf16x8, ar[ct][kb]), a_wn = __builtin_bit_cast(bf16x8, awn[ct][kb]);
                    v4u nr = ar[ct][kb]; nr.x ^= 0x80008000u; nr.y ^= 0x80008000u; nr.z ^= 0x80008000u; nr.w ^= 0x80008000u; const bf16x8 a_rn = __builtin_bit_cast(bf16x8, nr);
                    yr = __builtin_amdgcn_mfma_f32_16x16x32_bf16(a_r, cb_[kb], yr, 0, 0, 0); yr = __builtin_amdgcn_mfma_f32_16x16x32_bf16(a_wn, sb_[kb], yr, 0, 0, 0);
                    yi = __builtin_amdgcn_mfma_f32_16x16x32_bf16(a_wn, cb_[kb], yi, 0, 0, 0); yi = __builtin_amdgcn_mfma_f32_16x16x32_bf16(a_rn, sb_[kb], yi, 0, 0, 0); }
                v2u wr_, wi_;
                wr_.x = cvtpk(yr[0] * cw + yi[0] * sw, yr[1] * cw + yi[1] * sw); wr_.y = cvtpk(yr[2] * cw + yi[2] * sw, yr[3] * cw + yi[3] * sw);
                wi_.x = cvtpk(yi[0] * cw - yr[0] * sw, yi[1] * cw - yr[1] * sw); wi_.y = cvtpk(yi[2] * cw - yr[2] * sw, yi[3] * cw - yr[3] * sw);
                *(GAS v2u*)(Zr + zbase + 16 * ct) = wr_; *(GAS v2u*)(Zi + zbase + 16 * ct) = wi_;
            }
        }
    }
}
__device__ __forceinline__ void fourier_b(Frame& F, bool with_ctx) {
    bf16* Y = (bf16*)(F.ws + WS_H); const bf16* Zr = (const bf16*)(F.ws + WS_Z);
    dft64_tables(F, 0);
    __syncthreads();
    const LAS unsigned short* CT = (const LAS unsigned short*)(F.lds); const LAS unsigned short* ST = CT + 64 * 72;
    LAS unsigned short* ZT = (LAS unsigned short*)(F.lds + 18432 + F.wave * 9216);
    const int q = F.lane & 15, g = F.lane >> 4;
    const int gw = F.bid * NWAVES + F.wave, NGW = F.G * NWAVES;
    const int nun = BATCH * NHEAD * 64 + (with_ctx ? BATCH * NHEAD * 4 : 0);
    for (int un = gw; un < nun; un += NGW) {
        const bool lat = un < BATCH * NHEAD * 64; const int uc = un - BATCH * NHEAD * 64;
        const int b = lat ? (un >> 8) : (uc >> 4), h = lat ? ((un >> 6) & 3) : ((uc >> 2) & 3), n1p = lat ? (un & 63) : (uc & 3);
        const size_t z0 = lat ? (((size_t)(b * NHEAD + h) * 64 + n1p) * 64) * 64 : 2 * NZ + (((size_t)(b * NHEAD + h) * 4 + n1p) * 64) * 64;
        const size_t zim = lat ? NZ : NZC;
        const int tok0 = lat ? (b * SEQ + n1p) : (NLAT + b * CTXL + n1p), tstride = lat ? 64 : 4; const float oscale = lat ? (1.0f / 512.0f) : (1.0f / 128.0f);
        f32x4 acc[4][4];
#pragma unroll
        for (int ct = 0; ct < 4; ++ct)
#pragma unroll
            for (int nt = 0; nt < 4; ++nt) acc[ct][nt] = (f32x4){0.f, 0.f, 0.f, 0.f};
#pragma unroll
        for (int comp = 0; comp < 2; ++comp) {
            const bf16* zp = Zr + z0 + (comp ? zim : 0); const LAS unsigned short* FT = comp ? ST : CT;
#pragma unroll
            for (int i = 0; i < 8; ++i) { const int p = F.lane + 64 * i, n2 = p >> 3, c8 = p & 7; const v4u w = *(const GAS v4u*)(zp + (size_t)n2 * 64 + 8 * c8); LAS unsigned short* tp = ZT + (8 * c8) * 72 + n2;
                tp[0 * 72] = (unsigned short)w.x; tp[1 * 72] = (unsigned short)(w.x >> 16); tp[2 * 72] = (unsigned short)w.y; tp[3 * 72] = (unsigned short)(w.y >> 16);
                tp[4 * 72] = (unsigned short)w.z; tp[5 * 72] = (unsigned short)(w.z >> 16); tp[6 * 72] = (unsigned short)w.w; tp[7 * 72] = (unsigned short)(w.w >> 16); }
            LDS_WAIT(); asm volatile("" ::: "memory");
#pragma unroll
            for (int ks = 0; ks < 2; ++ks) {
                bf16x8 af[4], bf_[4];
#pragma unroll
                for (int ct = 0; ct < 4; ++ct) af[ct] = *(const LAS bf16x8*)(ZT + (16 * ct + q) * 72 + 32 * ks + 8 * g);
#pragma unroll
                for (int nt = 0; nt < 4; ++nt) bf_[nt] = *(const LAS bf16x8*)(FT + (16 * nt + q) * 72 + 32 * ks + 8 * g);
#pragma unroll
                for (int ct = 0; ct < 4; ++ct)
#pragma unroll
                    for (int nt = 0; nt < 4; ++nt) acc[ct][nt] = __builtin_amdgcn_mfma_f32_16x16x32_bf16(af[ct], bf_[nt], acc[ct][nt], 0, 0, 0);
            }
            LDS_WAIT(); asm volatile("" ::: "memory");
        }
#pragma unroll
        for (int nt = 0; nt < 4; ++nt) { bf16* yp = Y + (size_t)(tok0 + tstride * (16 * nt + q)) * D + 768 + h * HD + 4 * g;
#pragma unroll
            for (int ct = 0; ct < 4; ++ct) { v2u w; w.x = cvtpk(acc[ct][nt][0] * oscale, acc[ct][nt][1] * oscale); w.y = cvtpk(acc[ct][nt][2] * oscale, acc[ct][nt][3] * oscale); *(GAS v2u*)(yp + 16 * ct) = w; } }
    }
}
__device__ __forceinline__ v4u mul_bf8(v4u a, v4u b) { v4u r; r.x = cvtpk(bflo(a.x) * bflo(b.x), bfhi(a.x) * bfhi(b.x)); r.y = cvtpk(bflo(a.y) * bflo(b.y), bfhi(a.y) * bfhi(b.y)); r.z = cvtpk(bflo(a.z) * bflo(b.z), bfhi(a.z) * bfhi(b.z)); r.w = cvtpk(bflo(a.w) * bflo(b.w), bfhi(a.w) * bfhi(b.w)); return r; }
__device__ __forceinline__ void convpool_phase(Frame& F, int l, int nrows) {
    const bf16* U = (const bf16*)(F.ws + WS_U); bf16* Y = (bf16*)(F.ws + WS_H);
    const bf16* PWT = (const bf16*)(F.ws + WS_PWT) + (size_t)l * 4 * 64 * 64;
    const float* cw = F.inp(I_CONVW) + (size_t)l * 3 * GWID; const float* ps = F.inp(I_POOLS) + (size_t)l * GWID;
    LAS unsigned* PX = (LAS unsigned*)(F.lds + RING_OFF);
    LAS unsigned* DT = (LAS unsigned*)(F.lds + RING_OFF + 40960);
    const int q = F.lane & 15, g = F.lane >> 4;
    for (int tile = F.bid; tile < nrows / 64; tile += F.G) {
        const int r0 = tile * 64; int base, t0, L; seq_info(r0, base, t0, L);
#pragma unroll
        for (int i = 0; i < 4; ++i) { const int p = F.tid + NT * i, tr = p >> 5, c8 = p & 31, t = t0 + tr; const bf16* ur = U + (size_t)(r0 + tr) * INC + 8 * c8;
            const v4u zc = mul_bf8(*(const GAS v4u*)(ur + UC_AC), *(const GAS v4u*)(ur + UC_AV));
            v4u zp = (v4u){0u, 0u, 0u, 0u}, zn = (v4u){0u, 0u, 0u, 0u};
            if (t > 0) zp = mul_bf8(*(const GAS v4u*)(ur + UC_AC - INC), *(const GAS v4u*)(ur + UC_AV - INC));
            if (t < L - 1) zn = mul_bf8(*(const GAS v4u*)(ur + UC_AC + INC), *(const GAS v4u*)(ur + UC_AV + INC));
            const v4u ab = *(const GAS v4u*)(ur + UC_AB);
            const f32x4 w0a = *(const GAS f32x4*)(cw + 8 * c8), w0b = *(const GAS f32x4*)(cw + 8 * c8 + 4), w1a = *(const GAS f32x4*)(cw + GWID + 8 * c8), w1b = *(const GAS f32x4*)(cw + GWID + 8 * c8 + 4),
                        w2a = *(const GAS f32x4*)(cw + 2 * GWID + 8 * c8), w2b = *(const GAS f32x4*)(cw + 2 * GWID + 8 * c8 + 4);
            v4u o;
            o.x = cvtpk(bflo(ab.x) * (w0a.x * bflo(zp.x) + w1a.x * bflo(zc.x) + w2a.x * bflo(zn.x)), bfhi(ab.x) * (w0a.y * bfhi(zp.x) + w1a.y * bfhi(zc.x) + w2a.y * bfhi(zn.x)));
            o.y = cvtpk(bflo(ab.y) * (w0a.z * bflo(zp.y) + w1a.z * bflo(zc.y) + w2a.z * bflo(zn.y)), bfhi(ab.y) * (w0a.w * bfhi(zp.y) + w1a.w * bfhi(zc.y) + w2a.w * bfhi(zn.y)));
            o.z = cvtpk(bflo(ab.z) * (w0b.x * bflo(zp.z) + w1b.x * bflo(zc.z) + w2b.x * bflo(zn.z)), bfhi(ab.z) * (w0b.y * bfhi(zp.z) + w1b.y * bfhi(zc.z) + w2b.y * bfhi(zn.z)));
            o.w = cvtpk(bflo(ab.w) * (w0b.z * bflo(zp.w) + w1b.z * bflo(zc.w) + w2b.z * bflo(zn.w)), bfhi(ab.w) * (w0b.w * bfhi(zp.w) + w1b.w * bfhi(zc.w) + w2b.w * bfhi(zn.w)));
            *(GAS v4u*)(Y + (size_t)(r0 + tr) * D + 8 * c8) = o; }
#pragma unroll
        for (int i = 0; i < 5; ++i) { const int p = F.tid + NT * i, rr = p >> 5, c8 = p & 31, t = t0 - 8 + rr; v4u w = (v4u){0u, 0u, 0u, 0u};
            if (t >= 0 && t < L) w = *(const GAS v4u*)(U + (size_t)(base + t) * INC + UC_P + 8 * c8);
            *(LAS v4u*)(PX + rr * 128 + 4 * c8) = w; }
        __syncthreads();
        { const int c2 = F.tid & 127, tq = F.tid >> 7, hw = 1 << (c2 >> 5);
          float s0 = 0.f, s1 = 0.f;
          for (int k = -hw; k < hw; ++k) { const unsigned w = PX[(16 * tq + 8 + k) * 128 + c2]; s0 += bflo(w); s1 += bfhi(w); }
          for (int i = 0; i < 16; ++i) { const int tl = 16 * tq + i, t = t0 + tl;
              const int lo = t - hw > 0 ? t - hw : 0, hi = t + hw < L ? t + hw : L; const float rc = 1.0f / (float)(hi - lo);
              const unsigned xc = PX[(tl + 8) * 128 + c2];
              DT[tl * 132 + c2] = cvtpk(s0 * rc - bflo(xc), s1 * rc - bfhi(xc));
              const unsigned wa = PX[(tl + 8 + hw) * 128 + c2], wsb = PX[(tl + 8 - hw) * 128 + c2];
              s0 += bflo(wa) - bflo(wsb); s1 += bfhi(wa) - bfhi(wsb); } }
        __syncthreads();
        { const int gi = F.wave & 3;
          bf16x8 wf[4][2];
#pragma unroll
          for (int dt = 0; dt < 4; ++dt)
#pragma unroll
              for (int ks = 0; ks < 2; ++ks) wf[dt][ks] = *(const GAS bf16x8*)(PWT + ((size_t)gi * 64 + 16 * dt + q) * 64 + 32 * ks + 8 * g);
#pragma unroll
          for (int tj = 0; tj < 2; ++tj) { const int tt = 2 * (F.wave >> 2) + tj;
              bf16x8 df[2];
#pragma unroll
              for (int ks = 0; ks < 2; ++ks) df[ks] = *(const LAS bf16x8*)(DT + (16 * tt + q) * 132 + gi * 32 + 16 * ks + 4 * g);
#pragma unroll
              for (int dt = 0; dt < 4; ++dt) { f32x4 a = (f32x4){0.f, 0.f, 0.f, 0.f};
                  a = __builtin_amdgcn_mfma_f32_16x16x32_bf16(wf[dt][0], df[0], a, 0, 0, 0); a = __builtin_amdgcn_mfma_f32_16x16x32_bf16(wf[dt][1], df[1], a, 0, 0, 0);
                  const int oc = gi * 64 + 16 * dt + 4 * g; const f32x4 sc = *(const GAS f32x4*)(ps + oc);
                  v2u w; w.x = cvtpk(a[0] * sc.x, a[1] * sc.y); w.y = cvtpk(a[2] * sc.z, a[3] * sc.w);
                  *(GAS v2u*)(Y + (size_t)(r0 + 16 * tt + q) * D + 256 + oc) = w; } } }
        __syncthreads();
    }
}

__device__ __forceinline__ void fourier_ctx_a(Frame& F) {
    const bf16* U = (const bf16*)(F.ws + WS_U); bf16* Zc = (bf16*)(F.ws + WS_Z) + 2 * NZ;
    LAS float* cs = (LAS float*)(F.lds + TAB_OFF); LAS float* sn = cs + 64; LAS float* cs256 = cs + 128; LAS float* sn256 = cs + 384;
    if (F.tid < 64) { float s_, c_; sincospif((float)F.tid * (1.0f / 32.0f), &s_, &c_); cs[F.tid] = c_; sn[F.tid] = s_; }
    if (F.tid < 256) { float s_, c_; sincospif((float)F.tid * (1.0f / 128.0f), &s_, &c_); cs256[F.tid] = c_; sn256[F.tid] = s_; }
    __syncthreads();
    for (int item = F.bid * NT + F.tid; item < BATCH * NHEAD * 64 * 64; item += F.G * NT) {
        const int cp = item & 63, n2 = (item >> 6) & 63, h = (item >> 12) & 3, b = item >> 14;
        float xr[4], xi[4];
#pragma unroll
        for (int n1 = 0; n1 < 4; ++n1) { xr[n1] = 0.f; xi[n1] = 0.f; }
        for (int c8 = 0; c8 < 8; ++c8) {
            float cc[8], ss[8];
#pragma unroll
            for (int e = 0; e < 8; ++e) { const int idx = ((8 * c8 + e) * cp) & 63; cc[e] = cs[idx]; ss[e] = sn[idx]; }
#pragma unroll
            for (int n1 = 0; n1 < 4; ++n1) { const v4u w = *(const GAS v4u*)(U + (size_t)(NLAT + b * CTXL + 64 * n1 + n2) * INC + UC_F + h * HD + 8 * c8);
                const float f0 = bflo(w.x), f1 = bfhi(w.x), f2 = bflo(w.y), f3 = bfhi(w.y), f4 = bflo(w.z), f5 = bfhi(w.z), f6 = bflo(w.w), f7 = bfhi(w.w);
                xr[n1] += f0 * cc[0] + f1 * cc[1] + f2 * cc[2] + f3 * cc[3] + f4 * cc[4] + f5 * cc[5] + f6 * cc[6] + f7 * cc[7];
                xi[n1] -= f0 * ss[0] + f1 * ss[1] + f2 * ss[2] + f3 * ss[3] + f4 * ss[4] + f5 * ss[5] + f6 * ss[6] + f7 * ss[7]; }
        }
        float yr[4], yi[4];
        yr[0] = xr[0] + xr[1] + xr[2] + xr[3];           yi[0] = xi[0] + xi[1] + xi[2] + xi[3];
        yr[1] = xr[0] + xi[1] - xr[2] - xi[3];           yi[1] = xi[0] - xr[1] - xi[2] + xr[3];
        yr[2] = xr[0] - xr[1] + xr[2] - xr[3];           yi[2] = xi[0] - xi[1] + xi[2] - xi[3];
        yr[3] = xr[0] - xi[1] - xr[2] + xi[3];           yi[3] = xi[0] + xr[1] - xi[2] - xr[3];
#pragma unroll
        for (int k = 0; k < 4; ++k) { const int tix = (n2 * k) & 255; const float cw = cs256[tix], sw = sn256[tix];
            const size_t zi = ((((size_t)(b * NHEAD + h) * 4 + k) * 64 + n2) * 64) + cp;
            Zc[zi] = (bf16)f2bf(yr[k] * cw + yi[k] * sw); Zc[NZC + zi] = (bf16)f2bf(yi[k] * cw - yr[k] * sw); }
    }
}

#ifndef REP_CP
#define REP_CP 1
#endif
#ifndef REP_KV
#define REP_KV 1
#endif
#ifndef REP_FA
#define REP_FA 1
#endif
#ifndef REP_ATT
#define REP_ATT 1
#endif
#ifndef REP_FB
#define REP_FB 1
#endif
__device__ __forceinline__ void mixa_phase(int l, bool with_ctx) { Frame F = mk_frame();
    const int nrows = with_ctx ? NROW : NLAT;
    convpool_phase(F, l, nrows);
#if REP_CP > 1
    convpool_phase(F, l, nrows);
#endif
    kv_prepass(F);
#if REP_KV > 1
    kv_prepass(F);
#endif
    __syncthreads();
    fourier_a(F);
    __syncthreads();
#if REP_FA > 1
    fourier_a(F);
    __syncthreads();
#endif
    if (with_ctx) fourier_ctx_a(F);
}
__device__ __forceinline__ void mixb_phase(int l, bool with_ctx) { Frame F = mk_frame();
    attn_phase(F, l, with_ctx);
    __syncthreads();
#if REP_ATT > 1
    attn_phase(F, l, with_ctx);
    __syncthreads();
#endif
    fourier_b(F, with_ctx);
#if REP_FB > 1
    __syncthreads();
    fourier_b(F, with_ctx);
#endif
}

struct WinOrder {
    int G, c, nctx_cols, ctx_pn0;
    __device__ __forceinline__ bool next(int i, pg8::Unit& u) const {
        const long L = (long)i * G + c; const int nlatu = 1024, total = nlatu + 8 * nctx_cols; if (L >= total) return false;
        if (L < nlatu) { int wgid = (int)L; { const int xcd = wgid % 8, off = wgid / 8; wgid = xcd * 128 + off; }
            const int gid = wgid / 64, fm = gid * 8; u.pm = fm + ((wgid % 64) % 8); u.pn = (wgid % 64) / 8; }
        else { const int j = (int)L - nlatu; u.pm = 128 + (j % 8); u.pn = ctx_pn0 + j / 8; }
        u.pb = u.pn; u.lb = 0; u.nv = 256; return true;
    }
    __device__ __forceinline__ void a_ready(const pg8::Unit&) const {}
    __device__ __forceinline__ void done(const pg8::Unit&) const {}
    __device__ __forceinline__ int row_of(const pg8::Unit&, int i) const { return i; }
};

struct Args { const float* in[20]; float* out; unsigned char* ws; int l, e; };
#define PH_PTRS() \
    bf16* H = (bf16*)(F.ws + WS_H); bf16* U = (bf16*)(F.ws + WS_U); bf16* HE = (bf16*)(F.ws + WS_U); bf16* Y2 = (bf16*)(F.ws + WS_S); \
    float* MOD = (float*)(F.ws + WS_MOD); float* XC = (float*)(F.ws + WS_XC); const uint2* INFO = (const uint2*)(F.ws + WS_INFO); \
    const bool first = (l == 0); const int M = first ? NROW : NLAT; const float* modl = MOD + (size_t)l * 9 * 6144; \
    (void)H; (void)U; (void)HE; (void)XC; (void)Y2; (void)INFO; (void)M; (void)modl;

__device__ __forceinline__ void ph_norm1(int l) { Frame F = mk_frame(); PH_PTRS();
    norm_phase<0, false>(F, F.inp(I_X), F.inp(I_CTX), nullptr, nullptr, NROW, F.inp(I_N1G), modl, modl, 0, 1, H, nullptr, nullptr); }
__device__ __forceinline__ void ph_next(int l, bool probe = false) { Frame F = mk_frame(); PH_PTRS();
    if (first) norm_phase<1, false>(F, F.out, XC, probe ? (float*)(F.ws + WS_U) : F.out, probe ? (float*)(F.ws + WS_U) + (size_t)NLAT * D : XC, NROW, F.inp(I_N1G) + D, MOD + (size_t)9 * 6144, modl, 0, 1, H, Y2, nullptr);
    else norm_phase<1, true>(F, F.out, XC, F.out, XC, NLAT, F.inp(I_FG), modl, modl, 0, 0, nullptr, Y2, F.out); }
__device__ __forceinline__ void ph_route(int l, bool probe = false) { Frame F = mk_frame(); PH_PTRS();
    route_phase(F, l, first ? F.inp(I_X) : F.out, first ? F.inp(I_CTX) : XC, F.out, XC, U, M, F.inp(I_N2G) + (size_t)l * D, modl, H, (uint2*)(F.ws + WS_INFO), (unsigned*)(F.ctl + CW_CNT + l * 16)); }
__device__ __forceinline__ void ph_win(int l) { Frame F = mk_frame(); PH_PTRS();
    pg8::Gemm g{H, (const bf16*)(F.ws + WS_WIN) + (size_t)l * INC * D, NROW, INC, D};
    WinOrder S{F.G, F.bid, first ? 8 : 2, first ? 0 : 5};
    pg8::EpiBf16 E{U, INC};
    pg8::gemm_phase<pg8::EpiBf16, WinOrder>(F.lds + RING_OFF, g, S, E); }
__device__ __forceinline__ void ph_wout(int l) { Frame F = mk_frame(); PH_PTRS();
    pg8::Gemm g{H, (const bf16*)(F.ws + WS_WOUT) + (size_t)l * D * D, M, D, D};
    pg8::StaticOrder S; S.init(M, D, F.G, F.bid);
    pg8::EpiBf16 E{U, D};
    pg8::gemm_phase<pg8::EpiBf16, pg8::StaticOrder>(F.lds + RING_OFF, g, S, E); }
__device__ __forceinline__ void ph_moe1(int l) { Frame F = mk_frame(); PH_PTRS(); moe_table(F, l);
    pg8::Gemm g{H, (const bf16*)(F.ws + WS_W13) + (size_t)l * NEXP * 1024 * D, M, 1024, D};
    pg8::MoeOrder S{F.G, F.bid, CAP, (const LAS int*)(F.lds + TAB_OFF), INFO};
    pg8::EpiSwiGLU E{HE, MHID};
    pg8::gemm_phase<pg8::EpiSwiGLU, pg8::MoeOrder, true>(F.lds + RING_OFF, g, S, E); }
__device__ __forceinline__ void ph_moe2(int l) { Frame F = mk_frame(); PH_PTRS(); moe_table(F, l);
    pg8::Gemm g{HE, (const bf16*)(F.ws + WS_W2) + (size_t)l * NEXP * D * MHID, M, D, MHID};
    pg8::MoeOrder S{F.G, F.bid, CAP, (const LAS int*)(F.lds + TAB_OFF), INFO};
    pg8::EpiScatter E{Y2, INFO};
    pg8::gemm_phase<pg8::EpiScatter, pg8::MoeOrder, false>(F.lds + RING_OFF, g, S, E); }

__device__ __forceinline__ void grid_bar() {
    Frame F = mk_frame(); XcdBarrier b; b.bar = (unsigned*)(F.ctl + CW_BAR); b.x = xb_xcc_id(); b.st = F.MISC + 8; xcd_barrier(b);
}
#ifndef SINGLE_LAUNCH
#define SINGLE_LAUNCH 1
#endif
#if !SINGLE_LAUNCH
__global__ void __launch_bounds__(NT, 2) k_pa(Args args) { pa_phase(); }
__global__ void __launch_bounds__(NT, 2) k_norm1(Args args) { ph_norm1(args.l); }
__global__ void __launch_bounds__(NT, 2) k_next(Args args) { ph_next(args.l); }
__global__ void __launch_bounds__(NT, 2) k_route(Args args) { ph_route(args.l); }
__global__ void __launch_bounds__(NT, 2) k_win(Args args) { ph_win(args.l); }
__global__ void __launch_bounds__(NT, 2) k_mixa(Args args) { mixa_phase(args.l, args.l == 0); }
__global__ void __launch_bounds__(NT, 2) k_mixb(Args args) { mixb_phase(args.l, args.l == 0); }
__global__ void __launch_bounds__(NT, 2) k_wout(Args args) { ph_wout(args.l); }
__global__ void __launch_bounds__(NT, 2) k_moe1(Args args) { ph_moe1(args.l); }
__global__ void __launch_bounds__(NT, 2) k_moe2(Args args) { ph_moe2(args.l); }
#else
#define PMARK(name) asm volatile("; PHASE_MARK " name ::: "memory")
#ifndef REP_ROUTE
#define REP_ROUTE 1
#endif
#ifndef REP_NEXT
#define REP_NEXT 1
#endif
#ifndef REP_PA
#define REP_PA 1
#endif
#ifndef REP_WIN
#define REP_WIN 1
#endif
#ifndef REP_MIXA
#define REP_MIXA 1
#endif
#ifndef REP_MIXB
#define REP_MIXB 1
#endif
#ifndef REP_MOE1
#define REP_MOE1 1
#endif
#ifndef REP_MOE2
#define REP_MOE2 1
#endif
template <int L> __device__ __forceinline__ void layer_phases() {
    PMARK("win"); ph_win(L); grid_bar();
#if REP_WIN > 1
    ph_win(L); grid_bar();
#endif
    PMARK("mixa"); mixa_phase(L, L == 0); grid_bar();
#if REP_MIXA > 1
    mixa_phase(L, L == 0); grid_bar();
#endif
    PMARK("mixb"); mixb_phase(L, L == 0); grid_bar();
#if REP_MIXB > 1
    mixb_phase(L, L == 0); grid_bar();
#endif
    PMARK("wout"); ph_wout(L); grid_bar();
    PMARK("route"); ph_route(L); grid_bar();
    PMARK("moe1"); ph_moe1(L); grid_bar();
#if REP_MOE1 > 1
    ph_moe1(L); grid_bar();
#endif
    PMARK("moe2"); ph_moe2(L); grid_bar();
#if REP_MOE2 > 1
    ph_moe2(L); grid_bar();
#endif
#if REP_NEXT > 1
    if (L == 0) { ph_next(L, true); grid_bar(); }
#endif
    PMARK("next"); ph_next(L);
}
__global__ void __launch_bounds__(NT, 2) fwd_all(Args args) {
    { Frame F = mk_frame();
      for (int u = F.tid; u < (LDS_BYTES - LDSCTL_OFF) / 4; u += NT) ((LAS unsigned*)(F.lds + LDSCTL_OFF))[u] = 0u;
      __syncthreads();
      (void)xcd_barrier_post((unsigned*)(F.ctl + CW_BAR), F.MISC + 8); }
    PMARK("pa"); pa_phase(); grid_bar();
#if REP_PA > 1
    pa_phase(); grid_bar();
#endif
    PMARK("norm1"); ph_norm1(0); grid_bar();
    layer_phases<0>(); grid_bar();
    layer_phases<1>();
}
#endif

typedef void (*kern_t)(Args);
extern "C" void kernel_launch(void* const* d_in, const int* in_sizes, int n_in, void* d_out, int out_size, void* d_ws, size_t ws_size, hipStream_t stream) {
    static int grid = 0;
#if SINGLE_LAUNCH
    const kern_t kerns[] = {fwd_all};
#else
    const kern_t kerns[] = {k_pa, k_norm1, k_next, k_route, k_win, k_mixa, k_mixb, k_wout, k_moe1, k_moe2};
#endif
    if (grid == 0) {
        if (n_in != 20 || out_size != NLAT * D || ws_size < WS_END) { fprintf(stderr, "kernel_launch: unexpected shapes (n_in %d out %d ws %zu)\n", n_in, out_size, ws_size); grid = -1; return; }
        int dev = 0, cus = 0;
        if (hipGetDevice(&dev) != hipSuccess || hipDeviceGetAttribute(&cus, hipDeviceAttributeMultiprocessorCount, dev) != hipSuccess) { grid = -1; return; }
        for (kern_t k : kerns) if (hipFuncSetAttribute((const void*)k, hipFuncAttributeMaxDynamicSharedMemorySize, LDS_BYTES) != hipSuccess) { fprintf(stderr, "kernel_launch: hipFuncSetAttribute failed\n"); grid = -1; return; }
        int per_cu = 0; (void)hipOccupancyMaxActiveBlocksPerMultiprocessor(&per_cu, (const void*)kerns[0], NT, LDS_BYTES); (void)hipGetLastError();
        grid = cus;
    }
    if (grid < 0) return;
    (void)hipMemsetAsync((char*)d_ws + WS_CTL, 0, CTL_ZERO_BYTES, stream);
    Args a{};
    for (int i = 0; i < 20; ++i) a.in[i] = (const float*)d_in[i];
    a.out = (float*)d_out; a.ws = (unsigned char*)d_ws;
#if SINGLE_LAUNCH
    hipLaunchKernelGGL(fwd_all, dim3(grid), dim3(NT), LDS_BYTES, stream, a);
#else
#define LAUNCH(k, L, E) do { a.l = (L); a.e = (E); hipLaunchKernelGGL(k, dim3(grid), dim3(NT), LDS_BYTES, stream, a); } while (0)
    LAUNCH(k_pa, 0, 0);
    LAUNCH(k_norm1, 0, 0);
    for (int l = 0; l < DEPTH; ++l) {
        LAUNCH(k_win, l, 0); LAUNCH(k_mixa, l, 0); LAUNCH(k_mixb, l, 0); LAUNCH(k_wout, l, 0); LAUNCH(k_route, l, 0);
        LAUNCH(k_moe1, l, 0); LAUNCH(k_moe2, l, 0); LAUNCH(k_next, l, 0);
    }
#endif
}
```

```cpp
#include <hip/hip_runtime.h>
#include <cstdio>
#include <cstdint>
namespace pg8 {
#define PG8_LAS __attribute__((address_space(3)))
typedef unsigned short bf16_t;
typedef short bf16x8 __attribute__((ext_vector_type(8)));
typedef float f32x4 __attribute__((ext_vector_type(4)));
typedef unsigned u32x4 __attribute__((ext_vector_type(4)));
constexpr int BM = 256, BK = 64, HALF = 128, HTB = HALF * BK * 2  , STAGE_BYTES = 8 * HTB, NXCD = 8, WGM = 8;

__host__ __device__ __forceinline__ int lds_byte(int r, int c) { const int st = (r >> 4) * 2 + (c >> 5), rr = r & 15, cc = c & 31, ob = rr * 64 + cc * 2; return st * 1024 + (ob ^ (((ob >> 9) & 1) << 5)); }
__host__ __device__ __forceinline__ void stage_rc(int b, int& R, int& C) { const int st = b / 1024, sb = b % 1024, swz = sb ^ (((sb >> 9) & 1) << 5); R = (st >> 1) * 16 + swz / 64; C = (st & 1) * 32 + (swz % 64) / 2; }
__host__ __device__ __forceinline__ int perm32(int rho) { const int n = rho >> 4, i = rho & 15; return 8 * (i >> 2) + 4 * n + (i & 3); }

struct Unit { int pm, pn, pb, lb, nv; };
struct Gemm { const bf16_t* A; const bf16_t* Bt; int M, N, K; };

struct StaticOrder {
    int nM, nN, nwg, G, c;
    __host__ __device__ void init(int M, int N, int G_, int c_) { nM = M / BM; nN = N / BM; nwg = nM * nN; G = G_; c = c_; }
    __host__ __device__ bool next(int i, Unit& u) const {
        const long L = (long)i * G + c; if (L >= nwg) return false;
        int wgid = (int)L; { const int q = nwg / NXCD, r = nwg % NXCD, xcd = wgid % NXCD, off = wgid / NXCD; wgid = (xcd < r ? xcd * (q + 1) : r * (q + 1) + (xcd - r) * q) + off; }
        const int nig = WGM * nN, gid = wgid / nig, fm = gid * WGM, gsz = (nM - fm) < WGM ? (nM - fm) : WGM;
        u.pm = fm + ((wgid % nig) % gsz); u.pn = (wgid % nig) / gsz; u.pb = u.pn; u.lb = 0; u.nv = BM; return true;
    }
    __device__ __forceinline__ void a_ready(const Unit&) const {}
    __device__ __forceinline__ int row_of(const Unit&, int i) const { return i; }
    __device__ __forceinline__ void done(const Unit&) const {}
};


__device__ __forceinline__ unsigned cvt_pk_bf16(float lo, float hi) { unsigned r; asm volatile("v_cvt_pk_bf16_f32 %0, %1, %2" : "=v"(r) : "v"(lo), "v"(hi)); return r; }

struct EpiBf16 {
    static constexpr bool PERM = true, AFTER_DRAIN = false;
    bf16_t* O; int ldc;
    __device__ __forceinline__ void operator()(const f32x4 (&acc)[2][2][4][2], const Unit& u, int wr, int wc, int fr, int fq) const {
        const int row0 = u.pm * BM + wr * 64 + fr; const int col0 = u.pn * BM + wc * 32 + 8 * fq;
#pragma unroll
        for (int ai = 0; ai < 2; ++ai)
#pragma unroll
            for (int m = 0; m < 4; ++m) { bf16_t* rowp = O + (size_t)(row0 + ai * HALF + m * 16) * ldc + col0;
#pragma unroll
                for (int bj = 0; bj < 2; ++bj) { const f32x4 v0 = acc[ai][bj][m][0], v1 = acc[ai][bj][m][1];
                    u32x4 w; w.x = cvt_pk_bf16(v0[0], v0[1]); w.y = cvt_pk_bf16(v0[2], v0[3]); w.z = cvt_pk_bf16(v1[0], v1[1]); w.w = cvt_pk_bf16(v1[2], v1[3]);
                    *(u32x4*)(rowp + bj * HALF) = w; } }
    }
};
struct EpiSwiGLU {
    static constexpr bool PERM = true, AFTER_DRAIN = false;
    bf16_t* O; int ldc;
    __device__ __forceinline__ void operator()(const f32x4 (&acc)[2][2][4][2], const Unit& u, int wr, int wc, int fr, int fq) const {
        const int row0 = u.pm * BM + wr * 64 + fr; const int col0 = u.pn * HALF + wc * 32 + 8 * fq;
#pragma unroll
        for (int ai = 0; ai < 2; ++ai)
#pragma unroll
            for (int m = 0; m < 4; ++m) { bf16_t* rowp = O + (size_t)(row0 + ai * HALF + m * 16) * ldc + col0;
                float o[8];
#pragma unroll
                for (int n = 0; n < 2; ++n)
#pragma unroll
                    for (int j = 0; j < 4; ++j) { const float a = acc[ai][0][m][n][j], b = acc[ai][1][m][n][j]; o[n * 4 + j] = a * __builtin_amdgcn_rcpf(1.0f + __expf(-a)) * b; }
                u32x4 w; w.x = cvt_pk_bf16(o[0], o[1]); w.y = cvt_pk_bf16(o[2], o[3]); w.z = cvt_pk_bf16(o[4], o[5]); w.w = cvt_pk_bf16(o[6], o[7]);
                *(u32x4*)rowp = w; }
    }
};
struct EpiResid {
    static constexpr bool PERM = false, AFTER_DRAIN = false;
    const float* xin_lat; const float* xin_ctx; float* xout_lat; float* xout_ctx; const float* gmod; int gstride; const float* rowscale; int rs_stride; int nlat, seq;
    __device__ __forceinline__ void operator()(const f32x4 (&acc)[2][2][4][2], const Unit& u, int wr, int wc, int fr, int fq) const {
        const int prow = u.pm * BM; const bool isctx = prow >= nlat;
        const float* xin = isctx ? xin_ctx - (size_t)nlat * 1024 : xin_lat; float* xout = isctx ? xout_ctx - (size_t)nlat * 1024 : xout_lat;
        const int modrow = isctx ? 8 : prow / seq;
        const int row0 = prow + wr * 64 + fr, col0 = u.pn * BM + wc * 32 + 4 * fq;
        f32x4 gv[2][2];
#pragma unroll
        for (int bj = 0; bj < 2; ++bj)
#pragma unroll
            for (int n = 0; n < 2; ++n) gv[bj][n] = *(const f32x4*)(gmod + (size_t)modrow * gstride + col0 + bj * HALF + n * 16);
#pragma unroll
        for (int ai = 0; ai < 2; ++ai)
#pragma unroll
            for (int m = 0; m < 4; ++m) { const int row = row0 + ai * HALF + m * 16; const size_t off = (size_t)row * 1024 + col0;
                const float rs = rowscale ? rowscale[(size_t)row * rs_stride] : 1.0f;
#pragma unroll
                for (int bj = 0; bj < 2; ++bj)
#pragma unroll
                    for (int n = 0; n < 2; ++n) { const f32x4 xi = *(const f32x4*)(xin + off + bj * HALF + n * 16);
                        *(f32x4*)(xout + off + bj * HALF + n * 16) = xi + gv[bj][n] * rs * acc[ai][bj][m][n]; } }
    }
};
struct EpiScatter {
    static constexpr bool PERM = true, AFTER_DRAIN = false;
    bf16_t* Y2; const uint2* info;
    __device__ __forceinline__ void operator()(const f32x4 (&acc)[2][2][4][2], const Unit& u, int wr, int wc, int fr, int fq) const {
        const int col0 = u.pn * BM + wc * 32 + 8 * fq;
#pragma unroll
        for (int ai = 0; ai < 2; ++ai)
#pragma unroll
            for (int m = 0; m < 4; ++m) { const int i = ai * HALF + wr * 64 + m * 16 + fr;
                if (i < u.nv) { const uint2 inf = info[u.lb + i]; const float w = __builtin_bit_cast(float, inf.y); bf16_t* rowp = Y2 + (size_t)inf.x * 1024 + col0;
#pragma unroll
                    for (int bj = 0; bj < 2; ++bj) { const f32x4 v0 = acc[ai][bj][m][0] * w, v1 = acc[ai][bj][m][1] * w;
                        u32x4 q; q.x = cvt_pk_bf16(v0[0], v0[1]); q.y = cvt_pk_bf16(v0[2], v0[3]); q.z = cvt_pk_bf16(v1[0], v1[1]); q.w = cvt_pk_bf16(v1[2], v1[3]);
                        *(u32x4*)(rowp + bj * HALF) = q; } } }
    }
};
struct MoeOrder {
    int G, c, cap; const PG8_LAS int* tab; const uint2* info;
    __device__ __forceinline__ bool next(int i, Unit& u) const {
        const int nwg = __builtin_amdgcn_readfirstlane(tab[16]) * 4; const long L = (long)i * G + c; if (L >= nwg) return false;
        int wgid = (int)L; { const int q = nwg / NXCD, r = nwg % NXCD, xcd = wgid % NXCD, off = wgid / NXCD; wgid = (xcd < r ? xcd * (q + 1) : r * (q + 1) + (xcd - r) * q) + off; }
        const int gp = wgid >> 2; int e = 0;
#pragma unroll
        for (int q = 1; q < 16; ++q) e += (gp >= tab[q]) ? 1 : 0;
        e = __builtin_amdgcn_readfirstlane(e);
        const int p = gp - __builtin_amdgcn_readfirstlane(tab[e]); const int ne = __builtin_amdgcn_readfirstlane(tab[17 + e]);
        u.pm = gp; u.pn = wgid & 3; u.pb = e * 4 + u.pn; u.lb = e * cap + 256 * p; u.nv = (ne - 256 * p) < 256 ? (ne - 256 * p) : 256; return true;
    }
    __device__ __forceinline__ void a_ready(const Unit&) const {}
    __device__ __forceinline__ void done(const Unit&) const {}
    __device__ __forceinline__ int row_of(const Unit& u, int i) const { return i < u.nv ? (int)(info[u.lb + i].x >> 1) : 0; }
};
template <class Epi, class Sched, bool GATHER = false>
__device__ __forceinline__ void gemm_phase(PG8_LAS unsigned char* lds, const Gemm g, const Sched& S, const Epi& E) {
    int tid_ = threadIdx.x; asm volatile("" : "+v"(tid_));
    const int tid = tid_, wid = __builtin_amdgcn_readfirstlane(tid >> 6), lane = tid & 63, wr = wid >> 2, wc = wid & 3, fr = lane & 15, fq = lane >> 4;
    const int K = g.K, nt = K / BK;
    unsigned voffB[2];
#pragma unroll
    for (int i = 0; i < 2; ++i) { int R, C; stage_rc(tid * 16 + i * 8192, R, C); const int Rb = Epi::PERM ? ((R & ~31) + perm32(R & 31)) : R; voffB[i] = (unsigned)(Rb * K + C) * 2u; }
    const size_t kstep = (size_t)(BK * 2);
    const size_t hstep = (size_t)HALF * K * 2;
    const size_t tstep = 2 * hstep;
    const unsigned ldsw = (unsigned)wid * 1024u;
    const int aoff = lds_byte(wr * 64 + fr, fq * 8), boff = lds_byte(wc * 32 + fr, fq * 8);
#define PG8_SA(b, h) (((b) * 2 + (h)) * HTB)
#define PG8_SB(b, h) ((4 + (b) * 2 + (h)) * HTB)
#define PG8_STAGE(bufoff, gbase, voff) do { _Pragma("unroll") for (int _i = 0; _i < 2; ++_i) \
        __builtin_amdgcn_global_load_lds((const unsigned*)((const char*)(gbase) + (voff)[_i]), (PG8_LAS unsigned*)(lds + (bufoff) + ldsw + _i * 8192), 16, 0, 0); } while (0)
#define PG8_LDA(dst, b, h) do { _Pragma("unroll") for (int m = 0; m < 4; ++m) _Pragma("unroll") for (int k = 0; k < 2; ++k) dst[m][k] = *(const PG8_LAS bf16x8*)(lds + PG8_SA(b, h) + aoff + m * 2048 + k * 1024); } while (0)
#define PG8_LDB(dst, b, h) do { _Pragma("unroll") for (int n = 0; n < 2; ++n) _Pragma("unroll") for (int k = 0; k < 2; ++k) dst[n][k] = *(const PG8_LAS bf16x8*)(lds + PG8_SB(b, h) + boff + n * 2048 + k * 1024); } while (0)
#define PG8_MMA(ai, bj, At, Bt) do { __builtin_amdgcn_s_setprio(1); _Pragma("unroll") for (int m = 0; m < 4; ++m) _Pragma("unroll") for (int n = 0; n < 2; ++n) _Pragma("unroll") for (int k = 0; k < 2; ++k) \
        acc[ai][bj][m][n] = __builtin_amdgcn_mfma_f32_16x16x32_bf16(Bt[n][k], At[m][k], acc[ai][bj][m][n], 0, 0, 0); __builtin_amdgcn_s_setprio(0); } while (0)
#define PG8_WAIT_V(n) asm volatile("s_waitcnt vmcnt(" #n ")" ::: "memory")
#define PG8_WAIT_L(n) asm volatile("s_waitcnt lgkmcnt(" #n ")" ::: "memory")
#define PG8_BAR __builtin_amdgcn_s_barrier()
#define PG8_SCHED __builtin_amdgcn_sched_barrier(0)
#define PG8_AOFFS(o, u) do { _Pragma("unroll") for (int _h = 0; _h < 2; ++_h) _Pragma("unroll") for (int _i = 0; _i < 2; ++_i) { int _R, _C; stage_rc(tid * 16 + _i * 8192, _R, _C); \
        const int _row = GATHER ? S.row_of((u), _h * HALF + _R) : (_h * HALF + _R); (o)[_h][_i] = (unsigned)(_row * K + _C) * 2u; } } while (0)
    Unit cur, nxt; int ui = 0;
    if (!S.next(0, cur)) return;
    f32x4 acc[2][2][4][2];
#pragma unroll
    for (int a = 0; a < 2; ++a)
#pragma unroll
        for (int b = 0; b < 2; ++b)
#pragma unroll
            for (int m = 0; m < 4; ++m)
#pragma unroll
                for (int n = 0; n < 2; ++n) acc[a][b][m][n] = (f32x4){0.f, 0.f, 0.f, 0.f};
    bf16x8 At[4][2], B0[2][2], B1[2][2];
    unsigned offA[2][2], noffA[2][2];
    const char* cA = (const char*)g.A + (GATHER ? (size_t)0 : (size_t)cur.pm * tstep); const char* cB = (const char*)g.Bt + (size_t)cur.pb * tstep;
    S.a_ready(cur);
    PG8_AOFFS(offA, cur);
    PG8_STAGE(PG8_SB(0, 0), cB, voffB); PG8_STAGE(PG8_SB(0, 1), cB + hstep, voffB); PG8_STAGE(PG8_SA(0, 0), cA, offA[0]); PG8_STAGE(PG8_SA(0, 1), cA, offA[1]);
    if (wr == 1) PG8_BAR;
    PG8_WAIT_V(2); PG8_BAR;
    PG8_STAGE(PG8_SB(1, 0), cB + kstep, voffB); PG8_STAGE(PG8_SA(1, 0), cA + kstep, offA[0]); PG8_STAGE(PG8_SB(1, 1), cB + hstep + kstep, voffB);
    PG8_WAIT_V(6); PG8_BAR;
    for (;;) {
        const bool has_next = S.next(ui + 1, nxt);
        const char* nA = has_next ? (const char*)g.A + (GATHER ? (size_t)0 : (size_t)nxt.pm * tstep) : cA; const char* nB = has_next ? (const char*)g.Bt + (size_t)nxt.pb * tstep : cB;
        for (int t = 0; t < nt; t += 2) {
            const bool last = (t == nt - 2);
            const char* a1 = cA + (size_t)(t + 1) * kstep;
            const char* a2 = last ? nA : cA + (size_t)(t + 2) * kstep; const char* b2 = last ? nB : cB + (size_t)(t + 2) * kstep;
            const char* a3 = a2 + kstep; const char* b3 = b2 + kstep;
            if (last && has_next) S.a_ready(nxt);
            unsigned o2[2][2];
            if constexpr (GATHER) {
                if (last) { if (has_next) { PG8_AOFFS(noffA, nxt); } else {
#pragma unroll
                        for (int h = 0; h < 2; ++h) { noffA[h][0] = offA[h][0]; noffA[h][1] = offA[h][1]; } } }
#pragma unroll
                for (int h = 0; h < 2; ++h) { o2[h][0] = last ? noffA[h][0] : offA[h][0]; o2[h][1] = last ? noffA[h][1] : offA[h][1]; }
            } else {
#pragma unroll
                for (int h = 0; h < 2; ++h) { o2[h][0] = offA[h][0]; o2[h][1] = offA[h][1]; }
            }
            PG8_LDB(B0, 0, 0); PG8_LDB(B1, 0, 1); PG8_SCHED; PG8_LDA(At, 0, 0); PG8_STAGE(PG8_SA(1, 1), a1, offA[1]);
            PG8_WAIT_V(8); PG8_WAIT_L(0); PG8_BAR; PG8_MMA(0, 0, At, B0); PG8_MMA(0, 1, At, B1); PG8_BAR; PG8_SCHED;
            PG8_LDA(At, 0, 1); PG8_STAGE(PG8_SB(0, 0), b2, voffB); PG8_STAGE(PG8_SB(0, 1), b2 + hstep, voffB); PG8_STAGE(PG8_SA(0, 0), a2, o2[0]);
            PG8_WAIT_V(8); PG8_WAIT_L(0); PG8_BAR; PG8_MMA(1, 0, At, B0); PG8_MMA(1, 1, At, B1); PG8_BAR; PG8_SCHED;
            PG8_LDB(B0, 1, 0); PG8_LDB(B1, 1, 1); PG8_SCHED; PG8_LDA(At, 1, 0); PG8_STAGE(PG8_SA(0, 1), a2, o2[1]);
            PG8_WAIT_V(8); PG8_WAIT_L(0); PG8_BAR; PG8_MMA(0, 0, At, B0); PG8_MMA(0, 1, At, B1); PG8_BAR; PG8_SCHED;
            PG8_LDA(At, 1, 1); PG8_STAGE(PG8_SB(1, 0), b3, voffB); PG8_STAGE(PG8_SB(1, 1), b3 + hstep, voffB); PG8_STAGE(PG8_SA(1, 0), a3, o2[0]);
            PG8_WAIT_V(8); PG8_WAIT_L(0); PG8_BAR; PG8_MMA(1, 0, At, B0); PG8_MMA(1, 1, At, B1); PG8_BAR; PG8_SCHED;
        }
        if (wr == 0) PG8_BAR;
        E(acc, cur, wr, wc, fr, fq); S.done(cur);
        if (!has_next) break;
#pragma unroll
        for (int a = 0; a < 2; ++a)
#pragma unroll
            for (int b = 0; b < 2; ++b)
#pragma unroll
                for (int m = 0; m < 4; ++m)
#pragma unroll
                    for (int n = 0; n < 2; ++n) acc[a][b][m][n] = (f32x4){0.f, 0.f, 0.f, 0.f};
        cur = nxt; cA = nA; cB = nB; ++ui;
        if constexpr (GATHER) {
#pragma unroll
            for (int h = 0; h < 2; ++h) { offA[h][0] = noffA[h][0]; offA[h][1] = noffA[h][1]; } }
        if (wr == 1) PG8_BAR;
    }
    PG8_WAIT_V(0);
    PG8_BAR;
#undef PG8_SA
#undef PG8_SB
#undef PG8_STAGE
#undef PG8_LDA
#undef PG8_LDB
#undef PG8_MMA
#undef PG8_WAIT_V
#undef PG8_WAIT_L
#undef PG8_BAR
#undef PG8_SCHED
#undef PG8_AOFFS
}
}
#define GAS __attribute__((address_space(1)))
#define LAS __attribute__((address_space(3)))
typedef unsigned short bf16;
typedef unsigned v4u __attribute__((ext_vector_type(4)));
typedef float f32x4 __attribute__((ext_vector_type(4)));
typedef short bf16x8 __attribute__((ext_vector_type(8)));
typedef GAS unsigned gu32;
typedef GAS unsigned long long gu64;
#define RLX_AGENT __ATOMIC_RELAXED, __HIP_MEMORY_SCOPE_AGENT
#define LDS_WAIT() asm volatile("s_waitcnt lgkmcnt(0)" ::: "memory")
#define VM_WAIT() asm volatile("s_waitcnt vmcnt(0)" ::: "memory")
__device__ __forceinline__ unsigned long long rt() { return __builtin_amdgcn_s_memrealtime(); }
__device__ __forceinline__ unsigned f2bf(float f) { unsigned u = __builtin_bit_cast(unsigned, f); return (u + 0x7fffu + ((u >> 16) & 1u)) >> 16; }
__device__ __forceinline__ unsigned pk2(float lo, float hi) { return f2bf(lo) | (f2bf(hi) << 16); }

#define XB_TMO      128
#define XB_XCNT(j)  (256  + 64 * (j))
#define XB_XSUB(j)  (1280 + 64 * (j))
#define XB_XGEN(j)  (2304 + 64 * (j))
#define XB_TOP      3328
#define XB_TOPGEN   3392
#define XCD_BAR_WORDS 3456
#define XB_SPIN_CAP (1u << 18)

__device__ __forceinline__ unsigned xb_ld(unsigned* p)              { return __hip_atomic_load(p, __ATOMIC_RELAXED, __HIP_MEMORY_SCOPE_AGENT); }
__device__ __forceinline__ unsigned xb_add(unsigned* p, unsigned v) { return __hip_atomic_fetch_add(p, v, __ATOMIC_RELAXED, __HIP_MEMORY_SCOPE_AGENT); }
__device__ __forceinline__ unsigned xb_xcc_id() { return (unsigned)__builtin_amdgcn_s_getreg((3 << 11) | 20) & 0xFu; }
#define XB_SPIN(cond, bar) do { unsigned _sp = 0; while (cond) { __builtin_amdgcn_s_sleep(1); \
    if ((++_sp & 255u) == 0u) { if (xb_ld(&(bar)[XB_TMO])) break; if (_sp > XB_SPIN_CAP) { atomicAdd(&(bar)[XB_TMO], 1u); break; } } } } while (0)

struct XcdBarrier {
    unsigned* bar; unsigned x;
    volatile LAS unsigned* st;
};

__device__ __forceinline__ XcdBarrier xcd_barrier_post(unsigned* bar, volatile LAS unsigned* st) {
    XcdBarrier b; b.bar = bar; b.x = xb_xcc_id(); b.st = st;
    if (threadIdx.x == 0) (void)xb_add(&bar[XB_XCNT(b.x)], 1u);
    return b;
}
__device__ __forceinline__ void xcd_barrier_complete(unsigned* bar, unsigned x, unsigned& nloc, unsigned& nx) {
    const unsigned G = gridDim.x * gridDim.y * gridDim.z;
    unsigned sum, cnt, mine, sp = 0u;
    for (;;) {
        sum = 0u; cnt = 0u; mine = 0u;
#pragma unroll
        for (unsigned j = 0; j < 16; ++j) { const unsigned c = xb_ld(&bar[XB_XCNT(j)]); sum += c; cnt += (c > 0u) ? 1u : 0u; mine = (j == x) ? c : mine; }
        if (sum == G) break;
        __builtin_amdgcn_s_sleep(1);
        if ((++sp & 255u) == 0u) { if (xb_ld(&bar[XB_TMO])) break; if (sp > XB_SPIN_CAP) { atomicAdd(&bar[XB_TMO], 1u); break; } }
    }
    nloc = mine > 0u ? mine : 1u; nx = cnt > 0u ? cnt : 1u;
}

__device__ __forceinline__ void xcd_barrier(const XcdBarrier& b) {
    asm volatile("s_waitcnt vmcnt(0)" ::: "memory");
    __syncthreads();
    if (threadIdx.x == 0) {
        unsigned* bar = b.bar;
        __builtin_amdgcn_s_waitcnt(0);
        unsigned nloc = b.st[0], nx = b.st[1];
        if (nloc == 0u) { xcd_barrier_complete(bar, b.x, nloc, nx); b.st[0] = nloc; b.st[1] = nx; }
        const unsigned old = xb_add(&bar[XB_XSUB(b.x)], 1u);
        const unsigned gen = old / nloc;
        if (old + 1u == (gen + 1u) * nloc) {
            __builtin_amdgcn_fence(__ATOMIC_RELEASE, "agent");
            asm volatile("s_waitcnt vmcnt(0)" ::: "memory");
            const unsigned og = xb_add(&bar[XB_TOP], 1u);
            const unsigned tg = og / nx;
            if (og + 1u == (tg + 1u) * nx) xb_add(&bar[XB_TOPGEN], 1u);
            else XB_SPIN(xb_ld(&bar[XB_TOPGEN]) == tg, bar);
            __builtin_amdgcn_fence(__ATOMIC_ACQUIRE, "agent");
            xb_add(&bar[XB_XGEN(b.x)], 1u);
            asm volatile("s_waitcnt vmcnt(0)" ::: "memory");
        } else {
            XB_SPIN(xb_ld(&bar[XB_XGEN(b.x)]) == gen, bar);
            __builtin_amdgcn_fence(__ATOMIC_ACQUIRE, "agent");
            asm volatile("s_waitcnt vmcnt(0)" ::: "memory");
        }
    }
    __syncthreads();
}


constexpr int NWAVES = 8, NT = NWAVES * 64;
constexpr int D = 1024, BATCH = 8, SEQ = 4096, DEPTH = 2, GRIDW = 64, CTXL = 256, GWID = 256, HD = 64, NHEAD = 4;
constexpr int INC = 2048, NEXP = 16, MHID = 512;
constexpr int NLAT = BATCH * SEQ, NCTX = BATCH * CTXL, NROW = NLAT + NCTX;
constexpr float EPS = 1e-6f;
constexpr int UC_AV = 0, UC_AB = 256, UC_AC = 512, UC_P = 768, UC_Q = 1024, UC_K = 1280, UC_V = 1536, UC_F = 1792;

constexpr size_t MiB = 1u << 20;
constexpr size_t WS_CTL = 0, CTL_ZERO_BYTES = 65536;
constexpr size_t WS_MOD  = 1 * MiB;
constexpr size_t WS_PWT  = 1 * MiB + 768 * 1024;
constexpr size_t WS_INFO = 2 * MiB;
constexpr size_t WS_WIN  = 8 * MiB;
constexpr size_t WS_WOUT = 16 * MiB;
constexpr size_t WS_W13  = 20 * MiB;
constexpr size_t WS_W2   = 84 * MiB;
constexpr size_t WS_XC   = 116 * MiB;
constexpr size_t WS_H    = 124 * MiB;
constexpr size_t WS_U    = 192 * MiB;
constexpr size_t WS_S    = 328 * MiB;
constexpr size_t WS_END  = 472 * MiB;
constexpr size_t WS_KF   = WS_S;
constexpr size_t WS_VF   = WS_S + 28 * MiB;
constexpr size_t WS_KFC  = WS_S + 60 * MiB;
constexpr size_t WS_VFC  = WS_S + 61 * MiB;
constexpr size_t WS_Z    = WS_S + 64 * MiB;
constexpr size_t NZ = (size_t)BATCH * NHEAD * SEQ * HD;
constexpr size_t NZC = (size_t)BATCH * NHEAD * CTXL * HD;
constexpr int CAP = NROW;

constexpr int CW_CNT = 2048;
constexpr int CW_BAR = 4096;

constexpr int RING_OFF = 0, RING_BYTES = 131072;
constexpr int LDSCTL_OFF = RING_BYTES, MISC_OFF = LDSCTL_OFF + 320;
constexpr int TAB_OFF = RING_BYTES + 1024;
constexpr int LDS_BYTES = 147456;

struct Frame {
    LAS unsigned char* lds;
    volatile LAS unsigned* MISC;
    gu32* ctl;
    int tid, lane, wave, G, bid;
    float* out; unsigned char* ws;
    static __device__ __forceinline__ const void* karg(int off) {
        const __attribute__((address_space(4))) char* ka = (const __attribute__((address_space(4))) char*)__builtin_amdgcn_kernarg_segment_ptr();
        asm volatile("" : "+s"(ka));
        return *(const void* const __attribute__((address_space(4)))*)(ka + off);
    }
    __device__ __forceinline__ const float* inp(int i) const { return (const float*)karg(8 * i); }
};
extern __shared__ __attribute__((aligned(16))) unsigned char dyn_lds[];
__device__ __forceinline__ Frame mk_frame() {
    Frame F; int t_ = threadIdx.x; asm volatile("" : "+v"(t_));
    F.tid = t_; F.lane = F.tid & 63; F.wave = __builtin_amdgcn_readfirstlane(F.tid >> 6); F.G = gridDim.x; F.bid = blockIdx.x;
    F.lds = (LAS unsigned char*)dyn_lds; F.MISC = (volatile LAS unsigned*)(F.lds + MISC_OFF);
    F.out = (float*)Frame::karg(160); F.ws = (unsigned char*)Frame::karg(168); F.ctl = (gu32*)(F.ws + WS_CTL);
    return F;
}
enum { I_X = 0, I_C, I_CTX, I_CCTX, I_ADAW, I_ADAB, I_N1G, I_N2G, I_WIN, I_CONVW, I_POOLW, I_POOLS, I_RPB, I_WOUT, I_RW, I_RB, I_W1, I_W3, I_W2, I_FG };

__device__ __forceinline__ float wave_sum(float v) {
#pragma unroll
    for (int o = 1; o < 64; o <<= 1) v += __shfl_xor(v, o);
    return v;
}
__device__ __forceinline__ float bflo(unsigned w) { return __builtin_bit_cast(float, w << 16); }
__device__ __forceinline__ float bfhi(unsigned w) { return __builtin_bit_cast(float, w & 0xffff0000u); }
__device__ __forceinline__ float bf2f(bf16 b) { return __builtin_bit_cast(float, (unsigned)b << 16); }

__device__ __forceinline__ void tr_item(const float* W, int K, int N, bf16* WT, int k0, int n0, int drow0, LAS float* scr, int lane) {
#pragma unroll
    for (int i = 0; i < 8; ++i) { const int kk = 8 * i + (lane >> 3), n4 = 4 * (lane & 7); const f32x4 w = *(const GAS f32x4*)(W + (size_t)(k0 + kk) * N + n0 + n4);
        LAS float* sp = scr + kk * 33 + n4; sp[0] = w.x; sp[1] = w.y; sp[2] = w.z; sp[3] = w.w; }
    LDS_WAIT(); asm volatile("" ::: "memory");
    const int c = lane & 7;
#pragma unroll
    for (int j = 0; j < 4; ++j) { const int n = (lane >> 3) + 8 * j; const LAS float* s = scr + (8 * c) * 33 + n;
        v4u o; o.x = pk2(s[0 * 33], s[1 * 33]); o.y = pk2(s[2 * 33], s[3 * 33]); o.z = pk2(s[4 * 33], s[5 * 33]); o.w = pk2(s[6 * 33], s[7 * 33]);
        *(GAS v4u*)(WT + (size_t)(drow0 + n) * K + k0 + 8 * c) = o; }
    LDS_WAIT(); asm volatile("" ::: "memory");
}
__device__ __forceinline__ void pa_phase() { Frame F = mk_frame();
    LAS float* scr = (LAS float*)(F.lds + RING_OFF + F.wave * 16384);
    const int gw = F.bid * NWAVES + F.wave, NGW = F.G * NWAVES;
    bf16* WIN = (bf16*)(F.ws + WS_WIN); bf16* WOUT = (bf16*)(F.ws + WS_WOUT); bf16* W13 = (bf16*)(F.ws + WS_W13); bf16* W2 = (bf16*)(F.ws + WS_W2);
    constexpr int I_IN = 2 * 16 * 64, I_OUT = 2 * 16 * 32, I_1 = 32 * 16 * 16, I_2 = 32 * 8 * 32;
    constexpr int NITEMS = I_IN + I_OUT + 2 * I_1 + I_2;
    for (int it = gw; it < NITEMS; it += NGW) {
        int r = it;
        if (r < I_IN) { const int l = r / 1024, q = r % 1024, kb = q / 64, nb = q % 64;
            tr_item(F.inp(I_WIN) + (size_t)l * D * INC, D, INC, WIN + (size_t)l * INC * D, 64 * kb, 32 * nb, 32 * nb, scr, F.lane); continue; } r -= I_IN;
        if (r < I_OUT) { const int l = r / 512, q = r % 512, kb = q / 32, nb = q % 32;
            tr_item(F.inp(I_WOUT) + (size_t)l * D * D, D, D, WOUT + (size_t)l * D * D, 64 * kb, 32 * nb, 32 * nb, scr, F.lane); continue; } r -= I_OUT;
        if (r < 2 * I_1) { const int which = r / I_1; const int q0 = r % I_1; const int le = q0 / 256, q = q0 % 256, kb = q / 16, nb = q % 16;
            const int n0 = 32 * nb; const int drow0 = 256 * (n0 / 128) + 128 * which + (n0 % 128);
            tr_item(F.inp(which ? I_W3 : I_W1) + (size_t)le * D * MHID, D, MHID, W13 + (size_t)le * 1024 * D, 64 * kb, n0, drow0, scr, F.lane); continue; } r -= 2 * I_1;
        { const int le = r / 256, q = r % 256, kb = q / 32, nb = q % 32;
            tr_item(F.inp(I_W2) + (size_t)le * MHID * D, MHID, D, W2 + (size_t)le * D * MHID, 64 * kb, 32 * nb, 32 * nb, scr, F.lane); }
    }
    { bf16* PWT = (bf16*)(F.ws + WS_PWT); const float* pw = F.inp(I_POOLW);
      for (int i = F.bid * NT + F.tid; i < 2 * 4 * 64 * 64; i += F.G * NT) { const int c = i & 63, dd = (i >> 6) & 63, lg = i >> 12; PWT[i] = (bf16)f2bf(pw[((size_t)lg * 64 + c) * 64 + dd]); } }
    __syncthreads();
    LAS float* sc = (LAS float*)(F.lds + RING_OFF);
    LAS float* part = (LAS float*)(F.lds + RING_OFF + 40960);
    float* MOD = (float*)(F.ws + WS_MOD);
    bool have_sc = false;
    for (int it = F.bid; it < 2 * 96; it += F.G) {
        if (!have_sc) { for (int i = F.tid; i < 9 * 1024; i += NT) { const float v = i < 8192 ? F.inp(I_C)[i] : F.inp(I_CCTX)[i - 8192]; sc[i] = v / (1.0f + __expf(-v)); } have_sc = true; }
        __syncthreads();
        const int l = it / 96, cb = it % 96, col = cb * 64 + F.lane;
        const float* aw = F.inp(I_ADAW) + (size_t)l * D * 6144 + col;
        float acc[9];
#pragma unroll
        for (int r = 0; r < 9; ++r) acc[r] = 0.f;
        for (int k = F.wave * 128; k < F.wave * 128 + 128; ++k) { const float wv = aw[(size_t)k * 6144];
#pragma unroll
            for (int r = 0; r < 9; ++r) acc[r] += sc[r * 1024 + k] * wv; }
#pragma unroll
        for (int r = 0; r < 9; ++r) part[(F.wave * 9 + r) * 64 + F.lane] = acc[r];
        __syncthreads();
        for (int i = F.tid; i < 9 * 64; i += NT) { const int r = i >> 6, ln = i & 63; float s = F.inp(I_ADAB)[(size_t)l * 6144 + cb * 64 + ln];
#pragma unroll
            for (int w = 0; w < 8; ++w) s += part[(w * 9 + r) * 64 + ln];
            MOD[((size_t)l * 9 + r) * 6144 + cb * 64 + ln] = s; }
        __syncthreads();
    }
}

typedef unsigned v2u_ __attribute__((ext_vector_type(2)));
__device__ __forceinline__ unsigned cvt_pk_bf(float lo, float hi) { unsigned r; asm volatile("v_cvt_pk_bf16_f32 %0, %1, %2" : "=v"(r) : "v"(lo), "v"(hi)); return r; }
struct XStream { const char* lat; const char* ctx; int lat_stride, ctx_stride;
    __device__ __forceinline__ const char* row(int r) const { return r < NLAT ? lat + (size_t)r * lat_stride : ctx + (size_t)(r - NLAT) * ctx_stride; } };
struct RowIn { f32x4 x[4]; unsigned long long xb[4], ya[4], yb[4]; };
__device__ __forceinline__ f32x4 unpk4(unsigned long long a) { f32x4 y; y.x = bflo((unsigned)a); y.y = bfhi((unsigned)a); y.z = bflo((unsigned)(a >> 32)); y.w = bfhi((unsigned)(a >> 32)); return y; }
template <int ADD, bool XBF>
__device__ __forceinline__ void row_load(Frame& F, int r, const char* xr, const bf16* Y2, RowIn& in) {
#pragma unroll
    for (int j = 0; j < 4; ++j) { const int c = 4 * F.lane + 256 * j;
        if (XBF) in.xb[j] = *(const GAS unsigned long long*)(xr + 2 * c); else in.x[j] = *(const GAS f32x4*)(xr + 4 * c);
        if (ADD == 1) { in.ya[j] = *(const GAS unsigned long long*)(Y2 + (size_t)r * 2048 + c); in.yb[j] = *(const GAS unsigned long long*)(Y2 + (size_t)r * 2048 + 1024 + c); }
        if (ADD == 2) { in.ya[j] = *(const GAS unsigned long long*)(Y2 + (size_t)r * 1024 + c); } }
}
struct RowPar { f32x4 a[4], b[4], gt[4]; int modrow; };
template <int ADD, bool FINAL>
__device__ __forceinline__ void row_params(Frame& F, int modrow, const float* g, const float* modl, const float* modadd, int ch_sh, int ch_sc, RowPar& P) {
    P.modrow = modrow;
#pragma unroll
    for (int j = 0; j < 4; ++j) { const int c = 4 * F.lane + 256 * j; const f32x4 gv = *(const GAS f32x4*)(g + c);
        if (FINAL) { P.a[j] = gv; P.b[j] = (f32x4){0.f, 0.f, 0.f, 0.f}; }
        else { const float* mrow = modl + (size_t)modrow * 6144; P.a[j] = gv * (*(const GAS f32x4*)(mrow + ch_sc * 1024 + c) + 1.0f); P.b[j] = *(const GAS f32x4*)(mrow + ch_sh * 1024 + c); }
        if (ADD) P.gt[j] = *(const GAS f32x4*)(modadd + (size_t)modrow * 6144 + (ADD == 1 ? 5 : 2) * 1024 + c); else P.gt[j] = (f32x4){0.f, 0.f, 0.f, 0.f}; }
}
template <int ADD, bool FINAL, bool XBF>
__device__ __forceinline__ void row_finish(Frame& F, const RowIn& in, const RowPar& P, char* xw, bf16* dst, float* fout, f32x4 (&v)[4]) {
    float ss = 0.f;
#pragma unroll
    for (int j = 0; j < 4; ++j) { const int c = 4 * F.lane + 256 * j; v[j] = XBF ? unpk4(in.xb[j]) : in.x[j];
        if (ADD) { f32x4 ya = unpk4(in.ya[j]); if (ADD == 1) ya = ya + unpk4(in.yb[j]);
            v[j] = v[j] + P.gt[j] * ya;
            if (!FINAL) *(GAS v2u_*)(xw + 2 * c) = (v2u_){cvt_pk_bf(v[j].x, v[j].y), cvt_pk_bf(v[j].z, v[j].w)}; }
        ss += (v[j].x * v[j].x + v[j].y * v[j].y) + (v[j].z * v[j].z + v[j].w * v[j].w); }
    ss = wave_sum(ss);
    const float rstd = 1.0f / sqrtf(ss * (1.0f / D) + EPS);
#pragma unroll
    for (int j = 0; j < 4; ++j) { const int c = 4 * F.lane + 256 * j;
        if (FINAL) { *(GAS f32x4*)(fout + c) = v[j] * rstd * P.a[j]; }
        else { v[j] = v[j] * rstd * P.a[j] + P.b[j];
            *(GAS v2u_*)(dst + c) = (v2u_){cvt_pk_bf(v[j].x, v[j].y), cvt_pk_bf(v[j].z, v[j].w)}; } }
}
template <int ADD, bool FINAL, bool XBF>
__device__ __forceinline__ void norm_phase(Frame& F, const XStream xin, const XStream xout, int nrows, const float* g, const float* modl, const float* modadd, int ch_sh, int ch_sc, bf16* dst, const bf16* Y2, float* fout) {
    const int rpb = (nrows + F.G - 1) / F.G;
    int i = F.wave; int r = F.bid * rpb + i; if (i >= rpb || r >= nrows) return;
    RowIn cur; row_load<ADD, XBF>(F, r, xin.row(r), Y2, cur);
    RowPar P; P.modrow = -1;
    for (;;) {
        const int in_ = i + NWAVES, rn = F.bid * rpb + in_; const bool more = (in_ < rpb) && (rn < nrows);
        RowIn nxt;
        if (more) row_load<ADD, XBF>(F, rn, xin.row(rn), Y2, nxt);
        const int modrow = r < NLAT ? (r >> 12) : 8;
        if (modrow != P.modrow) row_params<ADD, FINAL>(F, modrow, g, modl, modadd, ch_sh, ch_sc, P);
        f32x4 v[4];
        row_finish<ADD, FINAL, XBF>(F, cur, P, (char*)xout.row(r), dst + (size_t)r * D, fout + (size_t)r * D, v);
        if (!more) break;
        cur = nxt; r = rn; i = in_;
    }
}
template <bool XBF>
__device__ __forceinline__ void route_phase(Frame& F, int l, const XStream xin, const XStream xout, const bf16* O, int nrows, const float* g, const float* modl, bf16* dst, uint2* info, unsigned* cnt) {
    LAS int* lcnt = (LAS int*)(F.lds + RING_OFF); LAS int* lbase = lcnt + 16; LAS int* rec_e = lcnt + 32; LAS int* rec_p = rec_e + 512; LAS float* rec_w = (LAS float*)(rec_p + 512);
    const int rpb = (nrows + F.G - 1) / F.G;
    if (F.tid < 16) lcnt[F.tid] = 0;
    LAS float* WT = (LAS float*)(F.lds + RING_OFF + 32768);
    LAS float* LG = (LAS float*)(F.lds + RING_OFF + 8192);
    { const float* rwp = F.inp(I_RW); for (int i = F.tid; i < 1024 * 16; i += NT) { const int k = i >> 4, e = i & 15; WT[e * 1024 + k] = rwp[i]; } }
    __syncthreads();
    const float* rbp = F.inp(I_RB);
    RowPar P; P.modrow = -1;
    RowIn cur; bool have = (F.wave < rpb) && (F.bid * rpb + F.wave < nrows);
    if (have) { const int r = F.bid * rpb + F.wave; row_load<2, XBF>(F, r, xin.row(r), O, cur); }
    for (int i = F.wave; have; i += NWAVES) {
        const int r = F.bid * rpb + i;
        const int in_ = i + NWAVES, rn = F.bid * rpb + in_; const bool more = (in_ < rpb) && (rn < nrows);
        RowIn nxt;
        if (more) row_load<2, XBF>(F, rn, xin.row(rn), O, nxt);
        f32x4 v[4];
        { const int modrow = r < NLAT ? (r >> 12) : 8; if (modrow != P.modrow) row_params<2, false>(F, modrow, g, modl, modl, 3, 4, P); }
        row_finish<2, false, XBF>(F, cur, P, (char*)xout.row(r), dst + (size_t)r * D, nullptr, v);
        typedef float f32x2 __attribute__((ext_vector_type(2)));
        f32x2 s2[16];
#pragma unroll
        for (int e = 0; e < 16; ++e) s2[e] = (f32x2){0.f, 0.f};
#pragma unroll
        for (int j = 0; j < 4; ++j) { const f32x2 vlo = (f32x2){v[j].x, v[j].y}, vhi = (f32x2){v[j].z, v[j].w};
#pragma unroll
            for (int e = 0; e < 16; ++e) { const f32x4 w4 = *(const LAS f32x4*)(WT + e * 1024 + 4 * F.lane + 256 * j); s2[e] += vlo * (f32x2){w4.x, w4.y}; s2[e] += vhi * (f32x2){w4.z, w4.w}; } }
        float s16[16];
#pragma unroll
        for (int e = 0; e < 16; ++e) s16[e] = s2[e].x + s2[e].y;
        { float a8[8], a4[4], a2[2]; const bool h5 = F.lane & 32, h4 = F.lane & 16, h3 = F.lane & 8, h2 = F.lane & 4;
#pragma unroll
          for (int k = 0; k < 8; ++k) { const float send = h5 ? s16[k] : s16[k + 8], keep = h5 ? s16[k + 8] : s16[k]; a8[k] = keep + __shfl_xor(send, 32); }
#pragma unroll
          for (int k = 0; k < 4; ++k) { const float send = h4 ? a8[k] : a8[k + 4], keep = h4 ? a8[k + 4] : a8[k]; a4[k] = keep + __shfl_xor(send, 16); }
#pragma unroll
          for (int k = 0; k < 2; ++k) { const float send = h3 ? a4[k] : a4[k + 2], keep = h3 ? a4[k + 2] : a4[k]; a2[k] = keep + __shfl_xor(send, 8); }
          const float send = h2 ? a2[0] : a2[1], keep = h2 ? a2[1] : a2[0]; float a1 = keep + __shfl_xor(send, 4);
          a1 += __shfl_xor(a1, 1); a1 += __shfl_xor(a1, 2);
          if ((F.lane & 3) == 0) LG[i * 17 + 8 * ((F.lane >> 5) & 1) + 4 * ((F.lane >> 4) & 1) + 2 * ((F.lane >> 3) & 1) + ((F.lane >> 2) & 1)] = a1; }
        have = more; cur = nxt;
    }
    __syncthreads();
    for (int i = F.tid; i < rpb; i += NT) { if (F.bid * rpb + i >= nrows) break;
        float s16[16], bs[16];
#pragma unroll
        for (int e = 0; e < 16; ++e) { s16[e] = 1.0f / (1.0f + expf(-LG[i * 17 + e])); bs[e] = s16[e] + rbp[e]; }
        float best = -3.0e38f; int bg = 0;
#pragma unroll
        for (int gq = 0; gq < 4; ++gq) { const float a0 = bs[4 * gq], a1 = bs[4 * gq + 1], a2 = bs[4 * gq + 2], a3 = bs[4 * gq + 3];
            const float gs = fmaxf(fmaxf(fmaxf(a0 + a1, a0 + a2), fmaxf(a0 + a3, a1 + a2)), fmaxf(a1 + a3, a2 + a3));
            if (gs > best) { best = gs; bg = gq; } }
        float cb[4], cs[4];
#pragma unroll
        for (int ii = 0; ii < 4; ++ii) { cb[ii] = 0.f; cs[ii] = 0.f; }
#pragma unroll
        for (int gq = 0; gq < 4; ++gq)
#pragma unroll
            for (int ii = 0; ii < 4; ++ii) { cb[ii] = (gq == bg) ? bs[4 * gq + ii] : cb[ii]; cs[ii] = (gq == bg) ? s16[4 * gq + ii] : cs[ii]; }
        int i1 = 0; float b1 = cb[0], s1 = cs[0];
#pragma unroll
        for (int ii = 1; ii < 4; ++ii) if (cb[ii] > b1) { b1 = cb[ii]; s1 = cs[ii]; i1 = ii; }
        int i2 = -1; float b2 = -3.0e38f, s2 = 0.f;
#pragma unroll
        for (int ii = 0; ii < 4; ++ii) if (ii != i1 && cb[ii] > b2) { b2 = cb[ii]; s2 = cs[ii]; i2 = ii; }
        const float inv = 1.0f / (s1 + s2);
        const int e1 = 4 * bg + i1, e2 = 4 * bg + i2;
        rec_e[2 * i] = e1; rec_p[2 * i] = atomicAdd((int*)&lcnt[e1], 1); rec_w[2 * i] = s1 * inv;
        rec_e[2 * i + 1] = e2; rec_p[2 * i + 1] = atomicAdd((int*)&lcnt[e2], 1); rec_w[2 * i + 1] = s2 * inv;
    }
    __syncthreads();
    if (F.tid < 16) lbase[F.tid] = (int)__hip_atomic_fetch_add(cnt + F.tid, (unsigned)lcnt[F.tid], __ATOMIC_RELAXED, __HIP_MEMORY_SCOPE_AGENT);
    __syncthreads();
    for (int j = F.tid; j < 2 * rpb; j += NT) { const int r = F.bid * rpb + (j >> 1); if (r < nrows) { const int e = rec_e[j];
        info[(size_t)e * CAP + lbase[e] + rec_p[j]] = make_uint2((unsigned)(r * 2 + (j & 1)), __builtin_bit_cast(unsigned, rec_w[j])); } }
}
__device__ __forceinline__ void moe_table(Frame& F, int l) {
    LAS int* tab = (LAS int*)(F.lds + TAB_OFF);
    if (F.tid == 0) { int acc = 0; const unsigned* cnt = (const unsigned*)(F.ctl + CW_CNT + l * 16);
        for (int e = 0; e < 16; ++e) { const int n = (int)__hip_atomic_load(cnt + e, __ATOMIC_RELAXED, __HIP_MEMORY_SCOPE_AGENT); tab[e] = acc; tab[17 + e] = n; acc += (n + 255) >> 8; }
        tab[16] = acc; }
    __syncthreads();
}

__device__ __forceinline__ void seq_info(int r, int& base, int& t, int& L) {
    if (r < NLAT) { base = r & ~(SEQ - 1); t = r & (SEQ - 1); L = SEQ; } else { const int j = r - NLAT; base = NLAT + (j & ~(CTXL - 1)); t = j & (CTXL - 1); L = CTXL; }
}
typedef unsigned v2u __attribute__((ext_vector_type(2)));
__device__ __forceinline__ unsigned cvtpk(float lo, float hi) { unsigned r; asm volatile("v_cvt_pk_bf16_f32 %0, %1, %2" : "=v"(r) : "v"(lo), "v"(hi)); return r; }
__device__ __forceinline__ bf16x8 mk8(v2u a, v2u b) { v4u w; w.x = a.x; w.y = a.y; w.z = b.x; w.w = b.y; return __builtin_bit_cast(bf16x8, w); }
template <bool LAT>
__device__ __forceinline__ void kv_unit(Frame& F, int bh, int rq, LAS unsigned short* T) {
    const bf16* U = (const bf16*)(F.ws + WS_U);
    const int q = F.lane & 15, g = F.lane >> 4, h = bh & 3;
    const int urow0 = LAT ? ((bh >> 2) * SEQ + rq * 64) : (NLAT + (bh >> 2) * CTXL + rq * 64);
    bf16* kdst = LAT ? (bf16*)(F.ws + WS_KF) + ((size_t)(bh * 64 + rq) * 14) * 512 : (bf16*)(F.ws + WS_KFC) + ((size_t)(bh * 16 + rq * 4) * 2) * 512;
    bf16* vdst = LAT ? (bf16*)(F.ws + WS_VF) + ((size_t)(bh * 64 + rq) * 16) * 512 : (bf16*)(F.ws + WS_VFC) + ((size_t)(bh * 8 + rq * 2) * 4) * 512;
    { const bf16* src = U + (size_t)(urow0 + F.lane) * INC + UC_V + h * HD;
#pragma unroll
      for (int p = 0; p < 8; ++p) { const v4u w = *(const GAS v4u*)(src + 8 * p); LAS unsigned short* tp = T + (8 * p) * 72 + F.lane;
          tp[0 * 72] = (unsigned short)w.x; tp[1 * 72] = (unsigned short)(w.x >> 16); tp[2 * 72] = (unsigned short)w.y; tp[3 * 72] = (unsigned short)(w.y >> 16);
          tp[4 * 72] = (unsigned short)w.z; tp[5 * 72] = (unsigned short)(w.z >> 16); tp[6 * 72] = (unsigned short)w.w; tp[7 * 72] = (unsigned short)(w.w >> 16); } }
    constexpr int NK = LAT ? 7 : 4, KST = LAT ? 8 : 16;
#pragma unroll
    for (int sidx = 0; sidx < NK; ++sidx)
#pragma unroll
        for (int ks = 0; ks < 2; ++ks) { const v4u w = *(const GAS v4u*)(U + (size_t)(urow0 + KST * sidx + q) * INC + UC_K + h * HD + 32 * ks + 8 * g); *(GAS v4u*)(kdst + (size_t)(sidx * 2 + ks) * 512 + F.lane * 8) = w; }
    LDS_WAIT(); asm volatile("" ::: "memory");
    constexpr int NV = LAT ? 4 : 2;
#pragma unroll
    for (int w = 0; w < NV; ++w) { const int vst = LAT ? (w == 0 ? 0 : (w == 1 ? 8 : (w == 2 ? 24 : 32))) : 32 * w;
#pragma unroll
        for (int dt = 0; dt < 4; ++dt) { const LAS unsigned short* tp = T + (16 * dt + q) * 72 + vst + 4 * g; const v2u lo = *(const LAS v2u*)tp, hi = *(const LAS v2u*)(tp + 16);
            v4u o; o.x = lo.x; o.y = lo.y; o.z = hi.x; o.w = hi.y; *(GAS v4u*)(vdst + (size_t)(w * 4 + dt) * 512 + F.lane * 8) = o; } }
    LDS_WAIT(); asm volatile("" ::: "memory");
}
__device__ __forceinline__ void kv_prepass(Frame& F) {
    LAS unsigned short* T = (LAS unsigned short*)(F.lds + RING_OFF + F.wave * 16384);
    const int gw = F.bid * NWAVES + F.wave, NGW = F.G * NWAVES;
#pragma unroll 1
    for (int idx = gw; idx < 2048; idx += NGW) kv_unit<true>(F, idx >> 6, idx & 63, T);
#pragma unroll 1
    for (int idx = gw; idx < 128; idx += NGW) kv_unit<false>(F, idx >> 2, idx & 3, T);
}
template <bool LAT>
__device__ __forceinline__ void attn_unit(Frame& F, int l, int b, int h, int r, int cb, const LAS float* rpbs) {
    const bf16* U = (const bf16*)(F.ws + WS_U); bf16* Y = (bf16*)(F.ws + WS_H);
    const bf16* KF = (const bf16*)(F.ws + WS_KF); const bf16* VF = (const bf16*)(F.ws + WS_VF); const bf16* KFC = (const bf16*)(F.ws + WS_KFC); const bf16* VFC = (const bf16*)(F.ws + WS_VFC);
    const size_t bh = (size_t)(b * NHEAD + h);
    const int q = F.lane & 15, g = F.lane >> 4;
    constexpr int NT_ = LAT ? 32 : 16, NB = LAT ? 16 : 0;
    const int qrow = LAT ? (b * SEQ + r * GRIDW + cb * 16 + q) : (NLAT + b * CTXL + cb * 16 + q);
    const int r0 = r - 4 < 0 ? 0 : (r - 4 > 56 ? 56 : r - 4);
    const int wb = cb * 16 - 8 < 0 ? 0 : (cb * 16 - 8 > 32 ? 32 : cb * 16 - 8);
    bf16x8 qf[2];
#pragma unroll
    for (int ks = 0; ks < 2; ++ks) qf[ks] = *(const GAS bf16x8*)(U + (size_t)qrow * INC + UC_Q + h * HD + 32 * ks + 8 * g);
    f32x4 s[NT_];
#pragma unroll
    for (int t = 0; t < NT_; ++t) {
        const bf16* kp;
        if (t < NB) { const int kr = t >> 1, seg = t & 1; kp = KF + (((bh * 64 + (r0 + kr)) * 7 + ((wb >> 3) + 2 * seg)) * 2) * 512 + F.lane * 8; } else kp = KFC + ((bh * 16 + (t - NB)) * 2) * 512 + F.lane * 8;
        const bf16x8 k0 = *(const GAS bf16x8*)kp, k1 = *(const GAS bf16x8*)(kp + 512);
        f32x4 a = (f32x4){0.f, 0.f, 0.f, 0.f};
        a = __builtin_amdgcn_mfma_f32_16x16x32_bf16(k0, qf[0], a, 0, 0, 0);
        s[t] = __builtin_amdgcn_mfma_f32_16x16x32_bf16(k1, qf[1], a, 0, 0, 0);
    }
    float m = -3.0e38f;
    if (LAT) {
        const int cq = cb * 16 + q; const int c0 = cq - 8 < 0 ? 0 : (cq - 8 > 48 ? 48 : cq - 8);
        const LAS float* rp = rpbs + h * 15 * 31;
#pragma unroll
        for (int t = 0; t < NB; ++t) { const int kr = t >> 1, seg = t & 1; const int rrel = r0 + kr - r + 7;
#pragma unroll
            for (int i = 0; i < 4; ++i) { const int cc = wb + seg * 16 + 4 * g + i; const bool ok = (cc >= c0) && (cc < c0 + 16);
                int ci = cc - cq + 15; ci = ci < 0 ? 0 : (ci > 30 ? 30 : ci);
                const float bias = rp[rrel * 31 + ci];
                float v = s[t][i] * 0.125f + bias; v = ok ? v : -3.0e38f; s[t][i] = v; m = fmaxf(m, v); } }
    }
#pragma unroll
    for (int t = NB; t < NT_; ++t)
#pragma unroll
        for (int i = 0; i < 4; ++i) { const float v = s[t][i] * 0.125f; s[t][i] = v; m = fmaxf(m, v); }
    m = fmaxf(m, __shfl_xor(m, 16)); m = fmaxf(m, __shfl_xor(m, 32));
    float sum = 0.f;
#pragma unroll
    for (int t = 0; t < NT_; ++t)
#pragma unroll
        for (int i = 0; i < 4; ++i) { const float p = __expf(s[t][i] - m); s[t][i] = p; sum += p; }
    sum += __shfl_xor(sum, 16); sum += __shfl_xor(sum, 32);
    f32x4 o[4];
#pragma unroll
    for (int dt = 0; dt < 4; ++dt) o[dt] = (f32x4){0.f, 0.f, 0.f, 0.f};
#pragma unroll
    for (int kk = 0; kk < NT_ / 2; ++kk) {
        v4u pw; pw.x = cvtpk(s[2 * kk][0], s[2 * kk][1]); pw.y = cvtpk(s[2 * kk][2], s[2 * kk][3]); pw.z = cvtpk(s[2 * kk + 1][0], s[2 * kk + 1][1]); pw.w = cvtpk(s[2 * kk + 1][2], s[2 * kk + 1][3]);
        const bf16x8 pf = __builtin_bit_cast(bf16x8, pw);
        const bf16* vbase;
        if (2 * kk < NB) vbase = VF + (((bh * 64 + (r0 + kk)) * 4 + cb) * 4) * 512 + F.lane * 8; else vbase = VFC + ((bh * 8 + (kk - NB / 2)) * 4) * 512 + F.lane * 8;
#pragma unroll
        for (int dt = 0; dt < 4; ++dt) { const bf16x8 vf = *(const GAS bf16x8*)(vbase + dt * 512);
            o[dt] = __builtin_amdgcn_mfma_f32_16x16x32_bf16(vf, pf, o[dt], 0, 0, 0); }
    }
    const float inv = 1.0f / sum; bf16* yp = Y + (size_t)qrow * D + 512 + h * HD + 4 * g;
#pragma unroll
    for (int dt = 0; dt < 4; ++dt) { v2u w; w.x = cvtpk(o[dt][0] * inv, o[dt][1] * inv); w.y = cvtpk(o[dt][2] * inv, o[dt][3] * inv); *(GAS v2u*)(yp + dt * 16) = w; }
}
__device__ __forceinline__ void attn_phase(Frame& F, int l, bool with_ctx) {
    LAS float* rpbs = (LAS float*)(F.lds + TAB_OFF);
    { const float* rp = F.inp(I_RPB) + (size_t)l * NHEAD * 15 * 31; for (int i = F.tid; i < NHEAD * 15 * 31; i += NT) rpbs[i] = rp[i]; }
    __syncthreads();
    const int gw = F.bid * NWAVES + F.wave, NGW = F.G * NWAVES;
    {
        const int x = F.bid & 7, lb = F.bid >> 3, nlb = (F.G - x + 7) >> 3;
#pragma unroll 1
        for (int uu = lb * NWAVES + F.wave; uu < 1024; uu += nlb * NWAVES) { const int bh = 4 * x + (uu >> 8), u = uu & 255; attn_unit<true>(F, l, bh >> 2, bh & 3, u >> 2, u & 3, rpbs); } }
    if (with_ctx) for (int uid = gw; uid < BATCH * NHEAD * 16; uid += NGW) { const int cb = uid & 15, h = (uid >> 4) & 3, b = uid >> 6; attn_unit<false>(F, l, b, h, 0, cb, rpbs); }
}
__device__ __forceinline__ void dft64_tables(Frame& F, int off) {
    LAS unsigned short* CT = (LAS unsigned short*)(F.lds + off); LAS unsigned short* ST = CT + 64 * 72;
    for (int i = F.tid; i < 4096; i += NT) { const int j = i >> 6, k = i & 63; float s_, c_; sincospif((float)((j * k) & 63) * (1.0f / 32.0f), &s_, &c_); CT[j * 72 + k] = (unsigned short)f2bf(c_); ST[j * 72 + k] = (unsigned short)f2bf(s_); }
}
__device__ __forceinline__ void fourier_a(Frame& F) {
    const bf16* U = (const bf16*)(F.ws + WS_U); bf16* Zr = (bf16*)(F.ws + WS_Z); bf16* Zi = Zr + NZ;
    constexpr int O_CT = 0, O_TWC = 18432, O_TWS = O_TWC + 16384;
    dft64_tables(F, O_CT);
    { LAS float* twc = (LAS float*)(F.lds + O_TWC); LAS float* tws = (LAS float*)(F.lds + O_TWS);
      for (int i = F.tid; i < 4096; i += NT) { float s_, c_; sincospif((float)i * (1.0f / 2048.0f), &s_, &c_); twc[i] = c_; tws[i] = s_; } }
    __syncthreads();
    const LAS unsigned short* CT = (const LAS unsigned short*)(F.lds + O_CT); const LAS unsigned short* ST = CT + 64 * 72;
    const LAS float* twc = (const LAS float*)(F.lds + O_TWC); const LAS float* tws = (const LAS float*)(F.lds + O_TWS);
    const int q = F.lane & 15, g = F.lane >> 4;
    const int gw = F.bid * NWAVES + F.wave, NGW = F.G * NWAVES;
    for (int un = gw; un < BATCH * NHEAD * 64; un += NGW) {
        const int b = un >> 8, h = (un >> 6) & 3, n2 = un & 63;
        f32x4 xr[4][4], xw[4][4];
#pragma unroll
        for (int mt = 0; mt < 4; ++mt)
#pragma unroll
            for (int ct = 0; ct < 4; ++ct) { xr[mt][ct] = (f32x4){0.f, 0.f, 0.f, 0.f}; xw[mt][ct] = (f32x4){0.f, 0.f, 0.f, 0.f}; }
#pragma unroll
        for (int ks = 0; ks < 2; ++ks) {
            bf16x8 tf[4], cf[4], sf[4];
#pragma unroll
            for (int mt = 0; mt < 4; ++mt) tf[mt] = *(const GAS bf16x8*)(U + (size_t)(b * SEQ + 64 * (16 * mt + q) + n2) * INC + UC_F + h * HD + 32 * ks + 8 * g);
#pragma unroll
            for (int ct = 0; ct < 4; ++ct) { cf[ct] = *(const LAS bf16x8*)(CT + (16 * ct + q) * 72 + 32 * ks + 8 * g); sf[ct] = *(const LAS bf16x8*)(ST + (16 * ct + q) * 72 + 32 * ks + 8 * g); }
#pragma unroll
            for (int mt = 0; mt < 4; ++mt)
#pragma unroll
                for (int ct = 0; ct < 4; ++ct) { xr[mt][ct] = __builtin_amdgcn_mfma_f32_16x16x32_bf16(tf[mt], cf[ct], xr[mt][ct], 0, 0, 0); xw[mt][ct] = __builtin_amdgcn_mfma_f32_16x16x32_bf16(tf[mt], sf[ct], xw[mt][ct], 0, 0, 0); }
        }
        v4u ar[4][2], awn[4][2];
#pragma unroll
        for (int ct = 0; ct < 4; ++ct)
#pragma unroll
            for (int kb = 0; kb < 2; ++kb) {
                ar[ct][kb].x = cvtpk(xr[2 * kb][ct][0], xr[2 * kb][ct][1]); ar[ct][kb].y = cvtpk(xr[2 * kb][ct][2], xr[2 * kb][ct][3]);
                ar[ct][kb].z = cvtpk(xr[2 * kb + 1][ct][0], xr[2 * kb + 1][ct][1]); ar[ct][kb].w = cvtpk(xr[2 * kb + 1][ct][2], xr[2 * kb + 1][ct][3]);
                awn[ct][kb].x = cvtpk(-xw[2 * kb][ct][0], -xw[2 * kb][ct][1]); awn[ct][kb].y = cvtpk(-xw[2 * kb][ct][2], -xw[2 * kb][ct][3]);
                awn[ct][kb].z = cvtpk(-xw[2 * kb + 1][ct][0], -xw[2 * kb + 1][ct][1]); awn[ct][kb].w = cvtpk(-xw[2 * kb + 1][ct][2], -xw[2 * kb + 1][ct][3]); }
#pragma unroll
        for (int rt = 0; rt < 4; ++rt) {
            const int n1p = 16 * rt + q;
            bf16x8 cb_[2], sb_[2];
#pragma unroll
            for (int kb = 0; kb < 2; ++kb) { const LAS unsigned short* cp = CT + n1p * 72 + 32 * kb + 4 * g; const LAS unsigned short* sp = ST + n1p * 72 + 32 * kb + 4 * g;
                cb_[kb] = mk8(*(const LAS v2u*)cp, *(const LAS v2u*)(cp + 16)); sb_[kb] = mk8(*(const LAS v2u*)sp, *(const LAS v2u*)(sp + 16)); }
            const int tix = n2 * n1p; const float cw = twc[tix], sw = tws[tix];
            const size_t zbase = ((((size_t)(b * NHEAD + h) * 64 + n1p) * 64 + n2) * 64) + 4 * g;
#pragma unroll
            for (int ct = 0; ct < 4; ++ct) {
                f32x4 yr = (f32x4){0.f, 0.f, 0.f, 0.f}, yi = (f32x4){0.f, 0.f, 0.f, 0.f};
#pragma unroll
                for (int kb = 0; kb < 2; ++kb) {
                    const bf16x8 a_r = __builtin_bit_cast(bf16x8, ar[ct][kb]), a_wn = __builtin_bit_cast(bf16x8, awn[ct][kb]);
                    v4u nr = ar[ct][kb]; nr.x ^= 0x80008000u; nr.y ^= 0x80008000u; nr.z ^= 0x80008000u; nr.w ^= 0x80008000u; const bf16x8 a_rn = __builtin_bit_cast(bf16x8, nr);
                    yr = __builtin_amdgcn_mfma_f32_16x16x32_bf16(a_r, cb_[kb], yr, 0, 0, 0); yr = __builtin_amdgcn_mfma_f32_16x16x32_bf16(a_wn, sb_[kb], yr, 0, 0, 0);
                    yi = __builtin_amdgcn_mfma_f32_16x16x32_bf16(a_wn, cb_[kb], yi, 0, 0, 0); yi = __builtin_amdgcn_mfma_f32_16x16x32_bf16(a_rn, sb_[kb], yi, 0, 0, 0); }
                v2u wr_, wi_;
                wr_.x = cvtpk(yr[0] * cw + yi[0] * sw, yr[1] * cw + yi[1] * sw); wr_.y = cvtpk(yr[2] * cw + yi[2] * sw, yr[3] * cw + yi[3] * sw);
                wi_.x = cvtpk(yi[0] * cw - yr[0] * sw, yi[1] * cw - yr[1] * sw); wi_.y = cvtpk(yi[2] * cw - yr[2] * sw, yi[3] * cw - yr[3] * sw);
                *(GAS v2u*)(Zr + zbase + 16 * ct) = wr_; *(GAS v2u*)(Zi + zbase + 16 * ct) = wi_;
            }
        }
    }
}
__device__ __forceinline__ void fourier_b(Frame& F, bool with_ctx) {
    bf16* Y = (bf16*)(F.ws + WS_H); const bf16* Zr = (const bf16*)(F.ws + WS_Z);
    dft64_tables(F, 0);
    __syncthreads();
    const LAS unsigned short* CT = (const LAS unsigned short*)(F.lds); const LAS unsigned short* ST = CT + 64 * 72;
    LAS unsigned short* ZT = (LAS unsigned short*)(F.lds + 18432 + F.wave * 9216);
    const int q = F.lane & 15, g = F.lane >> 4;
    const int gw = F.bid * NWAVES + F.wave, NGW = F.G * NWAVES;
    const int nun = BATCH * NHEAD * 64 + (with_ctx ? BATCH * NHEAD * 4 : 0);
    for (int un = gw; un < nun; un += NGW) {
        const bool lat = un < BATCH * NHEAD * 64; const int uc = un - BATCH * NHEAD * 64;
        const int b = lat ? (un >> 8) : (uc >> 4), h = lat ? ((un >> 6) & 3) : ((uc >> 2) & 3), n1p = lat ? (un & 63) : (uc & 3);
        const size_t z0 = lat ? (((size_t)(b * NHEAD + h) * 64 + n1p) * 64) * 64 : 2 * NZ + (((size_t)(b * NHEAD + h) * 4 + n1p) * 64) * 64;
        const size_t zim = lat ? NZ : NZC;
        const int tok0 = lat ? (b * SEQ + n1p) : (NLAT + b * CTXL + n1p), tstride = lat ? 64 : 4; const float oscale = lat ? (1.0f / 512.0f) : (1.0f / 128.0f);
        f32x4 acc[4][4];
#pragma unroll
        for (int ct = 0; ct < 4; ++ct)
#pragma unroll
            for (int nt = 0; nt < 4; ++nt) acc[ct][nt] = (f32x4){0.f, 0.f, 0.f, 0.f};
#pragma unroll
        for (int comp = 0; comp < 2; ++comp) {
            const bf16* zp = Zr + z0 + (comp ? zim : 0); const LAS unsigned short* FT = comp ? ST : CT;
#pragma unroll
            for (int i = 0; i < 8; ++i) { const int p = F.lane + 64 * i, n2 = p >> 3, c8 = p & 7; const v4u w = *(const GAS v4u*)(zp + (size_t)n2 * 64 + 8 * c8); LAS unsigned short* tp = ZT + (8 * c8) * 72 + n2;
                tp[0 * 72] = (unsigned short)w.x; tp[1 * 72] = (unsigned short)(w.x >> 16); tp[2 * 72] = (unsigned short)w.y; tp[3 * 72] = (unsigned short)(w.y >> 16);
                tp[4 * 72] = (unsigned short)w.z; tp[5 * 72] = (unsigned short)(w.z >> 16); tp[6 * 72] = (unsigned short)w.w; tp[7 * 72] = (unsigned short)(w.w >> 16); }
            LDS_WAIT(); asm volatile("" ::: "memory");
#pragma unroll
            for (int ks = 0; ks < 2; ++ks) {
                bf16x8 af[4], bf_[4];
#pragma unroll
                for (int ct = 0; ct < 4; ++ct) af[ct] = *(const LAS bf16x8*)(ZT + (16 * ct + q) * 72 + 32 * ks + 8 * g);
#pragma unroll
                for (int nt = 0; nt < 4; ++nt) bf_[nt] = *(const LAS bf16x8*)(FT + (16 * nt + q) * 72 + 32 * ks + 8 * g);
#pragma unroll
                for (int ct = 0; ct < 4; ++ct)
#pragma unroll
                    for (int nt = 0; nt < 4; ++nt) acc[ct][nt] = __builtin_amdgcn_mfma_f32_16x16x32_bf16(af[ct], bf_[nt], acc[ct][nt], 0, 0, 0);
            }
            LDS_WAIT(); asm volatile("" ::: "memory");
        }
#pragma unroll
        for (int nt = 0; nt < 4; ++nt) { bf16* yp = Y + (size_t)(tok0 + tstride * (16 * nt + q)) * D + 768 + h * HD + 4 * g;
#pragma unroll
            for (int ct = 0; ct < 4; ++ct) { v2u w; w.x = cvtpk(acc[ct][nt][0] * oscale, acc[ct][nt][1] * oscale); w.y = cvtpk(acc[ct][nt][2] * oscale, acc[ct][nt][3] * oscale); *(GAS v2u*)(yp + 16 * ct) = w; } }
    }
}
__device__ __forceinline__ v4u mul_bf8(v4u a, v4u b) { v4u r; r.x = cvtpk(bflo(a.x) * bflo(b.x), bfhi(a.x) * bfhi(b.x)); r.y = cvtpk(bflo(a.y) * bflo(b.y), bfhi(a.y) * bfhi(b.y)); r.z = cvtpk(bflo(a.z) * bflo(b.z), bfhi(a.z) * bfhi(b.z)); r.w = cvtpk(bflo(a.w) * bflo(b.w), bfhi(a.w) * bfhi(b.w)); return r; }
__device__ __forceinline__ void convpool_phase(Frame& F, int l, int nrows) {
    const bf16* U = (const bf16*)(F.ws + WS_U); bf16* Y = (bf16*)(F.ws + WS_H);
    const bf16* PWT = (const bf16*)(F.ws + WS_PWT) + (size_t)l * 4 * 64 * 64;
    const float* cw = F.inp(I_CONVW) + (size_t)l * 3 * GWID; const float* ps = F.inp(I_POOLS) + (size_t)l * GWID;
    LAS unsigned* PX = (LAS unsigned*)(F.lds + RING_OFF);
    LAS unsigned* DT = (LAS unsigned*)(F.lds + RING_OFF + 40960);
    const int q = F.lane & 15, g = F.lane >> 4;
    const int c8 = F.tid & 31, gi = F.wave & 3;
    const f32x4 w0a = *(const GAS f32x4*)(cw + 8 * c8), w0b = *(const GAS f32x4*)(cw + 8 * c8 + 4), w1a = *(const GAS f32x4*)(cw + GWID + 8 * c8), w1b = *(const GAS f32x4*)(cw + GWID + 8 * c8 + 4),
                w2a = *(const GAS f32x4*)(cw + 2 * GWID + 8 * c8), w2b = *(const GAS f32x4*)(cw + 2 * GWID + 8 * c8 + 4);
    bf16x8 wf[4][2]; f32x4 psc[4];
#pragma unroll
    for (int dt = 0; dt < 4; ++dt) { psc[dt] = *(const GAS f32x4*)(ps + gi * 64 + 16 * dt + 4 * g);
#pragma unroll
        for (int ks = 0; ks < 2; ++ks) wf[dt][ks] = *(const GAS bf16x8*)(PWT + ((size_t)gi * 64 + 16 * dt + q) * 64 + 32 * ks + 8 * g); }
    for (int tile = F.bid; tile < nrows / 64; tile += F.G) {
        const int r0 = tile * 64; int base, t0, L; seq_info(r0, base, t0, L);
#pragma unroll
        for (int i = 0; i < 4; ++i) { const int p = F.tid + NT * i, tr = p >> 5, t = t0 + tr; const bf16* ur = U + (size_t)(r0 + tr) * INC + 8 * c8;
            const v4u zc = mul_bf8(*(const GAS v4u*)(ur + UC_AC), *(const GAS v4u*)(ur + UC_AV));
            v4u zp = (v4u){0u, 0u, 0u, 0u}, zn = (v4u){0u, 0u, 0u, 0u};
            if (t > 0) zp = mul_bf8(*(const GAS v4u*)(ur + UC_AC - INC), *(const GAS v4u*)(ur + UC_AV - INC));
            if (t < L - 1) zn = mul_bf8(*(const GAS v4u*)(ur + UC_AC + INC), *(const GAS v4u*)(ur + UC_AV + INC));
            const v4u ab = *(const GAS v4u*)(ur + UC_AB);
            v4u o;
            o.x = cvtpk(bflo(ab.x) * (w0a.x * bflo(zp.x) + w1a.x * bflo(zc.x) + w2a.x * bflo(zn.x)), bfhi(ab.x) * (w0a.y * bfhi(zp.x) + w1a.y * bfhi(zc.x) + w2a.y * bfhi(zn.x)));
            o.y = cvtpk(bflo(ab.y) * (w0a.z * bflo(zp.y) + w1a.z * bflo(zc.y) + w2a.z * bflo(zn.y)), bfhi(ab.y) * (w0a.w * bfhi(zp.y) + w1a.w * bfhi(zc.y) + w2a.w * bfhi(zn.y)));
            o.z = cvtpk(bflo(ab.z) * (w0b.x * bflo(zp.z) + w1b.x * bflo(zc.z) + w2b.x * bflo(zn.z)), bfhi(ab.z) * (w0b.y * bfhi(zp.z) + w1b.y * bfhi(zc.z) + w2b.y * bfhi(zn.z)));
            o.w = cvtpk(bflo(ab.w) * (w0b.z * bflo(zp.w) + w1b.z * bflo(zc.w) + w2b.z * bflo(zn.w)), bfhi(ab.w) * (w0b.w * bfhi(zp.w) + w1b.w * bfhi(zc.w) + w2b.w * bfhi(zn.w)));
            *(GAS v4u*)(Y + (size_t)(r0 + tr) * D + 8 * c8) = o; }
#pragma unroll
        for (int i = 0; i < 5; ++i) { const int p = F.tid + NT * i, rr = p >> 5, t = t0 - 8 + rr; v4u w = (v4u){0u, 0u, 0u, 0u};
            if (t >= 0 && t < L) w = *(const GAS v4u*)(U + (size_t)(base + t) * INC + UC_P + 8 * c8);
            *(LAS v4u*)(PX + rr * 128 + 4 * c8) = w; }
        __syncthreads();
        { const int c2 = F.tid & 127, tq = F.tid >> 7, hw = 1 << (c2 >> 5);
          float s0 = 0.f, s1 = 0.f;
          for (int k = -hw; k < hw; ++k) { const unsigned w = PX[(16 * tq + 8 + k) * 128 + c2]; s0 += bflo(w); s1 += bfhi(w); }
          for (int i = 0; i < 16; ++i) { const int tl = 16 * tq + i, t = t0 + tl;
              const int lo = t - hw > 0 ? t - hw : 0, hi = t + hw < L ? t + hw : L; const float rc = 1.0f / (float)(hi - lo);
              const unsigned xc = PX[(tl + 8) * 128 + c2];
              DT[tl * 132 + c2] = cvtpk(s0 * rc - bflo(xc), s1 * rc - bfhi(xc));
              const unsigned wa = PX[(tl + 8 + hw) * 128 + c2], wsb = PX[(tl + 8 - hw) * 128 + c2];
              s0 += bflo(wa) - bflo(wsb); s1 += bfhi(wa) - bfhi(wsb); } }
        __syncthreads();
        {
#pragma unroll
          for (int tj = 0; tj < 2; ++tj) { const int tt = 2 * (F.wave >> 2) + tj;
              bf16x8 df[2];
#pragma unroll
              for (int ks = 0; ks < 2; ++ks) df[ks] = *(const LAS bf16x8*)(DT + (16 * tt + q) * 132 + gi * 32 + 16 * ks + 4 * g);
#pragma unroll
              for (int dt = 0; dt < 4; ++dt) { f32x4 a = (f32x4){0.f, 0.f, 0.f, 0.f};
                  a = __builtin_amdgcn_mfma_f32_16x16x32_bf16(wf[dt][0], df[0], a, 0, 0, 0); a = __builtin_amdgcn_mfma_f32_16x16x32_bf16(wf[dt][1], df[1], a, 0, 0, 0);
                  const int oc = gi * 64 + 16 * dt + 4 * g; const f32x4 sc = psc[dt];
                  v2u w; w.x = cvtpk(a[0] * sc.x, a[1] * sc.y); w.y = cvtpk(a[2] * sc.z, a[3] * sc.w);
                  *(GAS v2u*)(Y + (size_t)(r0 + 16 * tt + q) * D + 256 + oc) = w; } } }
        __syncthreads();
    }
}

__device__ __forceinline__ void fourier_ctx_a(Frame& F) {
    const bf16* U = (const bf16*)(F.ws + WS_U); bf16* Zc = (bf16*)(F.ws + WS_Z) + 2 * NZ;
    LAS float* cs = (LAS float*)(F.lds + TAB_OFF); LAS float* sn = cs + 64; LAS float* cs256 = cs + 128; LAS float* sn256 = cs + 384;
    if (F.tid < 64) { float s_, c_; sincospif((float)F.tid * (1.0f / 32.0f), &s_, &c_); cs[F.tid] = c_; sn[F.tid] = s_; }
    if (F.tid < 256) { float s_, c_; sincospif((float)F.tid * (1.0f / 128.0f), &s_, &c_); cs256[F.tid] = c_; sn256[F.tid] = s_; }
    __syncthreads();
    for (int item = F.bid * NT + F.tid; item < BATCH * NHEAD * 64 * 64; item += F.G * NT) {
        const int cp = item & 63, n2 = (item >> 6) & 63, h = (item >> 12) & 3, b = item >> 14;
        float xr[4], xi[4];
#pragma unroll
        for (int n1 = 0; n1 < 4; ++n1) { xr[n1] = 0.f; xi[n1] = 0.f; }
        for (int c8 = 0; c8 < 8; ++c8) {
            float cc[8], ss[8];
#pragma unroll
            for (int e = 0; e < 8; ++e) { const int idx = ((8 * c8 + e) * cp) & 63; cc[e] = cs[idx]; ss[e] = sn[idx]; }
#pragma unroll
            for (int n1 = 0; n1 < 4; ++n1) { const v4u w = *(const GAS v4u*)(U + (size_t)(NLAT + b * CTXL + 64 * n1 + n2) * INC + UC_F + h * HD + 8 * c8);
                const float f0 = bflo(w.x), f1 = bfhi(w.x), f2 = bflo(w.y), f3 = bfhi(w.y), f4 = bflo(w.z), f5 = bfhi(w.z), f6 = bflo(w.w), f7 = bfhi(w.w);
                xr[n1] += f0 * cc[0] + f1 * cc[1] + f2 * cc[2] + f3 * cc[3] + f4 * cc[4] + f5 * cc[5] + f6 * cc[6] + f7 * cc[7];
                xi[n1] -= f0 * ss[0] + f1 * ss[1] + f2 * ss[2] + f3 * ss[3] + f4 * ss[4] + f5 * ss[5] + f6 * ss[6] + f7 * ss[7]; }
        }
        float yr[4], yi[4];
        yr[0] = xr[0] + xr[1] + xr[2] + xr[3];           yi[0] = xi[0] + xi[1] + xi[2] + xi[3];
        yr[1] = xr[0] + xi[1] - xr[2] - xi[3];           yi[1] = xi[0] - xr[1] - xi[2] + xr[3];
        yr[2] = xr[0] - xr[1] + xr[2] - xr[3];           yi[2] = xi[0] - xi[1] + xi[2] - xi[3];
        yr[3] = xr[0] - xi[1] - xr[2] + xi[3];           yi[3] = xi[0] + xr[1] - xi[2] - xr[3];
#pragma unroll
        for (int k = 0; k < 4; ++k) { const int tix = (n2 * k) & 255; const float cw = cs256[tix], sw = sn256[tix];
            const size_t zi = ((((size_t)(b * NHEAD + h) * 4 + k) * 64 + n2) * 64) + cp;
            Zc[zi] = (bf16)f2bf(yr[k] * cw + yi[k] * sw); Zc[NZC + zi] = (bf16)f2bf(yi[k] * cw - yr[k] * sw); }
    }
}

#ifndef REP_CP
#define REP_CP 1
#endif
#ifndef REP_KV
#define REP_KV 1
#endif
#ifndef REP_FA
#define REP_FA 1
#endif
#ifndef REP_ATT
#define REP_ATT 1
#endif
#ifndef REP_FB
#define REP_FB 1
#endif
__device__ __forceinline__ void mixa_phase(int l, bool with_ctx) { Frame F = mk_frame();
    const int nrows = with_ctx ? NROW : NLAT;
    convpool_phase(F, l, nrows);
#if REP_CP > 1
    convpool_phase(F, l, nrows);
#endif
    kv_prepass(F);
#if REP_KV > 1
    kv_prepass(F);
#endif
    __syncthreads();
    fourier_a(F);
    __syncthreads();
#if REP_FA > 1
    fourier_a(F);
    __syncthreads();
#endif
    if (with_ctx) fourier_ctx_a(F);
}
__device__ __forceinline__ void mixb_phase(int l, bool with_ctx) { Frame F = mk_frame();
    attn_phase(F, l, with_ctx);
    __syncthreads();
#if REP_ATT > 1
    attn_phase(F, l, with_ctx);
    __syncthreads();
#endif
    fourier_b(F, with_ctx);
#if REP_FB > 1
    __syncthreads();
    fourier_b(F, with_ctx);
#endif
}

struct WinOrder {
    int G, c, nctx_cols, ctx_pn0;
    __device__ __forceinline__ bool next(int i, pg8::Unit& u) const {
        const long L = (long)i * G + c; const int nlatu = 1024, total = nlatu + 8 * nctx_cols; if (L >= total) return false;
        if (L < nlatu) { int wgid = (int)L; { const int xcd = wgid % 8, off = wgid / 8; wgid = xcd * 128 + off; }
            const int gid = wgid / 64, fm = gid * 8; u.pm = fm + ((wgid % 64) % 8); u.pn = (wgid % 64) / 8; }
        else { const int j = (int)L - nlatu; u.pm = 128 + (j % 8); u.pn = ctx_pn0 + j / 8; }
        u.pb = u.pn; u.lb = 0; u.nv = 256; return true;
    }
    __device__ __forceinline__ void a_ready(const pg8::Unit&) const {}
    __device__ __forceinline__ void done(const pg8::Unit&) const {}
    __device__ __forceinline__ int row_of(const pg8::Unit&, int i) const { return i; }
};

struct Args { const float* in[20]; float* out; unsigned char* ws; int l, e; };
#define PH_PTRS() \
    bf16* H = (bf16*)(F.ws + WS_H); bf16* U = (bf16*)(F.ws + WS_U); bf16* HE = (bf16*)(F.ws + WS_U); bf16* Y2 = (bf16*)(F.ws + WS_S); \
    float* MOD = (float*)(F.ws + WS_MOD); float* XC = (float*)(F.ws + WS_XC); const uint2* INFO = (const uint2*)(F.ws + WS_INFO); \
    const bool first = (l == 0); const int M = first ? NROW : NLAT; const float* modl = MOD + (size_t)l * 9 * 6144; \
    (void)H; (void)U; (void)HE; (void)XC; (void)Y2; (void)INFO; (void)M; (void)modl;

#define XS_IN()  XStream{(const char*)F.inp(I_X), (const char*)F.inp(I_CTX), 4096, 4096}
#define XS_BF()  XStream{(const char*)F.out, (const char*)XC, 4096, 2048}
__device__ __forceinline__ void ph_norm1(int l) { Frame F = mk_frame(); PH_PTRS();
    norm_phase<0, false, false>(F, XS_IN(), XS_IN(), NROW, F.inp(I_N1G), modl, modl, 0, 1, H, nullptr, nullptr); }
__device__ __forceinline__ void ph_next(int l, bool probe = false) { Frame F = mk_frame(); PH_PTRS();
    if (first) norm_phase<1, false, true>(F, XS_BF(), XS_BF(), NROW, F.inp(I_N1G) + D, MOD + (size_t)9 * 6144, modl, 0, 1, H, Y2, nullptr);
    else norm_phase<1, true, true>(F, XS_BF(), XS_BF(), NLAT, F.inp(I_FG), modl, modl, 0, 0, nullptr, Y2, F.out); }
__device__ __forceinline__ void ph_route(int l, bool probe = false) { Frame F = mk_frame(); PH_PTRS();
    if (first) route_phase<false>(F, l, XS_IN(), XS_BF(), U, M, F.inp(I_N2G) + (size_t)l * D, modl, H, (uint2*)(F.ws + WS_INFO), (unsigned*)(F.ctl + CW_CNT + l * 16));
    else route_phase<true>(F, l, XS_BF(), XS_BF(), U, M, F.inp(I_N2G) + (size_t)l * D, modl, H, (uint2*)(F.ws + WS_INFO), (unsigned*)(F.ctl + CW_CNT + l * 16)); }
__device__ __forceinline__ void ph_win(int l) { Frame F = mk_frame(); PH_PTRS();
    pg8::Gemm g{H, (const bf16*)(F.ws + WS_WIN) + (size_t)l * INC * D, NROW, INC, D};
    WinOrder S{F.G, F.bid, first ? 8 : 2, first ? 0 : 5};
    pg8::EpiBf16 E{U, INC};
    pg8::gemm_phase<pg8::EpiBf16, WinOrder>(F.lds + RING_OFF, g, S, E); }
__device__ __forceinline__ void ph_wout(int l) { Frame F = mk_frame(); PH_PTRS();
    pg8::Gemm g{H, (const bf16*)(F.ws + WS_WOUT) + (size_t)l * D * D, M, D, D};
    pg8::StaticOrder S; S.init(M, D, F.G, F.bid);
    pg8::EpiBf16 E{U, D};
    pg8::gemm_phase<pg8::EpiBf16, pg8::StaticOrder>(F.lds + RING_OFF, g, S, E); }
__device__ __forceinline__ void ph_moe1(int l) { Frame F = mk_frame(); PH_PTRS(); moe_table(F, l);
    pg8::Gemm g{H, (const bf16*)(F.ws + WS_W13) + (size_t)l * NEXP * 1024 * D, M, 1024, D};
    pg8::MoeOrder S{F.G, F.bid, CAP, (const LAS int*)(F.lds + TAB_OFF), INFO};
    pg8::EpiSwiGLU E{HE, MHID};
    pg8::gemm_phase<pg8::EpiSwiGLU, pg8::MoeOrder, true>(F.lds + RING_OFF, g, S, E); }
__device__ __forceinline__ void ph_moe2(int l) { Frame F = mk_frame(); PH_PTRS(); moe_table(F, l);
    pg8::Gemm g{HE, (const bf16*)(F.ws + WS_W2) + (size_t)l * NEXP * D * MHID, M, D, MHID};
    pg8::MoeOrder S{F.G, F.bid, CAP, (const LAS int*)(F.lds + TAB_OFF), INFO};
    pg8::EpiScatter E{Y2, INFO};
    pg8::gemm_phase<pg8::EpiScatter, pg8::MoeOrder, false>(F.lds + RING_OFF, g, S, E); }

__device__ __forceinline__ void grid_bar() {
    Frame F = mk_frame(); XcdBarrier b; b.bar = (unsigned*)(F.ctl + CW_BAR); b.x = xb_xcc_id(); b.st = F.MISC + 8; xcd_barrier(b);
}
#ifndef SINGLE_LAUNCH
#define SINGLE_LAUNCH 1
#endif
#if !SINGLE_LAUNCH
__global__ void __launch_bounds__(NT, 2) k_pa(Args args) { pa_phase(); }
__global__ void __launch_bounds__(NT, 2) k_norm1(Args args) { ph_norm1(args.l); }
__global__ void __launch_bounds__(NT, 2) k_next(Args args) { ph_next(args.l); }
__global__ void __launch_bounds__(NT, 2) k_route(Args args) { ph_route(args.l); }
__global__ void __launch_bounds__(NT, 2) k_win(Args args) { ph_win(args.l); }
__global__ void __launch_bounds__(NT, 2) k_mixa(Args args) { mixa_phase(args.l, args.l == 0); }
__global__ void __launch_bounds__(NT, 2) k_mixb(Args args) { mixb_phase(args.l, args.l == 0); }
__global__ void __launch_bounds__(NT, 2) k_wout(Args args) { ph_wout(args.l); }
__global__ void __launch_bounds__(NT, 2) k_moe1(Args args) { ph_moe1(args.l); }
__global__ void __launch_bounds__(NT, 2) k_moe2(Args args) { ph_moe2(args.l); }
#else
#define PMARK(name) asm volatile("; PHASE_MARK " name ::: "memory")
#ifndef REP_ROUTE
#define REP_ROUTE 1
#endif
#ifndef REP_NEXT
#define REP_NEXT 1
#endif
#ifndef REP_PA
#define REP_PA 1
#endif
#ifndef REP_WIN
#define REP_WIN 1
#endif
#ifndef REP_MIXA
#define REP_MIXA 1
#endif
#ifndef REP_MIXB
#define REP_MIXB 1
#endif
#ifndef REP_MOE1
#define REP_MOE1 1
#endif
#ifndef REP_MOE2
#define REP_MOE2 1
#endif
template <int L> __device__ __forceinline__ void layer_phases() {
    PMARK("win"); ph_win(L); grid_bar();
#if REP_WIN > 1
    ph_win(L); grid_bar();
#endif
    PMARK("mixa"); mixa_phase(L, L == 0); grid_bar();
#if REP_MIXA > 1
    mixa_phase(L, L == 0); grid_bar();
#endif
    PMARK("mixb"); mixb_phase(L, L == 0); grid_bar();
#if REP_MIXB > 1
    mixb_phase(L, L == 0); grid_bar();
#endif
    PMARK("wout"); ph_wout(L); grid_bar();
    PMARK("route"); ph_route(L); grid_bar();
    PMARK("moe1"); ph_moe1(L); grid_bar();
#if REP_MOE1 > 1
    ph_moe1(L); grid_bar();
#endif
    PMARK("moe2"); ph_moe2(L); grid_bar();
#if REP_MOE2 > 1
    ph_moe2(L); grid_bar();
#endif
    PMARK("next"); ph_next(L);
}
__global__ void __launch_bounds__(NT, 2) fwd_all(Args args) {
    { Frame F = mk_frame();
      for (int u = F.tid; u < (LDS_BYTES - LDSCTL_OFF) / 4; u += NT) ((LAS unsigned*)(F.lds + LDSCTL_OFF))[u] = 0u;
      __syncthreads();
      (void)xcd_barrier_post((unsigned*)(F.ctl + CW_BAR), F.MISC + 8); }
    PMARK("pa"); pa_phase(); grid_bar();
#if REP_PA > 1
    pa_phase(); grid_bar();
#endif
    PMARK("norm1"); ph_norm1(0); grid_bar();
    layer_phases<0>(); grid_bar();
    layer_phases<1>();
}
#endif

typedef void (*kern_t)(Args);
extern "C" void kernel_launch(void* const* d_in, const int* in_sizes, int n_in, void* d_out, int out_size, void* d_ws, size_t ws_size, hipStream_t stream) {
    static int grid = 0;
#if SINGLE_LAUNCH
    const kern_t kerns[] = {fwd_all};
#else
    const kern_t kerns[] = {k_pa, k_norm1, k_next, k_route, k_win, k_mixa, k_mixb, k_wout, k_moe1, k_moe2};
#endif
    if (grid == 0) {
        if (n_in != 20 || out_size != NLAT * D || ws_size < WS_END) { fprintf(stderr, "kernel_launch: unexpected shapes (n_in %d out %d ws %zu)\n", n_in, out_size, ws_size); grid = -1; return; }
        int dev = 0, cus = 0;
        if (hipGetDevice(&dev) != hipSuccess || hipDeviceGetAttribute(&cus, hipDeviceAttributeMultiprocessorCount, dev) != hipSuccess) { grid = -1; return; }
        for (kern_t k : kerns) if (hipFuncSetAttribute((const void*)k, hipFuncAttributeMaxDynamicSharedMemorySize, LDS_BYTES) != hipSuccess) { fprintf(stderr, "kernel_launch: hipFuncSetAttribute failed\n"); grid = -1; return; }
        int per_cu = 0; (void)hipOccupancyMaxActiveBlocksPerMultiprocessor(&per_cu, (const void*)kerns[0], NT, LDS_BYTES); (void)hipGetLastError();
        grid = cus;
    }
    if (grid < 0) return;
    (void)hipMemsetAsync((char*)d_ws + WS_CTL, 0, CTL_ZERO_BYTES, stream);
    Args a{};
    for (int i = 0; i < 20; ++i) a.in[i] = (const float*)d_in[i];
    a.out = (float*)d_out; a.ws = (unsigned char*)d_ws;
#if SINGLE_LAUNCH
    hipLaunchKernelGGL(fwd_all, dim3(grid), dim3(NT), LDS_BYTES, stream, a);
#else
#define LAUNCH(k, L, E) do { a.l = (L); a.e = (E); hipLaunchKernelGGL(k, dim3(grid), dim3(NT), LDS_BYTES, stream, a); } while (0)
    LAUNCH(k_pa, 0, 0);
    LAUNCH(k_norm1, 0, 0);
    for (int l = 0; l < DEPTH; ++l) {
        LAUNCH(k_win, l, 0); LAUNCH(k_mixa, l, 0); LAUNCH(k_mixb, l, 0); LAUNCH(k_wout, l, 0); LAUNCH(k_route, l, 0);
        LAUNCH(k_moe1, l, 0); LAUNCH(k_moe2, l, 0); LAUNCH(k_next, l, 0);
    }
#endif
}
```

```cpp
#include <hip/hip_runtime.h>
#include <cstdio>
#include <cstdint>
namespace pg8 {
#define PG8_LAS __attribute__((address_space(3)))
typedef unsigned short bf16_t;
typedef short bf16x8 __attribute__((ext_vector_type(8)));
typedef float f32x4 __attribute__((ext_vector_type(4)));
typedef unsigned u32x4 __attribute__((ext_vector_type(4)));
constexpr int BM = 256, BK = 64, HALF = 128, HTB = HALF * BK * 2  , STAGE_BYTES = 8 * HTB, NXCD = 8, WGM = 8;

__host__ __device__ __forceinline__ int lds_byte(int r, int c) { const int st = (r >> 4) * 2 + (c >> 5), rr = r & 15, cc = c & 31, ob = rr * 64 + cc * 2; return st * 1024 + (ob ^ (((ob >> 9) & 1) << 5)); }
__host__ __device__ __forceinline__ void stage_rc(int b, int& R, int& C) { const int st = b / 1024, sb = b % 1024, swz = sb ^ (((sb >> 9) & 1) << 5); R = (st >> 1) * 16 + swz / 64; C = (st & 1) * 32 + (swz % 64) / 2; }
__host__ __device__ __forceinline__ int perm32(int rho) { const int n = rho >> 4, i = rho & 15; return 8 * (i >> 2) + 4 * n + (i & 3); }

struct Unit { int pm, pn, pb, lb, nv; };
struct Gemm { const bf16_t* A; const bf16_t* Bt; int M, N, K; };

struct StaticOrder {
    int nM, nN, nwg, G, c;
    __host__ __device__ void init(int M, int N, int G_, int c_) { nM = M / BM; nN = N / BM; nwg = nM * nN; G = G_; c = c_; }
    __host__ __device__ bool next(int i, Unit& u) const {
        const long L = (long)i * G + c; if (L >= nwg) return false;
        int wgid = (int)L; { const int q = nwg / NXCD, r = nwg % NXCD, xcd = wgid % NXCD, off = wgid / NXCD; wgid = (xcd < r ? xcd * (q + 1) : r * (q + 1) + (xcd - r) * q) + off; }
        const int nig = WGM * nN, gid = wgid / nig, fm = gid * WGM, gsz = (nM - fm) < WGM ? (nM - fm) : WGM;
        u.pm = fm + ((wgid % nig) % gsz); u.pn = (wgid % nig) / gsz; u.pb = u.pn; u.lb = 0; u.nv = BM; return true;
    }
    __device__ __forceinline__ void a_ready(const Unit&) const {}
    __device__ __forceinline__ int row_of(const Unit&, int i) const { return i; }
    __device__ __forceinline__ void done(const Unit&) const {}
};


__device__ __forceinline__ unsigned cvt_pk_bf16(float lo, float hi) { unsigned r; asm volatile("v_cvt_pk_bf16_f32 %0, %1, %2" : "=v"(r) : "v"(lo), "v"(hi)); return r; }

struct EpiBf16 {
    static constexpr bool PERM = true, AFTER_DRAIN = false;
    bf16_t* O; int ldc;
    __device__ __forceinline__ void operator()(const f32x4 (&acc)[2][2][4][2], const Unit& u, int wr, int wc, int fr, int fq) const {
        const int row0 = u.pm * BM + wr * 64 + fr; const int col0 = u.pn * BM + wc * 32 + 8 * fq;
#pragma unroll
        for (int ai = 0; ai < 2; ++ai)
#pragma unroll
            for (int m = 0; m < 4; ++m) { bf16_t* rowp = O + (size_t)(row0 + ai * HALF + m * 16) * ldc + col0;
#pragma unroll
                for (int bj = 0; bj < 2; ++bj) { const f32x4 v0 = acc[ai][bj][m][0], v1 = acc[ai][bj][m][1];
                    u32x4 w; w.x = cvt_pk_bf16(v0[0], v0[1]); w.y = cvt_pk_bf16(v0[2], v0[3]); w.z = cvt_pk_bf16(v1[0], v1[1]); w.w = cvt_pk_bf16(v1[2], v1[3]);
                    *(u32x4*)(rowp + bj * HALF) = w; } }
    }
};
struct EpiSwiGLU {
    static constexpr bool PERM = true, AFTER_DRAIN = false;
    bf16_t* O; int ldc;
    __device__ __forceinline__ void operator()(const f32x4 (&acc)[2][2][4][2], const Unit& u, int wr, int wc, int fr, int fq) const {
        const int row0 = u.pm * BM + wr * 64 + fr; const int col0 = u.pn * HALF + wc * 32 + 8 * fq;
#pragma unroll
        for (int ai = 0; ai < 2; ++ai)
#pragma unroll
            for (int m = 0; m < 4; ++m) { bf16_t* rowp = O + (size_t)(row0 + ai * HALF + m * 16) * ldc + col0;
                float o[8];
#pragma unroll
                for (int n = 0; n < 2; ++n)
#pragma unroll
                    for (int j = 0; j < 4; ++j) { const float a = acc[ai][0][m][n][j], b = acc[ai][1][m][n][j]; o[n * 4 + j] = a * __builtin_amdgcn_rcpf(1.0f + __expf(-a)) * b; }
                u32x4 w; w.x = cvt_pk_bf16(o[0], o[1]); w.y = cvt_pk_bf16(o[2], o[3]); w.z = cvt_pk_bf16(o[4], o[5]); w.w = cvt_pk_bf16(o[6], o[7]);
                *(u32x4*)rowp = w; }
    }
};
struct EpiScatter {
    static constexpr bool PERM = true, AFTER_DRAIN = false;
    bf16_t* Y2; const uint2* info;
    __device__ __forceinline__ void operator()(const f32x4 (&acc)[2][2][4][2], const Unit& u, int wr, int wc, int fr, int fq) const {
        const int col0 = u.pn * BM + wc * 32 + 8 * fq;
#pragma unroll
        for (int ai = 0; ai < 2; ++ai)
#pragma unroll
            for (int m = 0; m < 4; ++m) { const int i = ai * HALF + wr * 64 + m * 16 + fr;
                if (i < u.nv) { const uint2 inf = info[u.lb + i]; const float w = __builtin_bit_cast(float, inf.y); bf16_t* rowp = Y2 + (size_t)inf.x * 1024 + col0;
#pragma unroll
                    for (int bj = 0; bj < 2; ++bj) { const f32x4 v0 = acc[ai][bj][m][0] * w, v1 = acc[ai][bj][m][1] * w;
                        u32x4 q; q.x = cvt_pk_bf16(v0[0], v0[1]); q.y = cvt_pk_bf16(v0[2], v0[3]); q.z = cvt_pk_bf16(v1[0], v1[1]); q.w = cvt_pk_bf16(v1[2], v1[3]);
                        *(u32x4*)(rowp + bj * HALF) = q; } } }
    }
};
struct MoeOrder {
    int G, c, cap; const PG8_LAS int* tab; const uint2* info;
    __device__ __forceinline__ bool next(int i, Unit& u) const {
        const int nwg = __builtin_amdgcn_readfirstlane(tab[16]) * 4; const long L = (long)i * G + c; if (L >= nwg) return false;
        int wgid = (int)L; { const int q = nwg / NXCD, r = nwg % NXCD, xcd = wgid % NXCD, off = wgid / NXCD; wgid = (xcd < r ? xcd * (q + 1) : r * (q + 1) + (xcd - r) * q) + off; }
        const int gp = wgid >> 2; int e = 0;
#pragma unroll
        for (int q = 1; q < 16; ++q) e += (gp >= tab[q]) ? 1 : 0;
        e = __builtin_amdgcn_readfirstlane(e);
        const int p = gp - __builtin_amdgcn_readfirstlane(tab[e]); const int ne = __builtin_amdgcn_readfirstlane(tab[17 + e]);
        u.pm = gp; u.pn = wgid & 3; u.pb = e * 4 + u.pn; u.lb = e * cap + 256 * p; u.nv = (ne - 256 * p) < 256 ? (ne - 256 * p) : 256; return true;
    }
    __device__ __forceinline__ void a_ready(const Unit&) const {}
    __device__ __forceinline__ void done(const Unit&) const {}
    __device__ __forceinline__ int row_of(const Unit& u, int i) const { return i < u.nv ? (int)(info[u.lb + i].x >> 1) : 0; }
};
template <class Epi, class Sched, bool GATHER = false>
__device__ __forceinline__ void gemm_phase(PG8_LAS unsigned char* lds, const Gemm g, const Sched& S, const Epi& E) {
    int tid_ = threadIdx.x; asm volatile("" : "+v"(tid_));
    const int tid = tid_, wid = __builtin_amdgcn_readfirstlane(tid >> 6), lane = tid & 63, wr = wid >> 2, wc = wid & 3, fr = lane & 15, fq = lane >> 4;
    const int K = g.K, nt = K / BK;
    unsigned voffB[2];
#pragma unroll
    for (int i = 0; i < 2; ++i) { int R, C; stage_rc(tid * 16 + i * 8192, R, C); const int Rb = Epi::PERM ? ((R & ~31) + perm32(R & 31)) : R; voffB[i] = (unsigned)(Rb * K + C) * 2u; }
    const size_t kstep = (size_t)(BK * 2);
    const size_t hstep = (size_t)HALF * K * 2;
    const size_t tstep = 2 * hstep;
    const unsigned ldsw = (unsigned)wid * 1024u;
    const int aoff = lds_byte(wr * 64 + fr, fq * 8), boff = lds_byte(wc * 32 + fr, fq * 8);
#define PG8_SA(b, h) (((b) * 2 + (h)) * HTB)
#define PG8_SB(b, h) ((4 + (b) * 2 + (h)) * HTB)
#define PG8_STAGE(bufoff, gbase, voff) do { _Pragma("unroll") for (int _i = 0; _i < 2; ++_i) \
        __builtin_amdgcn_global_load_lds((const unsigned*)((const char*)(gbase) + (voff)[_i]), (PG8_LAS unsigned*)(lds + (bufoff) + ldsw + _i * 8192), 16, 0, 0); } while (0)
#define PG8_LDA(dst, b, h) do { _Pragma("unroll") for (int m = 0; m < 4; ++m) _Pragma("unroll") for (int k = 0; k < 2; ++k) dst[m][k] = *(const PG8_LAS bf16x8*)(lds + PG8_SA(b, h) + aoff + m * 2048 + k * 1024); } while (0)
#define PG8_LDB(dst, b, h) do { _Pragma("unroll") for (int n = 0; n < 2; ++n) _Pragma("unroll") for (int k = 0; k < 2; ++k) dst[n][k] = *(const PG8_LAS bf16x8*)(lds + PG8_SB(b, h) + boff + n * 2048 + k * 1024); } while (0)
#define PG8_MMA(ai, bj, At, Bt) do { __builtin_amdgcn_s_setprio(1); _Pragma("unroll") for (int m = 0; m < 4; ++m) _Pragma("unroll") for (int n = 0; n < 2; ++n) _Pragma("unroll") for (int k = 0; k < 2; ++k) \
        acc[ai][bj][m][n] = __builtin_amdgcn_mfma_f32_16x16x32_bf16(Bt[n][k], At[m][k], acc[ai][bj][m][n], 0, 0, 0); __builtin_amdgcn_s_setprio(0); } while (0)
#define PG8_WAIT_V(n) asm volatile("s_waitcnt vmcnt(" #n ")" ::: "memory")
#define PG8_WAIT_L(n) asm volatile("s_waitcnt lgkmcnt(" #n ")" ::: "memory")
#define PG8_BAR __builtin_amdgcn_s_barrier()
#define PG8_SCHED __builtin_amdgcn_sched_barrier(0)
#define PG8_AOFFS(o, u) do { _Pragma("unroll") for (int _h = 0; _h < 2; ++_h) _Pragma("unroll") for (int _i = 0; _i < 2; ++_i) { int _R, _C; stage_rc(tid * 16 + _i * 8192, _R, _C); \
        const int _row = GATHER ? S.row_of((u), _h * HALF + _R) : (_h * HALF + _R); (o)[_h][_i] = (unsigned)(_row * K + _C) * 2u; } } while (0)
    Unit cur, nxt; int ui = 0;
    if (!S.next(0, cur)) return;
    f32x4 acc[2][2][4][2];
#pragma unroll
    for (int a = 0; a < 2; ++a)
#pragma unroll
        for (int b = 0; b < 2; ++b)
#pragma unroll
            for (int m = 0; m < 4; ++m)
#pragma unroll
                for (int n = 0; n < 2; ++n) acc[a][b][m][n] = (f32x4){0.f, 0.f, 0.f, 0.f};
    bf16x8 At[4][2], B0[2][2], B1[2][2];
    unsigned offA[2][2], noffA[2][2];
    const char* cA = (const char*)g.A + (GATHER ? (size_t)0 : (size_t)cur.pm * tstep); const char* cB = (const char*)g.Bt + (size_t)cur.pb * tstep;
    S.a_ready(cur);
    PG8_AOFFS(offA, cur);
    PG8_STAGE(PG8_SB(0, 0), cB, voffB); PG8_STAGE(PG8_SB(0, 1), cB + hstep, voffB); PG8_STAGE(PG8_SA(0, 0), cA, offA[0]); PG8_STAGE(PG8_SA(0, 1), cA, offA[1]);
    if (wr == 1) PG8_BAR;
    PG8_WAIT_V(2); PG8_BAR;
    PG8_STAGE(PG8_SB(1, 0), cB + kstep, voffB); PG8_STAGE(PG8_SA(1, 0), cA + kstep, offA[0]); PG8_STAGE(PG8_SB(1, 1), cB + hstep + kstep, voffB);
    PG8_WAIT_V(6); PG8_BAR;
    for (;;) {
        const bool has_next = S.next(ui + 1, nxt);
        const char* nA = has_next ? (const char*)g.A + (GATHER ? (size_t)0 : (size_t)nxt.pm * tstep) : cA; const char* nB = has_next ? (const char*)g.Bt + (size_t)nxt.pb * tstep : cB;
        for (int t = 0; t < nt; t += 2) {
            const bool last = (t == nt - 2);
            const char* a1 = cA + (size_t)(t + 1) * kstep;
            const char* a2 = last ? nA : cA + (size_t)(t + 2) * kstep; const char* b2 = last ? nB : cB + (size_t)(t + 2) * kstep;
            const char* a3 = a2 + kstep; const char* b3 = b2 + kstep;
            if (last && has_next) S.a_ready(nxt);
            unsigned o2[2][2];
            if constexpr (GATHER) {
                if (last) { if (has_next) { PG8_AOFFS(noffA, nxt); } else {
#pragma unroll
                        for (int h = 0; h < 2; ++h) { noffA[h][0] = offA[h][0]; noffA[h][1] = offA[h][1]; } } }
#pragma unroll
                for (int h = 0; h < 2; ++h) { o2[h][0] = last ? noffA[h][0] : offA[h][0]; o2[h][1] = last ? noffA[h][1] : offA[h][1]; }
            } else {
#pragma unroll
                for (int h = 0; h < 2; ++h) { o2[h][0] = offA[h][0]; o2[h][1] = offA[h][1]; }
            }
            PG8_LDB(B0, 0, 0); PG8_LDB(B1, 0, 1); PG8_SCHED; PG8_LDA(At, 0, 0); PG8_STAGE(PG8_SA(1, 1), a1, offA[1]);
            PG8_WAIT_V(8); PG8_WAIT_L(0); PG8_BAR; PG8_MMA(0, 0, At, B0); PG8_MMA(0, 1, At, B1); PG8_BAR; PG8_SCHED;
            PG8_LDA(At, 0, 1); PG8_STAGE(PG8_SB(0, 0), b2, voffB); PG8_STAGE(PG8_SB(0, 1), b2 + hstep, voffB); PG8_STAGE(PG8_SA(0, 0), a2, o2[0]);
            PG8_WAIT_V(8); PG8_WAIT_L(0); PG8_BAR; PG8_MMA(1, 0, At, B0); PG8_MMA(1, 1, At, B1); PG8_BAR; PG8_SCHED;
            PG8_LDB(B0, 1, 0); PG8_LDB(B1, 1, 1); PG8_SCHED; PG8_LDA(At, 1, 0); PG8_STAGE(PG8_SA(0, 1), a2, o2[1]);
            PG8_WAIT_V(8); PG8_WAIT_L(0); PG8_BAR; PG8_MMA(0, 0, At, B0); PG8_MMA(0, 1, At, B1); PG8_BAR; PG8_SCHED;
            PG8_LDA(At, 1, 1); PG8_STAGE(PG8_SB(1, 0), b3, voffB); PG8_STAGE(PG8_SB(1, 1), b3 + hstep, voffB); PG8_STAGE(PG8_SA(1, 0), a3, o2[0]);
            PG8_WAIT_V(8); PG8_WAIT_L(0); PG8_BAR; PG8_MMA(1, 0, At, B0); PG8_MMA(1, 1, At, B1); PG8_BAR; PG8_SCHED;
        }
        if (wr == 0) PG8_BAR;
        E(acc, cur, wr, wc, fr, fq); S.done(cur);
        if (!has_next) break;
#pragma unroll
        for (int a = 0; a < 2; ++a)
#pragma unroll
            for (int b = 0; b < 2; ++b)
#pragma unroll
                for (int m = 0; m < 4; ++m)
#pragma unroll
                    for (int n = 0; n < 2; ++n) acc[a][b][m][n] = (f32x4){0.f, 0.f, 0.f, 0.f};
        cur = nxt; cA = nA; cB = nB; ++ui;
        if constexpr (GATHER) {
#pragma unroll
            for (int h = 0; h < 2; ++h) { offA[h][0] = noffA[h][0]; offA[h][1] = noffA[h][1]; } }
        if (wr == 1) PG8_BAR;
    }
    PG8_WAIT_V(0);
    PG8_BAR;
#undef PG8_SA
#undef PG8_SB
#undef PG8_STAGE
#undef PG8_LDA
#undef PG8_LDB
#undef PG8_MMA
#undef PG8_WAIT_V
#undef PG8_WAIT_L
#undef PG8_BAR
#undef PG8_SCHED
#undef PG8_AOFFS
}
}
#define GAS __attribute__((address_space(1)))
#define LAS __attribute__((address_space(3)))
typedef unsigned short bf16;
typedef unsigned v4u __attribute__((ext_vector_type(4)));
typedef float f32x4 __attribute__((ext_vector_type(4)));
typedef short bf16x8 __attribute__((ext_vector_type(8)));
typedef GAS unsigned gu32;
typedef GAS unsigned long long gu64;
#define RLX_AGENT __ATOMIC_RELAXED, __HIP_MEMORY_SCOPE_AGENT
#define LDS_WAIT() asm volatile("s_waitcnt lgkmcnt(0)" ::: "memory")
#define VM_WAIT() asm volatile("s_waitcnt vmcnt(0)" ::: "memory")
__device__ __forceinline__ unsigned long long rt() { return __builtin_amdgcn_s_memrealtime(); }
__device__ __forceinline__ unsigned f2bf(float f) { unsigned u = __builtin_bit_cast(unsigned, f); return (u + 0x7fffu + ((u >> 16) & 1u)) >> 16; }
__device__ __forceinline__ unsigned pk2(float lo, float hi) { return f2bf(lo) | (f2bf(hi) << 16); }

#define XB_TMO      128
#define XB_XCNT(j)  (256  + 64 * (j))
#define XB_XSUB(j)  (1280 + 64 * (j))
#define XB_XGEN(j)  (2304 + 64 * (j))
#define XB_TOP      3328
#define XB_TOPGEN   3392
#define XCD_BAR_WORDS 3456
#define XB_SPIN_CAP (1u << 18)

__device__ __forceinline__ unsigned xb_ld(unsigned* p)              { return __hip_atomic_load(p, __ATOMIC_RELAXED, __HIP_MEMORY_SCOPE_AGENT); }
__device__ __forceinline__ unsigned xb_add(unsigned* p, unsigned v) { return __hip_atomic_fetch_add(p, v, __ATOMIC_RELAXED, __HIP_MEMORY_SCOPE_AGENT); }
__device__ __forceinline__ unsigned xb_xcc_id() { return (unsigned)__builtin_amdgcn_s_getreg((3 << 11) | 20) & 0xFu; }
#define XB_SPIN(cond, bar) do { unsigned _sp = 0; while (cond) { __builtin_amdgcn_s_sleep(1); \
    if ((++_sp & 255u) == 0u) { if (xb_ld(&(bar)[XB_TMO])) break; if (_sp > XB_SPIN_CAP) { atomicAdd(&(bar)[XB_TMO], 1u); break; } } } } while (0)

struct XcdBarrier {
    unsigned* bar; unsigned x;
    volatile LAS unsigned* st;
};

__device__ __forceinline__ XcdBarrier xcd_barrier_post(unsigned* bar, volatile LAS unsigned* st) {
    XcdBarrier b; b.bar = bar; b.x = xb_xcc_id(); b.st = st;
    if (threadIdx.x == 0) (void)xb_add(&bar[XB_XCNT(b.x)], 1u);
    return b;
}
__device__ __forceinline__ void xcd_barrier_complete(unsigned* bar, unsigned x, unsigned& nloc, unsigned& nx) {
    const unsigned G = gridDim.x * gridDim.y * gridDim.z;
    unsigned sum, cnt, mine, sp = 0u;
    for (;;) {
        sum = 0u; cnt = 0u; mine = 0u;
#pragma unroll
        for (unsigned j = 0; j < 16; ++j) { const unsigned c = xb_ld(&bar[XB_XCNT(j)]); sum += c; cnt += (c > 0u) ? 1u : 0u; mine = (j == x) ? c : mine; }
        if (sum == G) break;
        __builtin_amdgcn_s_sleep(1);
        if ((++sp & 255u) == 0u) { if (xb_ld(&bar[XB_TMO])) break; if (sp > XB_SPIN_CAP) { atomicAdd(&bar[XB_TMO], 1u); break; } }
    }
    nloc = mine > 0u ? mine : 1u; nx = cnt > 0u ? cnt : 1u;
}

__device__ __forceinline__ void xcd_barrier(const XcdBarrier& b) {
    asm volatile("s_waitcnt vmcnt(0)" ::: "memory");
    __syncthreads();
    if (threadIdx.x == 0) {
        unsigned* bar = b.bar;
        __builtin_amdgcn_s_waitcnt(0);
        unsigned nloc = b.st[0], nx = b.st[1];
        if (nloc == 0u) { xcd_barrier_complete(bar, b.x, nloc, nx); b.st[0] = nloc; b.st[1] = nx; }
        const unsigned old = xb_add(&bar[XB_XSUB(b.x)], 1u);
        const unsigned gen = old / nloc;
        if (old + 1u == (gen + 1u) * nloc) {
            __builtin_amdgcn_fence(__ATOMIC_RELEASE, "agent");
            asm volatile("s_waitcnt vmcnt(0)" ::: "memory");
            const unsigned og = xb_add(&bar[XB_TOP], 1u);
            const unsigned tg = og / nx;
            if (og + 1u == (tg + 1u) * nx) xb_add(&bar[XB_TOPGEN], 1u);
            else XB_SPIN(xb_ld(&bar[XB_TOPGEN]) == tg, bar);
            __builtin_amdgcn_fence(__ATOMIC_ACQUIRE, "agent");
            xb_add(&bar[XB_XGEN(b.x)], 1u);
            asm volatile("s_waitcnt vmcnt(0)" ::: "memory");
        } else {
            XB_SPIN(xb_ld(&bar[XB_XGEN(b.x)]) == gen, bar);
            __builtin_amdgcn_fence(__ATOMIC_ACQUIRE, "agent");
            asm volatile("s_waitcnt vmcnt(0)" ::: "memory");
        }
    }
    __syncthreads();
}


constexpr int NWAVES = 8, NT = NWAVES * 64;
constexpr int D = 1024, BATCH = 8, SEQ = 4096, DEPTH = 2, GRIDW = 64, CTXL = 256, GWID = 256, HD = 64, NHEAD = 4;
constexpr int INC = 2048, NEXP = 16, MHID = 512;
constexpr int NLAT = BATCH * SEQ, NCTX = BATCH * CTXL, NROW = NLAT + NCTX;
constexpr float EPS = 1e-6f;
constexpr int UC_AV = 0, UC_AB = 256, UC_AC = 512, UC_P = 768, UC_Q = 1024, UC_K = 1280, UC_V = 1536, UC_F = 1792;

constexpr size_t MiB = 1u << 20;
constexpr size_t WS_CTL = 0, CTL_ZERO_BYTES = 65536;
constexpr size_t WS_MOD  = 1 * MiB;
constexpr size_t WS_PWT  = 1 * MiB + 768 * 1024;
constexpr size_t WS_INFO = 2 * MiB;
constexpr size_t WS_WIN  = 8 * MiB;
constexpr size_t WS_WOUT = 16 * MiB;
constexpr size_t WS_W13  = 20 * MiB;
constexpr size_t WS_W2   = 84 * MiB;
constexpr size_t WS_XC   = 116 * MiB;
constexpr size_t WS_H    = 124 * MiB;
constexpr size_t WS_U    = 192 * MiB;
constexpr size_t WS_S    = 328 * MiB;
constexpr size_t WS_END  = 472 * MiB;
constexpr size_t WS_KF   = WS_S;
constexpr size_t WS_VF   = WS_S + 28 * MiB;
constexpr size_t WS_KFC  = WS_S + 60 * MiB;
constexpr size_t WS_VFC  = WS_S + 61 * MiB;
constexpr size_t WS_Z    = WS_S + 64 * MiB;
constexpr size_t NZ = (size_t)BATCH * NHEAD * SEQ * HD;
constexpr size_t NZC = (size_t)BATCH * NHEAD * CTXL * HD;
constexpr int CAP = NROW;

constexpr int CW_CNT = 2048;
constexpr int CW_BAR = 4096;

constexpr int RING_OFF = 0, RING_BYTES = 131072;
constexpr int LDSCTL_OFF = RING_BYTES, MISC_OFF = LDSCTL_OFF + 320;
constexpr int TAB_OFF = RING_BYTES + 1024;
constexpr int LDS_BYTES = 147456;

struct Frame {
    LAS unsigned char* lds;
    volatile LAS unsigned* MISC;
    gu32* ctl;
    int tid, lane, wave, G, bid;
    float* out; unsigned char* ws;
    static __device__ __forceinline__ const void* karg(int off) {
        const __attribute__((address_space(4))) char* ka = (const __attribute__((address_space(4))) char*)__builtin_amdgcn_kernarg_segment_ptr();
        asm volatile("" : "+s"(ka));
        return *(const void* const __attribute__((address_space(4)))*)(ka + off);
    }
    __device__ __forceinline__ const float* inp(int i) const { return (const float*)karg(8 * i); }
};
extern __shared__ __attribute__((aligned(16))) unsigned char dyn_lds[];
__device__ __forceinline__ Frame mk_frame() {
    Frame F; int t_ = threadIdx.x; asm volatile("" : "+v"(t_));
    F.tid = t_; F.lane = F.tid & 63; F.wave = __builtin_amdgcn_readfirstlane(F.tid >> 6); F.G = gridDim.x; F.bid = blockIdx.x;
    F.lds = (LAS unsigned char*)dyn_lds; F.MISC = (volatile LAS unsigned*)(F.lds + MISC_OFF);
    F.out = (float*)Frame::karg(160); F.ws = (unsigned char*)Frame::karg(168); F.ctl = (gu32*)(F.ws + WS_CTL);
    return F;
}
enum { I_X = 0, I_C, I_CTX, I_CCTX, I_ADAW, I_ADAB, I_N1G, I_N2G, I_WIN, I_CONVW, I_POOLW, I_POOLS, I_RPB, I_WOUT, I_RW, I_RB, I_W1, I_W3, I_W2, I_FG };

__device__ __forceinline__ float wave_sum(float v) {
#pragma unroll
    for (int o = 1; o < 64; o <<= 1) v += __shfl_xor(v, o);
    return v;
}
__device__ __forceinline__ float bflo(unsigned w) { return __builtin_bit_cast(float, w << 16); }
__device__ __forceinline__ float bfhi(unsigned w) { return __builtin_bit_cast(float, w & 0xffff0000u); }
__device__ __forceinline__ float bf2f(bf16 b) { return __builtin_bit_cast(float, (unsigned)b << 16); }

__device__ __forceinline__ void tr_item(const float* W, int K, int N, bf16* WT, int k0, int n0, int drow0, LAS float* scr, int lane) {
#pragma unroll
    for (int i = 0; i < 8; ++i) { const int kk = 8 * i + (lane >> 3), n4 = 4 * (lane & 7); const f32x4 w = *(const GAS f32x4*)(W + (size_t)(k0 + kk) * N + n0 + n4);
        LAS float* sp = scr + kk * 33 + n4; sp[0] = w.x; sp[1] = w.y; sp[2] = w.z; sp[3] = w.w; }
    LDS_WAIT(); asm volatile("" ::: "memory");
    const int c = lane & 7;
#pragma unroll
    for (int j = 0; j < 4; ++j) { const int n = (lane >> 3) + 8 * j; const LAS float* s = scr + (8 * c) * 33 + n;
        v4u o; o.x = pk2(s[0 * 33], s[1 * 33]); o.y = pk2(s[2 * 33], s[3 * 33]); o.z = pk2(s[4 * 33], s[5 * 33]); o.w = pk2(s[6 * 33], s[7 * 33]);
        *(GAS v4u*)(WT + (size_t)(drow0 + n) * K + k0 + 8 * c) = o; }
    LDS_WAIT(); asm volatile("" ::: "memory");
}
__device__ __forceinline__ void pa_phase() { Frame F = mk_frame();
    LAS float* scr = (LAS float*)(F.lds + RING_OFF + F.wave * 16384);
    const int gw = F.bid * NWAVES + F.wave, NGW = F.G * NWAVES;
    bf16* WIN = (bf16*)(F.ws + WS_WIN); bf16* WOUT = (bf16*)(F.ws + WS_WOUT); bf16* W13 = (bf16*)(F.ws + WS_W13); bf16* W2 = (bf16*)(F.ws + WS_W2);
    constexpr int I_IN = 2 * 16 * 64, I_OUT = 2 * 16 * 32, I_1 = 32 * 16 * 16, I_2 = 32 * 8 * 32;
    constexpr int NITEMS = I_IN + I_OUT + 2 * I_1 + I_2;
    for (int it = gw; it < NITEMS; it += NGW) {
        int r = it;
        if (r < I_IN) { const int l = r / 1024, q = r % 1024, kb = q / 64, nb = q % 64;
            tr_item(F.inp(I_WIN) + (size_t)l * D * INC, D, INC, WIN + (size_t)l * INC * D, 64 * kb, 32 * nb, 32 * nb, scr, F.lane); continue; } r -= I_IN;
        if (r < I_OUT) { const int l = r / 512, q = r % 512, kb = q / 32, nb = q % 32;
            tr_item(F.inp(I_WOUT) + (size_t)l * D * D, D, D, WOUT + (size_t)l * D * D, 64 * kb, 32 * nb, 32 * nb, scr, F.lane); continue; } r -= I_OUT;
        if (r < 2 * I_1) { const int which = r / I_1; const int q0 = r % I_1; const int le = q0 / 256, q = q0 % 256, kb = q / 16, nb = q % 16;
            const int n0 = 32 * nb; const int drow0 = 256 * (n0 / 128) + 128 * which + (n0 % 128);
            tr_item(F.inp(which ? I_W3 : I_W1) + (size_t)le * D * MHID, D, MHID, W13 + (size_t)le * 1024 * D, 64 * kb, n0, drow0, scr, F.lane); continue; } r -= 2 * I_1;
        { const int le = r / 256, q = r % 256, kb = q / 32, nb = q % 32;
            tr_item(F.inp(I_W2) + (size_t)le * MHID * D, MHID, D, W2 + (size_t)le * D * MHID, 64 * kb, 32 * nb, 32 * nb, scr, F.lane); }
    }
    { bf16* PWT = (bf16*)(F.ws + WS_PWT); const float* pw = F.inp(I_POOLW);
      for (int i = F.bid * NT + F.tid; i < 2 * 4 * 64 * 64; i += F.G * NT) { const int c = i & 63, dd = (i >> 6) & 63, lg = i >> 12; PWT[i] = (bf16)f2bf(pw[((size_t)lg * 64 + c) * 64 + dd]); } }
    __syncthreads();
    LAS float* sc = (LAS float*)(F.lds + RING_OFF);
    LAS float* part = (LAS float*)(F.lds + RING_OFF + 40960);
    float* MOD = (float*)(F.ws + WS_MOD);
    bool have_sc = false;
    for (int it = F.bid; it < 2 * 96; it += F.G) {
        if (!have_sc) { for (int i = F.tid; i < 9 * 1024; i += NT) { const float v = i < 8192 ? F.inp(I_C)[i] : F.inp(I_CCTX)[i - 8192]; sc[i] = v / (1.0f + __expf(-v)); } have_sc = true; }
        __syncthreads();
        const int l = it / 96, cb = it % 96, col = cb * 64 + F.lane;
        const float* aw = F.inp(I_ADAW) + (size_t)l * D * 6144 + col;
        float acc[9];
#pragma unroll
        for (int r = 0; r < 9; ++r) acc[r] = 0.f;
        for (int k = F.wave * 128; k < F.wave * 128 + 128; ++k) { const float wv = aw[(size_t)k * 6144];
#pragma unroll
            for (int r = 0; r < 9; ++r) acc[r] += sc[r * 1024 + k] * wv; }
#pragma unroll
        for (int r = 0; r < 9; ++r) part[(F.wave * 9 + r) * 64 + F.lane] = acc[r];
        __syncthreads();
        for (int i = F.tid; i < 9 * 64; i += NT) { const int r = i >> 6, ln = i & 63; float s = F.inp(I_ADAB)[(size_t)l * 6144 + cb * 64 + ln];
#pragma unroll
            for (int w = 0; w < 8; ++w) s += part[(w * 9 + r) * 64 + ln];
            MOD[((size_t)l * 9 + r) * 6144 + cb * 64 + ln] = s; }
        __syncthreads();
    }
}

typedef unsigned v2u_ __attribute__((ext_vector_type(2)));
__device__ __forceinline__ unsigned cvt_pk_bf(float lo, float hi) { unsigned r; asm volatile("v_cvt_pk_bf16_f32 %0, %1, %2" : "=v"(r) : "v"(lo), "v"(hi)); return r; }
struct XStream { const char* lat; const char* ctx; int lat_stride, ctx_stride;
    __device__ __forceinline__ const char* row(int r) const { return r < NLAT ? lat + (size_t)r * lat_stride : ctx + (size_t)(r - NLAT) * ctx_stride; } };
struct RowIn { f32x4 x[4]; unsigned long long xb[4], ya[4], yb[4]; };
__device__ __forceinline__ f32x4 unpk4(unsigned long long a) { f32x4 y; y.x = bflo((unsigned)a); y.y = bfhi((unsigned)a); y.z = bflo((unsigned)(a >> 32)); y.w = bfhi((unsigned)(a >> 32)); return y; }
template <int ADD, bool XBF>
__device__ __forceinline__ void row_load(Frame& F, int r, const char* xr, const bf16* Y2, RowIn& in) {
#pragma unroll
    for (int j = 0; j < 4; ++j) { const int c = 4 * F.lane + 256 * j;
        if (XBF) in.xb[j] = *(const GAS unsigned long long*)(xr + 2 * c); else in.x[j] = *(const GAS f32x4*)(xr + 4 * c);
        if (ADD == 1) { in.ya[j] = *(const GAS unsigned long long*)(Y2 + (size_t)r * 2048 + c); in.yb[j] = *(const GAS unsigned long long*)(Y2 + (size_t)r * 2048 + 1024 + c); }
        if (ADD == 2) { in.ya[j] = *(const GAS unsigned long long*)(Y2 + (size_t)r * 1024 + c); } }
}
struct RowPar { f32x4 a[4], b[4], gt[4]; int modrow; };
template <int ADD, bool FINAL>
__device__ __forceinline__ void row_params(Frame& F, int modrow, const float* g, const float* modl, const float* modadd, int ch_sh, int ch_sc, RowPar& P) {
    P.modrow = modrow;
#pragma unroll
    for (int j = 0; j < 4; ++j) { const int c = 4 * F.lane + 256 * j; const f32x4 gv = *(const GAS f32x4*)(g + c);
        if (FINAL) { P.a[j] = gv; P.b[j] = (f32x4){0.f, 0.f, 0.f, 0.f}; }
        else { const float* mrow = modl + (size_t)modrow * 6144; P.a[j] = gv * (*(const GAS f32x4*)(mrow + ch_sc * 1024 + c) + 1.0f); P.b[j] = *(const GAS f32x4*)(mrow + ch_sh * 1024 + c); }
        if (ADD) P.gt[j] = *(const GAS f32x4*)(modadd + (size_t)modrow * 6144 + (ADD == 1 ? 5 : 2) * 1024 + c); else P.gt[j] = (f32x4){0.f, 0.f, 0.f, 0.f}; }
}
template <int ADD, bool FINAL, bool XBF>
__device__ __forceinline__ void row_finish(Frame& F, const RowIn& in, const RowPar& P, char* xw, bf16* dst, float* fout, f32x4 (&v)[4]) {
    float ss = 0.f;
#pragma unroll
    for (int j = 0; j < 4; ++j) { const int c = 4 * F.lane + 256 * j; v[j] = XBF ? unpk4(in.xb[j]) : in.x[j];
        if (ADD) { f32x4 ya = unpk4(in.ya[j]); if (ADD == 1) ya = ya + unpk4(in.yb[j]);
            v[j] = v[j] + P.gt[j] * ya;
            if (!FINAL) *(GAS v2u_*)(xw + 2 * c) = (v2u_){cvt_pk_bf(v[j].x, v[j].y), cvt_pk_bf(v[j].z, v[j].w)}; }
        ss += (v[j].x * v[j].x + v[j].y * v[j].y) + (v[j].z * v[j].z + v[j].w * v[j].w); }
    ss = wave_sum(ss);
    const float rstd = 1.0f / sqrtf(ss * (1.0f / D) + EPS);
#pragma unroll
    for (int j = 0; j < 4; ++j) { const int c = 4 * F.lane + 256 * j;
        if (FINAL) { *(GAS f32x4*)(fout + c) = v[j] * rstd * P.a[j]; }
        else { v[j] = v[j] * rstd * P.a[j] + P.b[j];
            *(GAS v2u_*)(dst + c) = (v2u_){cvt_pk_bf(v[j].x, v[j].y), cvt_pk_bf(v[j].z, v[j].w)}; } }
}
template <int ADD, bool FINAL, bool XBF>
__device__ __forceinline__ void norm_phase(Frame& F, const XStream xin, const XStream xout, int nrows, const float* g, const float* modl, const float* modadd, int ch_sh, int ch_sc, bf16* dst, const bf16* Y2, float* fout) {
    const int rpb = (nrows + F.G - 1) / F.G;
    int i = F.wave; int r = F.bid * rpb + i; if (i >= rpb || r >= nrows) return;
    RowIn cur; row_load<ADD, XBF>(F, r, xin.row(r), Y2, cur);
    RowPar P; P.modrow = -1;
    for (;;) {
        const int in_ = i + NWAVES, rn = F.bid * rpb + in_; const bool more = (in_ < rpb) && (rn < nrows);
        RowIn nxt;
        if (more) row_load<ADD, XBF>(F, rn, xin.row(rn), Y2, nxt);
        const int modrow = r < NLAT ? (r >> 12) : 8;
        if (modrow != P.modrow) row_params<ADD, FINAL>(F, modrow, g, modl, modadd, ch_sh, ch_sc, P);
        f32x4 v[4];
        row_finish<ADD, FINAL, XBF>(F, cur, P, (char*)xout.row(r), dst + (size_t)r * D, fout + (size_t)r * D, v);
        if (!more) break;
        cur = nxt; r = rn; i = in_;
    }
}
template <bool XBF>
__device__ __forceinline__ void route_phase(Frame& F, int l, const XStream xin, const XStream xout, const bf16* O, int nrows, const float* g, const float* modl, bf16* dst, uint2* info, unsigned* cnt) {
    LAS int* lcnt = (LAS int*)(F.lds + RING_OFF); LAS int* lbase = lcnt + 16; LAS int* rec_e = lcnt + 32; LAS int* rec_p = rec_e + 512; LAS float* rec_w = (LAS float*)(rec_p + 512);
    const int rpb = (nrows + F.G - 1) / F.G;
    if (F.tid < 16) lcnt[F.tid] = 0;
    LAS float* WT = (LAS float*)(F.lds + RING_OFF + 32768);
    LAS float* LG = (LAS float*)(F.lds + RING_OFF + 8192);
    { const float* rwp = F.inp(I_RW); for (int i = F.tid; i < 1024 * 16; i += NT) { const int k = i >> 4, e = i & 15; WT[e * 1024 + k] = rwp[i]; } }
    __syncthreads();
    const float* rbp = F.inp(I_RB);
    RowPar P; P.modrow = -1;
    RowIn cur; bool have = (F.wave < rpb) && (F.bid * rpb + F.wave < nrows);
    if (have) { const int r = F.bid * rpb + F.wave; row_load<2, XBF>(F, r, xin.row(r), O, cur); }
    for (int i = F.wave; have; i += NWAVES) {
        const int r = F.bid * rpb + i;
        const int in_ = i + NWAVES, rn = F.bid * rpb + in_; const bool more = (in_ < rpb) && (rn < nrows);
        RowIn nxt;
        if (more) row_load<2, XBF>(F, rn, xin.row(rn), O, nxt);
        f32x4 v[4];
        { const int modrow = r < NLAT ? (r >> 12) : 8; if (modrow != P.modrow) row_params<2, false>(F, modrow, g, modl, modl, 3, 4, P); }
        row_finish<2, false, XBF>(F, cur, P, (char*)xout.row(r), dst + (size_t)r * D, nullptr, v);
        typedef float f32x2 __attribute__((ext_vector_type(2)));
        f32x2 s2[16];
#pragma unroll
        for (int e = 0; e < 16; ++e) s2[e] = (f32x2){0.f, 0.f};
#pragma unroll
        for (int j = 0; j < 4; ++j) { const f32x2 vlo = (f32x2){v[j].x, v[j].y}, vhi = (f32x2){v[j].z, v[j].w};
#pragma unroll
            for (int e = 0; e < 16; ++e) { const f32x4 w4 = *(const LAS f32x4*)(WT + e * 1024 + 4 * F.lane + 256 * j); s2[e] += vlo * (f32x2){w4.x, w4.y}; s2[e] += vhi * (f32x2){w4.z, w4.w}; } }
        float s16[16];
#pragma unroll
        for (int e = 0; e < 16; ++e) s16[e] = s2[e].x + s2[e].y;
        { float a8[8], a4[4], a2[2]; const bool h5 = F.lane & 32, h4 = F.lane & 16, h3 = F.lane & 8, h2 = F.lane & 4;
#pragma unroll
          for (int k = 0; k < 8; ++k) { const float send = h5 ? s16[k] : s16[k + 8], keep = h5 ? s16[k + 8] : s16[k]; a8[k] = keep + __shfl_xor(send, 32); }
#pragma unroll
          for (int k = 0; k < 4; ++k) { const float send = h4 ? a8[k] : a8[k + 4], keep = h4 ? a8[k + 4] : a8[k]; a4[k] = keep + __shfl_xor(send, 16); }
#pragma unroll
          for (int k = 0; k < 2; ++k) { const float send = h3 ? a4[k] : a4[k + 2], keep = h3 ? a4[k + 2] : a4[k]; a2[k] = keep + __shfl_xor(send, 8); }
          const float send = h2 ? a2[0] : a2[1], keep = h2 ? a2[1] : a2[0]; float a1 = keep + __shfl_xor(send, 4);
          a1 += __shfl_xor(a1, 1); a1 += __shfl_xor(a1, 2);
          if ((F.lane & 3) == 0) LG[i * 17 + 8 * ((F.lane >> 5) & 1) + 4 * ((F.lane >> 4) & 1) + 2 * ((F.lane >> 3) & 1) + ((F.lane >> 2) & 1)] = a1; }
        have = more; cur = nxt;
    }
    __syncthreads();
    for (int i = F.tid; i < rpb; i += NT) { if (F.bid * rpb + i >= nrows) break;
        float s16[16], bs[16];
#pragma unroll
        for (int e = 0; e < 16; ++e) { s16[e] = 1.0f / (1.0f + expf(-LG[i * 17 + e])); bs[e] = s16[e] + rbp[e]; }
        float best = -3.0e38f; int bg = 0;
#pragma unroll
        for (int gq = 0; gq < 4; ++gq) { const float a0 = bs[4 * gq], a1 = bs[4 * gq + 1], a2 = bs[4 * gq + 2], a3 = bs[4 * gq + 3];
            const float gs = fmaxf(fmaxf(fmaxf(a0 + a1, a0 + a2), fmaxf(a0 + a3, a1 + a2)), fmaxf(a1 + a3, a2 + a3));
            if (gs > best) { best = gs; bg = gq; } }
        float cb[4], cs[4];
#pragma unroll
        for (int ii = 0; ii < 4; ++ii) { cb[ii] = 0.f; cs[ii] = 0.f; }
#pragma unroll
        for (int gq = 0; gq < 4; ++gq)
#pragma unroll
            for (int ii = 0; ii < 4; ++ii) { cb[ii] = (gq == bg) ? bs[4 * gq + ii] : cb[ii]; cs[ii] = (gq == bg) ? s16[4 * gq + ii] : cs[ii]; }
        int i1 = 0; float b1 = cb[0], s1 = cs[0];
#pragma unroll
        for (int ii = 1; ii < 4; ++ii) if (cb[ii] > b1) { b1 = cb[ii]; s1 = cs[ii]; i1 = ii; }
        int i2 = -1; float b2 = -3.0e38f, s2 = 0.f;
#pragma unroll
        for (int ii = 0; ii < 4; ++ii) if (ii != i1 && cb[ii] > b2) { b2 = cb[ii]; s2 = cs[ii]; i2 = ii; }
        const float inv = 1.0f / (s1 + s2);
        const int e1 = 4 * bg + i1, e2 = 4 * bg + i2;
        rec_e[2 * i] = e1; rec_p[2 * i] = atomicAdd((int*)&lcnt[e1], 1); rec_w[2 * i] = s1 * inv;
        rec_e[2 * i + 1] = e2; rec_p[2 * i + 1] = atomicAdd((int*)&lcnt[e2], 1); rec_w[2 * i + 1] = s2 * inv;
    }
    __syncthreads();
    if (F.tid < 16) lbase[F.tid] = (int)__hip_atomic_fetch_add(cnt + F.tid, (unsigned)lcnt[F.tid], __ATOMIC_RELAXED, __HIP_MEMORY_SCOPE_AGENT);
    __syncthreads();
    for (int j = F.tid; j < 2 * rpb; j += NT) { const int r = F.bid * rpb + (j >> 1); if (r < nrows) { const int e = rec_e[j];
        info[(size_t)e * CAP + lbase[e] + rec_p[j]] = make_uint2((unsigned)(r * 2 + (j & 1)), __builtin_bit_cast(unsigned, rec_w[j])); } }
}
__device__ __forceinline__ void moe_table(Frame& F, int l) {
    LAS int* tab = (LAS int*)(F.lds + TAB_OFF);
    if (F.tid == 0) { int acc = 0; const unsigned* cnt = (const unsigned*)(F.ctl + CW_CNT + l * 16);
        for (int e = 0; e < 16; ++e) { const int n = (int)__hip_atomic_load(cnt + e, __ATOMIC_RELAXED, __HIP_MEMORY_SCOPE_AGENT); tab[e] = acc; tab[17 + e] = n; acc += (n + 255) >> 8; }
        tab[16] = acc; }
    __syncthreads();
}

__device__ __forceinline__ void seq_info(int r, int& base, int& t, int& L) {
    if (r < NLAT) { base = r & ~(SEQ - 1); t = r & (SEQ - 1); L = SEQ; } else { const int j = r - NLAT; base = NLAT + (j & ~(CTXL - 1)); t = j & (CTXL - 1); L = CTXL; }
}
typedef unsigned v2u __attribute__((ext_vector_type(2)));
__device__ __forceinline__ unsigned cvtpk(float lo, float hi) { unsigned r; asm volatile("v_cvt_pk_bf16_f32 %0, %1, %2" : "=v"(r) : "v"(lo), "v"(hi)); return r; }
__device__ __forceinline__ bf16x8 mk8(v2u a, v2u b) { v4u w; w.x = a.x; w.y = a.y; w.z = b.x; w.w = b.y; return __builtin_bit_cast(bf16x8, w); }
template <bool LAT>
__device__ __forceinline__ void kv_unit(Frame& F, int bh, int rq, LAS unsigned short* T) {
    const bf16* U = (const bf16*)(F.ws + WS_U);
    const int q = F.lane & 15, g = F.lane >> 4, h = bh & 3;
    const int urow0 = LAT ? ((bh >> 2) * SEQ + rq * 64) : (NLAT + (bh >> 2) * CTXL + rq * 64);
    bf16* kdst = LAT ? (bf16*)(F.ws + WS_KF) + ((size_t)(bh * 64 + rq) * 14) * 512 : (bf16*)(F.ws + WS_KFC) + ((size_t)(bh * 16 + rq * 4) * 2) * 512;
    bf16* vdst = LAT ? (bf16*)(F.ws + WS_VF) + ((size_t)(bh * 64 + rq) * 16) * 512 : (bf16*)(F.ws + WS_VFC) + ((size_t)(bh * 8 + rq * 2) * 4) * 512;
    { const bf16* src = U + (size_t)(urow0 + F.lane) * INC + UC_V + h * HD;
#pragma unroll
      for (int p = 0; p < 8; ++p) { const v4u w = *(const GAS v4u*)(src + 8 * p); LAS unsigned short* tp = T + (8 * p) * 72 + F.lane;
          tp[0 * 72] = (unsigned short)w.x; tp[1 * 72] = (unsigned short)(w.x >> 16); tp[2 * 72] = (unsigned short)w.y; tp[3 * 72] = (unsigned short)(w.y >> 16);
          tp[4 * 72] = (unsigned short)w.z; tp[5 * 72] = (unsigned short)(w.z >> 16); tp[6 * 72] = (unsigned short)w.w; tp[7 * 72] = (unsigned short)(w.w >> 16); } }
    constexpr int NK = LAT ? 7 : 4, KST = LAT ? 8 : 16;
#pragma unroll
    for (int sidx = 0; sidx < NK; ++sidx)
#pragma unroll
        for (int ks = 0; ks < 2; ++ks) { const v4u w = *(const GAS v4u*)(U + (size_t)(urow0 + KST * sidx + q) * INC + UC_K + h * HD + 32 * ks + 8 * g); *(GAS v4u*)(kdst + (size_t)(sidx * 2 + ks) * 512 + F.lane * 8) = w; }
    LDS_WAIT(); asm volatile("" ::: "memory");
    constexpr int NV = LAT ? 4 : 2;
#pragma unroll
    for (int w = 0; w < NV; ++w) { const int vst = LAT ? (w == 0 ? 0 : (w == 1 ? 8 : (w == 2 ? 24 : 32))) : 32 * w;
#pragma unroll
        for (int dt = 0; dt < 4; ++dt) { const LAS unsigned short* tp = T + (16 * dt + q) * 72 + vst + 4 * g; const v2u lo = *(const LAS v2u*)tp, hi = *(const LAS v2u*)(tp + 16);
            v4u o; o.x = lo.x; o.y = lo.y; o.z = hi.x; o.w = hi.y; *(GAS v4u*)(vdst + (size_t)(w * 4 + dt) * 512 + F.lane * 8) = o; } }
    LDS_WAIT(); asm volatile("" ::: "memory");
}
__device__ __forceinline__ void kv_prepass(Frame& F) {
    LAS unsigned short* T = (LAS unsigned short*)(F.lds + RING_OFF + F.wave * 16384);
    const int gw = F.bid * NWAVES + F.wave, NGW = F.G * NWAVES;
#pragma unroll 1
    for (int idx = gw; idx < 2048; idx += NGW) kv_unit<true>(F, idx >> 6, idx & 63, T);
#pragma unroll 1
    for (int idx = gw; idx < 128; idx += NGW) kv_unit<false>(F, idx >> 2, idx & 3, T);
}
template <bool LAT>
__device__ __forceinline__ void attn_unit(Frame& F, int l, int b, int h, int r, int cb, const LAS float* rpbs) {
    const bf16* U = (const bf16*)(F.ws + WS_U); bf16* Y = (bf16*)(F.ws + WS_H);
    const bf16* KF = (const bf16*)(F.ws + WS_KF); const bf16* VF = (const bf16*)(F.ws + WS_VF); const bf16* KFC = (const bf16*)(F.ws + WS_KFC); const bf16* VFC = (const bf16*)(F.ws + WS_VFC);
    const size_t bh = (size_t)(b * NHEAD + h);
    const int q = F.lane & 15, g = F.lane >> 4;
    constexpr int NT_ = LAT ? 32 : 16, NB = LAT ? 16 : 0;
    const int qrow = LAT ? (b * SEQ + r * GRIDW + cb * 16 + q) : (NLAT + b * CTXL + cb * 16 + q);
    const int r0 = r - 4 < 0 ? 0 : (r - 4 > 56 ? 56 : r - 4);
    const int wb = cb * 16 - 8 < 0 ? 0 : (cb * 16 - 8 > 32 ? 32 : cb * 16 - 8);
    bf16x8 qf[2];
#pragma unroll
    for (int ks = 0; ks < 2; ++ks) qf[ks] = *(const GAS bf16x8*)(U + (size_t)qrow * INC + UC_Q + h * HD + 32 * ks + 8 * g);
    f32x4 s[NT_];
#pragma unroll
    for (int t = 0; t < NT_; ++t) {
        const bf16* kp;
        if (t < NB) { const int kr = t >> 1, seg = t & 1; kp = KF + (((bh * 64 + (r0 + kr)) * 7 + ((wb >> 3) + 2 * seg)) * 2) * 512 + F.lane * 8; } else kp = KFC + ((bh * 16 + (t - NB)) * 2) * 512 + F.lane * 8;
        const bf16x8 k0 = *(const GAS bf16x8*)kp, k1 = *(const GAS bf16x8*)(kp + 512);
        f32x4 a = (f32x4){0.f, 0.f, 0.f, 0.f};
        a = __builtin_amdgcn_mfma_f32_16x16x32_bf16(k0, qf[0], a, 0, 0, 0);
        s[t] = __builtin_amdgcn_mfma_f32_16x16x32_bf16(k1, qf[1], a, 0, 0, 0);
    }
    float m = -3.0e38f;
    if (LAT) {
        const int cq = cb * 16 + q; const int c0 = cq - 8 < 0 ? 0 : (cq - 8 > 48 ? 48 : cq - 8);
        const LAS float* rp = rpbs + h * 15 * 31;
#pragma unroll
        for (int t = 0; t < NB; ++t) { const int kr = t >> 1, seg = t & 1; const int rrel = r0 + kr - r + 7;
#pragma unroll
            for (int i = 0; i < 4; ++i) { const int cc = wb + seg * 16 + 4 * g + i; const bool ok = (cc >= c0) && (cc < c0 + 16);
                int ci = cc - cq + 15; ci = ci < 0 ? 0 : (ci > 30 ? 30 : ci);
                const float bias = rp[rrel * 31 + ci];
                float v = s[t][i] * 0.125f + bias; v = ok ? v : -3.0e38f; s[t][i] = v; m = fmaxf(m, v); } }
    }
#pragma unroll
    for (int t = NB; t < NT_; ++t)
#pragma unroll
        for (int i = 0; i < 4; ++i) { const float v = s[t][i] * 0.125f; s[t][i] = v; m = fmaxf(m, v); }
    m = fmaxf(m, __shfl_xor(m, 16)); m = fmaxf(m, __shfl_xor(m, 32));
    float sum = 0.f;
#pragma unroll
    for (int t = 0; t < NT_; ++t)
#pragma unroll
        for (int i = 0; i < 4; ++i) { const float p = __expf(s[t][i] - m); s[t][i] = p; sum += p; }
    sum += __shfl_xor(sum, 16); sum += __shfl_xor(sum, 32);
    f32x4 o[4];
#pragma unroll
    for (int dt = 0; dt < 4; ++dt) o[dt] = (f32x4){0.f, 0.f, 0.f, 0.f};
#pragma unroll
    for (int kk = 0; kk < NT_ / 2; ++kk) {
        v4u pw; pw.x = cvtpk(s[2 * kk][0], s[2 * kk][1]); pw.y = cvtpk(s[2 * kk][2], s[2 * kk][3]); pw.z = cvtpk(s[2 * kk + 1][0], s[2 * kk + 1][1]); pw.w = cvtpk(s[2 * kk + 1][2], s[2 * kk + 1][3]);
        const bf16x8 pf = __builtin_bit_cast(bf16x8, pw);
        const bf16* vbase;
        if (2 * kk < NB) vbase = VF + (((bh * 64 + (r0 + kk)) * 4 + cb) * 4) * 512 + F.lane * 8; else vbase = VFC + ((bh * 8 + (kk - NB / 2)) * 4) * 512 + F.lane * 8;
#pragma unroll
        for (int dt = 0; dt < 4; ++dt) { const bf16x8 vf = *(const GAS bf16x8*)(vbase + dt * 512);
            o[dt] = __builtin_amdgcn_mfma_f32_16x16x32_bf16(vf, pf, o[dt], 0, 0, 0); }
    }
    const float inv = 1.0f / sum; bf16* yp = Y + (size_t)qrow * D + 512 + h * HD + 4 * g;
#pragma unroll
    for (int dt = 0; dt < 4; ++dt) { v2u w; w.x = cvtpk(o[dt][0] * inv, o[dt][1] * inv); w.y = cvtpk(o[dt][2] * inv, o[dt][3] * inv); *(GAS v2u*)(yp + dt * 16) = w; }
}
__device__ __forceinline__ void attn_phase(Frame& F, int l, bool with_ctx) {
    LAS float* rpbs = (LAS float*)(F.lds + TAB_OFF);
    { const float* rp = F.inp(I_RPB) + (size_t)l * NHEAD * 15 * 31; for (int i = F.tid; i < NHEAD * 15 * 31; i += NT) rpbs[i] = rp[i]; }
    __syncthreads();
    const int gw = F.bid * NWAVES + F.wave, NGW = F.G * NWAVES;
    {
        const int x = F.bid & 7, lb = F.bid >> 3, nlb = (F.G - x + 7) >> 3;
#pragma unroll 1
        for (int uu = lb * NWAVES + F.wave; uu < 1024; uu += nlb * NWAVES) { const int bh = 4 * x + (uu >> 8), u = uu & 255; attn_unit<true>(F, l, bh >> 2, bh & 3, u >> 2, u & 3, rpbs); } }
    if (with_ctx) for (int uid = gw; uid < BATCH * NHEAD * 16; uid += NGW) { const int cb = uid & 15, h = (uid >> 4) & 3, b = uid >> 6; attn_unit<false>(F, l, b, h, 0, cb, rpbs); }
}
__device__ __forceinline__ void dft64_tables(Frame& F, int off) {
    LAS unsigned short* CT = (LAS unsigned short*)(F.lds + off); LAS unsigned short* ST = CT + 64 * 72;
    for (int i = F.tid; i < 4096; i += NT) { const int j = i >> 6, k = i & 63; float s_, c_; sincospif((float)((j * k) & 63) * (1.0f / 32.0f), &s_, &c_); CT[j * 72 + k] = (unsigned short)f2bf(c_); ST[j * 72 + k] = (unsigned short)f2bf(s_); }
}
__device__ __forceinline__ void fourier_a(Frame& F) {
    const bf16* U = (const bf16*)(F.ws + WS_U); bf16* Zr = (bf16*)(F.ws + WS_Z); bf16* Zi = Zr + NZ;
    constexpr int O_CT = 0, O_TWC = 18432, O_TWS = O_TWC + 16384;
    dft64_tables(F, O_CT);
    { LAS float* twc = (LAS float*)(F.lds + O_TWC); LAS float* tws = (LAS float*)(F.lds + O_TWS);
      for (int i = F.tid; i < 4096; i += NT) { float s_, c_; sincospif((float)i * (1.0f / 2048.0f), &s_, &c_); twc[i] = c_; tws[i] = s_; } }
    __syncthreads();
    const LAS unsigned short* CT = (const LAS unsigned short*)(F.lds + O_CT); const LAS unsigned short* ST = CT + 64 * 72;
    const LAS float* twc = (const LAS float*)(F.lds + O_TWC); const LAS float* tws = (const LAS float*)(F.lds + O_TWS);
    const int q = F.lane & 15, g = F.lane >> 4;
    const int gw = F.bid * NWAVES + F.wave, NGW = F.G * NWAVES;
    for (int un = gw; un < BATCH * NHEAD * 64; un += NGW) {
        const int b = un >> 8, h = (un >> 6) & 3, n2 = un & 63;
        f32x4 xr[4][4], xw[4][4];
#pragma unroll
        for (int mt = 0; mt < 4; ++mt)
#pragma unroll
            for (int ct = 0; ct < 4; ++ct) { xr[mt][ct] = (f32x4){0.f, 0.f, 0.f, 0.f}; xw[mt][ct] = (f32x4){0.f, 0.f, 0.f, 0.f}; }
#pragma unroll
        for (int ks = 0; ks < 2; ++ks) {
            bf16x8 tf[4], cf[4], sf[4];
#pragma unroll
            for (int mt = 0; mt < 4; ++mt) tf[mt] = *(const GAS bf16x8*)(U + (size_t)(b * SEQ + 64 * (16 * mt + q) + n2) * INC + UC_F + h * HD + 32 * ks + 8 * g);
#pragma unroll
            for (int ct = 0; ct < 4; ++ct) { cf[ct] = *(const LAS bf16x8*)(CT + (16 * ct + q) * 72 + 32 * ks + 8 * g); sf[ct] = *(const LAS bf16x8*)(ST + (16 * ct + q) * 72 + 32 * ks + 8 * g); }
#pragma unroll
            for (int mt = 0; mt < 4; ++mt)
#pragma unroll
                for (int ct = 0; ct < 4; ++ct) { xr[mt][ct] = __builtin_amdgcn_mfma_f32_16x16x32_bf16(tf[mt], cf[ct], xr[mt][ct], 0, 0, 0); xw[mt][ct] = __builtin_amdgcn_mfma_f32_16x16x32_bf16(tf[mt], sf[ct], xw[mt][ct], 0, 0, 0); }
        }
        v4u ar[4][2], awn[4][2];
#pragma unroll
        for (int ct = 0; ct < 4; ++ct)
#pragma unroll
            for (int kb = 0; kb < 2; ++kb) {
                ar[ct][kb].x = cvtpk(xr[2 * kb][ct][0], xr[2 * kb][ct][1]); ar[ct][kb].y = cvtpk(xr[2 * kb][ct][2], xr[2 * kb][ct][3]);
                ar[ct][kb].z = cvtpk(xr[2 * kb + 1][ct][0], xr[2 * kb + 1][ct][1]); ar[ct][kb].w = cvtpk(xr[2 * kb + 1][ct][2], xr[2 * kb + 1][ct][3]);
                awn[ct][kb].x = cvtpk(-xw[2 * kb][ct][0], -xw[2 * kb][ct][1]); awn[ct][kb].y = cvtpk(-xw[2 * kb][ct][2], -xw[2 * kb][ct][3]);
                awn[ct][kb].z = cvtpk(-xw[2 * kb + 1][ct][0], -xw[2 * kb + 1][ct][1]); awn[ct][kb].w = cvtpk(-xw[2 * kb + 1][ct][2], -xw[2 * kb + 1][ct][3]); }
#pragma unroll
        for (int rt = 0; rt < 4; ++rt) {
            const int n1p = 16 * rt + q;
            bf16x8 cb_[2], sb_[2];
#pragma unroll
            for (int kb = 0; kb < 2; ++kb) { const LAS unsigned short* cp = CT + n1p * 72 + 32 * kb + 4 * g; const LAS unsigned short* sp = ST + n1p * 72 + 32 * kb + 4 * g;
                cb_[kb] = mk8(*(const LAS v2u*)cp, *(const LAS v2u*)(cp + 16)); sb_[kb] = mk8(*(const LAS v2u*)sp, *(const LAS v2u*)(sp + 16)); }
            const int tix = n2 * n1p; const float cw = twc[tix], sw = tws[tix];
            const size_t zbase = ((((size_t)(b * NHEAD + h) * 64 + n1p) * 64 + n2) * 64) + 4 * g;
#pragma unroll
            for (int ct = 0; ct < 4; ++ct) {
                f32x4 yr = (f32x4){0.f, 0.f, 0.f, 0.f}, yi = (f32x4){0.f, 0.f, 0.f, 0.f};
#pragma unroll
                for (int kb = 0; kb < 2; ++kb) {
                    const bf16x8 a_r = __builtin_bit_cast(bf16x8, ar[ct][kb]), a_wn = __builtin_bit_cast(bf16x8, awn[ct][kb]);
                    v4u nr = ar[ct][kb]; nr.x ^= 0x80008000u; nr.y ^= 0x80008000u; nr.z ^= 0x80008000u; nr.w ^= 0x80008000u; const bf16x8 a_rn = __builtin_bit_cast(bf16x8, nr);
                    yr = __builtin_amdgcn_mfma_f32_16x16x32_bf16(a_r, cb_[kb], yr, 0, 0, 0); yr = __builtin_amdgcn_mfma_f32_16x16x32_bf16(a_wn, sb_[kb], yr, 0, 0, 0);
                    yi = __builtin_amdgcn_mfma_f32_16x16x32_bf16(a_wn, cb_[kb], yi, 0, 0, 0); yi = __builtin_amdgcn_mfma_f32_16x16x32_bf16(a_rn, sb_[kb], yi, 0, 0, 0); }
                v2u wr_, wi_;
                wr_.x = cvtpk(yr[0] * cw + yi[0] * sw, yr[1] * cw + yi[1] * sw); wr_.y = cvtpk(yr[2] * cw + yi[2] * sw, yr[3] * cw + yi[3] * sw);
                wi_.x = cvtpk(yi[0] * cw - yr[0] * sw, yi[1] * cw - yr[1] * sw); wi_.y = cvtpk(yi[2] * cw - yr[2] * sw, yi[3] * cw - yr[3] * sw);
                *(GAS v2u*)(Zr + zbase + 16 * ct) = wr_; *(GAS v2u*)(Zi + zbase + 16 * ct) = wi_;
            }
        }
    }
}
__device__ __forceinline__ void fourier_b(Frame& F, bool with_ctx) {
    bf16* Y = (bf16*)(F.ws + WS_H); const bf16* Zr = (const bf16*)(F.ws + WS_Z);
    dft64_tables(F, 0);
    __syncthreads();
    const LAS unsigned short* CT = (const LAS unsigned short*)(F.lds); const LAS unsigned short* ST = CT + 64 * 72;
    LAS unsigned short* ZT = (LAS unsigned short*)(F.lds + 18432 + F.wave * 9216);
    const int q = F.lane & 15, g = F.lane >> 4;
    const int gw = F.bid * NWAVES + F.wave, NGW = F.G * NWAVES;
    const int nun = BATCH * NHEAD * 64 + (with_ctx ? BATCH * NHEAD * 4 : 0);
    for (int un = gw; un < nun; un += NGW) {
        const bool lat = un < BATCH * NHEAD * 64; const int uc = un - BATCH * NHEAD * 64;
        const int b = lat ? (un >> 8) : (uc >> 4), h = lat ? ((un >> 6) & 3) : ((uc >> 2) & 3), n1p = lat ? (un & 63) : (uc & 3);
        const size_t z0 = lat ? (((size_t)(b * NHEAD + h) * 64 + n1p) * 64) * 64 : 2 * NZ + (((size_t)(b * NHEAD + h) * 4 + n1p) * 64) * 64;
        const size_t zim = lat ? NZ : NZC;
        const int tok0 = lat ? (b * SEQ + n1p) : (NLAT + b * CTXL + n1p), tstride = lat ? 64 : 4; const float oscale = lat ? (1.0f / 512.0f) : (1.0f / 128.0f);
        f32x4 acc[4][4];
#pragma unroll
        for (int ct = 0; ct < 4; ++ct)
#pragma unroll
            for (int nt = 0; nt < 4; ++nt) acc[ct][nt] = (f32x4){0.f, 0.f, 0.f, 0.f};
#pragma unroll
        for (int comp = 0; comp < 2; ++comp) {
            const bf16* zp = Zr + z0 + (comp ? zim : 0); const LAS unsigned short* FT = comp ? ST : CT;
#pragma unroll
            for (int i = 0; i < 8; ++i) { const int p = F.lane + 64 * i, n2 = p >> 3, c8 = p & 7; const v4u w = *(const GAS v4u*)(zp + (size_t)n2 * 64 + 8 * c8); LAS unsigned short* tp = ZT + (8 * c8) * 72 + n2;
                tp[0 * 72] = (unsigned short)w.x; tp[1 * 72] = (unsigned short)(w.x >> 16); tp[2 * 72] = (unsigned short)w.y; tp[3 * 72] = (unsigned short)(w.y >> 16);
                tp[4 * 72] = (unsigned short)w.z; tp[5 * 72] = (unsigned short)(w.z >> 16); tp[6 * 72] = (unsigned short)w.w; tp[7 * 72] = (unsigned short)(w.w >> 16); }
            LDS_WAIT(); asm volatile("" ::: "memory");
#pragma unroll
            for (int ks = 0; ks < 2; ++ks) {
                bf16x8 af[4], bf_[4];
#pragma unroll
                for (int ct = 0; ct < 4; ++ct) af[ct] = *(const LAS bf16x8*)(ZT + (16 * ct + q) * 72 + 32 * ks + 8 * g);
#pragma unroll
                for (int nt = 0; nt < 4; ++nt) bf_[nt] = *(const LAS bf16x8*)(FT + (16 * nt + q) * 72 + 32 * ks + 8 * g);
#pragma unroll
                for (int ct = 0; ct < 4; ++ct)
#pragma unroll
                    for (int nt = 0; nt < 4; ++nt) acc[ct][nt] = __builtin_amdgcn_mfma_f32_16x16x32_bf16(af[ct], bf_[nt], acc[ct][nt], 0, 0, 0);
            }
            LDS_WAIT(); asm volatile("" ::: "memory");
        }
#pragma unroll
        for (int nt = 0; nt < 4; ++nt) { bf16* yp = Y + (size_t)(tok0 + tstride * (16 * nt + q)) * D + 768 + h * HD + 4 * g;
#pragma unroll
            for (int ct = 0; ct < 4; ++ct) { v2u w; w.x = cvtpk(acc[ct][nt][0] * oscale, acc[ct][nt][1] * oscale); w.y = cvtpk(acc[ct][nt][2] * oscale, acc[ct][nt][3] * oscale); *(GAS v2u*)(yp + 16 * ct) = w; } }
    }
}
__device__ __forceinline__ v4u mul_bf8(v4u a, v4u b) { v4u r; r.x = cvtpk(bflo(a.x) * bflo(b.x), bfhi(a.x) * bfhi(b.x)); r.y = cvtpk(bflo(a.y) * bflo(b.y), bfhi(a.y) * bfhi(b.y)); r.z = cvtpk(bflo(a.z) * bflo(b.z), bfhi(a.z) * bfhi(b.z)); r.w = cvtpk(bflo(a.w) * bflo(b.w), bfhi(a.w) * bfhi(b.w)); return r; }
__device__ __forceinline__ void convpool_phase(Frame& F, int l, int nrows) {
    const bf16* U = (const bf16*)(F.ws + WS_U); bf16* Y = (bf16*)(F.ws + WS_H);
    const bf16* PWT = (const bf16*)(F.ws + WS_PWT) + (size_t)l * 4 * 64 * 64;
    const float* cw = F.inp(I_CONVW) + (size_t)l * 3 * GWID; const float* ps = F.inp(I_POOLS) + (size_t)l * GWID;
    LAS unsigned* PX = (LAS unsigned*)(F.lds + RING_OFF);
    LAS unsigned* DT = (LAS unsigned*)(F.lds + RING_OFF + 40960);
    const int q = F.lane & 15, g = F.lane >> 4;
    const int c8 = F.tid & 31, gi = F.wave & 3;
    const f32x4 w0a = *(const GAS f32x4*)(cw + 8 * c8), w0b = *(const GAS f32x4*)(cw + 8 * c8 + 4), w1a = *(const GAS f32x4*)(cw + GWID + 8 * c8), w1b = *(const GAS f32x4*)(cw + GWID + 8 * c8 + 4),
                w2a = *(const GAS f32x4*)(cw + 2 * GWID + 8 * c8), w2b = *(const GAS f32x4*)(cw + 2 * GWID + 8 * c8 + 4);
    bf16x8 wf[4][2]; f32x4 psc[4];
#pragma unroll
    for (int dt = 0; dt < 4; ++dt) { psc[dt] = *(const GAS f32x4*)(ps + gi * 64 + 16 * dt + 4 * g);
#pragma unroll
        for (int ks = 0; ks < 2; ++ks) wf[dt][ks] = *(const GAS bf16x8*)(PWT + ((size_t)gi * 64 + 16 * dt + q) * 64 + 32 * ks + 8 * g); }
    for (int tile = F.bid; tile < nrows / 64; tile += F.G) {
        const int r0 = tile * 64; int base, t0, L; seq_info(r0, base, t0, L);
#pragma unroll
        for (int i = 0; i < 4; ++i) { const int p = F.tid + NT * i, tr = p >> 5, t = t0 + tr; const bf16* ur = U + (size_t)(r0 + tr) * INC + 8 * c8;
            const v4u zc = mul_bf8(*(const GAS v4u*)(ur + UC_AC), *(const GAS v4u*)(ur + UC_AV));
            v4u zp = (v4u){0u, 0u, 0u, 0u}, zn = (v4u){0u, 0u, 0u, 0u};
            if (t > 0) zp = mul_bf8(*(const GAS v4u*)(ur + UC_AC - INC), *(const GAS v4u*)(ur + UC_AV - INC));
            if (t < L - 1) zn = mul_bf8(*(const GAS v4u*)(ur + UC_AC + INC), *(const GAS v4u*)(ur + UC_AV + INC));
            const v4u ab = *(const GAS v4u*)(ur + UC_AB);
            v4u o;
            o.x = cvtpk(bflo(ab.x) * (w0a.x * bflo(zp.x) + w1a.x * bflo(zc.x) + w2a.x * bflo(zn.x)), bfhi(ab.x) * (w0a.y * bfhi(zp.x) + w1a.y * bfhi(zc.x) + w2a.y * bfhi(zn.x)));
            o.y = cvtpk(bflo(ab.y) * (w0a.z * bflo(zp.y) + w1a.z * bflo(zc.y) + w2a.z * bflo(zn.y)), bfhi(ab.y) * (w0a.w * bfhi(zp.y) + w1a.w * bfhi(zc.y) + w2a.w * bfhi(zn.y)));
            o.z = cvtpk(bflo(ab.z) * (w0b.x * bflo(zp.z) + w1b.x * bflo(zc.z) + w2b.x * bflo(zn.z)), bfhi(ab.z) * (w0b.y * bfhi(zp.z) + w1b.y * bfhi(zc.z) + w2b.y * bfhi(zn.z)));
            o.w = cvtpk(bflo(ab.w) * (w0b.z * bflo(zp.w) + w1b.z * bflo(zc.w) + w2b.z * bflo(zn.w)), bfhi(ab.w) * (w0b.w * bfhi(zp.w) + w1b.w * bfhi(zc.w) + w2b.w * bfhi(zn.w)));
            *(GAS v4u*)(Y + (size_t)(r0 + tr) * D + 8 * c8) = o; }
#pragma unroll
        for (int i = 0; i < 5; ++i) { const int p = F.tid + NT * i, rr = p >> 5, t = t0 - 8 + rr; v4u w = (v4u){0u, 0u, 0u, 0u};
            if (t >= 0 && t < L) w = *(const GAS v4u*)(U + (size_t)(base + t) * INC + UC_P + 8 * c8);
            *(LAS v4u*)(PX + rr * 128 + 4 * c8) = w; }
        __syncthreads();
        { const int c2 = F.tid & 127, tq = F.tid >> 7, hw = 1 << (c2 >> 5);
          float s0 = 0.f, s1 = 0.f;
          for (int k = -hw; k < hw; ++k) { const unsigned w = PX[(16 * tq + 8 + k) * 128 + c2]; s0 += bflo(w); s1 += bfhi(w); }
          for (int i = 0; i < 16; ++i) { const int tl = 16 * tq + i, t = t0 + tl;
              const int lo = t - hw > 0 ? t - hw : 0, hi = t + hw < L ? t + hw : L; const float rc = 1.0f / (float)(hi - lo);
              const unsigned xc = PX[(tl + 8) * 128 + c2];
              DT[tl * 132 + c2] = cvtpk(s0 * rc - bflo(xc), s1 * rc - bfhi(xc));
              const unsigned wa = PX[(tl + 8 + hw) * 128 + c2], wsb = PX[(tl + 8 - hw) * 128 + c2];
              s0 += bflo(wa) - bflo(wsb); s1 += bfhi(wa) - bfhi(wsb); } }
        __syncthreads();
        {
#pragma unroll
          for (int tj = 0; tj < 2; ++tj) { const int tt = 2 * (F.wave >> 2) + tj;
              bf16x8 df[2];
#pragma unroll
              for (int ks = 0; ks < 2; ++ks) df[ks] = *(const LAS bf16x8*)(DT + (16 * tt + q) * 132 + gi * 32 + 16 * ks + 4 * g);
#pragma unroll
              for (int dt = 0; dt < 4; ++dt) { f32x4 a = (f32x4){0.f, 0.f, 0.f, 0.f};
                  a = __builtin_amdgcn_mfma_f32_16x16x32_bf16(wf[dt][0], df[0], a, 0, 0, 0); a = __builtin_amdgcn_mfma_f32_16x16x32_bf16(wf[dt][1], df[1], a, 0, 0, 0);
                  const int oc = gi * 64 + 16 * dt + 4 * g; const f32x4 sc = psc[dt];
                  v2u w; w.x = cvtpk(a[0] * sc.x, a[1] * sc.y); w.y = cvtpk(a[2] * sc.z, a[3] * sc.w);
                  *(GAS v2u*)(Y + (size_t)(r0 + 16 * tt + q) * D + 256 + oc) = w; } } }
        __syncthreads();
    }
}

__device__ __forceinline__ void fourier_ctx_a(Frame& F) {
    const bf16* U = (const bf16*)(F.ws + WS_U); bf16* Zc = (bf16*)(F.ws + WS_Z) + 2 * NZ;
    LAS float* cs = (LAS float*)(F.lds + TAB_OFF); LAS float* sn = cs + 64; LAS float* cs256 = cs + 128; LAS float* sn256 = cs + 384;
    if (F.tid < 64) { float s_, c_; sincospif((float)F.tid * (1.0f / 32.0f), &s_, &c_); cs[F.tid] = c_; sn[F.tid] = s_; }
    if (F.tid < 256) { float s_, c_; sincospif((float)F.tid * (1.0f / 128.0f), &s_, &c_); cs256[F.tid] = c_; sn256[F.tid] = s_; }
    __syncthreads();
    for (int item = F.bid * NT + F.tid; item < BATCH * NHEAD * 64 * 64; item += F.G * NT) {
        const int cp = item & 63, n2 = (item >> 6) & 63, h = (item >> 12) & 3, b = item >> 14;
        float xr[4], xi[4];
#pragma unroll
        for (int n1 = 0; n1 < 4; ++n1) { xr[n1] = 0.f; xi[n1] = 0.f; }
        for (int c8 = 0; c8 < 8; ++c8) {
            float cc[8], ss[8];
#pragma unroll
            for (int e = 0; e < 8; ++e) { const int idx = ((8 * c8 + e) * cp) & 63; cc[e] = cs[idx]; ss[e] = sn[idx]; }
#pragma unroll
            for (int n1 = 0; n1 < 4; ++n1) { const v4u w = *(const GAS v4u*)(U + (size_t)(NLAT + b * CTXL + 64 * n1 + n2) * INC + UC_F + h * HD + 8 * c8);
                const float f0 = bflo(w.x), f1 = bfhi(w.x), f2 = bflo(w.y), f3 = bfhi(w.y), f4 = bflo(w.z), f5 = bfhi(w.z), f6 = bflo(w.w), f7 = bfhi(w.w);
                xr[n1] += f0 * cc[0] + f1 * cc[1] + f2 * cc[2] + f3 * cc[3] + f4 * cc[4] + f5 * cc[5] + f6 * cc[6] + f7 * cc[7];
                xi[n1] -= f0 * ss[0] + f1 * ss[1] + f2 * ss[2] + f3 * ss[3] + f4 * ss[4] + f5 * ss[5] + f6 * ss[6] + f7 * ss[7]; }
        }
        float yr[4], yi[4];
        yr[0] = xr[0] + xr[1] + xr[2] + xr[3];           yi[0] = xi[0] + xi[1] + xi[2] + xi[3];
        yr[1] = xr[0] + xi[1] - xr[2] - xi[3];           yi[1] = xi[0] - xr[1] - xi[2] + xr[3];
        yr[2] = xr[0] - xr[1] + xr[2] - xr[3];           yi[2] = xi[0] - xi[1] + xi[2] - xi[3];
        yr[3] = xr[0] - xi[1] - xr[2] + xi[3];           yi[3] = xi[0] + xr[1] - xi[2] - xr[3];
#pragma unroll
        for (int k = 0; k < 4; ++k) { const int tix = (n2 * k) & 255; const float cw = cs256[tix], sw = sn256[tix];
            const size_t zi = ((((size_t)(b * NHEAD + h) * 4 + k) * 64 + n2) * 64) + cp;
            Zc[zi] = (bf16)f2bf(yr[k] * cw + yi[k] * sw); Zc[NZC + zi] = (bf16)f2bf(yi[k] * cw - yr[k] * sw); }
    }
}

__device__ __forceinline__ void mixa_phase(int l, bool with_ctx) { Frame F = mk_frame();
    const int nrows = with_ctx ? NROW : NLAT;
    convpool_phase(F, l, nrows);
    kv_prepass(F);
    __syncthreads();
    fourier_a(F);
    __syncthreads();
    if (with_ctx) fourier_ctx_a(F);
}
__device__ __forceinline__ void mixb_phase(int l, bool with_ctx) { Frame F = mk_frame();
    attn_phase(F, l, with_ctx);
    __syncthreads();
    fourier_b(F, with_ctx);
}

struct WinOrder {
    int G, c, nctx_cols, ctx_pn0;
    __device__ __forceinline__ bool next(int i, pg8::Unit& u) const {
        const long L = (long)i * G + c; const int nlatu = 1024, total = nlatu + 8 * nctx_cols; if (L >= total) return false;
        if (L < nlatu) { int wgid = (int)L; { const int xcd = wgid % 8, off = wgid / 8; wgid = xcd * 128 + off; }
            const int gid = wgid / 64, fm = gid * 8; u.pm = fm + ((wgid % 64) % 8); u.pn = (wgid % 64) / 8; }
        else { const int j = (int)L - nlatu; u.pm = 128 + (j % 8); u.pn = ctx_pn0 + j / 8; }
        u.pb = u.pn; u.lb = 0; u.nv = 256; return true;
    }
    __device__ __forceinline__ void a_ready(const pg8::Unit&) const {}
    __device__ __forceinline__ void done(const pg8::Unit&) const {}
    __device__ __forceinline__ int row_of(const pg8::Unit&, int i) const { return i; }
};

struct Args { const float* in[20]; float* out; unsigned char* ws; int l, e; };
#define PH_PTRS() \
    bf16* H = (bf16*)(F.ws + WS_H); bf16* U = (bf16*)(F.ws + WS_U); bf16* HE = (bf16*)(F.ws + WS_U); bf16* Y2 = (bf16*)(F.ws + WS_S); \
    float* MOD = (float*)(F.ws + WS_MOD); float* XC = (float*)(F.ws + WS_XC); const uint2* INFO = (const uint2*)(F.ws + WS_INFO); \
    const bool first = (l == 0); const int M = first ? NROW : NLAT; const float* modl = MOD + (size_t)l * 9 * 6144; \
    (void)H; (void)U; (void)HE; (void)XC; (void)Y2; (void)INFO; (void)M; (void)modl;

#define XS_IN()  XStream{(const char*)F.inp(I_X), (const char*)F.inp(I_CTX), 4096, 4096}
#define XS_BF()  XStream{(const char*)F.out, (const char*)XC, 4096, 2048}
__device__ __forceinline__ void ph_norm1(int l) { Frame F = mk_frame(); PH_PTRS();
    norm_phase<0, false, false>(F, XS_IN(), XS_IN(), NROW, F.inp(I_N1G), modl, modl, 0, 1, H, nullptr, nullptr); }
__device__ __forceinline__ void ph_next(int l) { Frame F = mk_frame(); PH_PTRS();
    if (first) norm_phase<1, false, true>(F, XS_BF(), XS_BF(), NROW, F.inp(I_N1G) + D, MOD + (size_t)9 * 6144, modl, 0, 1, H, Y2, nullptr);
    else norm_phase<1, true, true>(F, XS_BF(), XS_BF(), NLAT, F.inp(I_FG), modl, modl, 0, 0, nullptr, Y2, F.out); }
__device__ __forceinline__ void ph_route(int l) { Frame F = mk_frame(); PH_PTRS();
    if (first) route_phase<false>(F, l, XS_IN(), XS_BF(), U, M, F.inp(I_N2G) + (size_t)l * D, modl, H, (uint2*)(F.ws + WS_INFO), (unsigned*)(F.ctl + CW_CNT + l * 16));
    else route_phase<true>(F, l, XS_BF(), XS_BF(), U, M, F.inp(I_N2G) + (size_t)l * D, modl, H, (uint2*)(F.ws + WS_INFO), (unsigned*)(F.ctl + CW_CNT + l * 16)); }
__device__ __forceinline__ void ph_win(int l) { Frame F = mk_frame(); PH_PTRS();
    pg8::Gemm g{H, (const bf16*)(F.ws + WS_WIN) + (size_t)l * INC * D, NROW, INC, D};
    WinOrder S{F.G, F.bid, first ? 8 : 2, first ? 0 : 5};
    pg8::EpiBf16 E{U, INC};
    pg8::gemm_phase<pg8::EpiBf16, WinOrder>(F.lds + RING_OFF, g, S, E); }
__device__ __forceinline__ void ph_wout(int l) { Frame F = mk_frame(); PH_PTRS();
    pg8::Gemm g{H, (const bf16*)(F.ws + WS_WOUT) + (size_t)l * D * D, M, D, D};
    pg8::StaticOrder S; S.init(M, D, F.G, F.bid);
    pg8::EpiBf16 E{U, D};
    pg8::gemm_phase<pg8::EpiBf16, pg8::StaticOrder>(F.lds + RING_OFF, g, S, E); }
__device__ __forceinline__ void ph_moe1(int l) { Frame F = mk_frame(); PH_PTRS(); moe_table(F, l);
    pg8::Gemm g{H, (const bf16*)(F.ws + WS_W13) + (size_t)l * NEXP * 1024 * D, M, 1024, D};
    pg8::MoeOrder S{F.G, F.bid, CAP, (const LAS int*)(F.lds + TAB_OFF), INFO};
    pg8::EpiSwiGLU E{HE, MHID};
    pg8::gemm_phase<pg8::EpiSwiGLU, pg8::MoeOrder, true>(F.lds + RING_OFF, g, S, E); }
__device__ __forceinline__ void ph_moe2(int l) { Frame F = mk_frame(); PH_PTRS(); moe_table(F, l);
    pg8::Gemm g{HE, (const bf16*)(F.ws + WS_W2) + (size_t)l * NEXP * D * MHID, M, D, MHID};
    pg8::MoeOrder S{F.G, F.bid, CAP, (const LAS int*)(F.lds + TAB_OFF), INFO};
    pg8::EpiScatter E{Y2, INFO};
    pg8::gemm_phase<pg8::EpiScatter, pg8::MoeOrder, false>(F.lds + RING_OFF, g, S, E); }

__device__ __forceinline__ void grid_bar() {
    Frame F = mk_frame(); XcdBarrier b; b.bar = (unsigned*)(F.ctl + CW_BAR); b.x = xb_xcc_id(); b.st = F.MISC + 8; xcd_barrier(b);
}
#define PMARK(name) asm volatile("; PHASE_MARK " name ::: "memory")
template <int L> __device__ __forceinline__ void layer_phases() {
    PMARK("win"); ph_win(L); grid_bar();
    PMARK("mixa"); mixa_phase(L, L == 0); grid_bar();
    PMARK("mixb"); mixb_phase(L, L == 0); grid_bar();
    PMARK("wout"); ph_wout(L); grid_bar();
    PMARK("route"); ph_route(L); grid_bar();
    PMARK("moe1"); ph_moe1(L); grid_bar();
    PMARK("moe2"); ph_moe2(L); grid_bar();
    PMARK("next"); ph_next(L);
}
__global__ void __launch_bounds__(NT, 2) fwd_all(Args args) {
    { Frame F = mk_frame();
      for (int u = F.tid; u < (LDS_BYTES - LDSCTL_OFF) / 4; u += NT) ((LAS unsigned*)(F.lds + LDSCTL_OFF))[u] = 0u;
      __syncthreads();
      (void)xcd_barrier_post((unsigned*)(F.ctl + CW_BAR), F.MISC + 8); }
    PMARK("pa"); pa_phase(); grid_bar();
    PMARK("norm1"); ph_norm1(0); grid_bar();
    layer_phases<0>(); grid_bar();
    layer_phases<1>();
}

typedef void (*kern_t)(Args);
extern "C" void kernel_launch(void* const* d_in, const int* in_sizes, int n_in, void* d_out, int out_size, void* d_ws, size_t ws_size, hipStream_t stream) {
    static int grid = 0;
    const kern_t kerns[] = {fwd_all};
    if (grid == 0) {
        if (n_in != 20 || out_size != NLAT * D || ws_size < WS_END) { fprintf(stderr, "kernel_launch: unexpected shapes (n_in %d out %d ws %zu)\n", n_in, out_size, ws_size); grid = -1; return; }
        int dev = 0, cus = 0;
        if (hipGetDevice(&dev) != hipSuccess || hipDeviceGetAttribute(&cus, hipDeviceAttributeMultiprocessorCount, dev) != hipSuccess) { grid = -1; return; }
        for (kern_t k : kerns) if (hipFuncSetAttribute((const void*)k, hipFuncAttributeMaxDynamicSharedMemorySize, LDS_BYTES) != hipSuccess) { fprintf(stderr, "kernel_launch: hipFuncSetAttribute failed\n"); grid = -1; return; }
        int per_cu = 0; (void)hipOccupancyMaxActiveBlocksPerMultiprocessor(&per_cu, (const void*)kerns[0], NT, LDS_BYTES); (void)hipGetLastError();
        grid = cus;
    }
    if (grid < 0) return;
    (void)hipMemsetAsync((char*)d_ws + WS_CTL, 0, CTL_ZERO_BYTES, stream);
    Args a{};
    for (int i = 0; i < 20; ++i) a.in[i] = (const float*)d_in[i];
    a.out = (float*)d_out; a.ws = (unsigned char*)d_ws;
    hipLaunchKernelGGL(fwd_all, dim3(grid), dim3(NT), LDS_BYTES, stream, a);
}
```

```cpp
#include <hip/hip_runtime.h>
#include <cstdio>
#include <cstdint>
namespace pg8 {
#define PG8_LAS __attribute__((address_space(3)))
typedef unsigned short bf16_t;
typedef short bf16x8 __attribute__((ext_vector_type(8)));
typedef float f32x4 __attribute__((ext_vector_type(4)));
typedef unsigned u32x4 __attribute__((ext_vector_type(4)));
constexpr int BM = 256, BK = 64, HALF = 128, HTB = HALF * BK * 2  , STAGE_BYTES = 8 * HTB, NXCD = 8, WGM = 8;

__host__ __device__ __forceinline__ int lds_byte(int r, int c) { const int st = (r >> 4) * 2 + (c >> 5), rr = r & 15, cc = c & 31, ob = rr * 64 + cc * 2; return st * 1024 + (ob ^ (((ob >> 9) & 1) << 5)); }
__host__ __device__ __forceinline__ void stage_rc(int b, int& R, int& C) { const int st = b / 1024, sb = b % 1024, swz = sb ^ (((sb >> 9) & 1) << 5); R = (st >> 1) * 16 + swz / 64; C = (st & 1) * 32 + (swz % 64) / 2; }
__host__ __device__ __forceinline__ int perm32(int rho) { const int n = rho >> 4, i = rho & 15; return 8 * (i >> 2) + 4 * n + (i & 3); }

struct Unit { int pm, pn, pb, lb, nv; };
struct Gemm { const bf16_t* A; const bf16_t* Bt; int M, N, K; };

struct StaticOrder {
    int nM, nN, nwg, G, c;
    __host__ __device__ void init(int M, int N, int G_, int c_) { nM = M / BM; nN = N / BM; nwg = nM * nN; G = G_; c = c_; }
    __host__ __device__ bool next(int i, Unit& u) const {
        const long L = (long)i * G + c; if (L >= nwg) return false;
        int wgid = (int)L; { const int q = nwg / NXCD, r = nwg % NXCD, xcd = wgid % NXCD, off = wgid / NXCD; wgid = (xcd < r ? xcd * (q + 1) : r * (q + 1) + (xcd - r) * q) + off; }
        const int nig = WGM * nN, gid = wgid / nig, fm = gid * WGM, gsz = (nM - fm) < WGM ? (nM - fm) : WGM;
        u.pm = fm + ((wgid % nig) % gsz); u.pn = (wgid % nig) / gsz; u.pb = u.pn; u.lb = 0; u.nv = BM; return true;
    }
    __device__ __forceinline__ void a_ready(const Unit&) const {}
    __device__ __forceinline__ int row_of(const Unit&, int i) const { return i; }
    __device__ __forceinline__ void done(const Unit&) const {}
};


__device__ __forceinline__ unsigned cvt_pk_bf16(float lo, float hi) { unsigned r; asm volatile("v_cvt_pk_bf16_f32 %0, %1, %2" : "=v"(r) : "v"(lo), "v"(hi)); return r; }

struct EpiBf16 {
    static constexpr bool PERM = true, AFTER_DRAIN = false;
    bf16_t* O; int ldc;
    __device__ __forceinline__ void operator()(const f32x4 (&acc)[2][2][4][2], const Unit& u, int wr, int wc, int fr, int fq) const {
        const int row0 = u.pm * BM + wr * 64 + fr; const int col0 = u.pn * BM + wc * 32 + 8 * fq;
#pragma unroll
        for (int ai = 0; ai < 2; ++ai)
#pragma unroll
            for (int m = 0; m < 4; ++m) { bf16_t* rowp = O + (size_t)(row0 + ai * HALF + m * 16) * ldc + col0;
#pragma unroll
                for (int bj = 0; bj < 2; ++bj) { const f32x4 v0 = acc[ai][bj][m][0], v1 = acc[ai][bj][m][1];
                    u32x4 w; w.x = cvt_pk_bf16(v0[0], v0[1]); w.y = cvt_pk_bf16(v0[2], v0[3]); w.z = cvt_pk_bf16(v1[0], v1[1]); w.w = cvt_pk_bf16(v1[2], v1[3]);
                    *(u32x4*)(rowp + bj * HALF) = w; } }
    }
};
struct EpiSwiGLU {
    static constexpr bool PERM = true, AFTER_DRAIN = false;
    bf16_t* O; int ldc;
    __device__ __forceinline__ void operator()(const f32x4 (&acc)[2][2][4][2], const Unit& u, int wr, int wc, int fr, int fq) const {
        const int row0 = u.pm * BM + wr * 64 + fr; const int col0 = u.pn * HALF + wc * 32 + 8 * fq;
#pragma unroll
        for (int ai = 0; ai < 2; ++ai)
#pragma unroll
            for (int m = 0; m < 4; ++m) { bf16_t* rowp = O + (size_t)(row0 + ai * HALF + m * 16) * ldc + col0;
                float o[8];
#pragma unroll
                for (int n = 0; n < 2; ++n)
#pragma unroll
                    for (int j = 0; j < 4; ++j) { const float a = acc[ai][0][m][n][j], b = acc[ai][1][m][n][j]; o[n * 4 + j] = a * __builtin_amdgcn_rcpf(1.0f + __expf(-a)) * b; }
                u32x4 w; w.x = cvt_pk_bf16(o[0], o[1]); w.y = cvt_pk_bf16(o[2], o[3]); w.z = cvt_pk_bf16(o[4], o[5]); w.w = cvt_pk_bf16(o[6], o[7]);
                *(u32x4*)rowp = w; }
    }
};
struct EpiScatter {
    static constexpr bool PERM = true, AFTER_DRAIN = false;
    bf16_t* Y2; const uint2* info;
    __device__ __forceinline__ void operator()(const f32x4 (&acc)[2][2][4][2], const Unit& u, int wr, int wc, int fr, int fq) const {
        const int col0 = u.pn * BM + wc * 32 + 8 * fq;
#pragma unroll
        for (int ai = 0; ai < 2; ++ai)
#pragma unroll
            for (int m = 0; m < 4; ++m) { const int i = ai * HALF + wr * 64 + m * 16 + fr;
                if (i < u.nv) { const uint2 inf = info[u.lb + i]; const float w = __builtin_bit_cast(float, inf.y); bf16_t* rowp = Y2 + (size_t)inf.x * 1024 + col0;
#pragma unroll
                    for (int bj = 0; bj < 2; ++bj) { const f32x4 v0 = acc[ai][bj][m][0] * w, v1 = acc[ai][bj][m][1] * w;
                        u32x4 q; q.x = cvt_pk_bf16(v0[0], v0[1]); q.y = cvt_pk_bf16(v0[2], v0[3]); q.z = cvt_pk_bf16(v1[0], v1[1]); q.w = cvt_pk_bf16(v1[2], v1[3]);
                        *(u32x4*)(rowp + bj * HALF) = q; } } }
    }
};
struct MoeOrder {
    int G, c, cap; const PG8_LAS int* tab; const uint2* info;
    __device__ __forceinline__ bool next(int i, Unit& u) const {
        const int nwg = __builtin_amdgcn_readfirstlane(tab[16]) * 4; const long L = (long)i * G + c; if (L >= nwg) return false;
        int wgid = (int)L; { const int q = nwg / NXCD, r = nwg % NXCD, xcd = wgid % NXCD, off = wgid / NXCD; wgid = (xcd < r ? xcd * (q + 1) : r * (q + 1) + (xcd - r) * q) + off; }
        const int gp = wgid >> 2; int e = 0;
#pragma unroll
        for (int q = 1; q < 16; ++q) e += (gp >= tab[q]) ? 1 : 0;
        e = __builtin_amdgcn_readfirstlane(e);
        const int p = gp - __builtin_amdgcn_readfirstlane(tab[e]); const int ne = __builtin_amdgcn_readfirstlane(tab[17 + e]);
        u.pm = gp; u.pn = wgid & 3; u.pb = e * 4 + u.pn; u.lb = e * cap + 256 * p; u.nv = (ne - 256 * p) < 256 ? (ne - 256 * p) : 256; return true;
    }
    __device__ __forceinline__ void a_ready(const Unit&) const {}
    __device__ __forceinline__ void done(const Unit&) const {}
    __device__ __forceinline__ int row_of(const Unit& u, int i) const { return i < u.nv ? (int)(info[u.lb + i].x >> 1) : 0; }
};
template <class Epi, class Sched, bool GATHER = false>
__device__ __forceinline__ void gemm_phase(PG8_LAS unsigned char* lds, const Gemm g, const Sched& S, const Epi& E) {
    int tid_ = threadIdx.x; asm volatile("" : "+v"(tid_));
    const int tid = tid_, wid = __builtin_amdgcn_readfirstlane(tid >> 6), lane = tid & 63, wr = wid >> 2, wc = wid & 3, fr = lane & 15, fq = lane >> 4;
    const int K = g.K, nt = K / BK;
    unsigned voffB[2];
#pragma unroll
    for (int i = 0; i < 2; ++i) { int R, C; stage_rc(tid * 16 + i * 8192, R, C); const int Rb = Epi::PERM ? ((R & ~31) + perm32(R & 31)) : R; voffB[i] = (unsigned)(Rb * K + C) * 2u; }
    const size_t kstep = (size_t)(BK * 2);
    const size_t hstep = (size_t)HALF * K * 2;
    const size_t tstep = 2 * hstep;
    const unsigned ldsw = (unsigned)wid * 1024u;
    const int aoff = lds_byte(wr * 64 + fr, fq * 8), boff = lds_byte(wc * 32 + fr, fq * 8);
#define PG8_SA(b, h) (((b) * 2 + (h)) * HTB)
#define PG8_SB(b, h) ((4 + (b) * 2 + (h)) * HTB)
#define PG8_STAGE(bufoff, gbase, voff) do { _Pragma("unroll") for (int _i = 0; _i < 2; ++_i) \
        __builtin_amdgcn_global_load_lds((const unsigned*)((const char*)(gbase) + (voff)[_i]), (PG8_LAS unsigned*)(lds + (bufoff) + ldsw + _i * 8192), 16, 0, 0); } while (0)
#define PG8_LDA(dst, b, h) do { _Pragma("unroll") for (int m = 0; m < 4; ++m) _Pragma("unroll") for (int k = 0; k < 2; ++k) dst[m][k] = *(const PG8_LAS bf16x8*)(lds + PG8_SA(b, h) + aoff + m * 2048 + k * 1024); } while (0)
#define PG8_LDB(dst, b, h) do { _Pragma("unroll") for (int n = 0; n < 2; ++n) _Pragma("unroll") for (int k = 0; k < 2; ++k) dst[n][k] = *(const PG8_LAS bf16x8*)(lds + PG8_SB(b, h) + boff + n * 2048 + k * 1024); } while (0)
#define PG8_MMA(ai, bj, At, Bt) do { __builtin_amdgcn_s_setprio(1); _Pragma("unroll") for (int m = 0; m < 4; ++m) _Pragma("unroll") for (int n = 0; n < 2; ++n) _Pragma("unroll") for (int k = 0; k < 2; ++k) \
        acc[ai][bj][m][n] = __builtin_amdgcn_mfma_f32_16x16x32_bf16(Bt[n][k], At[m][k], acc[ai][bj][m][n], 0, 0, 0); __builtin_amdgcn_s_setprio(0); } while (0)
#define PG8_WAIT_V(n) asm volatile("s_waitcnt vmcnt(" #n ")" ::: "memory")
#define PG8_WAIT_L(n) asm volatile("s_waitcnt lgkmcnt(" #n ")" ::: "memory")
#define PG8_BAR __builtin_amdgcn_s_barrier()
#define PG8_SCHED __builtin_amdgcn_sched_barrier(0)
#define PG8_AOFFS(o, u) do { _Pragma("unroll") for (int _h = 0; _h < 2; ++_h) _Pragma("unroll") for (int _i = 0; _i < 2; ++_i) { int _R, _C; stage_rc(tid * 16 + _i * 8192, _R, _C); \
        const int _row = GATHER ? S.row_of((u), _h * HALF + _R) : (_h * HALF + _R); (o)[_h][_i] = (unsigned)(_row * K + _C) * 2u; } } while (0)
    Unit cur, nxt; int ui = 0;
    if (!S.next(0, cur)) return;
    f32x4 acc[2][2][4][2];
#pragma unroll
    for (int a = 0; a < 2; ++a)
#pragma unroll
        for (int b = 0; b < 2; ++b)
#pragma unroll
            for (int m = 0; m < 4; ++m)
#pragma unroll
                for (int n = 0; n < 2; ++n) acc[a][b][m][n] = (f32x4){0.f, 0.f, 0.f, 0.f};
    bf16x8 At[4][2], B0[2][2], B1[2][2];
    unsigned offA[2][2], noffA[2][2];
    const char* cA = (const char*)g.A + (GATHER ? (size_t)0 : (size_t)cur.pm * tstep); const char* cB = (const char*)g.Bt + (size_t)cur.pb * tstep;
    S.a_ready(cur);
    PG8_AOFFS(offA, cur);
    PG8_STAGE(PG8_SB(0, 0), cB, voffB); PG8_STAGE(PG8_SB(0, 1), cB + hstep, voffB); PG8_STAGE(PG8_SA(0, 0), cA, offA[0]); PG8_STAGE(PG8_SA(0, 1), cA, offA[1]);
    if (wr == 1) PG8_BAR;
    PG8_WAIT_V(2); PG8_BAR;
    PG8_STAGE(PG8_SB(1, 0), cB + kstep, voffB); PG8_STAGE(PG8_SA(1, 0), cA + kstep, offA[0]); PG8_STAGE(PG8_SB(1, 1), cB + hstep + kstep, voffB);
    PG8_WAIT_V(6); PG8_BAR;
    for (;;) {
        const bool has_next = S.next(ui + 1, nxt);
        const char* nA = has_next ? (const char*)g.A + (GATHER ? (size_t)0 : (size_t)nxt.pm * tstep) : cA; const char* nB = has_next ? (const char*)g.Bt + (size_t)nxt.pb * tstep : cB;
        for (int t = 0; t < nt; t += 2) {
            const bool last = (t == nt - 2);
            const char* a1 = cA + (size_t)(t + 1) * kstep;
            const char* a2 = last ? nA : cA + (size_t)(t + 2) * kstep; const char* b2 = last ? nB : cB + (size_t)(t + 2) * kstep;
            const char* a3 = a2 + kstep; const char* b3 = b2 + kstep;
            if (last && has_next) S.a_ready(nxt);
            unsigned o2[2][2];
            if constexpr (GATHER) {
                if (last) { if (has_next) { PG8_AOFFS(noffA, nxt); } else {
#pragma unroll
                        for (int h = 0; h < 2; ++h) { noffA[h][0] = offA[h][0]; noffA[h][1] = offA[h][1]; } } }
#pragma unroll
                for (int h = 0; h < 2; ++h) { o2[h][0] = last ? noffA[h][0] : offA[h][0]; o2[h][1] = last ? noffA[h][1] : offA[h][1]; }
            } else {
#pragma unroll
                for (int h = 0; h < 2; ++h) { o2[h][0] = offA[h][0]; o2[h][1] = offA[h][1]; }
            }
            PG8_LDB(B0, 0, 0); PG8_LDB(B1, 0, 1); PG8_SCHED; PG8_LDA(At, 0, 0); PG8_STAGE(PG8_SA(1, 1), a1, offA[1]);
            PG8_WAIT_V(8); PG8_WAIT_L(0); PG8_BAR; PG8_MMA(0, 0, At, B0); PG8_MMA(0, 1, At, B1); PG8_BAR; PG8_SCHED;
            PG8_LDA(At, 0, 1); PG8_STAGE(PG8_SB(0, 0), b2, voffB); PG8_STAGE(PG8_SB(0, 1), b2 + hstep, voffB); PG8_STAGE(PG8_SA(0, 0), a2, o2[0]);
            PG8_WAIT_V(8); PG8_WAIT_L(0); PG8_BAR; PG8_MMA(1, 0, At, B0); PG8_MMA(1, 1, At, B1); PG8_BAR; PG8_SCHED;
            PG8_LDB(B0, 1, 0); PG8_LDB(B1, 1, 1); PG8_SCHED; PG8_LDA(At, 1, 0); PG8_STAGE(PG8_SA(0, 1), a2, o2[1]);
            PG8_WAIT_V(8); PG8_WAIT_L(0); PG8_BAR; PG8_MMA(0, 0, At, B0); PG8_MMA(0, 1, At, B1); PG8_BAR; PG8_SCHED;
            PG8_LDA(At, 1, 1); PG8_STAGE(PG8_SB(1, 0), b3, voffB); PG8_STAGE(PG8_SB(1, 1), b3 + hstep, voffB); PG8_STAGE(PG8_SA(1, 0), a3, o2[0]);
            PG8_WAIT_V(8); PG8_WAIT_L(0); PG8_BAR; PG8_MMA(1, 0, At, B0); PG8_MMA(1, 1, At, B1); PG8_BAR; PG8_SCHED;
        }
        if (wr == 0) PG8_BAR;
        E(acc, cur, wr, wc, fr, fq); S.done(cur);
        if (!has_next) break;
#pragma unroll
        for (int a = 0; a < 2; ++a)
#pragma unroll
            for (int b = 0; b < 2; ++b)
#pragma unroll
                for (int m = 0; m < 4; ++m)
#pragma unroll
                    for (int n = 0; n < 2; ++n) acc[a][b][m][n] = (f32x4){0.f, 0.f, 0.f, 0.f};
        cur = nxt; cA = nA; cB = nB; ++ui;
        if constexpr (GATHER) {
#pragma unroll
            for (int h = 0; h < 2; ++h) { offA[h][0] = noffA[h][0]; offA[h][1] = noffA[h][1]; } }
        if (wr == 1) PG8_BAR;
    }
    PG8_WAIT_V(0);
    PG8_BAR;
#undef PG8_SA
#undef PG8_SB
#undef PG8_STAGE
#undef PG8_LDA
#undef PG8_LDB
#undef PG8_MMA
#undef PG8_WAIT_V
#undef PG8_WAIT_L
#undef PG8_BAR
#undef PG8_SCHED
#undef PG8_AOFFS
}
}
#define GAS __attribute__((address_space(1)))
#define LAS __attribute__((address_space(3)))
typedef unsigned short bf16;
typedef unsigned v4u __attribute__((ext_vector_type(4)));
typedef float f32x4 __attribute__((ext_vector_type(4)));
typedef short bf16x8 __attribute__((ext_vector_type(8)));
typedef GAS unsigned gu32;
typedef GAS unsigned long long gu64;
#define RLX_AGENT __ATOMIC_RELAXED, __HIP_MEMORY_SCOPE_AGENT
#define LDS_WAIT() asm volatile("s_waitcnt lgkmcnt(0)" ::: "memory")
#define VM_WAIT() asm volatile("s_waitcnt vmcnt(0)" ::: "memory")
__device__ __forceinline__ unsigned long long rt() { return __builtin_amdgcn_s_memrealtime(); }
__device__ __forceinline__ unsigned f2bf(float f) { unsigned u = __builtin_bit_cast(unsigned, f); return (u + 0x7fffu + ((u >> 16) & 1u)) >> 16; }
__device__ __forceinline__ unsigned pk2(float lo, float hi) { return f2bf(lo) | (f2bf(hi) << 16); }

#define XB_TMO      128
#define XB_XCNT(j)  (256  + 64 * (j))
#define XB_XSUB(j)  (1280 + 64 * (j))
#define XB_XGEN(j)  (2304 + 64 * (j))
#define XB_TOP      3328
#define XB_TOPGEN   3392
#define XCD_BAR_WORDS 3456
#define XB_SPIN_CAP (1u << 18)

__device__ __forceinline__ unsigned xb_ld(unsigned* p)              { return __hip_atomic_load(p, __ATOMIC_RELAXED, __HIP_MEMORY_SCOPE_AGENT); }
__device__ __forceinline__ unsigned xb_add(unsigned* p, unsigned v) { return __hip_atomic_fetch_add(p, v, __ATOMIC_RELAXED, __HIP_MEMORY_SCOPE_AGENT); }
__device__ __forceinline__ unsigned xb_xcc_id() { return (unsigned)__builtin_amdgcn_s_getreg((3 << 11) | 20) & 0xFu; }
#define XB_SPIN(cond, bar) do { unsigned _sp = 0; while (cond) { __builtin_amdgcn_s_sleep(1); \
    if ((++_sp & 255u) == 0u) { if (xb_ld(&(bar)[XB_TMO])) break; if (_sp > XB_SPIN_CAP) { atomicAdd(&(bar)[XB_TMO], 1u); break; } } } } while (0)

struct XcdBarrier {
    unsigned* bar; unsigned x;
    volatile LAS unsigned* st;
};

__device__ __forceinline__ XcdBarrier xcd_barrier_post(unsigned* bar, volatile LAS unsigned* st) {
    XcdBarrier b; b.bar = bar; b.x = xb_xcc_id(); b.st = st;
    if (threadIdx.x == 0) (void)xb_add(&bar[XB_XCNT(b.x)], 1u);
    return b;
}
__device__ __forceinline__ void xcd_barrier_complete(unsigned* bar, unsigned x, unsigned& nloc, unsigned& nx) {
    const unsigned G = gridDim.x * gridDim.y * gridDim.z;
    unsigned sum, cnt, mine, sp = 0u;
    for (;;) {
        sum = 0u; cnt = 0u; mine = 0u;
#pragma unroll
        for (unsigned j = 0; j < 16; ++j) { const unsigned c = xb_ld(&bar[XB_XCNT(j)]); sum += c; cnt += (c > 0u) ? 1u : 0u; mine = (j == x) ? c : mine; }
        if (sum == G) break;
        __builtin_amdgcn_s_sleep(1);
        if ((++sp & 255u) == 0u) { if (xb_ld(&bar[XB_TMO])) break; if (sp > XB_SPIN_CAP) { atomicAdd(&bar[XB_TMO], 1u); break; } }
    }
    nloc = mine > 0u ? mine : 1u; nx = cnt > 0u ? cnt : 1u;
}

__device__ __forceinline__ void xcd_barrier(const XcdBarrier& b) {
    asm volatile("s_waitcnt vmcnt(0)" ::: "memory");
    __syncthreads();
    if (threadIdx.x == 0) {
        unsigned* bar = b.bar;
        __builtin_amdgcn_s_waitcnt(0);
        unsigned nloc = b.st[0], nx = b.st[1];
        if (nloc == 0u) { xcd_barrier_complete(bar, b.x, nloc, nx); b.st[0] = nloc; b.st[1] = nx; }
        const unsigned old = xb_add(&bar[XB_XSUB(b.x)], 1u);
        const unsigned gen = old / nloc;
        if (old + 1u == (gen + 1u) * nloc) {
            __builtin_amdgcn_fence(__ATOMIC_RELEASE, "agent");
            asm volatile("s_waitcnt vmcnt(0)" ::: "memory");
            const unsigned og = xb_add(&bar[XB_TOP], 1u);
            const unsigned tg = og / nx;
            if (og + 1u == (tg + 1u) * nx) xb_add(&bar[XB_TOPGEN], 1u);
            else XB_SPIN(xb_ld(&bar[XB_TOPGEN]) == tg, bar);
            __builtin_amdgcn_fence(__ATOMIC_ACQUIRE, "agent");
            xb_add(&bar[XB_XGEN(b.x)], 1u);
            asm volatile("s_waitcnt vmcnt(0)" ::: "memory");
        } else {
            XB_SPIN(xb_ld(&bar[XB_XGEN(b.x)]) == gen, bar);
            __builtin_amdgcn_fence(__ATOMIC_ACQUIRE, "agent");
            asm volatile("s_waitcnt vmcnt(0)" ::: "memory");
        }
    }
    __syncthreads();
}


constexpr int NWAVES = 8, NT = NWAVES * 64;
constexpr int D = 1024, BATCH = 8, SEQ = 4096, DEPTH = 2, GRIDW = 64, CTXL = 256, GWID = 256, HD = 64, NHEAD = 4;
constexpr int INC = 2048, NEXP = 16, MHID = 512;
constexpr int NLAT = BATCH * SEQ, NCTX = BATCH * CTXL, NROW = NLAT + NCTX;
constexpr float EPS = 1e-6f;
constexpr int UC_AV = 0, UC_AB = 256, UC_AC = 512, UC_P = 768, UC_Q = 1024, UC_K = 1280, UC_V = 1536, UC_F = 1792;

constexpr size_t MiB = 1u << 20;
constexpr size_t WS_CTL = 0, CTL_ZERO_BYTES = 65536;
constexpr size_t WS_MOD  = 1 * MiB;
constexpr size_t WS_PWT  = 1 * MiB + 768 * 1024;
constexpr size_t WS_INFO = 2 * MiB;
constexpr size_t WS_BM   = 7 * MiB;
constexpr size_t WS_WIN  = 8 * MiB;
constexpr size_t WS_WOUT = 16 * MiB;
constexpr size_t WS_W13  = 20 * MiB;
constexpr size_t WS_W2   = 84 * MiB;
constexpr size_t WS_XC   = 116 * MiB;
constexpr size_t WS_H    = 124 * MiB;
constexpr size_t WS_U    = 192 * MiB;
constexpr size_t WS_S    = 328 * MiB;
constexpr size_t WS_END  = 472 * MiB;
constexpr size_t WS_KF   = WS_S;
constexpr size_t WS_VF   = WS_S + 28 * MiB;
constexpr size_t WS_KFC  = WS_S + 60 * MiB;
constexpr size_t WS_VFC  = WS_S + 61 * MiB;
constexpr size_t WS_Z    = WS_S + 64 * MiB;
constexpr size_t NZ = (size_t)BATCH * NHEAD * SEQ * HD;
constexpr size_t NZC = (size_t)BATCH * NHEAD * CTXL * HD;
constexpr int CAP = NROW;

constexpr int CW_CNT = 2048;
constexpr int CW_BAR = 4096;

constexpr int RING_OFF = 0, RING_BYTES = 131072;
constexpr int LDSCTL_OFF = RING_BYTES, MISC_OFF = LDSCTL_OFF + 320;
constexpr int TAB_OFF = RING_BYTES + 1024;
constexpr int LDS_BYTES = 147456;

struct Frame {
    LAS unsigned char* lds;
    volatile LAS unsigned* MISC;
    gu32* ctl;
    int tid, lane, wave, G, bid;
    float* out; unsigned char* ws;
    static __device__ __forceinline__ const void* karg(int off) {
        const __attribute__((address_space(4))) char* ka = (const __attribute__((address_space(4))) char*)__builtin_amdgcn_kernarg_segment_ptr();
        asm volatile("" : "+s"(ka));
        return *(const void* const __attribute__((address_space(4)))*)(ka + off);
    }
    __device__ __forceinline__ const float* inp(int i) const { return (const float*)karg(8 * i); }
};
extern __shared__ __attribute__((aligned(16))) unsigned char dyn_lds[];
__device__ __forceinline__ Frame mk_frame() {
    Frame F; int t_ = threadIdx.x; asm volatile("" : "+v"(t_));
    F.tid = t_; F.lane = F.tid & 63; F.wave = __builtin_amdgcn_readfirstlane(F.tid >> 6); F.G = gridDim.x; F.bid = blockIdx.x;
    F.lds = (LAS unsigned char*)dyn_lds; F.MISC = (volatile LAS unsigned*)(F.lds + MISC_OFF);
    F.out = (float*)Frame::karg(160); F.ws = (unsigned char*)Frame::karg(168); F.ctl = (gu32*)(F.ws + WS_CTL);
    return F;
}
enum { I_X = 0, I_C, I_CTX, I_CCTX, I_ADAW, I_ADAB, I_N1G, I_N2G, I_WIN, I_CONVW, I_POOLW, I_POOLS, I_RPB, I_WOUT, I_RW, I_RB, I_W1, I_W3, I_W2, I_FG };

__device__ __forceinline__ float wave_sum(float v) {
#pragma unroll
    for (int o = 1; o < 64; o <<= 1) v += __shfl_xor(v, o);
    return v;
}
__device__ __forceinline__ float bflo(unsigned w) { return __builtin_bit_cast(float, w << 16); }
__device__ __forceinline__ float bfhi(unsigned w) { return __builtin_bit_cast(float, w & 0xffff0000u); }
__device__ __forceinline__ float bf2f(bf16 b) { return __builtin_bit_cast(float, (unsigned)b << 16); }

__device__ __forceinline__ void tr_item(const float* W, int K, int N, bf16* WT, int k0, int n0, int drow0, LAS float* scr, int lane) {
#pragma unroll
    for (int i = 0; i < 8; ++i) { const int kk = 8 * i + (lane >> 3), n4 = 4 * (lane & 7); const f32x4 w = *(const GAS f32x4*)(W + (size_t)(k0 + kk) * N + n0 + n4);
        LAS float* sp = scr + kk * 33 + n4; sp[0] = w.x; sp[1] = w.y; sp[2] = w.z; sp[3] = w.w; }
    LDS_WAIT(); asm volatile("" ::: "memory");
    const int c = lane & 7;
#pragma unroll
    for (int j = 0; j < 4; ++j) { const int n = (lane >> 3) + 8 * j; const LAS float* s = scr + (8 * c) * 33 + n;
        v4u o; o.x = pk2(s[0 * 33], s[1 * 33]); o.y = pk2(s[2 * 33], s[3 * 33]); o.z = pk2(s[4 * 33], s[5 * 33]); o.w = pk2(s[6 * 33], s[7 * 33]);
        *(GAS v4u*)(WT + (size_t)(drow0 + n) * K + k0 + 8 * c) = o; }
    LDS_WAIT(); asm volatile("" ::: "memory");
}
__device__ __forceinline__ void pa_phase() { Frame F = mk_frame();
    LAS float* scr = (LAS float*)(F.lds + RING_OFF + F.wave * 16384);
    const int gw = F.bid * NWAVES + F.wave, NGW = F.G * NWAVES;
    bf16* WIN = (bf16*)(F.ws + WS_WIN); bf16* WOUT = (bf16*)(F.ws + WS_WOUT); bf16* W13 = (bf16*)(F.ws + WS_W13); bf16* W2 = (bf16*)(F.ws + WS_W2);
    constexpr int I_IN = 2 * 16 * 64, I_OUT = 2 * 16 * 32, I_1 = 32 * 16 * 16, I_2 = 32 * 8 * 32;
    constexpr int NITEMS = I_IN + I_OUT + 2 * I_1 + I_2;
    for (int it = gw; it < NITEMS; it += NGW) {
        int r = it;
        if (r < I_IN) { const int l = r / 1024, q = r % 1024, kb = q / 64, nb = q % 64;
            tr_item(F.inp(I_WIN) + (size_t)l * D * INC, D, INC, WIN + (size_t)l * INC * D, 64 * kb, 32 * nb, 32 * nb, scr, F.lane); continue; } r -= I_IN;
        if (r < I_OUT) { const int l = r / 512, q = r % 512, kb = q / 32, nb = q % 32;
            tr_item(F.inp(I_WOUT) + (size_t)l * D * D, D, D, WOUT + (size_t)l * D * D, 64 * kb, 32 * nb, 32 * nb, scr, F.lane); continue; } r -= I_OUT;
        if (r < 2 * I_1) { const int which = r / I_1; const int q0 = r % I_1; const int le = q0 / 256, q = q0 % 256, kb = q / 16, nb = q % 16;
            const int n0 = 32 * nb; const int drow0 = 256 * (n0 / 128) + 128 * which + (n0 % 128);
            tr_item(F.inp(which ? I_W3 : I_W1) + (size_t)le * D * MHID, D, MHID, W13 + (size_t)le * 1024 * D, 64 * kb, n0, drow0, scr, F.lane); continue; } r -= 2 * I_1;
        { const int le = r / 256, q = r % 256, kb = q / 32, nb = q % 32;
            tr_item(F.inp(I_W2) + (size_t)le * MHID * D, MHID, D, W2 + (size_t)le * D * MHID, 64 * kb, 32 * nb, 32 * nb, scr, F.lane); }
    }
    { bf16* PWT = (bf16*)(F.ws + WS_PWT); const float* pw = F.inp(I_POOLW);
      for (int i = F.bid * NT + F.tid; i < 2 * 4 * 64 * 64; i += F.G * NT) { const int c = i & 63, dd = (i >> 6) & 63, lg = i >> 12; PWT[i] = (bf16)f2bf(pw[((size_t)lg * 64 + c) * 64 + dd]); } }
    __syncthreads();
    LAS float* sc = (LAS float*)(F.lds + RING_OFF);
    LAS float* part = (LAS float*)(F.lds + RING_OFF + 40960);
    float* MOD = (float*)(F.ws + WS_MOD);
    bool have_sc = false;
    for (int it = F.bid; it < 2 * 96; it += F.G) {
        if (!have_sc) { for (int i = F.tid; i < 9 * 1024; i += NT) { const float v = i < 8192 ? F.inp(I_C)[i] : F.inp(I_CCTX)[i - 8192]; sc[i] = v / (1.0f + __expf(-v)); } have_sc = true; }
        __syncthreads();
        const int l = it / 96, cb = it % 96, col = cb * 64 + F.lane;
        const float* aw = F.inp(I_ADAW) + (size_t)l * D * 6144 + col;
        float acc[9];
#pragma unroll
        for (int r = 0; r < 9; ++r) acc[r] = 0.f;
        for (int k = F.wave * 128; k < F.wave * 128 + 128; ++k) { const float wv = aw[(size_t)k * 6144];
#pragma unroll
            for (int r = 0; r < 9; ++r) acc[r] += sc[r * 1024 + k] * wv; }
#pragma unroll
        for (int r = 0; r < 9; ++r) part[(F.wave * 9 + r) * 64 + F.lane] = acc[r];
        __syncthreads();
        for (int i = F.tid; i < 9 * 64; i += NT) { const int r = i >> 6, ln = i & 63; float s = F.inp(I_ADAB)[(size_t)l * 6144 + cb * 64 + ln];
#pragma unroll
            for (int w = 0; w < 8; ++w) s += part[(w * 9 + r) * 64 + ln];
            MOD[((size_t)l * 9 + r) * 6144 + cb * 64 + ln] = s; }
        __syncthreads();
    }
}

typedef unsigned v2u_ __attribute__((ext_vector_type(2)));
__device__ __forceinline__ unsigned cvt_pk_bf(float lo, float hi) { unsigned r; asm volatile("v_cvt_pk_bf16_f32 %0, %1, %2" : "=v"(r) : "v"(lo), "v"(hi)); return r; }
struct XStream { const char* lat; const char* ctx; int lat_stride, ctx_stride;
    __device__ __forceinline__ const char* row(int r) const { return r < NLAT ? lat + (size_t)r * lat_stride : ctx + (size_t)(r - NLAT) * ctx_stride; } };
struct RowIn { f32x4 x[4]; unsigned long long xb[4], ya[4], yb[4]; };
__device__ __forceinline__ f32x4 unpk4(unsigned long long a) { f32x4 y; y.x = bflo((unsigned)a); y.y = bfhi((unsigned)a); y.z = bflo((unsigned)(a >> 32)); y.w = bfhi((unsigned)(a >> 32)); return y; }
template <int ADD, bool XBF>
__device__ __forceinline__ void row_load(Frame& F, int r, const char* xr, const bf16* Y2, RowIn& in) {
#pragma unroll
    for (int j = 0; j < 4; ++j) { const int c = 4 * F.lane + 256 * j;
        if (XBF) in.xb[j] = *(const GAS unsigned long long*)(xr + 2 * c); else in.x[j] = *(const GAS f32x4*)(xr + 4 * c);
        if (ADD == 1) { in.ya[j] = *(const GAS unsigned long long*)(Y2 + (size_t)r * 2048 + c); in.yb[j] = *(const GAS unsigned long long*)(Y2 + (size_t)r * 2048 + 1024 + c); }
        if (ADD == 2) { in.ya[j] = *(const GAS unsigned long long*)(Y2 + (size_t)r * 1024 + c); } }
}
struct RowPar { f32x4 a[4], b[4], gt[4]; int modrow; };
template <int ADD, bool FINAL>
__device__ __forceinline__ void row_params(Frame& F, int modrow, const float* g, const float* modl, const float* modadd, int ch_sh, int ch_sc, RowPar& P) {
    P.modrow = modrow;
#pragma unroll
    for (int j = 0; j < 4; ++j) { const int c = 4 * F.lane + 256 * j; const f32x4 gv = *(const GAS f32x4*)(g + c);
        if (FINAL) { P.a[j] = gv; P.b[j] = (f32x4){0.f, 0.f, 0.f, 0.f}; }
        else { const float* mrow = modl + (size_t)modrow * 6144; P.a[j] = gv * (*(const GAS f32x4*)(mrow + ch_sc * 1024 + c) + 1.0f); P.b[j] = *(const GAS f32x4*)(mrow + ch_sh * 1024 + c); }
        if (ADD) P.gt[j] = *(const GAS f32x4*)(modadd + (size_t)modrow * 6144 + (ADD == 1 ? 5 : 2) * 1024 + c); else P.gt[j] = (f32x4){0.f, 0.f, 0.f, 0.f}; }
}
template <int ADD, bool FINAL, bool XBF>
__device__ __forceinline__ void row_finish(Frame& F, const RowIn& in, const RowPar& P, char* xw, bf16* dst, float* fout, f32x4 (&v)[4]) {
    float ss = 0.f;
#pragma unroll
    for (int j = 0; j < 4; ++j) { const int c = 4 * F.lane + 256 * j; v[j] = XBF ? unpk4(in.xb[j]) : in.x[j];
        if (ADD) { f32x4 ya = unpk4(in.ya[j]); if (ADD == 1) ya = ya + unpk4(in.yb[j]);
            v[j] = v[j] + P.gt[j] * ya;
            if (!FINAL) *(GAS v2u_*)(xw + 2 * c) = (v2u_){cvt_pk_bf(v[j].x, v[j].y), cvt_pk_bf(v[j].z, v[j].w)}; }
        ss += (v[j].x * v[j].x + v[j].y * v[j].y) + (v[j].z * v[j].z + v[j].w * v[j].w); }
    ss = wave_sum(ss);
    const float rstd = 1.0f / sqrtf(ss * (1.0f / D) + EPS);
#pragma unroll
    for (int j = 0; j < 4; ++j) { const int c = 4 * F.lane + 256 * j;
        if (FINAL) { *(GAS f32x4*)(fout + c) = v[j] * rstd * P.a[j]; }
        else { v[j] = v[j] * rstd * P.a[j] + P.b[j];
            *(GAS v2u_*)(dst + c) = (v2u_){cvt_pk_bf(v[j].x, v[j].y), cvt_pk_bf(v[j].z, v[j].w)}; } }
}
template <int ADD, bool FINAL, bool XBF>
__device__ __forceinline__ void norm_phase(Frame& F, const XStream xin, const XStream xout, int nrows, const float* g, const float* modl, const float* modadd, int ch_sh, int ch_sc, bf16* dst, const bf16* Y2, float* fout) {
    const int rpb = (nrows + F.G - 1) / F.G;
    int i = F.wave; int r = F.bid * rpb + i; if (i >= rpb || r >= nrows) return;
    RowIn cur; row_load<ADD, XBF>(F, r, xin.row(r), Y2, cur);
    RowPar P; P.modrow = -1;
    for (;;) {
        const int in_ = i + NWAVES, rn = F.bid * rpb + in_; const bool more = (in_ < rpb) && (rn < nrows);
        RowIn nxt;
        if (more) row_load<ADD, XBF>(F, rn, xin.row(rn), Y2, nxt);
        const int modrow = r < NLAT ? (r >> 12) : 8;
        if (modrow != P.modrow) row_params<ADD, FINAL>(F, modrow, g, modl, modadd, ch_sh, ch_sc, P);
        f32x4 v[4];
        row_finish<ADD, FINAL, XBF>(F, cur, P, (char*)xout.row(r), dst + (size_t)r * D, fout + (size_t)r * D, v);
        if (!more) break;
        cur = nxt; r = rn; i = in_;
    }
}
template <bool XBF>
__device__ __forceinline__ void route_phase(Frame& F, int l, const XStream xin, const XStream xout, const bf16* O, int nrows, const float* g, const float* modl, bf16* dst, uint2* info, unsigned* cnt) {
    LAS int* lcnt = (LAS int*)(F.lds + RING_OFF); LAS int* lbase = lcnt + 16; LAS int* rec_e = lcnt + 32; LAS int* rec_p = rec_e + 512; LAS float* rec_w = (LAS float*)(rec_p + 512);
    const int rpb = (nrows + F.G - 1) / F.G;
    if (F.tid < 16) lcnt[F.tid] = 0;
    LAS float* WT = (LAS float*)(F.lds + RING_OFF + 32768);
    LAS float* LG = (LAS float*)(F.lds + RING_OFF + 8192);
    { const float* rwp = F.inp(I_RW); for (int i = F.tid; i < 1024 * 16; i += NT) { const int k = i >> 4, e = i & 15; WT[e * 1024 + k] = rwp[i]; } }
    __syncthreads();
    const float* rbp = F.inp(I_RB);
    RowPar P; P.modrow = -1;
    RowIn cur; bool have = (F.wave < rpb) && (F.bid * rpb + F.wave < nrows);
    if (have) { const int r = F.bid * rpb + F.wave; row_load<2, XBF>(F, r, xin.row(r), O, cur); }
    for (int i = F.wave; have; i += NWAVES) {
        const int r = F.bid * rpb + i;
        const int in_ = i + NWAVES, rn = F.bid * rpb + in_; const bool more = (in_ < rpb) && (rn < nrows);
        RowIn nxt;
        if (more) row_load<2, XBF>(F, rn, xin.row(rn), O, nxt);
        f32x4 v[4];
        { const int modrow = r < NLAT ? (r >> 12) : 8; if (modrow != P.modrow) row_params<2, false>(F, modrow, g, modl, modl, 3, 4, P); }
        row_finish<2, false, XBF>(F, cur, P, (char*)xout.row(r), dst + (size_t)r * D, nullptr, v);
        typedef float f32x2 __attribute__((ext_vector_type(2)));
        f32x2 s2[16];
#pragma unroll
        for (int e = 0; e < 16; ++e) s2[e] = (f32x2){0.f, 0.f};
#pragma unroll
        for (int j = 0; j < 4; ++j) { const f32x2 vlo = (f32x2){v[j].x, v[j].y}, vhi = (f32x2){v[j].z, v[j].w};
#pragma unroll
            for (int e = 0; e < 16; ++e) { const f32x4 w4 = *(const LAS f32x4*)(WT + e * 1024 + 4 * F.lane + 256 * j); s2[e] += vlo * (f32x2){w4.x, w4.y}; s2[e] += vhi * (f32x2){w4.z, w4.w}; } }
        float s16[16];
#pragma unroll
        for (int e = 0; e < 16; ++e) s16[e] = s2[e].x + s2[e].y;
        { float a8[8], a4[4], a2[2]; const bool h5 = F.lane & 32, h4 = F.lane & 16, h3 = F.lane & 8, h2 = F.lane & 4;
#pragma unroll
          for (int k = 0; k < 8; ++k) { const float send = h5 ? s16[k] : s16[k + 8], keep = h5 ? s16[k + 8] : s16[k]; a8[k] = keep + __shfl_xor(send, 32); }
#pragma unroll
          for (int k = 0; k < 4; ++k) { const float send = h4 ? a8[k] : a8[k + 4], keep = h4 ? a8[k + 4] : a8[k]; a4[k] = keep + __shfl_xor(send, 16); }
#pragma unroll
          for (int k = 0; k < 2; ++k) { const float send = h3 ? a4[k] : a4[k + 2], keep = h3 ? a4[k + 2] : a4[k]; a2[k] = keep + __shfl_xor(send, 8); }
          const float send = h2 ? a2[0] : a2[1], keep = h2 ? a2[1] : a2[0]; float a1 = keep + __shfl_xor(send, 4);
          a1 += __shfl_xor(a1, 1); a1 += __shfl_xor(a1, 2);
          if ((F.lane & 3) == 0) LG[i * 17 + 8 * ((F.lane >> 5) & 1) + 4 * ((F.lane >> 4) & 1) + 2 * ((F.lane >> 3) & 1) + ((F.lane >> 2) & 1)] = a1; }
        have = more; cur = nxt;
    }
    __syncthreads();
    for (int i = F.tid; i < rpb; i += NT) { if (F.bid * rpb + i >= nrows) break;
        float s16[16], bs[16];
#pragma unroll
        for (int e = 0; e < 16; ++e) { s16[e] = 1.0f / (1.0f + expf(-LG[i * 17 + e])); bs[e] = s16[e] + rbp[e]; }
        float best = -3.0e38f; int bg = 0;
#pragma unroll
        for (int gq = 0; gq < 4; ++gq) { const float a0 = bs[4 * gq], a1 = bs[4 * gq + 1], a2 = bs[4 * gq + 2], a3 = bs[4 * gq + 3];
            const float gs = fmaxf(fmaxf(fmaxf(a0 + a1, a0 + a2), fmaxf(a0 + a3, a1 + a2)), fmaxf(a1 + a3, a2 + a3));
            if (gs > best) { best = gs; bg = gq; } }
        float cb[4], cs[4];
#pragma unroll
        for (int ii = 0; ii < 4; ++ii) { cb[ii] = 0.f; cs[ii] = 0.f; }
#pragma unroll
        for (int gq = 0; gq < 4; ++gq)
#pragma unroll
            for (int ii = 0; ii < 4; ++ii) { cb[ii] = (gq == bg) ? bs[4 * gq + ii] : cb[ii]; cs[ii] = (gq == bg) ? s16[4 * gq + ii] : cs[ii]; }
        int i1 = 0; float b1 = cb[0], s1 = cs[0];
#pragma unroll
        for (int ii = 1; ii < 4; ++ii) if (cb[ii] > b1) { b1 = cb[ii]; s1 = cs[ii]; i1 = ii; }
        int i2 = -1; float b2 = -3.0e38f, s2 = 0.f;
#pragma unroll
        for (int ii = 0; ii < 4; ++ii) if (ii != i1 && cb[ii] > b2) { b2 = cb[ii]; s2 = cs[ii]; i2 = ii; }
        const float inv = 1.0f / (s1 + s2);
        const int e1 = 4 * bg + i1, e2 = 4 * bg + i2;
        rec_e[2 * i] = e1; rec_p[2 * i] = atomicAdd((int*)&lcnt[e1], 1); rec_w[2 * i] = s1 * inv;
        rec_e[2 * i + 1] = e2; rec_p[2 * i + 1] = atomicAdd((int*)&lcnt[e2], 1); rec_w[2 * i + 1] = s2 * inv;
    }
    __syncthreads();
    if (F.tid < 16) lbase[F.tid] = (int)__hip_atomic_fetch_add(cnt + F.tid, (unsigned)lcnt[F.tid], __ATOMIC_RELAXED, __HIP_MEMORY_SCOPE_AGENT);
    __syncthreads();
    for (int j = F.tid; j < 2 * rpb; j += NT) { const int r = F.bid * rpb + (j >> 1); if (r < nrows) { const int e = rec_e[j];
        info[(size_t)e * CAP + lbase[e] + rec_p[j]] = make_uint2((unsigned)(r * 2 + (j & 1)), __builtin_bit_cast(unsigned, rec_w[j])); } }
}
__device__ __forceinline__ void moe_table(Frame& F, int l) {
    LAS int* tab = (LAS int*)(F.lds + TAB_OFF);
    if (F.tid == 0) { int acc = 0; const unsigned* cnt = (const unsigned*)(F.ctl + CW_CNT + l * 16);
        for (int e = 0; e < 16; ++e) { const int n = (int)__hip_atomic_load(cnt + e, __ATOMIC_RELAXED, __HIP_MEMORY_SCOPE_AGENT); tab[e] = acc; tab[17 + e] = n; acc += (n + 255) >> 8; }
        tab[16] = acc; }
    __syncthreads();
}

__device__ __forceinline__ void seq_info(int r, int& base, int& t, int& L) {
    if (r < NLAT) { base = r & ~(SEQ - 1); t = r & (SEQ - 1); L = SEQ; } else { const int j = r - NLAT; base = NLAT + (j & ~(CTXL - 1)); t = j & (CTXL - 1); L = CTXL; }
}
typedef unsigned v2u __attribute__((ext_vector_type(2)));
__device__ __forceinline__ unsigned cvtpk(float lo, float hi) { unsigned r; asm volatile("v_cvt_pk_bf16_f32 %0, %1, %2" : "=v"(r) : "v"(lo), "v"(hi)); return r; }
__device__ __forceinline__ bf16x8 mk8(v2u a, v2u b) { v4u w; w.x = a.x; w.y = a.y; w.z = b.x; w.w = b.y; return __builtin_bit_cast(bf16x8, w); }
template <bool LAT>
__device__ __forceinline__ void kv_unit(Frame& F, int bh, int rq, LAS unsigned short* T) {
    const bf16* U = (const bf16*)(F.ws + WS_U);
    const int q = F.lane & 15, g = F.lane >> 4, h = bh & 3;
    const int urow0 = LAT ? ((bh >> 2) * SEQ + rq * 64) : (NLAT + (bh >> 2) * CTXL + rq * 64);
    bf16* kdst = LAT ? (bf16*)(F.ws + WS_KF) + ((size_t)(bh * 64 + rq) * 14) * 512 : (bf16*)(F.ws + WS_KFC) + ((size_t)(bh * 16 + rq * 4) * 2) * 512;
    bf16* vdst = LAT ? (bf16*)(F.ws + WS_VF) + ((size_t)(bh * 64 + rq) * 16) * 512 : (bf16*)(F.ws + WS_VFC) + ((size_t)(bh * 8 + rq * 2) * 4) * 512;
    { const bf16* src = U + (size_t)(urow0 + F.lane) * INC + UC_V + h * HD;
#pragma unroll
      for (int p = 0; p < 8; ++p) { const v4u w = *(const GAS v4u*)(src + 8 * p); LAS unsigned short* tp = T + (8 * p) * 72 + F.lane;
          tp[0 * 72] = (unsigned short)w.x; tp[1 * 72] = (unsigned short)(w.x >> 16); tp[2 * 72] = (unsigned short)w.y; tp[3 * 72] = (unsigned short)(w.y >> 16);
          tp[4 * 72] = (unsigned short)w.z; tp[5 * 72] = (unsigned short)(w.z >> 16); tp[6 * 72] = (unsigned short)w.w; tp[7 * 72] = (unsigned short)(w.w >> 16); } }
    constexpr int NK = LAT ? 7 : 4, KST = LAT ? 8 : 16;
#pragma unroll
    for (int sidx = 0; sidx < NK; ++sidx)
#pragma unroll
        for (int ks = 0; ks < 2; ++ks) { const v4u w = *(const GAS v4u*)(U + (size_t)(urow0 + KST * sidx + q) * INC + UC_K + h * HD + 32 * ks + 8 * g); *(GAS v4u*)(kdst + (size_t)(sidx * 2 + ks) * 512 + F.lane * 8) = w; }
    LDS_WAIT(); asm volatile("" ::: "memory");
    constexpr int NV = LAT ? 4 : 2;
#pragma unroll
    for (int w = 0; w < NV; ++w) { const int vst = LAT ? (w == 0 ? 0 : (w == 1 ? 8 : (w == 2 ? 24 : 32))) : 32 * w;
#pragma unroll
        for (int dt = 0; dt < 4; ++dt) { const LAS unsigned short* tp = T + (16 * dt + q) * 72 + vst + 4 * g; const v2u lo = *(const LAS v2u*)tp, hi = *(const LAS v2u*)(tp + 16);
            v4u o; o.x = lo.x; o.y = lo.y; o.z = hi.x; o.w = hi.y; *(GAS v4u*)(vdst + (size_t)(w * 4 + dt) * 512 + F.lane * 8) = o; } }
    LDS_WAIT(); asm volatile("" ::: "memory");
}
__device__ __forceinline__ void kv_prepass(Frame& F) {
    LAS unsigned short* T = (LAS unsigned short*)(F.lds + RING_OFF + F.wave * 16384);
    const int gw = F.bid * NWAVES + F.wave, NGW = F.G * NWAVES;
#pragma unroll 1
    for (int idx = gw; idx < 2048; idx += NGW) kv_unit<true>(F, idx >> 6, idx & 63, T);
#pragma unroll 1
    for (int idx = gw; idx < 128; idx += NGW) kv_unit<false>(F, idx >> 2, idx & 3, T);
}
__device__ __forceinline__ void bias_table(Frame& F, int l) {
    float* BM = (float*)(F.ws + WS_BM); const float* rp = F.inp(I_RPB) + (size_t)l * NHEAD * 15 * 31;
    for (int i = F.bid * NT + F.tid; i < 4 * 4 * 15 * 64 * 8; i += F.G * NT) {
        const int e = i & 7, lane = (i >> 3) & 63, rrel = (i >> 9) % 15, hc = (i >> 9) / 15, cb = hc & 3, h = hc >> 2;
        const int q = lane & 15, g = lane >> 4, seg = e >> 2, ii = e & 3;
        const int wb = cb * 16 - 8 < 0 ? 0 : (cb * 16 - 8 > 32 ? 32 : cb * 16 - 8);
        const int cq = cb * 16 + q, c0 = cq - 8 < 0 ? 0 : (cq - 8 > 48 ? 48 : cq - 8), cc = wb + seg * 16 + 4 * g + ii;
        const bool ok = (cc >= c0) && (cc < c0 + 16);
        BM[i] = ok ? rp[(h * 15 + rrel) * 31 + (cc - cq + 15)] : -3.0e38f;
    }
}
template <bool LAT>
__device__ __forceinline__ void attn_unit(Frame& F, int l, int b, int h, int r, int cb, const LAS float* rpbs) {
    const bf16* U = (const bf16*)(F.ws + WS_U); bf16* Y = (bf16*)(F.ws + WS_H);
    const bf16* KF = (const bf16*)(F.ws + WS_KF); const bf16* VF = (const bf16*)(F.ws + WS_VF); const bf16* KFC = (const bf16*)(F.ws + WS_KFC); const bf16* VFC = (const bf16*)(F.ws + WS_VFC);
    const size_t bh = (size_t)(b * NHEAD + h);
    const int q = F.lane & 15, g = F.lane >> 4;
    constexpr int NT_ = LAT ? 32 : 16, NB = LAT ? 16 : 0;
    const int qrow = LAT ? (b * SEQ + r * GRIDW + cb * 16 + q) : (NLAT + b * CTXL + cb * 16 + q);
    const int r0 = r - 4 < 0 ? 0 : (r - 4 > 56 ? 56 : r - 4);
    const int wb = cb * 16 - 8 < 0 ? 0 : (cb * 16 - 8 > 32 ? 32 : cb * 16 - 8);
    bf16x8 qf[2];
#pragma unroll
    for (int ks = 0; ks < 2; ++ks) qf[ks] = *(const GAS bf16x8*)(U + (size_t)qrow * INC + UC_Q + h * HD + 32 * ks + 8 * g);
    f32x4 s[NT_];
#pragma unroll
    for (int t = 0; t < NT_; ++t) {
        const bf16* kp;
        if (t < NB) { const int kr = t >> 1, seg = t & 1; kp = KF + (((bh * 64 + (r0 + kr)) * 7 + ((wb >> 3) + 2 * seg)) * 2) * 512 + F.lane * 8; } else kp = KFC + ((bh * 16 + (t - NB)) * 2) * 512 + F.lane * 8;
        const bf16x8 k0 = *(const GAS bf16x8*)kp, k1 = *(const GAS bf16x8*)(kp + 512);
        f32x4 a = (f32x4){0.f, 0.f, 0.f, 0.f};
        a = __builtin_amdgcn_mfma_f32_16x16x32_bf16(k0, qf[0], a, 0, 0, 0);
        s[t] = __builtin_amdgcn_mfma_f32_16x16x32_bf16(k1, qf[1], a, 0, 0, 0);
    }
    float m = -3.0e38f;
    if (LAT) {
        const float* bm = (const float*)(F.ws + WS_BM) + ((size_t)((h * 4 + cb) * 15 + (r0 - r + 7)) * 64 + F.lane) * 8;
#pragma unroll
        for (int kr = 0; kr < 8; ++kr) { const f32x4 b0 = *(const GAS f32x4*)(bm + kr * 512), b1 = *(const GAS f32x4*)(bm + kr * 512 + 4);
#pragma unroll
            for (int i = 0; i < 4; ++i) { const float v0 = s[2 * kr][i] * 0.125f + b0[i], v1 = s[2 * kr + 1][i] * 0.125f + b1[i]; s[2 * kr][i] = v0; s[2 * kr + 1][i] = v1; m = fmaxf(m, fmaxf(v0, v1)); } }
    }
#pragma unroll
    for (int t = NB; t < NT_; ++t)
#pragma unroll
        for (int i = 0; i < 4; ++i) { const float v = s[t][i] * 0.125f; s[t][i] = v; m = fmaxf(m, v); }
    m = fmaxf(m, __shfl_xor(m, 16)); m = fmaxf(m, __shfl_xor(m, 32));
    float sum = 0.f;
#pragma unroll
    for (int t = 0; t < NT_; ++t)
#pragma unroll
        for (int i = 0; i < 4; ++i) { const float p = __expf(s[t][i] - m); s[t][i] = p; sum += p; }
    sum += __shfl_xor(sum, 16); sum += __shfl_xor(sum, 32);
    f32x4 o[4];
#pragma unroll
    for (int dt = 0; dt < 4; ++dt) o[dt] = (f32x4){0.f, 0.f, 0.f, 0.f};
#pragma unroll
    for (int kk = 0; kk < NT_ / 2; ++kk) {
        v4u pw; pw.x = cvtpk(s[2 * kk][0], s[2 * kk][1]); pw.y = cvtpk(s[2 * kk][2], s[2 * kk][3]); pw.z = cvtpk(s[2 * kk + 1][0], s[2 * kk + 1][1]); pw.w = cvtpk(s[2 * kk + 1][2], s[2 * kk + 1][3]);
        const bf16x8 pf = __builtin_bit_cast(bf16x8, pw);
        const bf16* vbase;
        if (2 * kk < NB) vbase = VF + (((bh * 64 + (r0 + kk)) * 4 + cb) * 4) * 512 + F.lane * 8; else vbase = VFC + ((bh * 8 + (kk - NB / 2)) * 4) * 512 + F.lane * 8;
#pragma unroll
        for (int dt = 0; dt < 4; ++dt) { const bf16x8 vf = *(const GAS bf16x8*)(vbase + dt * 512);
            o[dt] = __builtin_amdgcn_mfma_f32_16x16x32_bf16(vf, pf, o[dt], 0, 0, 0); }
    }
    const float inv = 1.0f / sum; bf16* yp = Y + (size_t)qrow * D + 512 + h * HD + 4 * g;
#pragma unroll
    for (int dt = 0; dt < 4; ++dt) { v2u w; w.x = cvtpk(o[dt][0] * inv, o[dt][1] * inv); w.y = cvtpk(o[dt][2] * inv, o[dt][3] * inv); *(GAS v2u*)(yp + dt * 16) = w; }
}
__device__ __forceinline__ void attn_phase(Frame& F, int l, bool with_ctx) {
    const LAS float* rpbs = nullptr;
    const int gw = F.bid * NWAVES + F.wave, NGW = F.G * NWAVES;
    {
        const int x = F.bid & 7, lb = F.bid >> 3, nlb = (F.G - x + 7) >> 3;
#pragma unroll 1
        for (int uu = lb * NWAVES + F.wave; uu < 1024; uu += nlb * NWAVES) { const int bh = 4 * x + (uu >> 8), u = uu & 255; attn_unit<true>(F, l, bh >> 2, bh & 3, u >> 2, u & 3, rpbs); } }
    if (with_ctx) for (int uid = gw; uid < BATCH * NHEAD * 16; uid += NGW) { const int cb = uid & 15, h = (uid >> 4) & 3, b = uid >> 6; attn_unit<false>(F, l, b, h, 0, cb, rpbs); }
}
__device__ __forceinline__ void dft64_tables(Frame& F, int off) {
    LAS unsigned short* CT = (LAS unsigned short*)(F.lds + off); LAS unsigned short* ST = CT + 64 * 72;
    for (int i = F.tid; i < 4096; i += NT) { const int j = i >> 6, k = i & 63; float s_, c_; sincospif((float)((j * k) & 63) * (1.0f / 32.0f), &s_, &c_); CT[j * 72 + k] = (unsigned short)f2bf(c_); ST[j * 72 + k] = (unsigned short)f2bf(s_); }
}
__device__ __forceinline__ void fourier_a(Frame& F) {
    const bf16* U = (const bf16*)(F.ws + WS_U); bf16* Zr = (bf16*)(F.ws + WS_Z); bf16* Zi = Zr + NZ;
    constexpr int O_CT = 0, O_TWC = 18432, O_TWS = O_TWC + 16384;
    dft64_tables(F, O_CT);
    { LAS float* twc = (LAS float*)(F.lds + O_TWC); LAS float* tws = (LAS float*)(F.lds + O_TWS);
      for (int i = F.tid; i < 4096; i += NT) { float s_, c_; sincospif((float)i * (1.0f / 2048.0f), &s_, &c_); twc[i] = c_; tws[i] = s_; } }
    __syncthreads();
    const LAS unsigned short* CT = (const LAS unsigned short*)(F.lds + O_CT); const LAS unsigned short* ST = CT + 64 * 72;
    const LAS float* twc = (const LAS float*)(F.lds + O_TWC); const LAS float* tws = (const LAS float*)(F.lds + O_TWS);
    const int q = F.lane & 15, g = F.lane >> 4;
    const int gw = F.bid * NWAVES + F.wave, NGW = F.G * NWAVES;
    for (int un = gw; un < BATCH * NHEAD * 64; un += NGW) {
        const int b = un >> 8, h = (un >> 6) & 3, n2 = un & 63;
        f32x4 xr[4][4], xw[4][4];
#pragma unroll
        for (int mt = 0; mt < 4; ++mt)
#pragma unroll
            for (int ct = 0; ct < 4; ++ct) { xr[mt][ct] = (f32x4){0.f, 0.f, 0.f, 0.f}; xw[mt][ct] = (f32x4){0.f, 0.f, 0.f, 0.f}; }
#pragma unroll
        for (int ks = 0; ks < 2; ++ks) {
            bf16x8 tf[4], cf[4], sf[4];
#pragma unroll
            for (int mt = 0; mt < 4; ++mt) tf[mt] = *(const GAS bf16x8*)(U + (size_t)(b * SEQ + 64 * (16 * mt + q) + n2) * INC + UC_F + h * HD + 32 * ks + 8 * g);
#pragma unroll
            for (int ct = 0; ct < 4; ++ct) { cf[ct] = *(const LAS bf16x8*)(CT + (16 * ct + q) * 72 + 32 * ks + 8 * g); sf[ct] = *(const LAS bf16x8*)(ST + (16 * ct + q) * 72 + 32 * ks + 8 * g); }
#pragma unroll
            for (int mt = 0; mt < 4; ++mt)
#pragma unroll
                for (int ct = 0; ct < 4; ++ct) { xr[mt][ct] = __builtin_amdgcn_mfma_f32_16x16x32_bf16(tf[mt], cf[ct], xr[mt][ct], 0, 0, 0); xw[mt][ct] = __builtin_amdgcn_mfma_f32_16x16x32_bf16(tf[mt], sf[ct], xw[mt][ct], 0, 0, 0); }
        }
        v4u ar[4][2], awn[4][2];
#pragma unroll
        for (int ct = 0; ct < 4; ++ct)
#pragma unroll
            for (int kb = 0; kb < 2; ++kb) {
                ar[ct][kb].x = cvtpk(xr[2 * kb][ct][0], xr[2 * kb][ct][1]); ar[ct][kb].y = cvtpk(xr[2 * kb][ct][2], xr[2 * kb][ct][3]);
                ar[ct][kb].z = cvtpk(xr[2 * kb + 1][ct][0], xr[2 * kb + 1][ct][1]); ar[ct][kb].w = cvtpk(xr[2 * kb + 1][ct][2], xr[2 * kb + 1][ct][3]);
                awn[ct][kb].x = cvtpk(-xw[2 * kb][ct][0], -xw[2 * kb][ct][1]); awn[ct][kb].y = cvtpk(-xw[2 * kb][ct][2], -xw[2 * kb][ct][3]);
                awn[ct][kb].z = cvtpk(-xw[2 * kb + 1][ct][0], -xw[2 * kb + 1][ct][1]); awn[ct][kb].w = cvtpk(-xw[2 * kb + 1][ct][2], -xw[2 * kb + 1][ct][3]); }
#pragma unroll
        for (int rt = 0; rt < 4; ++rt) {
            const int n1p = 16 * rt + q;
            bf16x8 cb_[2], sb_[2];
#pragma unroll
            for (int kb = 0; kb < 2; ++kb) { const LAS unsigned short* cp = CT + n1p * 72 + 32 * kb + 4 * g; const LAS unsigned short* sp = ST + n1p * 72 + 32 * kb + 4 * g;
                cb_[kb] = mk8(*(const LAS v2u*)cp, *(const LAS v2u*)(cp + 16)); sb_[kb] = mk8(*(const LAS v2u*)sp, *(const LAS v2u*)(sp + 16)); }
            const int tix = n2 * n1p; const float cw = twc[tix], sw = tws[tix];
            const size_t zbase = ((((size_t)(b * NHEAD + h) * 64 + n1p) * 64 + n2) * 64) + 4 * g;
#pragma unroll
            for (int ct = 0; ct < 4; ++ct) {
                f32x4 yr = (f32x4){0.f, 0.f, 0.f, 0.f}, yi = (f32x4){0.f, 0.f, 0.f, 0.f};
#pragma unroll
                for (int kb = 0; kb < 2; ++kb) {
                    const bf16x8 a_r = __builtin_bit_cast(bf16x8, ar[ct][kb]), a_wn = __builtin_bit_cast(bf16x8, awn[ct][kb]);
                    v4u nr = ar[ct][kb]; nr.x ^= 0x80008000u; nr.y ^= 0x80008000u; nr.z ^= 0x80008000u; nr.w ^= 0x80008000u; const bf16x8 a_rn = __builtin_bit_cast(bf16x8, nr);
                    yr = __builtin_amdgcn_mfma_f32_16x16x32_bf16(a_r, cb_[kb], yr, 0, 0, 0); yr = __builtin_amdgcn_mfma_f32_16x16x32_bf16(a_wn, sb_[kb], yr, 0, 0, 0);
                    yi = __builtin_amdgcn_mfma_f32_16x16x32_bf16(a_wn, cb_[kb], yi, 0, 0, 0); yi = __builtin_amdgcn_mfma_f32_16x16x32_bf16(a_rn, sb_[kb], yi, 0, 0, 0); }
                v2u wr_, wi_;
                wr_.x = cvtpk(yr[0] * cw + yi[0] * sw, yr[1] * cw + yi[1] * sw); wr_.y = cvtpk(yr[2] * cw + yi[2] * sw, yr[3] * cw + yi[3] * sw);
                wi_.x = cvtpk(yi[0] * cw - yr[0] * sw, yi[1] * cw - yr[1] * sw); wi_.y = cvtpk(yi[2] * cw - yr[2] * sw, yi[3] * cw - yr[3] * sw);
                *(GAS v2u*)(Zr + zbase + 16 * ct) = wr_; *(GAS v2u*)(Zi + zbase + 16 * ct) = wi_;
            }
        }
    }
}
__device__ __forceinline__ void fourier_b(Frame& F, bool with_ctx) {
    bf16* Y = (bf16*)(F.ws + WS_H); const bf16* Zr = (const bf16*)(F.ws + WS_Z);
    dft64_tables(F, 0);
    __syncthreads();
    const LAS unsigned short* CT = (const LAS unsigned short*)(F.lds); const LAS unsigned short* ST = CT + 64 * 72;
    LAS unsigned short* ZT = (LAS unsigned short*)(F.lds + 18432 + F.wave * 9216);
    const int q = F.lane & 15, g = F.lane >> 4;
    const int gw = F.bid * NWAVES + F.wave, NGW = F.G * NWAVES;
    const int nun = BATCH * NHEAD * 64 + (with_ctx ? BATCH * NHEAD * 4 : 0);
    for (int un = gw; un < nun; un += NGW) {
        const bool lat = un < BATCH * NHEAD * 64; const int uc = un - BATCH * NHEAD * 64;
        const int b = lat ? (un >> 8) : (uc >> 4), h = lat ? ((un >> 6) & 3) : ((uc >> 2) & 3), n1p = lat ? (un & 63) : (uc & 3);
        const size_t z0 = lat ? (((size_t)(b * NHEAD + h) * 64 + n1p) * 64) * 64 : 2 * NZ + (((size_t)(b * NHEAD + h) * 4 + n1p) * 64) * 64;
        const size_t zim = lat ? NZ : NZC;
        const int tok0 = lat ? (b * SEQ + n1p) : (NLAT + b * CTXL + n1p), tstride = lat ? 64 : 4; const float oscale = lat ? (1.0f / 512.0f) : (1.0f / 128.0f);
        f32x4 acc[4][4];
#pragma unroll
        for (int ct = 0; ct < 4; ++ct)
#pragma unroll
            for (int nt = 0; nt < 4; ++nt) acc[ct][nt] = (f32x4){0.f, 0.f, 0.f, 0.f};
#pragma unroll
        for (int comp = 0; comp < 2; ++comp) {
            const bf16* zp = Zr + z0 + (comp ? zim : 0); const LAS unsigned short* FT = comp ? ST : CT;
#pragma unroll
            for (int i = 0; i < 8; ++i) { const int p = F.lane + 64 * i, n2 = p >> 3, c8 = p & 7; const v4u w = *(const GAS v4u*)(zp + (size_t)n2 * 64 + 8 * c8); LAS unsigned short* tp = ZT + (8 * c8) * 72 + n2;
                tp[0 * 72] = (unsigned short)w.x; tp[1 * 72] = (unsigned short)(w.x >> 16); tp[2 * 72] = (unsigned short)w.y; tp[3 * 72] = (unsigned short)(w.y >> 16);
                tp[4 * 72] = (unsigned short)w.z; tp[5 * 72] = (unsigned short)(w.z >> 16); tp[6 * 72] = (unsigned short)w.w; tp[7 * 72] = (unsigned short)(w.w >> 16); }
            LDS_WAIT(); asm volatile("" ::: "memory");
#pragma unroll
            for (int ks = 0; ks < 2; ++ks) {
                bf16x8 af[4], bf_[4];
#pragma unroll
                for (int ct = 0; ct < 4; ++ct) af[ct] = *(const LAS bf16x8*)(ZT + (16 * ct + q) * 72 + 32 * ks + 8 * g);
#pragma unroll
                for (int nt = 0; nt < 4; ++nt) bf_[nt] = *(const LAS bf16x8*)(FT + (16 * nt + q) * 72 + 32 * ks + 8 * g);
#pragma unroll
                for (int ct = 0; ct < 4; ++ct)
#pragma unroll
                    for (int nt = 0; nt < 4; ++nt) acc[ct][nt] = __builtin_amdgcn_mfma_f32_16x16x32_bf16(af[ct], bf_[nt], acc[ct][nt], 0, 0, 0);
            }
            LDS_WAIT(); asm volatile("" ::: "memory");
        }
#pragma unroll
        for (int nt = 0; nt < 4; ++nt) { bf16* yp = Y + (size_t)(tok0 + tstride * (16 * nt + q)) * D + 768 + h * HD + 4 * g;
#pragma unroll
            for (int ct = 0; ct < 4; ++ct) { v2u w; w.x = cvtpk(acc[ct][nt][0] * oscale, acc[ct][nt][1] * oscale); w.y = cvtpk(acc[ct][nt][2] * oscale, acc[ct][nt][3] * oscale); *(GAS v2u*)(yp + 16 * ct) = w; } }
    }
}
__device__ __forceinline__ v4u mul_bf8(v4u a, v4u b) { v4u r; r.x = cvtpk(bflo(a.x) * bflo(b.x), bfhi(a.x) * bfhi(b.x)); r.y = cvtpk(bflo(a.y) * bflo(b.y), bfhi(a.y) * bfhi(b.y)); r.z = cvtpk(bflo(a.z) * bflo(b.z), bfhi(a.z) * bfhi(b.z)); r.w = cvtpk(bflo(a.w) * bflo(b.w), bfhi(a.w) * bfhi(b.w)); return r; }
__device__ __forceinline__ void convpool_phase(Frame& F, int l, int nrows) {
    const bf16* U = (const bf16*)(F.ws + WS_U); bf16* Y = (bf16*)(F.ws + WS_H);
    const bf16* PWT = (const bf16*)(F.ws + WS_PWT) + (size_t)l * 4 * 64 * 64;
    const float* cw = F.inp(I_CONVW) + (size_t)l * 3 * GWID; const float* ps = F.inp(I_POOLS) + (size_t)l * GWID;
    LAS unsigned* PX = (LAS unsigned*)(F.lds + RING_OFF);
    LAS unsigned* DT = (LAS unsigned*)(F.lds + RING_OFF + 40960);
    const int q = F.lane & 15, g = F.lane >> 4;
    const int c8 = F.tid & 31, gi = F.wave & 3;
    const f32x4 w0a = *(const GAS f32x4*)(cw + 8 * c8), w0b = *(const GAS f32x4*)(cw + 8 * c8 + 4), w1a = *(const GAS f32x4*)(cw + GWID + 8 * c8), w1b = *(const GAS f32x4*)(cw + GWID + 8 * c8 + 4),
                w2a = *(const GAS f32x4*)(cw + 2 * GWID + 8 * c8), w2b = *(const GAS f32x4*)(cw + 2 * GWID + 8 * c8 + 4);
    bf16x8 wf[4][2]; f32x4 psc[4];
#pragma unroll
    for (int dt = 0; dt < 4; ++dt) { psc[dt] = *(const GAS f32x4*)(ps + gi * 64 + 16 * dt + 4 * g);
#pragma unroll
        for (int ks = 0; ks < 2; ++ks) wf[dt][ks] = *(const GAS bf16x8*)(PWT + ((size_t)gi * 64 + 16 * dt + q) * 64 + 32 * ks + 8 * g); }
    for (int tile = F.bid; tile < nrows / 64; tile += F.G) {
        const int r0 = tile * 64; int base, t0, L; seq_info(r0, base, t0, L);
#pragma unroll
        for (int i = 0; i < 4; ++i) { const int p = F.tid + NT * i, tr = p >> 5, t = t0 + tr; const bf16* ur = U + (size_t)(r0 + tr) * INC + 8 * c8;
            const v4u zc = mul_bf8(*(const GAS v4u*)(ur + UC_AC), *(const GAS v4u*)(ur + UC_AV));
            v4u zp = (v4u){0u, 0u, 0u, 0u}, zn = (v4u){0u, 0u, 0u, 0u};
            if (t > 0) zp = mul_bf8(*(const GAS v4u*)(ur + UC_AC - INC), *(const GAS v4u*)(ur + UC_AV - INC));
            if (t < L - 1) zn = mul_bf8(*(const GAS v4u*)(ur + UC_AC + INC), *(const GAS v4u*)(ur + UC_AV + INC));
            const v4u ab = *(const GAS v4u*)(ur + UC_AB);
            v4u o;
            o.x = cvtpk(bflo(ab.x) * (w0a.x * bflo(zp.x) + w1a.x * bflo(zc.x) + w2a.x * bflo(zn.x)), bfhi(ab.x) * (w0a.y * bfhi(zp.x) + w1a.y * bfhi(zc.x) + w2a.y * bfhi(zn.x)));
            o.y = cvtpk(bflo(ab.y) * (w0a.z * bflo(zp.y) + w1a.z * bflo(zc.y) + w2a.z * bflo(zn.y)), bfhi(ab.y) * (w0a.w * bfhi(zp.y) + w1a.w * bfhi(zc.y) + w2a.w * bfhi(zn.y)));
            o.z = cvtpk(bflo(ab.z) * (w0b.x * bflo(zp.z) + w1b.x * bflo(zc.z) + w2b.x * bflo(zn.z)), bfhi(ab.z) * (w0b.y * bfhi(zp.z) + w1b.y * bfhi(zc.z) + w2b.y * bfhi(zn.z)));
            o.w = cvtpk(bflo(ab.w) * (w0b.z * bflo(zp.w) + w1b.z * bflo(zc.w) + w2b.z * bflo(zn.w)), bfhi(ab.w) * (w0b.w * bfhi(zp.w) + w1b.w * bfhi(zc.w) + w2b.w * bfhi(zn.w)));
            *(GAS v4u*)(Y + (size_t)(r0 + tr) * D + 8 * c8) = o; }
#pragma unroll
        for (int i = 0; i < 5; ++i) { const int p = F.tid + NT * i, rr = p >> 5, t = t0 - 8 + rr; v4u w = (v4u){0u, 0u, 0u, 0u};
            if (t >= 0 && t < L) w = *(const GAS v4u*)(U + (size_t)(base + t) * INC + UC_P + 8 * c8);
            *(LAS v4u*)(PX + rr * 128 + 4 * c8) = w; }
        __syncthreads();
        { const int c2 = F.tid & 127, tq = F.tid >> 7, hw = 1 << (c2 >> 5);
          float s0 = 0.f, s1 = 0.f;
          for (int k = -hw; k < hw; ++k) { const unsigned w = PX[(16 * tq + 8 + k) * 128 + c2]; s0 += bflo(w); s1 += bfhi(w); }
          for (int i = 0; i < 16; ++i) { const int tl = 16 * tq + i, t = t0 + tl;
              const int lo = t - hw > 0 ? t - hw : 0, hi = t + hw < L ? t + hw : L; const float rc = 1.0f / (float)(hi - lo);
              const unsigned xc = PX[(tl + 8) * 128 + c2];
              DT[tl * 132 + c2] = cvtpk(s0 * rc - bflo(xc), s1 * rc - bfhi(xc));
              const unsigned wa = PX[(tl + 8 + hw) * 128 + c2], wsb = PX[(tl + 8 - hw) * 128 + c2];
              s0 += bflo(wa) - bflo(wsb); s1 += bfhi(wa) - bfhi(wsb); } }
        __syncthreads();
        {
#pragma unroll
          for (int tj = 0; tj < 2; ++tj) { const int tt = 2 * (F.wave >> 2) + tj;
              bf16x8 df[2];
#pragma unroll
              for (int ks = 0; ks < 2; ++ks) df[ks] = *(const LAS bf16x8*)(DT + (16 * tt + q) * 132 + gi * 32 + 16 * ks + 4 * g);
#pragma unroll
              for (int dt = 0; dt < 4; ++dt) { f32x4 a = (f32x4){0.f, 0.f, 0.f, 0.f};
                  a = __builtin_amdgcn_mfma_f32_16x16x32_bf16(wf[dt][0], df[0], a, 0, 0, 0); a = __builtin_amdgcn_mfma_f32_16x16x32_bf16(wf[dt][1], df[1], a, 0, 0, 0);
                  const int oc = gi * 64 + 16 * dt + 4 * g; const f32x4 sc = psc[dt];
                  v2u w; w.x = cvtpk(a[0] * sc.x, a[1] * sc.y); w.y = cvtpk(a[2] * sc.z, a[3] * sc.w);
                  *(GAS v2u*)(Y + (size_t)(r0 + 16 * tt + q) * D + 256 + oc) = w; } } }
        __syncthreads();
    }
}

__device__ __forceinline__ void fourier_ctx_a(Frame& F) {
    const bf16* U = (const bf16*)(F.ws + WS_U); bf16* Zc = (bf16*)(F.ws + WS_Z) + 2 * NZ;
    LAS float* cs = (LAS float*)(F.lds + TAB_OFF); LAS float* sn = cs + 64; LAS float* cs256 = cs + 128; LAS float* sn256 = cs + 384;
    if (F.tid < 64) { float s_, c_; sincospif((float)F.tid * (1.0f / 32.0f), &s_, &c_); cs[F.tid] = c_; sn[F.tid] = s_; }
    if (F.tid < 256) { float s_, c_; sincospif((float)F.tid * (1.0f / 128.0f), &s_, &c_); cs256[F.tid] = c_; sn256[F.tid] = s_; }
    __syncthreads();
    for (int item = F.bid * NT + F.tid; item < BATCH * NHEAD * 64 * 64; item += F.G * NT) {
        const int cp = item & 63, n2 = (item >> 6) & 63, h = (item >> 12) & 3, b = item >> 14;
        float xr[4], xi[4];
#pragma unroll
        for (int n1 = 0; n1 < 4; ++n1) { xr[n1] = 0.f; xi[n1] = 0.f; }
        for (int c8 = 0; c8 < 8; ++c8) {
            float cc[8], ss[8];
#pragma unroll
            for (int e = 0; e < 8; ++e) { const int idx = ((8 * c8 + e) * cp) & 63; cc[e] = cs[idx]; ss[e] = sn[idx]; }
#pragma unroll
            for (int n1 = 0; n1 < 4; ++n1) { const v4u w = *(const GAS v4u*)(U + (size_t)(NLAT + b * CTXL + 64 * n1 + n2) * INC + UC_F + h * HD + 8 * c8);
                const float f0 = bflo(w.x), f1 = bfhi(w.x), f2 = bflo(w.y), f3 = bfhi(w.y), f4 = bflo(w.z), f5 = bfhi(w.z), f6 = bflo(w.w), f7 = bfhi(w.w);
                xr[n1] += f0 * cc[0] + f1 * cc[1] + f2 * cc[2] + f3 * cc[3] + f4 * cc[4] + f5 * cc[5] + f6 * cc[6] + f7 * cc[7];
                xi[n1] -= f0 * ss[0] + f1 * ss[1] + f2 * ss[2] + f3 * ss[3] + f4 * ss[4] + f5 * ss[5] + f6 * ss[6] + f7 * ss[7]; }
        }
        float yr[4], yi[4];
        yr[0] = xr[0] + xr[1] + xr[2] + xr[3];           yi[0] = xi[0] + xi[1] + xi[2] + xi[3];
        yr[1] = xr[0] + xi[1] - xr[2] - xi[3];           yi[1] = xi[0] - xr[1] - xi[2] + xr[3];
        yr[2] = xr[0] - xr[1] + xr[2] - xr[3];           yi[2] = xi[0] - xi[1] + xi[2] - xi[3];
        yr[3] = xr[0] - xi[1] - xr[2] + xi[3];           yi[3] = xi[0] + xr[1] - xi[2] - xr[3];
#pragma unroll
        for (int k = 0; k < 4; ++k) { const int tix = (n2 * k) & 255; const float cw = cs256[tix], sw = sn256[tix];
            const size_t zi = ((((size_t)(b * NHEAD + h) * 4 + k) * 64 + n2) * 64) + cp;
            Zc[zi] = (bf16)f2bf(yr[k] * cw + yi[k] * sw); Zc[NZC + zi] = (bf16)f2bf(yi[k] * cw - yr[k] * sw); }
    }
}

__device__ __forceinline__ void mixa_phase(int l, bool with_ctx) { Frame F = mk_frame();
    const int nrows = with_ctx ? NROW : NLAT;
    convpool_phase(F, l, nrows);
    kv_prepass(F);
    bias_table(F, l);
    __syncthreads();
    fourier_a(F);
    __syncthreads();
    if (with_ctx) fourier_ctx_a(F);
}
__device__ __forceinline__ void mixb_phase(int l, bool with_ctx) { Frame F = mk_frame();
    attn_phase(F, l, with_ctx);
    __syncthreads();
    fourier_b(F, with_ctx);
}

struct WinOrder {
    int G, c, nctx_cols, ctx_pn0;
    __device__ __forceinline__ bool next(int i, pg8::Unit& u) const {
        const long L = (long)i * G + c; const int nlatu = 1024, total = nlatu + 8 * nctx_cols; if (L >= total) return false;
        if (L < nlatu) { int wgid = (int)L; { const int xcd = wgid % 8, off = wgid / 8; wgid = xcd * 128 + off; }
            const int gid = wgid / 64, fm = gid * 8; u.pm = fm + ((wgid % 64) % 8); u.pn = (wgid % 64) / 8; }
        else { const int j = (int)L - nlatu; u.pm = 128 + (j % 8); u.pn = ctx_pn0 + j / 8; }
        u.pb = u.pn; u.lb = 0; u.nv = 256; return true;
    }
    __device__ __forceinline__ void a_ready(const pg8::Unit&) const {}
    __device__ __forceinline__ void done(const pg8::Unit&) const {}
    __device__ __forceinline__ int row_of(const pg8::Unit&, int i) const { return i; }
};

struct Args { const float* in[20]; float* out; unsigned char* ws; int l, e; };
#define PH_PTRS() \
    bf16* H = (bf16*)(F.ws + WS_H); bf16* U = (bf16*)(F.ws + WS_U); bf16* HE = (bf16*)(F.ws + WS_U); bf16* Y2 = (bf16*)(F.ws + WS_S); \
    float* MOD = (float*)(F.ws + WS_MOD); float* XC = (float*)(F.ws + WS_XC); const uint2* INFO = (const uint2*)(F.ws + WS_INFO); \
    const bool first = (l == 0); const int M = first ? NROW : NLAT; const float* modl = MOD + (size_t)l * 9 * 6144; \
    (void)H; (void)U; (void)HE; (void)XC; (void)Y2; (void)INFO; (void)M; (void)modl;

#define XS_IN()  XStream{(const char*)F.inp(I_X), (const char*)F.inp(I_CTX), 4096, 4096}
#define XS_BF()  XStream{(const char*)F.out, (const char*)XC, 4096, 2048}
__device__ __forceinline__ void ph_norm1(int l) { Frame F = mk_frame(); PH_PTRS();
    norm_phase<0, false, false>(F, XS_IN(), XS_IN(), NROW, F.inp(I_N1G), modl, modl, 0, 1, H, nullptr, nullptr); }
__device__ __forceinline__ void ph_next(int l) { Frame F = mk_frame(); PH_PTRS();
    if (first) norm_phase<1, false, true>(F, XS_BF(), XS_BF(), NROW, F.inp(I_N1G) + D, MOD + (size_t)9 * 6144, modl, 0, 1, H, Y2, nullptr);
    else norm_phase<1, true, true>(F, XS_BF(), XS_BF(), NLAT, F.inp(I_FG), modl, modl, 0, 0, nullptr, Y2, F.out); }
__device__ __forceinline__ void ph_route(int l) { Frame F = mk_frame(); PH_PTRS();
    if (first) route_phase<false>(F, l, XS_IN(), XS_BF(), U, M, F.inp(I_N2G) + (size_t)l * D, modl, H, (uint2*)(F.ws + WS_INFO), (unsigned*)(F.ctl + CW_CNT + l * 16));
    else route_phase<true>(F, l, XS_BF(), XS_BF(), U, M, F.inp(I_N2G) + (size_t)l * D, modl, H, (uint2*)(F.ws + WS_INFO), (unsigned*)(F.ctl + CW_CNT + l * 16)); }
__device__ __forceinline__ void ph_win(int l) { Frame F = mk_frame(); PH_PTRS();
    pg8::Gemm g{H, (const bf16*)(F.ws + WS_WIN) + (size_t)l * INC * D, NROW, INC, D};
    WinOrder S{F.G, F.bid, first ? 8 : 2, first ? 0 : 5};
    pg8::EpiBf16 E{U, INC};
    pg8::gemm_phase<pg8::EpiBf16, WinOrder>(F.lds + RING_OFF, g, S, E); }
__device__ __forceinline__ void ph_wout(int l) { Frame F = mk_frame(); PH_PTRS();
    pg8::Gemm g{H, (const bf16*)(F.ws + WS_WOUT) + (size_t)l * D * D, M, D, D};
    pg8::StaticOrder S; S.init(M, D, F.G, F.bid);
    pg8::EpiBf16 E{U, D};
    pg8::gemm_phase<pg8::EpiBf16, pg8::StaticOrder>(F.lds + RING_OFF, g, S, E); }
__device__ __forceinline__ void ph_moe1(int l) { Frame F = mk_frame(); PH_PTRS(); moe_table(F, l);
    pg8::Gemm g{H, (const bf16*)(F.ws + WS_W13) + (size_t)l * NEXP * 1024 * D, M, 1024, D};
    pg8::MoeOrder S{F.G, F.bid, CAP, (const LAS int*)(F.lds + TAB_OFF), INFO};
    pg8::EpiSwiGLU E{HE, MHID};
    pg8::gemm_phase<pg8::EpiSwiGLU, pg8::MoeOrder, true>(F.lds + RING_OFF, g, S, E); }
__device__ __forceinline__ void ph_moe2(int l) { Frame F = mk_frame(); PH_PTRS(); moe_table(F, l);
    pg8::Gemm g{HE, (const bf16*)(F.ws + WS_W2) + (size_t)l * NEXP * D * MHID, M, D, MHID};
    pg8::MoeOrder S{F.G, F.bid, CAP, (const LAS int*)(F.lds + TAB_OFF), INFO};
    pg8::EpiScatter E{Y2, INFO};
    pg8::gemm_phase<pg8::EpiScatter, pg8::MoeOrder, false>(F.lds + RING_OFF, g, S, E); }

__device__ __forceinline__ void grid_bar() {
    Frame F = mk_frame(); XcdBarrier b; b.bar = (unsigned*)(F.ctl + CW_BAR); b.x = xb_xcc_id(); b.st = F.MISC + 8; xcd_barrier(b);
}
#define PMARK(name) asm volatile("; PHASE_MARK " name ::: "memory")
template <int L> __device__ __forceinline__ void layer_phases() {
    PMARK("win"); ph_win(L); grid_bar();
    PMARK("mixa"); mixa_phase(L, L == 0); grid_bar();
    PMARK("mixb"); mixb_phase(L, L == 0); grid_bar();
    PMARK("wout"); ph_wout(L); grid_bar();
    PMARK("route"); ph_route(L); grid_bar();
    PMARK("moe1"); ph_moe1(L); grid_bar();
    PMARK("moe2"); ph_moe2(L); grid_bar();
    PMARK("next"); ph_next(L);
}
__global__ void __launch_bounds__(NT, 2) fwd_all(Args args) {
    { Frame F = mk_frame();
      for (int u = F.tid; u < (LDS_BYTES - LDSCTL_OFF) / 4; u += NT) ((LAS unsigned*)(F.lds + LDSCTL_OFF))[u] = 0u;
      __syncthreads();
      (void)xcd_barrier_post((unsigned*)(F.ctl + CW_BAR), F.MISC + 8); }
    PMARK("pa"); pa_phase(); grid_bar();
    PMARK("norm1"); ph_norm1(0); grid_bar();
    layer_phases<0>(); grid_bar();
    layer_phases<1>();
}

typedef void (*kern_t)(Args);
extern "C" void kernel_launch(void* const* d_in, const int* in_sizes, int n_in, void* d_out, int out_size, void* d_ws, size_t ws_size, hipStream_t stream) {
    static int grid = 0;
    const kern_t kerns[] = {fwd_all};
    if (grid == 0) {
        if (n_in != 20 || out_size != NLAT * D || ws_size < WS_END) { fprintf(stderr, "kernel_launch: unexpected shapes (n_in %d out %d ws %zu)\n", n_in, out_size, ws_size); grid = -1; return; }
        int dev = 0, cus = 0;
        if (hipGetDevice(&dev) != hipSuccess || hipDeviceGetAttribute(&cus, hipDeviceAttributeMultiprocessorCount, dev) != hipSuccess) { grid = -1; return; }
        for (kern_t k : kerns) if (hipFuncSetAttribute((const void*)k, hipFuncAttributeMaxDynamicSharedMemorySize, LDS_BYTES) != hipSuccess) { fprintf(stderr, "kernel_launch: hipFuncSetAttribute failed\n"); grid = -1; return; }
        int per_cu = 0; (void)hipOccupancyMaxActiveBlocksPerMultiprocessor(&per_cu, (const void*)kerns[0], NT, LDS_BYTES); (void)hipGetLastError();
        grid = cus;
    }
    if (grid < 0) return;
    (void)hipMemsetAsync((char*)d_ws + WS_CTL, 0, CTL_ZERO_BYTES, stream);
    Args a{};
    for (int i = 0; i < 20; ++i) a.in[i] = (const float*)d_in[i];
    a.out = (float*)d_out; a.ws = (unsigned char*)d_ws;
    hipLaunchKernelGGL(fwd_all, dim3(grid), dim3(NT), LDS_BYTES, stream, a);
}
```

```cpp
#include <hip/hip_runtime.h>
#include <cstdio>
#include <cstdint>
namespace pg8 {
#define PG8_LAS __attribute__((address_space(3)))
typedef unsigned short bf16_t;
typedef short bf16x8 __attribute__((ext_vector_type(8)));
typedef float f32x4 __attribute__((ext_vector_type(4)));
typedef unsigned u32x4 __attribute__((ext_vector_type(4)));
constexpr int BM = 256, BK = 64, HALF = 128, HTB = HALF * BK * 2  , STAGE_BYTES = 8 * HTB, NXCD = 8, WGM = 8;

__host__ __device__ __forceinline__ int lds_byte(int r, int c) { const int st = (r >> 4) * 2 + (c >> 5), rr = r & 15, cc = c & 31, ob = rr * 64 + cc * 2; return st * 1024 + (ob ^ (((ob >> 9) & 1) << 5)); }
__host__ __device__ __forceinline__ void stage_rc(int b, int& R, int& C) { const int st = b / 1024, sb = b % 1024, swz = sb ^ (((sb >> 9) & 1) << 5); R = (st >> 1) * 16 + swz / 64; C = (st & 1) * 32 + (swz % 64) / 2; }
__host__ __device__ __forceinline__ int perm32(int rho) { const int n = rho >> 4, i = rho & 15; return 8 * (i >> 2) + 4 * n + (i & 3); }

struct Unit { int pm, pn, pb, lb, nv; };
struct Gemm { const bf16_t* A; const bf16_t* Bt; int M, N, K; };

struct StaticOrder {
    int nM, nN, nwg, G, c;
    __host__ __device__ void init(int M, int N, int G_, int c_) { nM = M / BM; nN = N / BM; nwg = nM * nN; G = G_; c = c_; }
    __host__ __device__ bool next(int i, Unit& u) const {
        const long L = (long)i * G + c; if (L >= nwg) return false;
        int wgid = (int)L; { const int q = nwg / NXCD, r = nwg % NXCD, xcd = wgid % NXCD, off = wgid / NXCD; wgid = (xcd < r ? xcd * (q + 1) : r * (q + 1) + (xcd - r) * q) + off; }
        const int nig = WGM * nN, gid = wgid / nig, fm = gid * WGM, gsz = (nM - fm) < WGM ? (nM - fm) : WGM;
        u.pm = fm + ((wgid % nig) % gsz); u.pn = (wgid % nig) / gsz; u.pb = u.pn; u.lb = 0; u.nv = BM; return true;
    }
    __device__ __forceinline__ void a_ready(const Unit&) const {}
    __device__ __forceinline__ int row_of(const Unit&, int i) const { return i; }
    __device__ __forceinline__ void done(const Unit&) const {}
};


__device__ __forceinline__ unsigned cvt_pk_bf16(float lo, float hi) { unsigned r; asm volatile("v_cvt_pk_bf16_f32 %0, %1, %2" : "=v"(r) : "v"(lo), "v"(hi)); return r; }

struct EpiBf16 {
    static constexpr bool PERM = true, AFTER_DRAIN = false;
    bf16_t* O; int ldc;
    __device__ __forceinline__ void operator()(const f32x4 (&acc)[2][2][4][2], const Unit& u, int wr, int wc, int fr, int fq) const {
        const int row0 = u.pm * BM + wr * 64 + fr; const int col0 = u.pn * BM + wc * 32 + 8 * fq;
        float one = 1.0f; asm volatile("" : "+v"(one));
#pragma unroll
        for (int ai = 0; ai < 2; ++ai)
#pragma unroll
            for (int m = 0; m < 4; ++m) { bf16_t* rowp = O + (size_t)(row0 + ai * HALF + m * 16) * ldc + col0;
#pragma unroll
                for (int bj = 0; bj < 2; ++bj) { const f32x4 v0 = acc[ai][bj][m][0] * one, v1 = acc[ai][bj][m][1] * one;
                    u32x4 w; w.x = cvt_pk_bf16(v0[0], v0[1]); w.y = cvt_pk_bf16(v0[2], v0[3]); w.z = cvt_pk_bf16(v1[0], v1[1]); w.w = cvt_pk_bf16(v1[2], v1[3]);
                    *(u32x4*)(rowp + bj * HALF) = w; } }
    }
};
struct EpiSwiGLU {
    static constexpr bool PERM = true, AFTER_DRAIN = false;
    bf16_t* O; int ldc;
    __device__ __forceinline__ void operator()(const f32x4 (&acc)[2][2][4][2], const Unit& u, int wr, int wc, int fr, int fq) const {
        const int row0 = u.pm * BM + wr * 64 + fr; const int col0 = u.pn * HALF + wc * 32 + 8 * fq;
#pragma unroll
        for (int ai = 0; ai < 2; ++ai)
#pragma unroll
            for (int m = 0; m < 4; ++m) { bf16_t* rowp = O + (size_t)(row0 + ai * HALF + m * 16) * ldc + col0;
                float o[8];
#pragma unroll
                for (int n = 0; n < 2; ++n)
#pragma unroll
                    for (int j = 0; j < 4; ++j) { const float a = acc[ai][0][m][n][j], b = acc[ai][1][m][n][j]; o[n * 4 + j] = a * __builtin_amdgcn_rcpf(1.0f + __expf(-a)) * b; }
                u32x4 w; w.x = cvt_pk_bf16(o[0], o[1]); w.y = cvt_pk_bf16(o[2], o[3]); w.z = cvt_pk_bf16(o[4], o[5]); w.w = cvt_pk_bf16(o[6], o[7]);
                *(u32x4*)rowp = w; }
    }
};
struct EpiScatter {
    static constexpr bool PERM = true, AFTER_DRAIN = false;
    bf16_t* Y2; const uint2* info;
    __device__ __forceinline__ void operator()(const f32x4 (&acc)[2][2][4][2], const Unit& u, int wr, int wc, int fr, int fq) const {
        const int col0 = u.pn * BM + wc * 32 + 8 * fq;
#pragma unroll
        for (int ai = 0; ai < 2; ++ai)
#pragma unroll
            for (int m = 0; m < 4; ++m) { const int i = ai * HALF + wr * 64 + m * 16 + fr;
                if (i < u.nv) { const uint2 inf = info[u.lb + i]; const float w = __builtin_bit_cast(float, inf.y); bf16_t* rowp = Y2 + (size_t)inf.x * 1024 + col0;
#pragma unroll
                    for (int bj = 0; bj < 2; ++bj) { const f32x4 v0 = acc[ai][bj][m][0] * w, v1 = acc[ai][bj][m][1] * w;
                        u32x4 q; q.x = cvt_pk_bf16(v0[0], v0[1]); q.y = cvt_pk_bf16(v0[2], v0[3]); q.z = cvt_pk_bf16(v1[0], v1[1]); q.w = cvt_pk_bf16(v1[2], v1[3]);
                        *(u32x4*)(rowp + bj * HALF) = q; } } }
    }
};
struct MoeOrder {
    int G, c, cap; const PG8_LAS int* tab; const uint2* info;
    __device__ __forceinline__ bool next(int i, Unit& u) const {
        const int nwg = __builtin_amdgcn_readfirstlane(tab[16]) * 4; const long L = (long)i * G + c; if (L >= nwg) return false;
        int wgid = (int)L; { const int q = nwg / NXCD, r = nwg % NXCD, xcd = wgid % NXCD, off = wgid / NXCD; wgid = (xcd < r ? xcd * (q + 1) : r * (q + 1) + (xcd - r) * q) + off; }
        const int gp = wgid >> 2; int e = 0;
#pragma unroll
        for (int q = 1; q < 16; ++q) e += (gp >= tab[q]) ? 1 : 0;
        e = __builtin_amdgcn_readfirstlane(e);
        const int p = gp - __builtin_amdgcn_readfirstlane(tab[e]); const int ne = __builtin_amdgcn_readfirstlane(tab[17 + e]);
        u.pm = gp; u.pn = wgid & 3; u.pb = e * 4 + u.pn; u.lb = e * cap + 256 * p; u.nv = (ne - 256 * p) < 256 ? (ne - 256 * p) : 256; return true;
    }
    __device__ __forceinline__ void a_ready(const Unit&) const {}
    __device__ __forceinline__ void done(const Unit&) const {}
    __device__ __forceinline__ int row_of(const Unit& u, int i) const { return (int)(info[u.lb + (i < u.nv ? i : 0)].x >> 1); }
};
template <class Epi, class Sched, bool GATHER = false>
__device__ __forceinline__ void gemm_phase(PG8_LAS unsigned char* lds, const Gemm g, const Sched& S, const Epi& E) {
    int tid_ = threadIdx.x; asm volatile("" : "+v"(tid_));
    const int tid = tid_, wid = __builtin_amdgcn_readfirstlane(tid >> 6), lane = tid & 63, wr = wid >> 2, wc = wid & 3, fr = lane & 15, fq = lane >> 4;
    const int K = g.K, nt = K / BK;
    unsigned voffB[2];
#pragma unroll
    for (int i = 0; i < 2; ++i) { int R, C; stage_rc(tid * 16 + i * 8192, R, C); const int Rb = Epi::PERM ? ((R & ~31) + perm32(R & 31)) : R; voffB[i] = (unsigned)(Rb * K + C) * 2u; }
    const size_t kstep = (size_t)(BK * 2);
    const size_t hstep = (size_t)HALF * K * 2;
    const size_t tstep = 2 * hstep;
    const unsigned ldsw = (unsigned)wid * 1024u;
    const int aoff = lds_byte(wr * 64 + fr, fq * 8), boff = lds_byte(wc * 32 + fr, fq * 8);
#define PG8_SA(b, h) (((b) * 2 + (h)) * HTB)
#define PG8_SB(b, h) ((4 + (b) * 2 + (h)) * HTB)
#define PG8_STAGE(bufoff, gbase, voff) do { _Pragma("unroll") for (int _i = 0; _i < 2; ++_i) \
        __builtin_amdgcn_global_load_lds((const unsigned*)((const char*)(gbase) + (voff)[_i]), (PG8_LAS unsigned*)(lds + (bufoff) + ldsw + _i * 8192), 16, 0, 0); } while (0)
#define PG8_LDA(dst, b, h) do { _Pragma("unroll") for (int m = 0; m < 4; ++m) _Pragma("unroll") for (int k = 0; k < 2; ++k) dst[m][k] = *(const PG8_LAS bf16x8*)(lds + PG8_SA(b, h) + aoff + m * 2048 + k * 1024); } while (0)
#define PG8_LDB(dst, b, h) do { _Pragma("unroll") for (int n = 0; n < 2; ++n) _Pragma("unroll") for (int k = 0; k < 2; ++k) dst[n][k] = *(const PG8_LAS bf16x8*)(lds + PG8_SB(b, h) + boff + n * 2048 + k * 1024); } while (0)
#define PG8_MMA(ai, bj, At, Bt) do { __builtin_amdgcn_s_setprio(1); _Pragma("unroll") for (int m = 0; m < 4; ++m) _Pragma("unroll") for (int n = 0; n < 2; ++n) _Pragma("unroll") for (int k = 0; k < 2; ++k) \
        acc[ai][bj][m][n] = __builtin_amdgcn_mfma_f32_16x16x32_bf16(Bt[n][k], At[m][k], acc[ai][bj][m][n], 0, 0, 0); __builtin_amdgcn_s_setprio(0); } while (0)
#define PG8_WAIT_V(n) asm volatile("s_waitcnt vmcnt(" #n ")" ::: "memory")
#define PG8_WAIT_L(n) asm volatile("s_waitcnt lgkmcnt(" #n ")" ::: "memory")
#define PG8_BAR __builtin_amdgcn_s_barrier()
#define PG8_SCHED __builtin_amdgcn_sched_barrier(0)
#define PG8_AOFFS(o, u) do { _Pragma("unroll") for (int _h = 0; _h < 2; ++_h) _Pragma("unroll") for (int _i = 0; _i < 2; ++_i) { int _R, _C; stage_rc(tid * 16 + _i * 8192, _R, _C); \
        const int _row = GATHER ? S.row_of((u), _h * HALF + _R) : (_h * HALF + _R); (o)[_h][_i] = (unsigned)(_row * K + _C) * 2u; } } while (0)
    Unit cur, nxt; int ui = 0;
    if (!S.next(0, cur)) return;
    f32x4 acc[2][2][4][2];
#pragma unroll
    for (int a = 0; a < 2; ++a)
#pragma unroll
        for (int b = 0; b < 2; ++b)
#pragma unroll
            for (int m = 0; m < 4; ++m)
#pragma unroll
                for (int n = 0; n < 2; ++n) acc[a][b][m][n] = (f32x4){0.f, 0.f, 0.f, 0.f};
    bf16x8 At[4][2], B0[2][2], B1[2][2];
    unsigned offA[2][2], noffA[2][2];
    const char* cA = (const char*)g.A + (GATHER ? (size_t)0 : (size_t)cur.pm * tstep); const char* cB = (const char*)g.Bt + (size_t)cur.pb * tstep;
    S.a_ready(cur);
    PG8_AOFFS(offA, cur);
    PG8_STAGE(PG8_SB(0, 0), cB, voffB); PG8_STAGE(PG8_SB(0, 1), cB + hstep, voffB); PG8_STAGE(PG8_SA(0, 0), cA, offA[0]); PG8_STAGE(PG8_SA(0, 1), cA, offA[1]);
    if (wr == 1) PG8_BAR;
    PG8_WAIT_V(2); PG8_BAR;
    PG8_STAGE(PG8_SB(1, 0), cB + kstep, voffB); PG8_STAGE(PG8_SA(1, 0), cA + kstep, offA[0]); PG8_STAGE(PG8_SB(1, 1), cB + hstep + kstep, voffB);
    PG8_WAIT_V(6); PG8_BAR;
    for (;;) {
        const bool has_next = S.next(ui + 1, nxt);
        const char* nA = has_next ? (const char*)g.A + (GATHER ? (size_t)0 : (size_t)nxt.pm * tstep) : cA; const char* nB = has_next ? (const char*)g.Bt + (size_t)nxt.pb * tstep : cB;
        for (int t = 0; t < nt; t += 2) {
            const bool last = (t == nt - 2);
            const char* a1 = cA + (size_t)(t + 1) * kstep;
            const char* a2 = last ? nA : cA + (size_t)(t + 2) * kstep; const char* b2 = last ? nB : cB + (size_t)(t + 2) * kstep;
            const char* a3 = a2 + kstep; const char* b3 = b2 + kstep;
            if (last && has_next) S.a_ready(nxt);
            unsigned o2[2][2];
            if constexpr (GATHER) {
                if (last) { if (has_next) { PG8_AOFFS(noffA, nxt); } else {
#pragma unroll
                        for (int h = 0; h < 2; ++h) { noffA[h][0] = offA[h][0]; noffA[h][1] = offA[h][1]; } } }
#pragma unroll
                for (int h = 0; h < 2; ++h) { o2[h][0] = last ? noffA[h][0] : offA[h][0]; o2[h][1] = last ? noffA[h][1] : offA[h][1]; }
            } else {
#pragma unroll
                for (int h = 0; h < 2; ++h) { o2[h][0] = offA[h][0]; o2[h][1] = offA[h][1]; }
            }
            PG8_LDB(B0, 0, 0); PG8_LDB(B1, 0, 1); PG8_SCHED; PG8_LDA(At, 0, 0); PG8_STAGE(PG8_SA(1, 1), a1, offA[1]);
            PG8_WAIT_V(8); PG8_WAIT_L(0); PG8_BAR; PG8_MMA(0, 0, At, B0); PG8_MMA(0, 1, At, B1); PG8_BAR; PG8_SCHED;
            PG8_LDA(At, 0, 1); PG8_STAGE(PG8_SB(0, 0), b2, voffB); PG8_STAGE(PG8_SB(0, 1), b2 + hstep, voffB); PG8_STAGE(PG8_SA(0, 0), a2, o2[0]);
            PG8_WAIT_V(8); PG8_WAIT_L(0); PG8_BAR; PG8_MMA(1, 0, At, B0); PG8_MMA(1, 1, At, B1); PG8_BAR; PG8_SCHED;
            PG8_LDB(B0, 1, 0); PG8_LDB(B1, 1, 1); PG8_SCHED; PG8_LDA(At, 1, 0); PG8_STAGE(PG8_SA(0, 1), a2, o2[1]);
            PG8_WAIT_V(8); PG8_WAIT_L(0); PG8_BAR; PG8_MMA(0, 0, At, B0); PG8_MMA(0, 1, At, B1); PG8_BAR; PG8_SCHED;
            PG8_LDA(At, 1, 1); PG8_STAGE(PG8_SB(1, 0), b3, voffB); PG8_STAGE(PG8_SB(1, 1), b3 + hstep, voffB); PG8_STAGE(PG8_SA(1, 0), a3, o2[0]);
            PG8_WAIT_V(8); PG8_WAIT_L(0); PG8_BAR; PG8_MMA(1, 0, At, B0); PG8_MMA(1, 1, At, B1); PG8_BAR; PG8_SCHED;
        }
        if (wr == 0) PG8_BAR;
        E(acc, cur, wr, wc, fr, fq); S.done(cur);
        if (!has_next) break;
#pragma unroll
        for (int a = 0; a < 2; ++a)
#pragma unroll
            for (int b = 0; b < 2; ++b)
#pragma unroll
                for (int m = 0; m < 4; ++m)
#pragma unroll
                    for (int n = 0; n < 2; ++n) acc[a][b][m][n] = (f32x4){0.f, 0.f, 0.f, 0.f};
        cur = nxt; cA = nA; cB = nB; ++ui;
        if constexpr (GATHER) {
#pragma unroll
            for (int h = 0; h < 2; ++h) { offA[h][0] = noffA[h][0]; offA[h][1] = noffA[h][1]; } }
        if (wr == 1) PG8_BAR;
    }
    PG8_WAIT_V(0);
    PG8_BAR;
#undef PG8_SA
#undef PG8_SB
#undef PG8_STAGE
#undef PG8_LDA
#undef PG8_LDB
#undef PG8_MMA
#undef PG8_WAIT_V
#undef PG8_WAIT_L
#undef PG8_BAR
#undef PG8_SCHED
#undef PG8_AOFFS
}
}
#define GAS __attribute__((address_space(1)))
#define LAS __attribute__((address_space(3)))
typedef unsigned short bf16;
typedef unsigned v4u __attribute__((ext_vector_type(4)));
typedef float f32x4 __attribute__((ext_vector_type(4)));
typedef short bf16x8 __attribute__((ext_vector_type(8)));
typedef GAS unsigned gu32;
typedef GAS unsigned long long gu64;
#define RLX_AGENT __ATOMIC_RELAXED, __HIP_MEMORY_SCOPE_AGENT
#define LDS_WAIT() asm volatile("s_waitcnt lgkmcnt(0)" ::: "memory")
#define VM_WAIT() asm volatile("s_waitcnt vmcnt(0)" ::: "memory")
__device__ __forceinline__ unsigned long long rt() { return __builtin_amdgcn_s_memrealtime(); }
__device__ __forceinline__ unsigned f2bf(float f) { unsigned u = __builtin_bit_cast(unsigned, f); return (u + 0x7fffu + ((u >> 16) & 1u)) >> 16; }
__device__ __forceinline__ unsigned pk2(float lo, float hi) { return f2bf(lo) | (f2bf(hi) << 16); }

#define XB_TMO      128
#define XB_XCNT(j)  (256  + 64 * (j))
#define XB_XSUB(j)  (1280 + 64 * (j))
#define XB_XGEN(j)  (2304 + 64 * (j))
#define XB_TOP      3328
#define XB_TOPGEN   3392
#define XCD_BAR_WORDS 3456
#define XB_SPIN_CAP (1u << 18)

__device__ __forceinline__ unsigned xb_ld(unsigned* p)              { return __hip_atomic_load(p, __ATOMIC_RELAXED, __HIP_MEMORY_SCOPE_AGENT); }
__device__ __forceinline__ unsigned xb_add(unsigned* p, unsigned v) { return __hip_atomic_fetch_add(p, v, __ATOMIC_RELAXED, __HIP_MEMORY_SCOPE_AGENT); }
__device__ __forceinline__ unsigned xb_xcc_id() { return (unsigned)__builtin_amdgcn_s_getreg((3 << 11) | 20) & 0xFu; }
#define XB_SPIN(cond, bar) do { unsigned _sp = 0; while (cond) { __builtin_amdgcn_s_sleep(1); \
    if ((++_sp & 255u) == 0u) { if (xb_ld(&(bar)[XB_TMO])) break; if (_sp > XB_SPIN_CAP) { atomicAdd(&(bar)[XB_TMO], 1u); break; } } } } while (0)

struct XcdBarrier {
    unsigned* bar; unsigned x;
    volatile LAS unsigned* st;
};

__device__ __forceinline__ XcdBarrier xcd_barrier_post(unsigned* bar, volatile LAS unsigned* st) {
    XcdBarrier b; b.bar = bar; b.x = xb_xcc_id(); b.st = st;
    if (threadIdx.x == 0) (void)xb_add(&bar[XB_XCNT(b.x)], 1u);
    return b;
}
__device__ __forceinline__ void xcd_barrier_complete(unsigned* bar, unsigned x, unsigned& nloc, unsigned& nx) {
    const unsigned G = gridDim.x * gridDim.y * gridDim.z;
    unsigned sum, cnt, mine, sp = 0u;
    for (;;) {
        sum = 0u; cnt = 0u; mine = 0u;
#pragma unroll
        for (unsigned j = 0; j < 16; ++j) { const unsigned c = xb_ld(&bar[XB_XCNT(j)]); sum += c; cnt += (c > 0u) ? 1u : 0u; mine = (j == x) ? c : mine; }
        if (sum == G) break;
        __builtin_amdgcn_s_sleep(1);
        if ((++sp & 255u) == 0u) { if (xb_ld(&bar[XB_TMO])) break; if (sp > XB_SPIN_CAP) { atomicAdd(&bar[XB_TMO], 1u); break; } }
    }
    nloc = mine > 0u ? mine : 1u; nx = cnt > 0u ? cnt : 1u;
}

__device__ __forceinline__ void xcd_barrier(const XcdBarrier& b) {
    asm volatile("s_waitcnt vmcnt(0)" ::: "memory");
    __syncthreads();
    if (threadIdx.x == 0) {
        unsigned* bar = b.bar;
        __builtin_amdgcn_s_waitcnt(0);
        unsigned nloc = b.st[0], nx = b.st[1];
        if (nloc == 0u) { xcd_barrier_complete(bar, b.x, nloc, nx); b.st[0] = nloc; b.st[1] = nx; }
        const unsigned old = xb_add(&bar[XB_XSUB(b.x)], 1u);
        const unsigned gen = old / nloc;
        if (old + 1u == (gen + 1u) * nloc) {
            __builtin_amdgcn_fence(__ATOMIC_RELEASE, "agent");
            asm volatile("s_waitcnt vmcnt(0)" ::: "memory");
            const unsigned og = xb_add(&bar[XB_TOP], 1u);
            const unsigned tg = og / nx;
            if (og + 1u == (tg + 1u) * nx) xb_add(&bar[XB_TOPGEN], 1u);
            else XB_SPIN(xb_ld(&bar[XB_TOPGEN]) == tg, bar);
            __builtin_amdgcn_fence(__ATOMIC_ACQUIRE, "agent");
            xb_add(&bar[XB_XGEN(b.x)], 1u);
            asm volatile("s_waitcnt vmcnt(0)" ::: "memory");
        } else {
            XB_SPIN(xb_ld(&bar[XB_XGEN(b.x)]) == gen, bar);
            __builtin_amdgcn_fence(__ATOMIC_ACQUIRE, "agent");
            asm volatile("s_waitcnt vmcnt(0)" ::: "memory");
        }
    }
    __syncthreads();
}


constexpr int NWAVES = 8, NT = NWAVES * 64;
constexpr int D = 1024, BATCH = 8, SEQ = 4096, DEPTH = 2, GRIDW = 64, CTXL = 256, GWID = 256, HD = 64, NHEAD = 4;
constexpr int INC = 2048, NEXP = 16, MHID = 512;
constexpr int NLAT = BATCH * SEQ, NCTX = BATCH * CTXL, NROW = NLAT + NCTX;
constexpr float EPS = 1e-6f;
constexpr int UC_AV = 0, UC_AB = 256, UC_AC = 512, UC_P = 768, UC_Q = 1024, UC_K = 1280, UC_V = 1536, UC_F = 1792;

constexpr size_t MiB = 1u << 20;
constexpr size_t WS_CTL = 0, CTL_ZERO_BYTES = 65536;
constexpr size_t WS_MOD  = 1 * MiB;
constexpr size_t WS_PWT  = 1 * MiB + 768 * 1024;
constexpr size_t WS_INFO = 2 * MiB;
constexpr size_t WS_BM   = 7 * MiB;
constexpr size_t WS_WIN  = 8 * MiB;
constexpr size_t WS_WOUT = 16 * MiB;
constexpr size_t WS_W13  = 20 * MiB;
constexpr size_t WS_W2   = 84 * MiB;
constexpr size_t WS_XC   = 116 * MiB;
constexpr size_t WS_H    = 124 * MiB;
constexpr size_t WS_U    = 192 * MiB;
constexpr size_t WS_S    = 328 * MiB;
constexpr size_t WS_END  = 472 * MiB;
constexpr size_t WS_KF   = WS_S;
constexpr size_t WS_VF   = WS_S + 28 * MiB;
constexpr size_t WS_KFC  = WS_S + 60 * MiB;
constexpr size_t WS_VFC  = WS_S + 61 * MiB;
constexpr size_t WS_Z    = WS_S + 64 * MiB;
constexpr size_t NZ = (size_t)BATCH * NHEAD * SEQ * HD;
constexpr size_t NZC = (size_t)BATCH * NHEAD * CTXL * HD;
constexpr int CAP = NROW;

constexpr int CW_CNT = 2048;
constexpr int CW_BAR = 4096;

constexpr int RING_OFF = 0, RING_BYTES = 131072;
constexpr int LDSCTL_OFF = RING_BYTES, MISC_OFF = LDSCTL_OFF + 320;
constexpr int TAB_OFF = RING_BYTES + 1024;
constexpr int LDS_BYTES = 147456;

struct Frame {
    LAS unsigned char* lds;
    volatile LAS unsigned* MISC;
    gu32* ctl;
    int tid, lane, wave, G, bid;
    float* out; unsigned char* ws;
    static __device__ __forceinline__ const void* karg(int off) {
        const __attribute__((address_space(4))) char* ka = (const __attribute__((address_space(4))) char*)__builtin_amdgcn_kernarg_segment_ptr();
        asm volatile("" : "+s"(ka));
        return *(const void* const __attribute__((address_space(4)))*)(ka + off);
    }
    __device__ __forceinline__ const float* inp(int i) const { return (const float*)karg(8 * i); }
};
extern __shared__ __attribute__((aligned(16))) unsigned char dyn_lds[];
__device__ __forceinline__ Frame mk_frame() {
    Frame F; int t_ = threadIdx.x; asm volatile("" : "+v"(t_));
    F.tid = t_; F.lane = F.tid & 63; F.wave = __builtin_amdgcn_readfirstlane(F.tid >> 6); F.G = gridDim.x; F.bid = blockIdx.x;
    F.lds = (LAS unsigned char*)dyn_lds; F.MISC = (volatile LAS unsigned*)(F.lds + MISC_OFF);
    F.out = (float*)Frame::karg(160); F.ws = (unsigned char*)Frame::karg(168); F.ctl = (gu32*)(F.ws + WS_CTL);
    return F;
}
enum { I_X = 0, I_C, I_CTX, I_CCTX, I_ADAW, I_ADAB, I_N1G, I_N2G, I_WIN, I_CONVW, I_POOLW, I_POOLS, I_RPB, I_WOUT, I_RW, I_RB, I_W1, I_W3, I_W2, I_FG };

__device__ __forceinline__ float wave_sum(float v) {
#pragma unroll
    for (int o = 1; o < 64; o <<= 1) v += __shfl_xor(v, o);
    return v;
}
__device__ __forceinline__ float bflo(unsigned w) { return __builtin_bit_cast(float, w << 16); }
__device__ __forceinline__ float bfhi(unsigned w) { return __builtin_bit_cast(float, w & 0xffff0000u); }
__device__ __forceinline__ float bf2f(bf16 b) { return __builtin_bit_cast(float, (unsigned)b << 16); }

__device__ __forceinline__ void tr_item(const float* W, int K, int N, bf16* WT, int k0, int n0, int drow0, LAS float* scr, int lane) {
#pragma unroll
    for (int i = 0; i < 8; ++i) { const int kk = 8 * i + (lane >> 3), n4 = 4 * (lane & 7); const f32x4 w = *(const GAS f32x4*)(W + (size_t)(k0 + kk) * N + n0 + n4);
        LAS float* sp = scr + kk * 33 + n4; sp[0] = w.x; sp[1] = w.y; sp[2] = w.z; sp[3] = w.w; }
    LDS_WAIT(); asm volatile("" ::: "memory");
    const int c = lane & 7;
#pragma unroll
    for (int j = 0; j < 4; ++j) { const int n = (lane >> 3) + 8 * j; const LAS float* s = scr + (8 * c) * 33 + n;
        v4u o; o.x = pk2(s[0 * 33], s[1 * 33]); o.y = pk2(s[2 * 33], s[3 * 33]); o.z = pk2(s[4 * 33], s[5 * 33]); o.w = pk2(s[6 * 33], s[7 * 33]);
        *(GAS v4u*)(WT + (size_t)(drow0 + n) * K + k0 + 8 * c) = o; }
    LDS_WAIT(); asm volatile("" ::: "memory");
}
__device__ __forceinline__ void pa_phase() { Frame F = mk_frame();
    LAS float* scr = (LAS float*)(F.lds + RING_OFF + F.wave * 16384);
    const int gw = F.bid * NWAVES + F.wave, NGW = F.G * NWAVES;
    bf16* WIN = (bf16*)(F.ws + WS_WIN); bf16* WOUT = (bf16*)(F.ws + WS_WOUT); bf16* W13 = (bf16*)(F.ws + WS_W13); bf16* W2 = (bf16*)(F.ws + WS_W2);
    constexpr int I_IN = 2 * 16 * 64, I_OUT = 2 * 16 * 32, I_1 = 32 * 16 * 16, I_2 = 32 * 8 * 32;
    constexpr int NITEMS = I_IN + I_OUT + 2 * I_1 + I_2;
    for (int it = gw; it < NITEMS; it += NGW) {
        int r = it;
        if (r < I_IN) { const int l = r / 1024, q = r % 1024, kb = q / 64, nb = q % 64;
            tr_item(F.inp(I_WIN) + (size_t)l * D * INC, D, INC, WIN + (size_t)l * INC * D, 64 * kb, 32 * nb, 32 * nb, scr, F.lane); continue; } r -= I_IN;
        if (r < I_OUT) { const int l = r / 512, q = r % 512, kb = q / 32, nb = q % 32;
            tr_item(F.inp(I_WOUT) + (size_t)l * D * D, D, D, WOUT + (size_t)l * D * D, 64 * kb, 32 * nb, 32 * nb, scr, F.lane); continue; } r -= I_OUT;
        if (r < 2 * I_1) { const int which = r / I_1; const int q0 = r % I_1; const int le = q0 / 256, q = q0 % 256, kb = q / 16, nb = q % 16;
            const int n0 = 32 * nb; const int drow0 = 256 * (n0 / 128) + 128 * which + (n0 % 128);
            tr_item(F.inp(which ? I_W3 : I_W1) + (size_t)le * D * MHID, D, MHID, W13 + (size_t)le * 1024 * D, 64 * kb, n0, drow0, scr, F.lane); continue; } r -= 2 * I_1;
        { const int le = r / 256, q = r % 256, kb = q / 32, nb = q % 32;
            tr_item(F.inp(I_W2) + (size_t)le * MHID * D, MHID, D, W2 + (size_t)le * D * MHID, 64 * kb, 32 * nb, 32 * nb, scr, F.lane); }
    }
    { bf16* PWT = (bf16*)(F.ws + WS_PWT); const float* pw = F.inp(I_POOLW);
      for (int i = F.bid * NT + F.tid; i < 2 * 4 * 64 * 64; i += F.G * NT) { const int c = i & 63, dd = (i >> 6) & 63, lg = i >> 12; PWT[i] = (bf16)f2bf(pw[((size_t)lg * 64 + c) * 64 + dd]); } }
    __syncthreads();
    LAS float* sc = (LAS float*)(F.lds + RING_OFF);
    LAS float* part = (LAS float*)(F.lds + RING_OFF + 40960);
    float* MOD = (float*)(F.ws + WS_MOD);
    bool have_sc = false;
    for (int it = F.bid; it < 2 * 96; it += F.G) {
        if (!have_sc) { for (int i = F.tid; i < 9 * 1024; i += NT) { const float v = i < 8192 ? F.inp(I_C)[i] : F.inp(I_CCTX)[i - 8192]; sc[i] = v / (1.0f + __expf(-v)); } have_sc = true; }
        __syncthreads();
        const int l = it / 96, cb = it % 96, col = cb * 64 + F.lane;
        const float* aw = F.inp(I_ADAW) + (size_t)l * D * 6144 + col;
        float acc[9];
#pragma unroll
        for (int r = 0; r < 9; ++r) acc[r] = 0.f;
        for (int k = F.wave * 128; k < F.wave * 128 + 128; ++k) { const float wv = aw[(size_t)k * 6144];
#pragma unroll
            for (int r = 0; r < 9; ++r) acc[r] += sc[r * 1024 + k] * wv; }
#pragma unroll
        for (int r = 0; r < 9; ++r) part[(F.wave * 9 + r) * 64 + F.lane] = acc[r];
        __syncthreads();
        for (int i = F.tid; i < 9 * 64; i += NT) { const int r = i >> 6, ln = i & 63; float s = F.inp(I_ADAB)[(size_t)l * 6144 + cb * 64 + ln];
#pragma unroll
            for (int w = 0; w < 8; ++w) s += part[(w * 9 + r) * 64 + ln];
            MOD[((size_t)l * 9 + r) * 6144 + cb * 64 + ln] = s; }
        __syncthreads();
    }
}

typedef unsigned v2u_ __attribute__((ext_vector_type(2)));
__device__ __forceinline__ unsigned cvt_pk_bf(float lo, float hi) { unsigned r; asm volatile("v_cvt_pk_bf16_f32 %0, %1, %2" : "=v"(r) : "v"(lo), "v"(hi)); return r; }
struct XStream { const char* lat; const char* ctx; int lat_stride, ctx_stride;
    __device__ __forceinline__ const char* row(int r) const { return r < NLAT ? lat + (size_t)r * lat_stride : ctx + (size_t)(r - NLAT) * ctx_stride; } };
struct RowIn { f32x4 x[4]; unsigned long long xb[4], ya[4], yb[4]; };
__device__ __forceinline__ f32x4 unpk4(unsigned long long a) { f32x4 y; y.x = bflo((unsigned)a); y.y = bfhi((unsigned)a); y.z = bflo((unsigned)(a >> 32)); y.w = bfhi((unsigned)(a >> 32)); return y; }
template <int ADD, bool XBF>
__device__ __forceinline__ void row_load(Frame& F, int r, const char* xr, const bf16* Y2, RowIn& in) {
#pragma unroll
    for (int j = 0; j < 4; ++j) { const int c = 4 * F.lane + 256 * j;
        if (XBF) in.xb[j] = *(const GAS unsigned long long*)(xr + 2 * c); else in.x[j] = *(const GAS f32x4*)(xr + 4 * c);
        if (ADD == 1) { in.ya[j] = *(const GAS unsigned long long*)(Y2 + (size_t)r * 2048 + c); in.yb[j] = *(const GAS unsigned long long*)(Y2 + (size_t)r * 2048 + 1024 + c); }
        if (ADD == 2) { in.ya[j] = *(const GAS unsigned long long*)(Y2 + (size_t)r * 1024 + c); } }
}
struct RowPar { f32x4 a[4], b[4], gt[4]; int modrow; };
template <int ADD, bool FINAL>
__device__ __forceinline__ void row_params(Frame& F, int modrow, const float* g, const float* modl, const float* modadd, int ch_sh, int ch_sc, RowPar& P) {
    P.modrow = modrow;
#pragma unroll
    for (int j = 0; j < 4; ++j) { const int c = 4 * F.lane + 256 * j; const f32x4 gv = *(const GAS f32x4*)(g + c);
        if (FINAL) { P.a[j] = gv; P.b[j] = (f32x4){0.f, 0.f, 0.f, 0.f}; }
        else { const float* mrow = modl + (size_t)modrow * 6144; P.a[j] = gv * (*(const GAS f32x4*)(mrow + ch_sc * 1024 + c) + 1.0f); P.b[j] = *(const GAS f32x4*)(mrow + ch_sh * 1024 + c); }
        if (ADD) P.gt[j] = *(const GAS f32x4*)(modadd + (size_t)modrow * 6144 + (ADD == 1 ? 5 : 2) * 1024 + c); else P.gt[j] = (f32x4){0.f, 0.f, 0.f, 0.f}; }
}
template <int ADD, bool FINAL, bool XBF>
__device__ __forceinline__ void row_finish(Frame& F, const RowIn& in, const RowPar& P, char* xw, bf16* dst, float* fout, f32x4 (&v)[4]) {
    float ss = 0.f;
#pragma unroll
    for (int j = 0; j < 4; ++j) { const int c = 4 * F.lane + 256 * j; v[j] = XBF ? unpk4(in.xb[j]) : in.x[j];
        if (ADD) { f32x4 ya = unpk4(in.ya[j]); if (ADD == 1) ya = ya + unpk4(in.yb[j]);
            v[j] = v[j] + P.gt[j] * ya;
            if (!FINAL) *(GAS v2u_*)(xw + 2 * c) = (v2u_){cvt_pk_bf(v[j].x, v[j].y), cvt_pk_bf(v[j].z, v[j].w)}; }
        ss += (v[j].x * v[j].x + v[j].y * v[j].y) + (v[j].z * v[j].z + v[j].w * v[j].w); }
    ss = wave_sum(ss);
    const float rstd = 1.0f / sqrtf(ss * (1.0f / D) + EPS);
#pragma unroll
    for (int j = 0; j < 4; ++j) { const int c = 4 * F.lane + 256 * j;
        if (FINAL) { *(GAS f32x4*)(fout + c) = v[j] * rstd * P.a[j]; }
        else { v[j] = v[j] * rstd * P.a[j] + P.b[j];
            *(GAS v2u_*)(dst + c) = (v2u_){cvt_pk_bf(v[j].x, v[j].y), cvt_pk_bf(v[j].z, v[j].w)}; } }
}
template <int ADD, bool FINAL, bool XBF>
__device__ __forceinline__ void norm_phase(Frame& F, const XStream xin, const XStream xout, int nrows, const float* g, const float* modl, const float* modadd, int ch_sh, int ch_sc, bf16* dst, const bf16* Y2, float* fout) {
    const int rpb = (nrows + F.G - 1) / F.G;
    int i = F.wave; int r = F.bid * rpb + i; if (i >= rpb || r >= nrows) return;
    RowIn cur; row_load<ADD, XBF>(F, r, xin.row(r), Y2, cur);
    RowPar P; P.modrow = -1;
    for (;;) {
        const int in_ = i + NWAVES, rn = F.bid * rpb + in_; const bool more = (in_ < rpb) && (rn < nrows);
        RowIn nxt;
        if (more) row_load<ADD, XBF>(F, rn, xin.row(rn), Y2, nxt);
        const int modrow = r < NLAT ? (r >> 12) : 8;
        if (modrow != P.modrow) row_params<ADD, FINAL>(F, modrow, g, modl, modadd, ch_sh, ch_sc, P);
        f32x4 v[4];
        row_finish<ADD, FINAL, XBF>(F, cur, P, (char*)xout.row(r), dst + (size_t)r * D, fout + (size_t)r * D, v);
        if (!more) break;
        cur = nxt; r = rn; i = in_;
    }
}
template <bool XBF>
__device__ __forceinline__ void route_phase(Frame& F, int l, const XStream xin, const XStream xout, const bf16* O, int nrows, const float* g, const float* modl, bf16* dst, uint2* info, unsigned* cnt) {
    LAS int* lcnt = (LAS int*)(F.lds + RING_OFF); LAS int* lbase = lcnt + 16; LAS int* rec_e = lcnt + 32; LAS int* rec_p = rec_e + 512; LAS float* rec_w = (LAS float*)(rec_p + 512);
    const int rpb = (nrows + F.G - 1) / F.G;
    if (F.tid < 16) lcnt[F.tid] = 0;
    LAS float* WT = (LAS float*)(F.lds + RING_OFF + 32768);
    LAS float* LG = (LAS float*)(F.lds + RING_OFF + 8192);
    { const float* rwp = F.inp(I_RW); for (int i = F.tid; i < 1024 * 16; i += NT) { const int k = i >> 4, e = i & 15; WT[e * 1024 + k] = rwp[i]; } }
    __syncthreads();
    const float* rbp = F.inp(I_RB);
    RowPar P; P.modrow = -1;
    RowIn cur; bool have = (F.wave < rpb) && (F.bid * rpb + F.wave < nrows);
    if (have) { const int r = F.bid * rpb + F.wave; row_load<2, XBF>(F, r, xin.row(r), O, cur); }
    for (int i = F.wave; have; i += NWAVES) {
        const int r = F.bid * rpb + i;
        const int in_ = i + NWAVES, rn = F.bid * rpb + in_; const bool more = (in_ < rpb) && (rn < nrows);
        RowIn nxt;
        if (more) row_load<2, XBF>(F, rn, xin.row(rn), O, nxt);
        f32x4 v[4];
        { const int modrow = r < NLAT ? (r >> 12) : 8; if (modrow != P.modrow) row_params<2, false>(F, modrow, g, modl, modl, 3, 4, P); }
        row_finish<2, false, XBF>(F, cur, P, (char*)xout.row(r), dst + (size_t)r * D, nullptr, v);
        typedef float f32x2 __attribute__((ext_vector_type(2)));
        f32x2 s2[16];
#pragma unroll
        for (int e = 0; e < 16; ++e) s2[e] = (f32x2){0.f, 0.f};
#pragma unroll
        for (int j = 0; j < 4; ++j) { const f32x2 vlo = (f32x2){v[j].x, v[j].y}, vhi = (f32x2){v[j].z, v[j].w};
#pragma unroll
            for (int e = 0; e < 16; ++e) { const f32x4 w4 = *(const LAS f32x4*)(WT + e * 1024 + 4 * F.lane + 256 * j); s2[e] += vlo * (f32x2){w4.x, w4.y}; s2[e] += vhi * (f32x2){w4.z, w4.w}; } }
        float s16[16];
#pragma unroll
        for (int e = 0; e < 16; ++e) s16[e] = s2[e].x + s2[e].y;
        { float a8[8], a4[4], a2[2]; const bool h5 = F.lane & 32, h4 = F.lane & 16, h3 = F.lane & 8, h2 = F.lane & 4;
#pragma unroll
          for (int k = 0; k < 8; ++k) { const float send = h5 ? s16[k] : s16[k + 8], keep = h5 ? s16[k + 8] : s16[k]; a8[k] = keep + __shfl_xor(send, 32); }
#pragma unroll
          for (int k = 0; k < 4; ++k) { const float send = h4 ? a8[k] : a8[k + 4], keep = h4 ? a8[k + 4] : a8[k]; a4[k] = keep + __shfl_xor(send, 16); }
#pragma unroll
          for (int k = 0; k < 2; ++k) { const float send = h3 ? a4[k] : a4[k + 2], keep = h3 ? a4[k + 2] : a4[k]; a2[k] = keep + __shfl_xor(send, 8); }
          const float send = h2 ? a2[0] : a2[1], keep = h2 ? a2[1] : a2[0]; float a1 = keep + __shfl_xor(send, 4);
          a1 += __shfl_xor(a1, 1); a1 += __shfl_xor(a1, 2);
          if ((F.lane & 3) == 0) LG[i * 17 + 8 * ((F.lane >> 5) & 1) + 4 * ((F.lane >> 4) & 1) + 2 * ((F.lane >> 3) & 1) + ((F.lane >> 2) & 1)] = a1; }
        have = more; cur = nxt;
    }
    __syncthreads();
    for (int i = F.tid; i < rpb; i += NT) { if (F.bid * rpb + i >= nrows) break;
        float s16[16], bs[16];
#pragma unroll
        for (int e = 0; e < 16; ++e) { s16[e] = 1.0f / (1.0f + expf(-LG[i * 17 + e])); bs[e] = s16[e] + rbp[e]; }
        float best = -3.0e38f; int bg = 0;
#pragma unroll
        for (int gq = 0; gq < 4; ++gq) { const float a0 = bs[4 * gq], a1 = bs[4 * gq + 1], a2 = bs[4 * gq + 2], a3 = bs[4 * gq + 3];
            const float gs = fmaxf(fmaxf(fmaxf(a0 + a1, a0 + a2), fmaxf(a0 + a3, a1 + a2)), fmaxf(a1 + a3, a2 + a3));
            if (gs > best) { best = gs; bg = gq; } }
        float cb[4], cs[4];
#pragma unroll
        for (int ii = 0; ii < 4; ++ii) { cb[ii] = 0.f; cs[ii] = 0.f; }
#pragma unroll
        for (int gq = 0; gq < 4; ++gq)
#pragma unroll
            for (int ii = 0; ii < 4; ++ii) { cb[ii] = (gq == bg) ? bs[4 * gq + ii] : cb[ii]; cs[ii] = (gq == bg) ? s16[4 * gq + ii] : cs[ii]; }
        int i1 = 0; float b1 = cb[0], s1 = cs[0];
#pragma unroll
        for (int ii = 1; ii < 4; ++ii) if (cb[ii] > b1) { b1 = cb[ii]; s1 = cs[ii]; i1 = ii; }
        int i2 = -1; float b2 = -3.0e38f, s2 = 0.f;
#pragma unroll
        for (int ii = 0; ii < 4; ++ii) if (ii != i1 && cb[ii] > b2) { b2 = cb[ii]; s2 = cs[ii]; i2 = ii; }
        const float inv = 1.0f / (s1 + s2);
        const int e1 = 4 * bg + i1, e2 = 4 * bg + i2;
        rec_e[2 * i] = e1; rec_p[2 * i] = atomicAdd((int*)&lcnt[e1], 1); rec_w[2 * i] = s1 * inv;
        rec_e[2 * i + 1] = e2; rec_p[2 * i + 1] = atomicAdd((int*)&lcnt[e2], 1); rec_w[2 * i + 1] = s2 * inv;
    }
    __syncthreads();
    if (F.tid < 16) lbase[F.tid] = (int)__hip_atomic_fetch_add(cnt + F.tid, (unsigned)lcnt[F.tid], __ATOMIC_RELAXED, __HIP_MEMORY_SCOPE_AGENT);
    __syncthreads();
    for (int j = F.tid; j < 2 * rpb; j += NT) { const int r = F.bid * rpb + (j >> 1); if (r < nrows) { const int e = rec_e[j];
        info[(size_t)e * CAP + lbase[e] + rec_p[j]] = make_uint2((unsigned)(r * 2 + (j & 1)), __builtin_bit_cast(unsigned, rec_w[j])); } }
}
__device__ __forceinline__ void moe_table(Frame& F, int l) {
    LAS int* tab = (LAS int*)(F.lds + TAB_OFF);
    if (F.tid < 64) {
        const unsigned* cnt = (const unsigned*)(F.ctl + CW_CNT + l * 16);
        const int n = F.tid < 16 ? (int)__hip_atomic_load(cnt + F.tid, __ATOMIC_RELAXED, __HIP_MEMORY_SCOPE_AGENT) : 0;
        const int np = (n + 255) >> 8; int x = np;
#pragma unroll
        for (int d = 1; d < 16; d <<= 1) { const int y = __shfl_up(x, d); if (F.lane >= d) x += y; }
        if (F.tid < 16) { tab[F.tid] = x - np; tab[17 + F.tid] = n; }
        if (F.tid == 15) tab[16] = x;
    }
    __syncthreads();
}

__device__ __forceinline__ void seq_info(int r, int& base, int& t, int& L) {
    if (r < NLAT) { base = r & ~(SEQ - 1); t = r & (SEQ - 1); L = SEQ; } else { const int j = r - NLAT; base = NLAT + (j & ~(CTXL - 1)); t = j & (CTXL - 1); L = CTXL; }
}
typedef unsigned v2u __attribute__((ext_vector_type(2)));
__device__ __forceinline__ unsigned cvtpk(float lo, float hi) { unsigned r; asm volatile("v_cvt_pk_bf16_f32 %0, %1, %2" : "=v"(r) : "v"(lo), "v"(hi)); return r; }
__device__ __forceinline__ bf16x8 mk8(v2u a, v2u b) { v4u w; w.x = a.x; w.y = a.y; w.z = b.x; w.w = b.y; return __builtin_bit_cast(bf16x8, w); }
template <bool LAT>
__device__ __forceinline__ void kv_unit(Frame& F, int bh, int rq, LAS unsigned short* T) {
    const bf16* U = (const bf16*)(F.ws + WS_U);
    const int q = F.lane & 15, g = F.lane >> 4, h = bh & 3;
    const int urow0 = LAT ? ((bh >> 2) * SEQ + rq * 64) : (NLAT + (bh >> 2) * CTXL + rq * 64);
    bf16* kdst = LAT ? (bf16*)(F.ws + WS_KF) + ((size_t)(bh * 64 + rq) * 14) * 512 : (bf16*)(F.ws + WS_KFC) + ((size_t)(bh * 16 + rq * 4) * 2) * 512;
    bf16* vdst = LAT ? (bf16*)(F.ws + WS_VF) + ((size_t)(bh * 64 + rq) * 16) * 512 : (bf16*)(F.ws + WS_VFC) + ((size_t)(bh * 8 + rq * 2) * 4) * 512;
    { const bf16* src = U + (size_t)(urow0 + F.lane) * INC + UC_V + h * HD;
      v4u vw[8];
#pragma unroll
      for (int p = 0; p < 8; ++p) vw[p] = *(const GAS v4u*)(src + 8 * p);
#pragma unroll
      for (int p = 0; p < 8; ++p) { const v4u w = vw[p]; LAS unsigned short* tp = T + (8 * p) * 72 + F.lane;
          tp[0 * 72] = (unsigned short)w.x; tp[1 * 72] = (unsigned short)(w.x >> 16); tp[2 * 72] = (unsigned short)w.y; tp[3 * 72] = (unsigned short)(w.y >> 16);
          tp[4 * 72] = (unsigned short)w.z; tp[5 * 72] = (unsigned short)(w.z >> 16); tp[6 * 72] = (unsigned short)w.w; tp[7 * 72] = (unsigned short)(w.w >> 16); } }
    constexpr int NK = LAT ? 7 : 4, KST = LAT ? 8 : 16;
    { v4u kw[NK][2];
#pragma unroll
      for (int sidx = 0; sidx < NK; ++sidx)
#pragma unroll
          for (int ks = 0; ks < 2; ++ks) kw[sidx][ks] = *(const GAS v4u*)(U + (size_t)(urow0 + KST * sidx + q) * INC + UC_K + h * HD + 32 * ks + 8 * g);
      __builtin_amdgcn_sched_barrier(0);
#pragma unroll
      for (int sidx = 0; sidx < NK; ++sidx)
#pragma unroll
          for (int ks = 0; ks < 2; ++ks) *(GAS v4u*)(kdst + (size_t)(sidx * 2 + ks) * 512 + F.lane * 8) = kw[sidx][ks]; }
    LDS_WAIT(); asm volatile("" ::: "memory");
    constexpr int NV = LAT ? 4 : 2;
#pragma unroll
    for (int w = 0; w < NV; ++w) { const int vst = LAT ? (w == 0 ? 0 : (w == 1 ? 8 : (w == 2 ? 24 : 32))) : 32 * w;
#pragma unroll
        for (int dt = 0; dt < 4; ++dt) { const LAS unsigned short* tp = T + (16 * dt + q) * 72 + vst + 4 * g; const v2u lo = *(const LAS v2u*)tp, hi = *(const LAS v2u*)(tp + 16);
            v4u o; o.x = lo.x; o.y = lo.y; o.z = hi.x; o.w = hi.y; *(GAS v4u*)(vdst + (size_t)(w * 4 + dt) * 512 + F.lane * 8) = o; } }
    LDS_WAIT(); asm volatile("" ::: "memory");
}
__device__ __forceinline__ void kv_prepass(Frame& F) {
    LAS unsigned short* T = (LAS unsigned short*)(F.lds + RING_OFF + F.wave * 16384);
    const int gw = F.bid * NWAVES + F.wave, NGW = F.G * NWAVES;
#pragma unroll 1
    for (int idx = gw; idx < 2048; idx += NGW) kv_unit<true>(F, idx >> 6, idx & 63, T);
#pragma unroll 1
    for (int idx = gw; idx < 128; idx += NGW) kv_unit<false>(F, idx >> 2, idx & 3, T);
}
__device__ __forceinline__ void bias_table(Frame& F, int l) {
    float* BM = (float*)(F.ws + WS_BM); const float* rp = F.inp(I_RPB) + (size_t)l * NHEAD * 15 * 31;
    for (int i = F.bid * NT + F.tid; i < 4 * 4 * 15 * 64 * 8; i += F.G * NT) {
        const int e = i & 7, lane = (i >> 3) & 63, rrel = (i >> 9) % 15, hc = (i >> 9) / 15, cb = hc & 3, h = hc >> 2;
        const int q = lane & 15, g = lane >> 4, seg = e >> 2, ii = e & 3;
        const int wb = cb * 16 - 8 < 0 ? 0 : (cb * 16 - 8 > 32 ? 32 : cb * 16 - 8);
        const int cq = cb * 16 + q, c0 = cq - 8 < 0 ? 0 : (cq - 8 > 48 ? 48 : cq - 8), cc = wb + seg * 16 + 4 * g + ii;
        const bool ok = (cc >= c0) && (cc < c0 + 16);
        BM[i] = ok ? rp[(h * 15 + rrel) * 31 + (cc - cq + 15)] : -3.0e38f;
    }
}
template <bool LAT>
__device__ __forceinline__ void attn_unit(Frame& F, int l, int b, int h, int r, int cb, const LAS float* rpbs) {
    const bf16* U = (const bf16*)(F.ws + WS_U); bf16* Y = (bf16*)(F.ws + WS_H);
    const bf16* KF = (const bf16*)(F.ws + WS_KF); const bf16* VF = (const bf16*)(F.ws + WS_VF); const bf16* KFC = (const bf16*)(F.ws + WS_KFC); const bf16* VFC = (const bf16*)(F.ws + WS_VFC);
    const size_t bh = (size_t)(b * NHEAD + h);
    const int q = F.lane & 15, g = F.lane >> 4;
    constexpr int NT_ = LAT ? 32 : 16, NB = LAT ? 16 : 0;
    const int qrow = LAT ? (b * SEQ + r * GRIDW + cb * 16 + q) : (NLAT + b * CTXL + cb * 16 + q);
    const int r0 = r - 4 < 0 ? 0 : (r - 4 > 56 ? 56 : r - 4);
    const int wb = cb * 16 - 8 < 0 ? 0 : (cb * 16 - 8 > 32 ? 32 : cb * 16 - 8);
    bf16x8 qf[2];
#pragma unroll
    for (int ks = 0; ks < 2; ++ks) qf[ks] = *(const GAS bf16x8*)(U + (size_t)qrow * INC + UC_Q + h * HD + 32 * ks + 8 * g);
    f32x4 s[NT_];
#pragma unroll
    for (int t = 0; t < NT_; ++t) {
        const bf16* kp;
        if (t < NB) { const int kr = t >> 1, seg = t & 1; kp = KF + (((bh * 64 + (r0 + kr)) * 7 + ((wb >> 3) + 2 * seg)) * 2) * 512 + F.lane * 8; } else kp = KFC + ((bh * 16 + (t - NB)) * 2) * 512 + F.lane * 8;
        const bf16x8 k0 = *(const GAS bf16x8*)kp, k1 = *(const GAS bf16x8*)(kp + 512);
        f32x4 a = (f32x4){0.f, 0.f, 0.f, 0.f};
        a = __builtin_amdgcn_mfma_f32_16x16x32_bf16(k0, qf[0], a, 0, 0, 0);
        s[t] = __builtin_amdgcn_mfma_f32_16x16x32_bf16(k1, qf[1], a, 0, 0, 0);
    }
    float m = -3.0e38f;
    if (LAT) {
        const float* bm = (const float*)(F.ws + WS_BM) + ((size_t)((h * 4 + cb) * 15 + (r0 - r + 7)) * 64 + F.lane) * 8;
#pragma unroll
        for (int kr = 0; kr < 8; ++kr) { const f32x4 b0 = *(const GAS f32x4*)(bm + kr * 512), b1 = *(const GAS f32x4*)(bm + kr * 512 + 4);
#pragma unroll
            for (int i = 0; i < 4; ++i) { const float v0 = s[2 * kr][i] * 0.125f + b0[i], v1 = s[2 * kr + 1][i] * 0.125f + b1[i]; s[2 * kr][i] = v0; s[2 * kr + 1][i] = v1; m = fmaxf(m, fmaxf(v0, v1)); } }
    }
#pragma unroll
    for (int t = NB; t < NT_; ++t)
#pragma unroll
        for (int i = 0; i < 4; ++i) { const float v = s[t][i] * 0.125f; s[t][i] = v; m = fmaxf(m, v); }
    m = fmaxf(m, __shfl_xor(m, 16)); m = fmaxf(m, __shfl_xor(m, 32));
    float sum = 0.f;
#pragma unroll
    for (int t = 0; t < NT_; ++t)
#pragma unroll
        for (int i = 0; i < 4; ++i) { const float p = __expf(s[t][i] - m); s[t][i] = p; sum += p; }
    sum += __shfl_xor(sum, 16); sum += __shfl_xor(sum, 32);
    f32x4 o[4];
#pragma unroll
    for (int dt = 0; dt < 4; ++dt) o[dt] = (f32x4){0.f, 0.f, 0.f, 0.f};
#pragma unroll
    for (int kk = 0; kk < NT_ / 2; ++kk) {
        v4u pw; pw.x = cvtpk(s[2 * kk][0], s[2 * kk][1]); pw.y = cvtpk(s[2 * kk][2], s[2 * kk][3]); pw.z = cvtpk(s[2 * kk + 1][0], s[2 * kk + 1][1]); pw.w = cvtpk(s[2 * kk + 1][2], s[2 * kk + 1][3]);
        const bf16x8 pf = __builtin_bit_cast(bf16x8, pw);
        const bf16* vbase;
        if (2 * kk < NB) vbase = VF + (((bh * 64 + (r0 + kk)) * 4 + cb) * 4) * 512 + F.lane * 8; else vbase = VFC + ((bh * 8 + (kk - NB / 2)) * 4) * 512 + F.lane * 8;
#pragma unroll
        for (int dt = 0; dt < 4; ++dt) { const bf16x8 vf = *(const GAS bf16x8*)(vbase + dt * 512);
            o[dt] = __builtin_amdgcn_mfma_f32_16x16x32_bf16(vf, pf, o[dt], 0, 0, 0); }
    }
    const float inv = 1.0f / sum; bf16* yp = Y + (size_t)qrow * D + 512 + h * HD + 4 * g;
#pragma unroll
    for (int dt = 0; dt < 4; ++dt) { v2u w; w.x = cvtpk(o[dt][0] * inv, o[dt][1] * inv); w.y = cvtpk(o[dt][2] * inv, o[dt][3] * inv); *(GAS v2u*)(yp + dt * 16) = w; }
}
__device__ __forceinline__ void attn_phase(Frame& F, int l, bool with_ctx) {
    const LAS float* rpbs = nullptr;
    const int gw = F.bid * NWAVES + F.wave, NGW = F.G * NWAVES;
    {
        const int x = F.bid & 7, lb = F.bid >> 3, nlb = (F.G - x + 7) >> 3;
#pragma unroll 1
        for (int uu = lb * NWAVES + F.wave; uu < 1024; uu += nlb * NWAVES) { const int bh = 4 * x + (uu >> 8), u = uu & 255; attn_unit<true>(F, l, bh >> 2, bh & 3, u >> 2, u & 3, rpbs); } }
    if (with_ctx) for (int uid = gw; uid < BATCH * NHEAD * 16; uid += NGW) { const int cb = uid & 15, h = (uid >> 4) & 3, b = uid >> 6; attn_unit<false>(F, l, b, h, 0, cb, rpbs); }
}
__device__ __forceinline__ void dft64_tables(Frame& F, int off) {
    LAS unsigned short* CT = (LAS unsigned short*)(F.lds + off); LAS unsigned short* ST = CT + 64 * 72;
    for (int i = F.tid; i < 4096; i += NT) { const int j = i >> 6, k = i & 63; float s_, c_; sincospif((float)((j * k) & 63) * (1.0f / 32.0f), &s_, &c_); CT[j * 72 + k] = (unsigned short)f2bf(c_); ST[j * 72 + k] = (unsigned short)f2bf(s_); }
}
__device__ __forceinline__ void fourier_a(Frame& F) {
    const bf16* U = (const bf16*)(F.ws + WS_U); bf16* Zr = (bf16*)(F.ws + WS_Z); bf16* Zi = Zr + NZ;
    constexpr int O_CT = 0, O_TWC = 18432, O_TWS = O_TWC + 16384;
    dft64_tables(F, O_CT);
    { LAS float* twc = (LAS float*)(F.lds + O_TWC); LAS float* tws = (LAS float*)(F.lds + O_TWS);
      for (int i = F.tid; i < 4096; i += NT) { float s_, c_; sincospif((float)i * (1.0f / 2048.0f), &s_, &c_); twc[i] = c_; tws[i] = s_; } }
    __syncthreads();
    const LAS unsigned short* CT = (const LAS unsigned short*)(F.lds + O_CT); const LAS unsigned short* ST = CT + 64 * 72;
    const LAS float* twc = (const LAS float*)(F.lds + O_TWC); const LAS float* tws = (const LAS float*)(F.lds + O_TWS);
    const int q = F.lane & 15, g = F.lane >> 4;
    const int gw = F.bid * NWAVES + F.wave, NGW = F.G * NWAVES;
    for (int un = gw; un < BATCH * NHEAD * 64; un += NGW) {
        const int b = un >> 8, h = (un >> 6) & 3, n2 = un & 63;
        f32x4 xr[4][4], xw[4][4];
#pragma unroll
        for (int mt = 0; mt < 4; ++mt)
#pragma unroll
            for (int ct = 0; ct < 4; ++ct) { xr[mt][ct] = (f32x4){0.f, 0.f, 0.f, 0.f}; xw[mt][ct] = (f32x4){0.f, 0.f, 0.f, 0.f}; }
        bf16x8 tfa[2][4];
#pragma unroll
        for (int ks = 0; ks < 2; ++ks)
#pragma unroll
            for (int mt = 0; mt < 4; ++mt) tfa[ks][mt] = *(const GAS bf16x8*)(U + (size_t)(b * SEQ + 64 * (16 * mt + q) + n2) * INC + UC_F + h * HD + 32 * ks + 8 * g);
        __builtin_amdgcn_sched_barrier(0);
#pragma unroll
        for (int ks = 0; ks < 2; ++ks) {
            bf16x8 tf[4], cf[4], sf[4];
#pragma unroll
            for (int mt = 0; mt < 4; ++mt) tf[mt] = tfa[ks][mt];
#pragma unroll
            for (int ct = 0; ct < 4; ++ct) { cf[ct] = *(const LAS bf16x8*)(CT + (16 * ct + q) * 72 + 32 * ks + 8 * g); sf[ct] = *(const LAS bf16x8*)(ST + (16 * ct + q) * 72 + 32 * ks + 8 * g); }
#pragma unroll
            for (int mt = 0; mt < 4; ++mt)
#pragma unroll
                for (int ct = 0; ct < 4; ++ct) { xr[mt][ct] = __builtin_amdgcn_mfma_f32_16x16x32_bf16(tf[mt], cf[ct], xr[mt][ct], 0, 0, 0); xw[mt][ct] = __builtin_amdgcn_mfma_f32_16x16x32_bf16(tf[mt], sf[ct], xw[mt][ct], 0, 0, 0); }
        }
        __builtin_amdgcn_sched_barrier(0); asm volatile("s_nop 7\n\ts_nop 7" ::: "memory"); __builtin_amdgcn_sched_barrier(0);
        v4u ar[4][2], awn[4][2];
#pragma unroll
        for (int ct = 0; ct < 4; ++ct)
#pragma unroll
            for (int kb = 0; kb < 2; ++kb) {
                ar[ct][kb].x = cvtpk(xr[2 * kb][ct][0], xr[2 * kb][ct][1]); ar[ct][kb].y = cvtpk(xr[2 * kb][ct][2], xr[2 * kb][ct][3]);
                ar[ct][kb].z = cvtpk(xr[2 * kb + 1][ct][0], xr[2 * kb + 1][ct][1]); ar[ct][kb].w = cvtpk(xr[2 * kb + 1][ct][2], xr[2 * kb + 1][ct][3]);
                awn[ct][kb].x = cvtpk(-xw[2 * kb][ct][0], -xw[2 * kb][ct][1]); awn[ct][kb].y = cvtpk(-xw[2 * kb][ct][2], -xw[2 * kb][ct][3]);
                awn[ct][kb].z = cvtpk(-xw[2 * kb + 1][ct][0], -xw[2 * kb + 1][ct][1]); awn[ct][kb].w = cvtpk(-xw[2 * kb + 1][ct][2], -xw[2 * kb + 1][ct][3]); }
#pragma unroll
        for (int rt = 0; rt < 4; ++rt) {
            const int n1p = 16 * rt + q;
            bf16x8 cb_[2], sb_[2];
#pragma unroll
            for (int kb = 0; kb < 2; ++kb) { const LAS unsigned short* cp = CT + n1p * 72 + 32 * kb + 4 * g; const LAS unsigned short* sp = ST + n1p * 72 + 32 * kb + 4 * g;
                cb_[kb] = mk8(*(const LAS v2u*)cp, *(const LAS v2u*)(cp + 16)); sb_[kb] = mk8(*(const LAS v2u*)sp, *(const LAS v2u*)(sp + 16)); }
            const int tix = n2 * n1p; const float cw = twc[tix], sw = tws[tix];
            const size_t zbase = ((((size_t)(b * NHEAD + h) * 64 + n1p) * 64 + n2) * 64) + 4 * g;
#pragma unroll
            for (int ct = 0; ct < 4; ++ct) {
                f32x4 yr = (f32x4){0.f, 0.f, 0.f, 0.f}, yi = (f32x4){0.f, 0.f, 0.f, 0.f};
#pragma unroll
                for (int kb = 0; kb < 2; ++kb) {
                    const bf16x8 a_r = __builtin_bit_cast(bf16x8, ar[ct][kb]), a_wn = __builtin_bit_cast(bf16x8, awn[ct][kb]);
                    v4u nr = ar[ct][kb]; nr.x ^= 0x80008000u; nr.y ^= 0x80008000u; nr.z ^= 0x80008000u; nr.w ^= 0x80008000u; const bf16x8 a_rn = __builtin_bit_cast(bf16x8, nr);
                    yr = __builtin_amdgcn_mfma_f32_16x16x32_bf16(a_r, cb_[kb], yr, 0, 0, 0); yr = __builtin_amdgcn_mfma_f32_16x16x32_bf16(a_wn, sb_[kb], yr, 0, 0, 0);
                    yi = __builtin_amdgcn_mfma_f32_16x16x32_bf16(a_wn, cb_[kb], yi, 0, 0, 0); yi = __builtin_amdgcn_mfma_f32_16x16x32_bf16(a_rn, sb_[kb], yi, 0, 0, 0); }
                v2u wr_, wi_;
                wr_.x = cvtpk(yr[0] * cw + yi[0] * sw, yr[1] * cw + yi[1] * sw); wr_.y = cvtpk(yr[2] * cw + yi[2] * sw, yr[3] * cw + yi[3] * sw);
                wi_.x = cvtpk(yi[0] * cw - yr[0] * sw, yi[1] * cw - yr[1] * sw); wi_.y = cvtpk(yi[2] * cw - yr[2] * sw, yi[3] * cw - yr[3] * sw);
                *(GAS v2u*)(Zr + zbase + 16 * ct) = wr_; *(GAS v2u*)(Zi + zbase + 16 * ct) = wi_;
            }
        }
    }
}
__device__ __forceinline__ void fourier_b(Frame& F, bool with_ctx) {
    bf16* Y = (bf16*)(F.ws + WS_H); const bf16* Zr = (const bf16*)(F.ws + WS_Z);
    dft64_tables(F, 0);
    __syncthreads();
    const LAS unsigned short* CT = (const LAS unsigned short*)(F.lds); const LAS unsigned short* ST = CT + 64 * 72;
    LAS unsigned short* ZT = (LAS unsigned short*)(F.lds + 18432 + F.wave * 9216);
    const int q = F.lane & 15, g = F.lane >> 4;
    const int gw = F.bid * NWAVES + F.wave, NGW = F.G * NWAVES;
    const int nun = BATCH * NHEAD * 64 + (with_ctx ? BATCH * NHEAD * 4 : 0);
    for (int un = gw; un < nun; un += NGW) {
        const bool lat = un < BATCH * NHEAD * 64; const int uc = un - BATCH * NHEAD * 64;
        const int b = lat ? (un >> 8) : (uc >> 4), h = lat ? ((un >> 6) & 3) : ((uc >> 2) & 3), n1p = lat ? (un & 63) : (uc & 3);
        const size_t z0 = lat ? (((size_t)(b * NHEAD + h) * 64 + n1p) * 64) * 64 : 2 * NZ + (((size_t)(b * NHEAD + h) * 4 + n1p) * 64) * 64;
        const size_t zim = lat ? NZ : NZC;
        const int tok0 = lat ? (b * SEQ + n1p) : (NLAT + b * CTXL + n1p), tstride = lat ? 64 : 4; const float oscale = lat ? (1.0f / 512.0f) : (1.0f / 128.0f);
        f32x4 acc[4][4];
#pragma unroll
        for (int ct = 0; ct < 4; ++ct)
#pragma unroll
            for (int nt = 0; nt < 4; ++nt) acc[ct][nt] = (f32x4){0.f, 0.f, 0.f, 0.f};
#pragma unroll
        for (int comp = 0; comp < 2; ++comp) {
            const bf16* zp = Zr + z0 + (comp ? zim : 0); const LAS unsigned short* FT = comp ? ST : CT;
#pragma unroll
            for (int i = 0; i < 8; ++i) { const int p = F.lane + 64 * i, n2 = p >> 3, c8 = p & 7; const v4u w = *(const GAS v4u*)(zp + (size_t)n2 * 64 + 8 * c8); LAS unsigned short* tp = ZT + (8 * c8) * 72 + n2;
                tp[0 * 72] = (unsigned short)w.x; tp[1 * 72] = (unsigned short)(w.x >> 16); tp[2 * 72] = (unsigned short)w.y; tp[3 * 72] = (unsigned short)(w.y >> 16);
                tp[4 * 72] = (unsigned short)w.z; tp[5 * 72] = (unsigned short)(w.z >> 16); tp[6 * 72] = (unsigned short)w.w; tp[7 * 72] = (unsigned short)(w.w >> 16); }
            LDS_WAIT(); asm volatile("" ::: "memory");
#pragma unroll
            for (int ks = 0; ks < 2; ++ks) {
                bf16x8 af[4], bf_[4];
#pragma unroll
                for (int ct = 0; ct < 4; ++ct) af[ct] = *(const LAS bf16x8*)(ZT + (16 * ct + q) * 72 + 32 * ks + 8 * g);
#pragma unroll
                for (int nt = 0; nt < 4; ++nt) bf_[nt] = *(const LAS bf16x8*)(FT + (16 * nt + q) * 72 + 32 * ks + 8 * g);
#pragma unroll
                for (int ct = 0; ct < 4; ++ct)
#pragma unroll
                    for (int nt = 0; nt < 4; ++nt) acc[ct][nt] = __builtin_amdgcn_mfma_f32_16x16x32_bf16(af[ct], bf_[nt], acc[ct][nt], 0, 0, 0);
            }
            LDS_WAIT(); asm volatile("" ::: "memory");
        }
#pragma unroll
        for (int nt = 0; nt < 4; ++nt) { bf16* yp = Y + (size_t)(tok0 + tstride * (16 * nt + q)) * D + 768 + h * HD + 4 * g;
#pragma unroll
            for (int ct = 0; ct < 4; ++ct) { v2u w; w.x = cvtpk(acc[ct][nt][0] * oscale, acc[ct][nt][1] * oscale); w.y = cvtpk(acc[ct][nt][2] * oscale, acc[ct][nt][3] * oscale); *(GAS v2u*)(yp + 16 * ct) = w; } }
    }
}
__device__ __forceinline__ v4u mul_bf8(v4u a, v4u b) { v4u r; r.x = cvtpk(bflo(a.x) * bflo(b.x), bfhi(a.x) * bfhi(b.x)); r.y = cvtpk(bflo(a.y) * bflo(b.y), bfhi(a.y) * bfhi(b.y)); r.z = cvtpk(bflo(a.z) * bflo(b.z), bfhi(a.z) * bfhi(b.z)); r.w = cvtpk(bflo(a.w) * bflo(b.w), bfhi(a.w) * bfhi(b.w)); return r; }
__device__ __forceinline__ void convpool_phase(Frame& F, int l, int nrows) {
    const bf16* __restrict__ U = (const bf16*)(F.ws + WS_U); bf16* __restrict__ Y = (bf16*)(F.ws + WS_H);
    const bf16* PWT = (const bf16*)(F.ws + WS_PWT) + (size_t)l * 4 * 64 * 64;
    const float* cw = F.inp(I_CONVW) + (size_t)l * 3 * GWID; const float* ps = F.inp(I_POOLS) + (size_t)l * GWID;
    LAS unsigned* PX = (LAS unsigned*)(F.lds + RING_OFF + F.wave * 16384);
    LAS unsigned* DT = PX + 32 * 64;
    const int q = F.lane & 15, g = F.lane >> 4;
    const int c8 = F.tid & 31, tt = F.wave >> 1, ch = F.wave & 1;
    const f32x4 w0a = *(const GAS f32x4*)(cw + 8 * c8), w0b = *(const GAS f32x4*)(cw + 8 * c8 + 4), w1a = *(const GAS f32x4*)(cw + GWID + 8 * c8), w1b = *(const GAS f32x4*)(cw + GWID + 8 * c8 + 4),
                w2a = *(const GAS f32x4*)(cw + 2 * GWID + 8 * c8), w2b = *(const GAS f32x4*)(cw + 2 * GWID + 8 * c8 + 4);
    bf16x8 wf[2][4][2]; f32x4 psc[2][4];
#pragma unroll
    for (int gs = 0; gs < 2; ++gs)
#pragma unroll
        for (int dt = 0; dt < 4; ++dt) { const int gi = 2 * ch + gs; psc[gs][dt] = *(const GAS f32x4*)(ps + gi * 64 + 16 * dt + 4 * g);
#pragma unroll
            for (int ks = 0; ks < 2; ++ks) wf[gs][dt][ks] = *(const GAS bf16x8*)(PWT + ((size_t)gi * 64 + 16 * dt + q) * 64 + 32 * ks + 8 * g); }
    for (int tile = F.bid; tile < nrows / 64; tile += F.G) {
        const int r0 = tile * 64; int base, t0, L; seq_info(r0, base, t0, L);
        v4u pw_[8];
#pragma unroll
        for (int i = 0; i < 8; ++i) { const int p = F.lane + 64 * i, rr = p >> 4, c16 = p & 15, t = t0 + 16 * tt - 8 + rr; const bool in_ = (t >= 0) && (t < L); const int tc = in_ ? t : t0;
            const v4u w = *(const GAS v4u*)(U + (size_t)(base + tc) * INC + UC_P + ch * 128 + 8 * c16);
            pw_[i].x = in_ ? w.x : 0u; pw_[i].y = in_ ? w.y : 0u; pw_[i].z = in_ ? w.z : 0u; pw_[i].w = in_ ? w.w : 0u; }
#pragma unroll
        for (int ib = 0; ib < 2; ++ib) {
            v4u ac_[2], av_[2], pc_[2], pv_[2], nc_[2], nv_[2], ab_[2];
#pragma unroll
            for (int k = 0; k < 2; ++k) { const int p = F.tid + NT * (2 * ib + k), tr = p >> 5; const bf16* ur = U + (size_t)(r0 + tr) * INC + 8 * c8;
                ac_[k] = *(const GAS v4u*)(ur + UC_AC); av_[k] = *(const GAS v4u*)(ur + UC_AV); pc_[k] = *(const GAS v4u*)(ur + UC_AC - INC); pv_[k] = *(const GAS v4u*)(ur + UC_AV - INC);
                nc_[k] = *(const GAS v4u*)(ur + UC_AC + INC); nv_[k] = *(const GAS v4u*)(ur + UC_AV + INC); ab_[k] = *(const GAS v4u*)(ur + UC_AB); }
            __builtin_amdgcn_sched_barrier(0);
#pragma unroll
            for (int k = 0; k < 2; ++k) { const int p = F.tid + NT * (2 * ib + k), tr = p >> 5, t = t0 + tr;
                const v4u zc = mul_bf8(ac_[k], av_[k]); v4u zp = mul_bf8(pc_[k], pv_[k]), zn = mul_bf8(nc_[k], nv_[k]); const v4u ab = ab_[k];
                { const bool hp = t > 0, hn = t < L - 1; zp.x = hp ? zp.x : 0u; zp.y = hp ? zp.y : 0u; zp.z = hp ? zp.z : 0u; zp.w = hp ? zp.w : 0u; zn.x = hn ? zn.x : 0u; zn.y = hn ? zn.y : 0u; zn.z = hn ? zn.z : 0u; zn.w = hn ? zn.w : 0u; }
                v4u o;
                o.x = cvtpk(bflo(ab.x) * (w0a.x * bflo(zp.x) + w1a.x * bflo(zc.x) + w2a.x * bflo(zn.x)), bfhi(ab.x) * (w0a.y * bfhi(zp.x) + w1a.y * bfhi(zc.x) + w2a.y * bfhi(zn.x)));
                o.y = cvtpk(bflo(ab.y) * (w0a.z * bflo(zp.y) + w1a.z * bflo(zc.y) + w2a.z * bflo(zn.y)), bfhi(ab.y) * (w0a.w * bfhi(zp.y) + w1a.w * bfhi(zc.y) + w2a.w * bfhi(zn.y)));
                o.z = cvtpk(bflo(ab.z) * (w0b.x * bflo(zp.z) + w1b.x * bflo(zc.z) + w2b.x * bflo(zn.z)), bfhi(ab.z) * (w0b.y * bfhi(zp.z) + w1b.y * bfhi(zc.z) + w2b.y * bfhi(zn.z)));
                o.w = cvtpk(bflo(ab.w) * (w0b.z * bflo(zp.w) + w1b.z * bflo(zc.w) + w2b.z * bflo(zn.w)), bfhi(ab.w) * (w0b.w * bfhi(zp.w) + w1b.w * bfhi(zc.w) + w2b.w * bfhi(zn.w)));
                *(GAS v4u*)(Y + (size_t)(r0 + tr) * D + 8 * c8) = o; }
        }
#pragma unroll
        for (int i = 0; i < 8; ++i) { const int p = F.lane + 64 * i, rr = p >> 4, c16 = p & 15; *(LAS v4u*)(PX + rr * 64 + 4 * c16) = pw_[i]; }
        LDS_WAIT(); asm volatile("" ::: "memory");
        { const int hw = 1 << (2 * ch + (F.lane >> 5));
          float s0 = 0.f, s1 = 0.f;
          for (int k = -hw; k < hw; ++k) { const unsigned w = PX[(8 + k) * 64 + F.lane]; s0 += bflo(w); s1 += bfhi(w); }
          for (int i = 0; i < 16; ++i) { const int t = t0 + 16 * tt + i;
              const int lo = t - hw > 0 ? t - hw : 0, hi = t + hw < L ? t + hw : L; const float rc = 1.0f / (float)(hi - lo);
              const unsigned xc = PX[(i + 8) * 64 + F.lane];
              DT[i * 68 + F.lane] = cvtpk(s0 * rc - bflo(xc), s1 * rc - bfhi(xc));
              const unsigned wa = PX[(i + 8 + hw) * 64 + F.lane], wsb = PX[(i + 8 - hw) * 64 + F.lane];
              s0 += bflo(wa) - bflo(wsb); s1 += bfhi(wa) - bfhi(wsb); } }
        LDS_WAIT(); asm volatile("" ::: "memory");
#pragma unroll
        for (int gs = 0; gs < 2; ++gs) { const int gi = 2 * ch + gs;
            bf16x8 df[2];
#pragma unroll
            for (int ks = 0; ks < 2; ++ks) df[ks] = *(const LAS bf16x8*)(DT + q * 68 + gs * 32 + 16 * ks + 4 * g);
#pragma unroll
            for (int dt = 0; dt < 4; ++dt) { f32x4 a = (f32x4){0.f, 0.f, 0.f, 0.f};
                a = __builtin_amdgcn_mfma_f32_16x16x32_bf16(wf[gs][dt][0], df[0], a, 0, 0, 0); a = __builtin_amdgcn_mfma_f32_16x16x32_bf16(wf[gs][dt][1], df[1], a, 0, 0, 0);
                const int oc = gi * 64 + 16 * dt + 4 * g; const f32x4 sc = psc[gs][dt];
                v2u w; w.x = cvtpk(a[0] * sc.x, a[1] * sc.y); w.y = cvtpk(a[2] * sc.z, a[3] * sc.w);
                *(GAS v2u*)(Y + (size_t)(r0 + 16 * tt + q) * D + 256 + oc) = w; } }
        LDS_WAIT(); asm volatile("" ::: "memory");
    }
    __syncthreads();
}

__device__ __forceinline__ void fourier_ctx_a(Frame& F) {
    const bf16* U = (const bf16*)(F.ws + WS_U); bf16* Zc = (bf16*)(F.ws + WS_Z) + 2 * NZ;
    LAS float* cs = (LAS float*)(F.lds + TAB_OFF); LAS float* sn = cs + 64; LAS float* cs256 = cs + 128; LAS float* sn256 = cs + 384;
    if (F.tid < 64) { float s_, c_; sincospif((float)F.tid * (1.0f / 32.0f), &s_, &c_); cs[F.tid] = c_; sn[F.tid] = s_; }
    if (F.tid < 256) { float s_, c_; sincospif((float)F.tid * (1.0f / 128.0f), &s_, &c_); cs256[F.tid] = c_; sn256[F.tid] = s_; }
    __syncthreads();
    for (int item = F.bid * NT + F.tid; item < BATCH * NHEAD * 64 * 64; item += F.G * NT) {
        const int cp = item & 63, n2 = (item >> 6) & 63, h = (item >> 12) & 3, b = item >> 14;
        float xr[4], xi[4];
#pragma unroll
        for (int n1 = 0; n1 < 4; ++n1) { xr[n1] = 0.f; xi[n1] = 0.f; }
        for (int c8 = 0; c8 < 8; ++c8) {
            float cc[8], ss[8];
#pragma unroll
            for (int e = 0; e < 8; ++e) { const int idx = ((8 * c8 + e) * cp) & 63; cc[e] = cs[idx]; ss[e] = sn[idx]; }
#pragma unroll
            for (int n1 = 0; n1 < 4; ++n1) { const v4u w = *(const GAS v4u*)(U + (size_t)(NLAT + b * CTXL + 64 * n1 + n2) * INC + UC_F + h * HD + 8 * c8);
                const float f0 = bflo(w.x), f1 = bfhi(w.x), f2 = bflo(w.y), f3 = bfhi(w.y), f4 = bflo(w.z), f5 = bfhi(w.z), f6 = bflo(w.w), f7 = bfhi(w.w);
                xr[n1] += f0 * cc[0] + f1 * cc[1] + f2 * cc[2] + f3 * cc[3] + f4 * cc[4] + f5 * cc[5] + f6 * cc[6] + f7 * cc[7];
                xi[n1] -= f0 * ss[0] + f1 * ss[1] + f2 * ss[2] + f3 * ss[3] + f4 * ss[4] + f5 * ss[5] + f6 * ss[6] + f7 * ss[7]; }
        }
        float yr[4], yi[4];
        yr[0] = xr[0] + xr[1] + xr[2] + xr[3];           yi[0] = xi[0] + xi[1] + xi[2] + xi[3];
        yr[1] = xr[0] + xi[1] - xr[2] - xi[3];           yi[1] = xi[0] - xr[1] - xi[2] + xr[3];
        yr[2] = xr[0] - xr[1] + xr[2] - xr[3];           yi[2] = xi[0] - xi[1] + xi[2] - xi[3];
        yr[3] = xr[0] - xi[1] - xr[2] + xi[3];           yi[3] = xi[0] + xr[1] - xi[2] - xr[3];
#pragma unroll
        for (int k = 0; k < 4; ++k) { const int tix = (n2 * k) & 255; const float cw = cs256[tix], sw = sn256[tix];
            const size_t zi = ((((size_t)(b * NHEAD + h) * 4 + k) * 64 + n2) * 64) + cp;
            Zc[zi] = (bf16)f2bf(yr[k] * cw + yi[k] * sw); Zc[NZC + zi] = (bf16)f2bf(yi[k] * cw - yr[k] * sw); }
    }
}

__device__ __forceinline__ void mixa_phase(int l, bool with_ctx) { Frame F = mk_frame();
    const int nrows = with_ctx ? NROW : NLAT;
    convpool_phase(F, l, nrows);
    kv_prepass(F);
    bias_table(F, l);
    __syncthreads();
    fourier_a(F);
    __syncthreads();
    if (with_ctx) fourier_ctx_a(F);
}
__device__ __forceinline__ void mixb_phase(int l, bool with_ctx) { Frame F = mk_frame();
    attn_phase(F, l, with_ctx);
    __syncthreads();
    fourier_b(F, with_ctx);
}

struct WinOrder {
    int G, c, nctx_cols, ctx_pn0;
    __device__ __forceinline__ bool next(int i, pg8::Unit& u) const {
        const long L = (long)i * G + c; const int nlatu = 1024, total = nlatu + 8 * nctx_cols; if (L >= total) return false;
        if (L < nlatu) { int wgid = (int)L; { const int xcd = wgid % 8, off = wgid / 8; wgid = xcd * 128 + off; }
            const int gid = wgid / 64, fm = gid * 8; u.pm = fm + ((wgid % 64) % 8); u.pn = (wgid % 64) / 8; }
        else { const int j = (int)L - nlatu; u.pm = 128 + (j % 8); u.pn = ctx_pn0 + j / 8; }
        u.pb = u.pn; u.lb = 0; u.nv = 256; return true;
    }
    __device__ __forceinline__ void a_ready(const pg8::Unit&) const {}
    __device__ __forceinline__ void done(const pg8::Unit&) const {}
    __device__ __forceinline__ int row_of(const pg8::Unit&, int i) const { return i; }
};

struct Args { const float* in[20]; float* out; unsigned char* ws; int l, e; };
#define PH_PTRS() \
    bf16* H = (bf16*)(F.ws + WS_H); bf16* U = (bf16*)(F.ws + WS_U); bf16* HE = (bf16*)(F.ws + WS_U); bf16* Y2 = (bf16*)(F.ws + WS_S); \
    float* MOD = (float*)(F.ws + WS_MOD); float* XC = (float*)(F.ws + WS_XC); const uint2* INFO = (const uint2*)(F.ws + WS_INFO); \
    const bool first = (l == 0); const int M = first ? NROW : NLAT; const float* modl = MOD + (size_t)l * 9 * 6144; \
    (void)H; (void)U; (void)HE; (void)XC; (void)Y2; (void)INFO; (void)M; (void)modl;

#define XS_IN()  XStream{(const char*)F.inp(I_X), (const char*)F.inp(I_CTX), 4096, 4096}
#define XS_BF()  XStream{(const char*)F.out, (const char*)XC, 4096, 2048}
__device__ __forceinline__ void ph_norm1(int l) { Frame F = mk_frame(); PH_PTRS();
    norm_phase<0, false, false>(F, XS_IN(), XS_IN(), NROW, F.inp(I_N1G), modl, modl, 0, 1, H, nullptr, nullptr); }
__device__ __forceinline__ void ph_next(int l) { Frame F = mk_frame(); PH_PTRS();
    if (first) norm_phase<1, false, true>(F, XS_BF(), XS_BF(), NROW, F.inp(I_N1G) + D, MOD + (size_t)9 * 6144, modl, 0, 1, H, Y2, nullptr);
    else norm_phase<1, true, true>(F, XS_BF(), XS_BF(), NLAT, F.inp(I_FG), modl, modl, 0, 0, nullptr, Y2, F.out); }
__device__ __forceinline__ void ph_route(int l) { Frame F = mk_frame(); PH_PTRS();
    if (first) route_phase<false>(F, l, XS_IN(), XS_BF(), U, M, F.inp(I_N2G) + (size_t)l * D, modl, H, (uint2*)(F.ws + WS_INFO), (unsigned*)(F.ctl + CW_CNT + l * 16));
    else route_phase<true>(F, l, XS_BF(), XS_BF(), U, M, F.inp(I_N2G) + (size_t)l * D, modl, H, (uint2*)(F.ws + WS_INFO), (unsigned*)(F.ctl + CW_CNT + l * 16)); }
__device__ __forceinline__ void ph_win(int l) { Frame F = mk_frame(); PH_PTRS();
    pg8::Gemm g{H, (const bf16*)(F.ws + WS_WIN) + (size_t)l * INC * D, NROW, INC, D};
    WinOrder S{F.G, F.bid, first ? 8 : 2, first ? 0 : 5};
    pg8::EpiBf16 E{U, INC};
    pg8::gemm_phase<pg8::EpiBf16, WinOrder>(F.lds + RING_OFF, g, S, E); }
__device__ __forceinline__ void ph_wout(int l) { Frame F = mk_frame(); PH_PTRS();
    pg8::Gemm g{H, (const bf16*)(F.ws + WS_WOUT) + (size_t)l * D * D, M, D, D};
    pg8::StaticOrder S; S.init(M, D, F.G, F.bid);
    pg8::EpiBf16 E{U, D};
    pg8::gemm_phase<pg8::EpiBf16, pg8::StaticOrder>(F.lds + RING_OFF, g, S, E); }
__device__ __forceinline__ void ph_moe1(int l) { Frame F = mk_frame(); PH_PTRS(); moe_table(F, l);
    pg8::Gemm g{H, (const bf16*)(F.ws + WS_W13) + (size_t)l * NEXP * 1024 * D, M, 1024, D};
    pg8::MoeOrder S{F.G, F.bid, CAP, (const LAS int*)(F.lds + TAB_OFF), INFO};
    pg8::EpiSwiGLU E{HE, MHID};
    pg8::gemm_phase<pg8::EpiSwiGLU, pg8::MoeOrder, true>(F.lds + RING_OFF, g, S, E); }
__device__ __forceinline__ void ph_moe2(int l) { Frame F = mk_frame(); PH_PTRS(); moe_table(F, l);
    pg8::Gemm g{HE, (const bf16*)(F.ws + WS_W2) + (size_t)l * NEXP * D * MHID, M, D, MHID};
    pg8::MoeOrder S{F.G, F.bid, CAP, (const LAS int*)(F.lds + TAB_OFF), INFO};
    pg8::EpiScatter E{Y2, INFO};
    pg8::gemm_phase<pg8::EpiScatter, pg8::MoeOrder, false>(F.lds + RING_OFF, g, S, E); }

__device__ __forceinline__ void grid_bar() {
    Frame F = mk_frame(); XcdBarrier b; b.bar = (unsigned*)(F.ctl + CW_BAR); b.x = xb_xcc_id(); b.st = F.MISC + 8; xcd_barrier(b);
}
#define PMARK(name) asm volatile("; PHASE_MARK " name ::: "memory")
template <int L> __device__ __forceinline__ void layer_phases() {
    PMARK("win"); ph_win(L); grid_bar();
    PMARK("mixa"); mixa_phase(L, L == 0); grid_bar();
    PMARK("mixb"); mixb_phase(L, L == 0); grid_bar();
    PMARK("wout"); ph_wout(L); grid_bar();
    PMARK("route"); ph_route(L); grid_bar();
    PMARK("moe1"); ph_moe1(L); grid_bar();
    PMARK("moe2"); ph_moe2(L); grid_bar();
    PMARK("next"); ph_next(L);
}
__global__ void __launch_bounds__(NT, 2) fwd_all(Args args) {
    { Frame F = mk_frame();
      for (int u = F.tid; u < (LDS_BYTES - LDSCTL_OFF) / 4; u += NT) ((LAS unsigned*)(F.lds + LDSCTL_OFF))[u] = 0u;
      __syncthreads();
      (void)xcd_barrier_post((unsigned*)(F.ctl + CW_BAR), F.MISC + 8); }
    PMARK("pa"); pa_phase(); grid_bar();
    PMARK("norm1"); ph_norm1(0); grid_bar();
    layer_phases<0>(); grid_bar();
    layer_phases<1>();
}

typedef void (*kern_t)(Args);
extern "C" void kernel_launch(void* const* d_in, const int* in_sizes, int n_in, void* d_out, int out_size, void* d_ws, size_t ws_size, hipStream_t stream) {
    static int grid = 0;
    const kern_t kerns[] = {fwd_all};
    if (grid == 0) {
        if (n_in != 20 || out_size != NLAT * D || ws_size < WS_END) { fprintf(stderr, "kernel_launch: unexpected shapes (n_in %d out %d ws %zu)\n", n_in, out_size, ws_size); grid = -1; return; }
        int dev = 0, cus = 0;
        if (hipGetDevice(&dev) != hipSuccess || hipDeviceGetAttribute(&cus, hipDeviceAttributeMultiprocessorCount, dev) != hipSuccess) { grid = -1; return; }
        for (kern_t k : kerns) if (hipFuncSetAttribute((const void*)k, hipFuncAttributeMaxDynamicSharedMemorySize, LDS_BYTES) != hipSuccess) { fprintf(stderr, "kernel_launch: hipFuncSetAttribute failed\n"); grid = -1; return; }
        int per_cu = 0; (void)hipOccupancyMaxActiveBlocksPerMultiprocessor(&per_cu, (const void*)kerns[0], NT, LDS_BYTES); (void)hipGetLastError();
        grid = cus;
    }
    if (grid < 0) return;
    (void)hipMemsetAsync((char*)d_ws + WS_CTL, 0, CTL_ZERO_BYTES, stream);
    Args a{};
    for (int i = 0; i < 20; ++i) a.in[i] = (const float*)d_in[i];
    a.out = (float*)d_out; a.ws = (unsigned char*)d_ws;
    hipLaunchKernelGGL(fwd_all, dim3(grid), dim3(NT), LDS_BYTES, stream, a);
}
```

```cpp
#include <hip/hip_runtime.h>
#include <cstdio>
#include <cstdint>
namespace pg8 {
#define PG8_LAS __attribute__((address_space(3)))
typedef unsigned short bf16_t;
typedef short bf16x8 __attribute__((ext_vector_type(8)));
typedef float f32x4 __attribute__((ext_vector_type(4)));
typedef unsigned u32x4 __attribute__((ext_vector_type(4)));
constexpr int BM = 256, BK = 64, HALF = 128, HTB = HALF * BK * 2  , STAGE_BYTES = 8 * HTB, NXCD = 8, WGM = 8;

__host__ __device__ __forceinline__ int lds_byte(int r, int c) { const int st = (r >> 4) * 2 + (c >> 5), rr = r & 15, cc = c & 31, ob = rr * 64 + cc * 2; return st * 1024 + (ob ^ (((ob >> 9) & 1) << 5)); }
__host__ __device__ __forceinline__ void stage_rc(int b, int& R, int& C) { const int st = b / 1024, sb = b % 1024, swz = sb ^ (((sb >> 9) & 1) << 5); R = (st >> 1) * 16 + swz / 64; C = (st & 1) * 32 + (swz % 64) / 2; }
__host__ __device__ __forceinline__ int perm32(int rho) { const int n = rho >> 4, i = rho & 15; return 8 * (i >> 2) + 4 * n + (i & 3); }

struct Unit { int pm, pn, pb, lb, nv; };
struct Gemm { const bf16_t* A; const bf16_t* Bt; int M, N, K; };

struct StaticOrder {
    int nM, nN, nwg, G, c;
    __host__ __device__ void init(int M, int N, int G_, int c_) { nM = M / BM; nN = N / BM; nwg = nM * nN; G = G_; c = c_; }
    __host__ __device__ bool next(int i, Unit& u) const {
        const long L = (long)i * G + c; if (L >= nwg) return false;
        int wgid = (int)L; { const int q = nwg / NXCD, r = nwg % NXCD, xcd = wgid % NXCD, off = wgid / NXCD; wgid = (xcd < r ? xcd * (q + 1) : r * (q + 1) + (xcd - r) * q) + off; }
        const int nig = WGM * nN, gid = wgid / nig, fm = gid * WGM, gsz = (nM - fm) < WGM ? (nM - fm) : WGM;
        u.pm = fm + ((wgid % nig) % gsz); u.pn = (wgid % nig) / gsz; u.pb = u.pn; u.lb = 0; u.nv = BM; return true;
    }
    __device__ __forceinline__ void a_ready(const Unit&) const {}
    __device__ __forceinline__ int row_of(const Unit&, int i) const { return i; }
    __device__ __forceinline__ void done(const Unit&) const {}
};


__device__ __forceinline__ unsigned cvt_pk_bf16(float lo, float hi) { unsigned r; asm volatile("v_cvt_pk_bf16_f32 %0, %1, %2" : "=v"(r) : "v"(lo), "v"(hi)); return r; }

struct EpiBf16 {
    static constexpr bool PERM = true, AFTER_DRAIN = false;
    bf16_t* O; int ldc;
    __device__ __forceinline__ void operator()(const f32x4 (&acc)[2][2][4][2], const Unit& u, int wr, int wc, int fr, int fq) const {
        const int row0 = u.pm * BM + wr * 64 + fr; const int col0 = u.pn * BM + wc * 32 + 8 * fq;
        float one = 1.0f; asm volatile("" : "+v"(one));
#pragma unroll
        for (int ai = 0; ai < 2; ++ai)
#pragma unroll
            for (int m = 0; m < 4; ++m) { bf16_t* rowp = O + (size_t)(row0 + ai * HALF + m * 16) * ldc + col0;
#pragma unroll
                for (int bj = 0; bj < 2; ++bj) { const f32x4 v0 = acc[ai][bj][m][0] * one, v1 = acc[ai][bj][m][1] * one;
                    u32x4 w; w.x = cvt_pk_bf16(v0[0], v0[1]); w.y = cvt_pk_bf16(v0[2], v0[3]); w.z = cvt_pk_bf16(v1[0], v1[1]); w.w = cvt_pk_bf16(v1[2], v1[3]);
                    *(u32x4*)(rowp + bj * HALF) = w; } }
    }
};
struct EpiSwiGLU {
    static constexpr bool PERM = true, AFTER_DRAIN = false;
    bf16_t* O; int ldc;
    __device__ __forceinline__ void operator()(const f32x4 (&acc)[2][2][4][2], const Unit& u, int wr, int wc, int fr, int fq) const {
        const int row0 = u.pm * BM + wr * 64 + fr; const int col0 = u.pn * HALF + wc * 32 + 8 * fq;
#pragma unroll
        for (int ai = 0; ai < 2; ++ai)
#pragma unroll
            for (int m = 0; m < 4; ++m) { bf16_t* rowp = O + (size_t)(row0 + ai * HALF + m * 16) * ldc + col0;
                float o[8];
#pragma unroll
                for (int n = 0; n < 2; ++n)
#pragma unroll
                    for (int j = 0; j < 4; ++j) { const float a = acc[ai][0][m][n][j], b = acc[ai][1][m][n][j]; o[n * 4 + j] = a * __builtin_amdgcn_rcpf(1.0f + __expf(-a)) * b; }
                u32x4 w; w.x = cvt_pk_bf16(o[0], o[1]); w.y = cvt_pk_bf16(o[2], o[3]); w.z = cvt_pk_bf16(o[4], o[5]); w.w = cvt_pk_bf16(o[6], o[7]);
                *(u32x4*)rowp = w; }
    }
};
struct EpiScatter {
    static constexpr bool PERM = true, AFTER_DRAIN = false;
    bf16_t* Y2; const uint2* info;
    __device__ __forceinline__ void operator()(const f32x4 (&acc)[2][2][4][2], const Unit& u, int wr, int wc, int fr, int fq) const {
        const int col0 = u.pn * BM + wc * 32 + 8 * fq;
        uint2 infs[2][4];
#pragma unroll
        for (int ai = 0; ai < 2; ++ai)
#pragma unroll
            for (int m = 0; m < 4; ++m) { const int i = ai * HALF + wr * 64 + m * 16 + fr; infs[ai][m] = info[u.lb + (i < u.nv ? i : 0)]; }
#pragma unroll
        for (int ai = 0; ai < 2; ++ai)
#pragma unroll
            for (int m = 0; m < 4; ++m) { const int i = ai * HALF + wr * 64 + m * 16 + fr;
                if (i < u.nv) { const uint2 inf = infs[ai][m]; const float w = __builtin_bit_cast(float, inf.y); bf16_t* rowp = Y2 + (size_t)inf.x * 1024 + col0;
#pragma unroll
                    for (int bj = 0; bj < 2; ++bj) { const f32x4 v0 = acc[ai][bj][m][0] * w, v1 = acc[ai][bj][m][1] * w;
                        u32x4 q; q.x = cvt_pk_bf16(v0[0], v0[1]); q.y = cvt_pk_bf16(v0[2], v0[3]); q.z = cvt_pk_bf16(v1[0], v1[1]); q.w = cvt_pk_bf16(v1[2], v1[3]);
                        *(u32x4*)(rowp + bj * HALF) = q; } } }
    }
};
struct MoeOrder {
    int G, c, cap; const PG8_LAS int* tab; const uint2* info;
    __device__ __forceinline__ bool next(int i, Unit& u) const {
        const int nwg = __builtin_amdgcn_readfirstlane(tab[16]) * 4; const long L = (long)i * G + c; if (L >= nwg) return false;
        int wgid = (int)L; { const int q = nwg / NXCD, r = nwg % NXCD, xcd = wgid % NXCD, off = wgid / NXCD; wgid = (xcd < r ? xcd * (q + 1) : r * (q + 1) + (xcd - r) * q) + off; }
        const int gp = wgid >> 2; int e = 0;
#pragma unroll
        for (int q = 1; q < 16; ++q) e += (gp >= tab[q]) ? 1 : 0;
        e = __builtin_amdgcn_readfirstlane(e);
        const int p = gp - __builtin_amdgcn_readfirstlane(tab[e]); const int ne = __builtin_amdgcn_readfirstlane(tab[17 + e]);
        u.pm = gp; u.pn = wgid & 3; u.pb = e * 4 + u.pn; u.lb = e * cap + 256 * p; u.nv = (ne - 256 * p) < 256 ? (ne - 256 * p) : 256; return true;
    }
    __device__ __forceinline__ void a_ready(const Unit&) const {}
    __device__ __forceinline__ void done(const Unit&) const {}
    __device__ __forceinline__ int row_of(const Unit& u, int i) const { return (int)(info[u.lb + (i < u.nv ? i : 0)].x >> 1); }
};
template <class Epi, class Sched, bool GATHER = false>
__device__ __forceinline__ void gemm_phase(PG8_LAS unsigned char* lds, const Gemm g, const Sched& S, const Epi& E) {
    int tid_ = threadIdx.x; asm volatile("" : "+v"(tid_));
    const int tid = tid_, wid = __builtin_amdgcn_readfirstlane(tid >> 6), lane = tid & 63, wr = wid >> 2, wc = wid & 3, fr = lane & 15, fq = lane >> 4;
    const int K = g.K, nt = K / BK;
    unsigned voffB[2];
#pragma unroll
    for (int i = 0; i < 2; ++i) { int R, C; stage_rc(tid * 16 + i * 8192, R, C); const int Rb = Epi::PERM ? ((R & ~31) + perm32(R & 31)) : R; voffB[i] = (unsigned)(Rb * K + C) * 2u; }
    const size_t kstep = (size_t)(BK * 2);
    const size_t hstep = (size_t)HALF * K * 2;
    const size_t tstep = 2 * hstep;
    const unsigned ldsw = (unsigned)wid * 1024u;
    const int aoff = lds_byte(wr * 64 + fr, fq * 8), boff = lds_byte(wc * 32 + fr, fq * 8);
#define PG8_SA(b, h) (((b) * 2 + (h)) * HTB)
#define PG8_SB(b, h) ((4 + (b) * 2 + (h)) * HTB)
#define PG8_STAGE(bufoff, gbase, voff) do { _Pragma("unroll") for (int _i = 0; _i < 2; ++_i) \
        __builtin_amdgcn_global_load_lds((const unsigned*)((const char*)(gbase) + (voff)[_i]), (PG8_LAS unsigned*)(lds + (bufoff) + ldsw + _i * 8192), 16, 0, 0); } while (0)
#define PG8_LDA(dst, b, h) do { _Pragma("unroll") for (int m = 0; m < 4; ++m) _Pragma("unroll") for (int k = 0; k < 2; ++k) dst[m][k] = *(const PG8_LAS bf16x8*)(lds + PG8_SA(b, h) + aoff + m * 2048 + k * 1024); } while (0)
#define PG8_LDB(dst, b, h) do { _Pragma("unroll") for (int n = 0; n < 2; ++n) _Pragma("unroll") for (int k = 0; k < 2; ++k) dst[n][k] = *(const PG8_LAS bf16x8*)(lds + PG8_SB(b, h) + boff + n * 2048 + k * 1024); } while (0)
#define PG8_MMA(ai, bj, At, Bt) do { __builtin_amdgcn_s_setprio(1); _Pragma("unroll") for (int m = 0; m < 4; ++m) _Pragma("unroll") for (int n = 0; n < 2; ++n) _Pragma("unroll") for (int k = 0; k < 2; ++k) \
        acc[ai][bj][m][n] = __builtin_amdgcn_mfma_f32_16x16x32_bf16(Bt[n][k], At[m][k], acc[ai][bj][m][n], 0, 0, 0); __builtin_amdgcn_s_setprio(0); } while (0)
#define PG8_WAIT_V(n) asm volatile("s_waitcnt vmcnt(" #n ")" ::: "memory")
#define PG8_WAIT_L(n) asm volatile("s_waitcnt lgkmcnt(" #n ")" ::: "memory")
#define PG8_BAR __builtin_amdgcn_s_barrier()
#define PG8_SCHED __builtin_amdgcn_sched_barrier(0)
#define PG8_AOFFS(o, u) do { _Pragma("unroll") for (int _h = 0; _h < 2; ++_h) _Pragma("unroll") for (int _i = 0; _i < 2; ++_i) { int _R, _C; stage_rc(tid * 16 + _i * 8192, _R, _C); \
        const int _row = GATHER ? S.row_of((u), _h * HALF + _R) : (_h * HALF + _R); (o)[_h][_i] = (unsigned)(_row * K + _C) * 2u; } } while (0)
    Unit cur, nxt; int ui = 0;
    if (!S.next(0, cur)) return;
    f32x4 acc[2][2][4][2];
#pragma unroll
    for (int a = 0; a < 2; ++a)
#pragma unroll
        for (int b = 0; b < 2; ++b)
#pragma unroll
            for (int m = 0; m < 4; ++m)
#pragma unroll
                for (int n = 0; n < 2; ++n) acc[a][b][m][n] = (f32x4){0.f, 0.f, 0.f, 0.f};
    bf16x8 At[4][2], B0[2][2], B1[2][2];
    unsigned offA[2][2], noffA[2][2];
    const char* cA = (const char*)g.A + (GATHER ? (size_t)0 : (size_t)cur.pm * tstep); const char* cB = (const char*)g.Bt + (size_t)cur.pb * tstep;
    S.a_ready(cur);
    PG8_AOFFS(offA, cur);
    PG8_STAGE(PG8_SB(0, 0), cB, voffB); PG8_STAGE(PG8_SB(0, 1), cB + hstep, voffB); PG8_STAGE(PG8_SA(0, 0), cA, offA[0]); PG8_STAGE(PG8_SA(0, 1), cA, offA[1]);
    if (wr == 1) PG8_BAR;
    PG8_WAIT_V(2); PG8_BAR;
    PG8_STAGE(PG8_SB(1, 0), cB + kstep, voffB); PG8_STAGE(PG8_SA(1, 0), cA + kstep, offA[0]); PG8_STAGE(PG8_SB(1, 1), cB + hstep + kstep, voffB);
    PG8_WAIT_V(6); PG8_BAR;
    for (;;) {
        const bool has_next = S.next(ui + 1, nxt);
        const char* nA = has_next ? (const char*)g.A + (GATHER ? (size_t)0 : (size_t)nxt.pm * tstep) : cA; const char* nB = has_next ? (const char*)g.Bt + (size_t)nxt.pb * tstep : cB;
        for (int t = 0; t < nt; t += 2) {
            const bool last = (t == nt - 2);
            const char* a1 = cA + (size_t)(t + 1) * kstep;
            const char* a2 = last ? nA : cA + (size_t)(t + 2) * kstep; const char* b2 = last ? nB : cB + (size_t)(t + 2) * kstep;
            const char* a3 = a2 + kstep; const char* b3 = b2 + kstep;
            if (last && has_next) S.a_ready(nxt);
            unsigned o2[2][2];
            if constexpr (GATHER) {
                if (last) { if (has_next) { PG8_AOFFS(noffA, nxt); } else {
#pragma unroll
                        for (int h = 0; h < 2; ++h) { noffA[h][0] = offA[h][0]; noffA[h][1] = offA[h][1]; } } }
#pragma unroll
                for (int h = 0; h < 2; ++h) { o2[h][0] = last ? noffA[h][0] : offA[h][0]; o2[h][1] = last ? noffA[h][1] : offA[h][1]; }
            } else {
#pragma unroll
                for (int h = 0; h < 2; ++h) { o2[h][0] = offA[h][0]; o2[h][1] = offA[h][1]; }
            }
            PG8_LDB(B0, 0, 0); PG8_LDB(B1, 0, 1); PG8_SCHED; PG8_LDA(At, 0, 0); PG8_STAGE(PG8_SA(1, 1), a1, offA[1]);
            PG8_WAIT_V(8); PG8_WAIT_L(0); PG8_BAR; PG8_MMA(0, 0, At, B0); PG8_MMA(0, 1, At, B1); PG8_BAR; PG8_SCHED;
            PG8_LDA(At, 0, 1); PG8_STAGE(PG8_SB(0, 0), b2, voffB); PG8_STAGE(PG8_SB(0, 1), b2 + hstep, voffB); PG8_STAGE(PG8_SA(0, 0), a2, o2[0]);
            PG8_WAIT_V(8); PG8_WAIT_L(0); PG8_BAR; PG8_MMA(1, 0, At, B0); PG8_MMA(1, 1, At, B1); PG8_BAR; PG8_SCHED;
            PG8_LDB(B0, 1, 0); PG8_LDB(B1, 1, 1); PG8_SCHED; PG8_LDA(At, 1, 0); PG8_STAGE(PG8_SA(0, 1), a2, o2[1]);
            PG8_WAIT_V(8); PG8_WAIT_L(0); PG8_BAR; PG8_MMA(0, 0, At, B0); PG8_MMA(0, 1, At, B1); PG8_BAR; PG8_SCHED;
            PG8_LDA(At, 1, 1); PG8_STAGE(PG8_SB(1, 0), b3, voffB); PG8_STAGE(PG8_SB(1, 1), b3 + hstep, voffB); PG8_STAGE(PG8_SA(1, 0), a3, o2[0]);
            PG8_WAIT_V(8); PG8_WAIT_L(0); PG8_BAR; PG8_MMA(1, 0, At, B0); PG8_MMA(1, 1, At, B1); PG8_BAR; PG8_SCHED;
        }
        if (wr == 0) PG8_BAR;
        E(acc, cur, wr, wc, fr, fq); S.done(cur);
        if (!has_next) break;
#pragma unroll
        for (int a = 0; a < 2; ++a)
#pragma unroll
            for (int b = 0; b < 2; ++b)
#pragma unroll
                for (int m = 0; m < 4; ++m)
#pragma unroll
                    for (int n = 0; n < 2; ++n) acc[a][b][m][n] = (f32x4){0.f, 0.f, 0.f, 0.f};
        cur = nxt; cA = nA; cB = nB; ++ui;
        if constexpr (GATHER) {
#pragma unroll
            for (int h = 0; h < 2; ++h) { offA[h][0] = noffA[h][0]; offA[h][1] = noffA[h][1]; } }
        if (wr == 1) PG8_BAR;
    }
    PG8_WAIT_V(0);
    PG8_BAR;
#undef PG8_SA
#undef PG8_SB
#undef PG8_STAGE
#undef PG8_LDA
#undef PG8_LDB
#undef PG8_MMA
#undef PG8_WAIT_V
#undef PG8_WAIT_L
#undef PG8_BAR
#undef PG8_SCHED
#undef PG8_AOFFS
}
}
#define GAS __attribute__((address_space(1)))
#define LAS __attribute__((address_space(3)))
typedef unsigned short bf16;
typedef unsigned v4u __attribute__((ext_vector_type(4)));
typedef float f32x4 __attribute__((ext_vector_type(4)));
typedef short bf16x8 __attribute__((ext_vector_type(8)));
typedef GAS unsigned gu32;
typedef GAS unsigned long long gu64;
#define RLX_AGENT __ATOMIC_RELAXED, __HIP_MEMORY_SCOPE_AGENT
#define LDS_WAIT() asm volatile("s_waitcnt lgkmcnt(0)" ::: "memory")
#define VM_WAIT() asm volatile("s_waitcnt vmcnt(0)" ::: "memory")
__device__ __forceinline__ unsigned long long rt() { return __builtin_amdgcn_s_memrealtime(); }
__device__ __forceinline__ unsigned f2bf(float f) { unsigned u = __builtin_bit_cast(unsigned, f); return (u + 0x7fffu + ((u >> 16) & 1u)) >> 16; }
__device__ __forceinline__ unsigned pk2(float lo, float hi) { return f2bf(lo) | (f2bf(hi) << 16); }

#define XB_TMO      128
#define XB_XCNT(j)  (256  + 64 * (j))
#define XB_XSUB(j)  (1280 + 64 * (j))
#define XB_XGEN(j)  (2304 + 64 * (j))
#define XB_TOP      3328
#define XB_TOPGEN   3392
#define XCD_BAR_WORDS 3456
#define XB_SPIN_CAP (1u << 18)

__device__ __forceinline__ unsigned xb_ld(unsigned* p)              { return __hip_atomic_load(p, __ATOMIC_RELAXED, __HIP_MEMORY_SCOPE_AGENT); }
__device__ __forceinline__ unsigned xb_add(unsigned* p, unsigned v) { return __hip_atomic_fetch_add(p, v, __ATOMIC_RELAXED, __HIP_MEMORY_SCOPE_AGENT); }
__device__ __forceinline__ unsigned xb_xcc_id() { return (unsigned)__builtin_amdgcn_s_getreg((3 << 11) | 20) & 0xFu; }
#define XB_SPIN(cond, bar) do { unsigned _sp = 0; while (cond) { __builtin_amdgcn_s_sleep(1); \
    if ((++_sp & 255u) == 0u) { if (xb_ld(&(bar)[XB_TMO])) break; if (_sp > XB_SPIN_CAP) { atomicAdd(&(bar)[XB_TMO], 1u); break; } } } } while (0)

struct XcdBarrier {
    unsigned* bar; unsigned x;
    volatile LAS unsigned* st;
};

__device__ __forceinline__ XcdBarrier xcd_barrier_post(unsigned* bar, volatile LAS unsigned* st) {
    XcdBarrier b; b.bar = bar; b.x = xb_xcc_id(); b.st = st;
    if (threadIdx.x == 0) (void)xb_add(&bar[XB_XCNT(b.x)], 1u);
    return b;
}
__device__ __forceinline__ void xcd_barrier_complete(unsigned* bar, unsigned x, unsigned& nloc, unsigned& nx) {
    const unsigned G = gridDim.x * gridDim.y * gridDim.z;
    unsigned sum, cnt, mine, sp = 0u;
    for (;;) {
        sum = 0u; cnt = 0u; mine = 0u;
#pragma unroll
        for (unsigned j = 0; j < 16; ++j) { const unsigned c = xb_ld(&bar[XB_XCNT(j)]); sum += c; cnt += (c > 0u) ? 1u : 0u; mine = (j == x) ? c : mine; }
        if (sum == G) break;
        __builtin_amdgcn_s_sleep(1);
        if ((++sp & 255u) == 0u) { if (xb_ld(&bar[XB_TMO])) break; if (sp > XB_SPIN_CAP) { atomicAdd(&bar[XB_TMO], 1u); break; } }
    }
    nloc = mine > 0u ? mine : 1u; nx = cnt > 0u ? cnt : 1u;
}

__device__ __forceinline__ void xcd_barrier(const XcdBarrier& b) {
    asm volatile("s_waitcnt vmcnt(0)" ::: "memory");
    __syncthreads();
    if (threadIdx.x == 0) {
        unsigned* bar = b.bar;
        __builtin_amdgcn_s_waitcnt(0);
        unsigned nloc = b.st[0], nx = b.st[1];
        if (nloc == 0u) { xcd_barrier_complete(bar, b.x, nloc, nx); b.st[0] = nloc; b.st[1] = nx; }
        const unsigned old = xb_add(&bar[XB_XSUB(b.x)], 1u);
        const unsigned gen = old / nloc;
        if (old + 1u == (gen + 1u) * nloc) {
            __builtin_amdgcn_fence(__ATOMIC_RELEASE, "agent");
            asm volatile("s_waitcnt vmcnt(0)" ::: "memory");
            const unsigned og = xb_add(&bar[XB_TOP], 1u);
            const unsigned tg = og / nx;
            if (og + 1u == (tg + 1u) * nx) xb_add(&bar[XB_TOPGEN], 1u);
            else XB_SPIN(xb_ld(&bar[XB_TOPGEN]) == tg, bar);
            __builtin_amdgcn_fence(__ATOMIC_ACQUIRE, "agent");
            xb_add(&bar[XB_XGEN(b.x)], 1u);
            asm volatile("s_waitcnt vmcnt(0)" ::: "memory");
        } else {
            XB_SPIN(xb_ld(&bar[XB_XGEN(b.x)]) == gen, bar);
            __builtin_amdgcn_fence(__ATOMIC_ACQUIRE, "agent");
            asm volatile("s_waitcnt vmcnt(0)" ::: "memory");
        }
    }
    __syncthreads();
}


constexpr int NWAVES = 8, NT = NWAVES * 64;
constexpr int D = 1024, BATCH = 8, SEQ = 4096, DEPTH = 2, GRIDW = 64, CTXL = 256, GWID = 256, HD = 64, NHEAD = 4;
constexpr int INC = 2048, NEXP = 16, MHID = 512;
constexpr int NLAT = BATCH * SEQ, NCTX = BATCH * CTXL, NROW = NLAT + NCTX;
constexpr float EPS = 1e-6f;
constexpr int UC_AV = 0, UC_AB = 256, UC_AC = 512, UC_P = 768, UC_Q = 1024, UC_K = 1280, UC_V = 1536, UC_F = 1792;

constexpr size_t MiB = 1u << 20;
constexpr size_t WS_CTL = 0, CTL_ZERO_BYTES = 65536;
constexpr size_t WS_MOD  = 1 * MiB;
constexpr size_t WS_PWT  = 1 * MiB + 768 * 1024;
constexpr size_t WS_INFO = 2 * MiB;
constexpr size_t WS_BM   = 7 * MiB;
constexpr size_t WS_WIN  = 8 * MiB;
constexpr size_t WS_WOUT = 16 * MiB;
constexpr size_t WS_W13  = 20 * MiB;
constexpr size_t WS_W2   = 84 * MiB;
constexpr size_t WS_XC   = 116 * MiB;
constexpr size_t WS_H    = 124 * MiB;
constexpr size_t WS_U    = 192 * MiB;
constexpr size_t WS_S    = 328 * MiB;
constexpr size_t WS_END  = 472 * MiB;
constexpr size_t WS_KF   = WS_S;
constexpr size_t WS_VF   = WS_S + 28 * MiB;
constexpr size_t WS_KFC  = WS_S + 60 * MiB;
constexpr size_t WS_VFC  = WS_S + 61 * MiB;
constexpr size_t WS_Z    = WS_S + 64 * MiB;
constexpr size_t NZ = (size_t)BATCH * NHEAD * SEQ * HD;
constexpr size_t NZC = (size_t)BATCH * NHEAD * CTXL * HD;
constexpr int CAP = NROW;

constexpr int CW_CNT = 2048;
constexpr int CW_BAR = 4096;

constexpr int RING_OFF = 0, RING_BYTES = 131072;
constexpr int LDSCTL_OFF = RING_BYTES, MISC_OFF = LDSCTL_OFF + 320;
constexpr int TAB_OFF = RING_BYTES + 1024;
constexpr int LDS_BYTES = 147456;

struct Frame {
    LAS unsigned char* lds;
    volatile LAS unsigned* MISC;
    gu32* ctl;
    int tid, lane, wave, G, bid;
    float* out; unsigned char* ws;
    static __device__ __forceinline__ const void* karg(int off) {
        const __attribute__((address_space(4))) char* ka = (const __attribute__((address_space(4))) char*)__builtin_amdgcn_kernarg_segment_ptr();
        asm volatile("" : "+s"(ka));
        return *(const void* const __attribute__((address_space(4)))*)(ka + off);
    }
    __device__ __forceinline__ const float* inp(int i) const { return (const float*)karg(8 * i); }
};
extern __shared__ __attribute__((aligned(16))) unsigned char dyn_lds[];
__device__ __forceinline__ Frame mk_frame() {
    Frame F; int t_ = threadIdx.x; asm volatile("" : "+v"(t_));
    F.tid = t_; F.lane = F.tid & 63; F.wave = __builtin_amdgcn_readfirstlane(F.tid >> 6); F.G = gridDim.x; F.bid = blockIdx.x;
    F.lds = (LAS unsigned char*)dyn_lds; F.MISC = (volatile LAS unsigned*)(F.lds + MISC_OFF);
    F.out = (float*)Frame::karg(160); F.ws = (unsigned char*)Frame::karg(168); F.ctl = (gu32*)(F.ws + WS_CTL);
    return F;
}
enum { I_X = 0, I_C, I_CTX, I_CCTX, I_ADAW, I_ADAB, I_N1G, I_N2G, I_WIN, I_CONVW, I_POOLW, I_POOLS, I_RPB, I_WOUT, I_RW, I_RB, I_W1, I_W3, I_W2, I_FG };

__device__ __forceinline__ float wave_sum(float v) {
#pragma unroll
    for (int o = 1; o < 64; o <<= 1) v += __shfl_xor(v, o);
    return v;
}
__device__ __forceinline__ float bflo(unsigned w) { return __builtin_bit_cast(float, w << 16); }
__device__ __forceinline__ float bfhi(unsigned w) { return __builtin_bit_cast(float, w & 0xffff0000u); }
__device__ __forceinline__ float bf2f(bf16 b) { return __builtin_bit_cast(float, (unsigned)b << 16); }

__device__ __forceinline__ void tr_item(const float* W, int K, int N, bf16* WT, int k0, int n0, int drow0, LAS float* scr, int lane) {
#pragma unroll
    for (int i = 0; i < 8; ++i) { const int kk = 8 * i + (lane >> 3), n4 = 4 * (lane & 7); const f32x4 w = *(const GAS f32x4*)(W + (size_t)(k0 + kk) * N + n0 + n4);
        LAS float* sp = scr + kk * 33 + n4; sp[0] = w.x; sp[1] = w.y; sp[2] = w.z; sp[3] = w.w; }
    LDS_WAIT(); asm volatile("" ::: "memory");
    const int c = lane & 7;
#pragma unroll
    for (int j = 0; j < 4; ++j) { const int n = (lane >> 3) + 8 * j; const LAS float* s = scr + (8 * c) * 33 + n;
        v4u o; o.x = pk2(s[0 * 33], s[1 * 33]); o.y = pk2(s[2 * 33], s[3 * 33]); o.z = pk2(s[4 * 33], s[5 * 33]); o.w = pk2(s[6 * 33], s[7 * 33]);
        *(GAS v4u*)(WT + (size_t)(drow0 + n) * K + k0 + 8 * c) = o; }
    LDS_WAIT(); asm volatile("" ::: "memory");
}
__device__ __forceinline__ void pa_phase() { Frame F = mk_frame();
    LAS float* scr = (LAS float*)(F.lds + RING_OFF + F.wave * 16384);
    const int gw = F.bid * NWAVES + F.wave, NGW = F.G * NWAVES;
    bf16* WIN = (bf16*)(F.ws + WS_WIN); bf16* WOUT = (bf16*)(F.ws + WS_WOUT); bf16* W13 = (bf16*)(F.ws + WS_W13); bf16* W2 = (bf16*)(F.ws + WS_W2);
    constexpr int I_IN = 2 * 16 * 64, I_OUT = 2 * 16 * 32, I_1 = 32 * 16 * 16, I_2 = 32 * 8 * 32;
    constexpr int NITEMS = I_IN + I_OUT + 2 * I_1 + I_2;
    for (int it = gw; it < NITEMS; it += NGW) {
        int r = it;
        if (r < I_IN) { const int l = r / 1024, q = r % 1024, kb = q / 64, nb = q % 64;
            tr_item(F.inp(I_WIN) + (size_t)l * D * INC, D, INC, WIN + (size_t)l * INC * D, 64 * kb, 32 * nb, 32 * nb, scr, F.lane); continue; } r -= I_IN;
        if (r < I_OUT) { const int l = r / 512, q = r % 512, kb = q / 32, nb = q % 32;
            tr_item(F.inp(I_WOUT) + (size_t)l * D * D, D, D, WOUT + (size_t)l * D * D, 64 * kb, 32 * nb, 32 * nb, scr, F.lane); continue; } r -= I_OUT;
        if (r < 2 * I_1) { const int which = r / I_1; const int q0 = r % I_1; const int le = q0 / 256, q = q0 % 256, kb = q / 16, nb = q % 16;
            const int n0 = 32 * nb; const int drow0 = 256 * (n0 / 128) + 128 * which + (n0 % 128);
            tr_item(F.inp(which ? I_W3 : I_W1) + (size_t)le * D * MHID, D, MHID, W13 + (size_t)le * 1024 * D, 64 * kb, n0, drow0, scr, F.lane); continue; } r -= 2 * I_1;
        { const int le = r / 256, q = r % 256, kb = q / 32, nb = q % 32;
            tr_item(F.inp(I_W2) + (size_t)le * MHID * D, MHID, D, W2 + (size_t)le * D * MHID, 64 * kb, 32 * nb, 32 * nb, scr, F.lane); }
    }
    { bf16* PWT = (bf16*)(F.ws + WS_PWT); const float* pw = F.inp(I_POOLW);
      for (int i = F.bid * NT + F.tid; i < 2 * 4 * 64 * 64; i += F.G * NT) { const int c = i & 63, dd = (i >> 6) & 63, lg = i >> 12; PWT[i] = (bf16)f2bf(pw[((size_t)lg * 64 + c) * 64 + dd]); } }
    __syncthreads();
    LAS float* sc = (LAS float*)(F.lds + RING_OFF);
    LAS float* part = (LAS float*)(F.lds + RING_OFF + 40960);
    float* MOD = (float*)(F.ws + WS_MOD);
    bool have_sc = false;
    for (int it = F.bid; it < 2 * 96; it += F.G) {
        if (!have_sc) { for (int i = F.tid; i < 9 * 1024; i += NT) { const float v = i < 8192 ? F.inp(I_C)[i] : F.inp(I_CCTX)[i - 8192]; sc[i] = v / (1.0f + __expf(-v)); } have_sc = true; }
        __syncthreads();
        const int l = it / 96, cb = it % 96, col = cb * 64 + F.lane;
        const float* aw = F.inp(I_ADAW) + (size_t)l * D * 6144 + col;
        float acc[9];
#pragma unroll
        for (int r = 0; r < 9; ++r) acc[r] = 0.f;
        for (int k0 = F.wave * 128; k0 < F.wave * 128 + 128; k0 += 16) { float wv[16];
#pragma unroll
            for (int kk = 0; kk < 16; ++kk) wv[kk] = aw[(size_t)(k0 + kk) * 6144];
#pragma unroll
            for (int kk = 0; kk < 16; ++kk)
#pragma unroll
                for (int r = 0; r < 9; ++r) acc[r] += sc[r * 1024 + k0 + kk] * wv[kk]; }
#pragma unroll
        for (int r = 0; r < 9; ++r) part[(F.wave * 9 + r) * 64 + F.lane] = acc[r];
        __syncthreads();
        for (int i = F.tid; i < 9 * 64; i += NT) { const int r = i >> 6, ln = i & 63; float s = F.inp(I_ADAB)[(size_t)l * 6144 + cb * 64 + ln];
#pragma unroll
            for (int w = 0; w < 8; ++w) s += part[(w * 9 + r) * 64 + ln];
            MOD[((size_t)l * 9 + r) * 6144 + cb * 64 + ln] = s; }
        __syncthreads();
    }
}

typedef unsigned v2u_ __attribute__((ext_vector_type(2)));
__device__ __forceinline__ unsigned cvt_pk_bf(float lo, float hi) { unsigned r; asm volatile("v_cvt_pk_bf16_f32 %0, %1, %2" : "=v"(r) : "v"(lo), "v"(hi)); return r; }
struct XStream { const char* lat; const char* ctx; int lat_stride, ctx_stride;
    __device__ __forceinline__ const char* row(int r) const { return r < NLAT ? lat + (size_t)r * lat_stride : ctx + (size_t)(r - NLAT) * ctx_stride; } };
struct RowIn { f32x4 x[4]; unsigned long long xb[4], ya[4], yb[4]; };
__device__ __forceinline__ f32x4 unpk4(unsigned long long a) { f32x4 y; y.x = bflo((unsigned)a); y.y = bfhi((unsigned)a); y.z = bflo((unsigned)(a >> 32)); y.w = bfhi((unsigned)(a >> 32)); return y; }
template <int ADD, bool XBF>
__device__ __forceinline__ void row_load(Frame& F, int r, const char* xr, const bf16* Y2, RowIn& in) {
#pragma unroll
    for (int j = 0; j < 4; ++j) { const int c = 4 * F.lane + 256 * j;
        if (XBF) in.xb[j] = *(const GAS unsigned long long*)(xr + 2 * c); else in.x[j] = *(const GAS f32x4*)(xr + 4 * c);
        if (ADD == 1) { in.ya[j] = *(const GAS unsigned long long*)(Y2 + (size_t)r * 2048 + c); in.yb[j] = *(const GAS unsigned long long*)(Y2 + (size_t)r * 2048 + 1024 + c); }
        if (ADD == 2) { in.ya[j] = *(const GAS unsigned long long*)(Y2 + (size_t)r * 1024 + c); } }
}
struct RowPar { f32x4 a[4], b[4], gt[4]; int modrow; };
template <int ADD, bool FINAL>
__device__ __forceinline__ void row_params(Frame& F, int modrow, const float* g, const float* modl, const float* modadd, int ch_sh, int ch_sc, RowPar& P) {
    P.modrow = modrow;
#pragma unroll
    for (int j = 0; j < 4; ++j) { const int c = 4 * F.lane + 256 * j; const f32x4 gv = *(const GAS f32x4*)(g + c);
        if (FINAL) { P.a[j] = gv; P.b[j] = (f32x4){0.f, 0.f, 0.f, 0.f}; }
        else { const float* mrow = modl + (size_t)modrow * 6144; P.a[j] = gv * (*(const GAS f32x4*)(mrow + ch_sc * 1024 + c) + 1.0f); P.b[j] = *(const GAS f32x4*)(mrow + ch_sh * 1024 + c); }
        if (ADD) P.gt[j] = *(const GAS f32x4*)(modadd + (size_t)modrow * 6144 + (ADD == 1 ? 5 : 2) * 1024 + c); else P.gt[j] = (f32x4){0.f, 0.f, 0.f, 0.f}; }
}
template <int ADD, bool FINAL, bool XBF>
__device__ __forceinline__ void row_finish(Frame& F, const RowIn& in, const RowPar& P, char* xw, bf16* dst, float* fout, f32x4 (&v)[4]) {
    float ss = 0.f;
#pragma unroll
    for (int j = 0; j < 4; ++j) { const int c = 4 * F.lane + 256 * j; v[j] = XBF ? unpk4(in.xb[j]) : in.x[j];
        if (ADD) { f32x4 ya = unpk4(in.ya[j]); if (ADD == 1) ya = ya + unpk4(in.yb[j]);
            v[j] = v[j] + P.gt[j] * ya;
            if (!FINAL) *(GAS v2u_*)(xw + 2 * c) = (v2u_){cvt_pk_bf(v[j].x, v[j].y), cvt_pk_bf(v[j].z, v[j].w)}; }
        ss += (v[j].x * v[j].x + v[j].y * v[j].y) + (v[j].z * v[j].z + v[j].w * v[j].w); }
    ss = wave_sum(ss);
    const float rstd = 1.0f / sqrtf(ss * (1.0f / D) + EPS);
#pragma unroll
    for (int j = 0; j < 4; ++j) { const int c = 4 * F.lane + 256 * j;
        if (FINAL) { *(GAS f32x4*)(fout + c) = v[j] * rstd * P.a[j]; }
        else { v[j] = v[j] * rstd * P.a[j] + P.b[j];
            *(GAS v2u_*)(dst + c) = (v2u_){cvt_pk_bf(v[j].x, v[j].y), cvt_pk_bf(v[j].z, v[j].w)}; } }
}
template <int ADD, bool FINAL, bool XBF>
__device__ __forceinline__ void norm_phase(Frame& F, const XStream xin, const XStream xout, int nrows, const float* g, const float* modl, const float* modadd, int ch_sh, int ch_sc, bf16* dst, const bf16* Y2, float* fout) {
    const int rpb = (nrows + F.G - 1) / F.G;
    int i = F.wave; int r = F.bid * rpb + i; if (i >= rpb || r >= nrows) return;
    RowIn cur; row_load<ADD, XBF>(F, r, xin.row(r), Y2, cur);
    RowPar P; P.modrow = -1;
    for (;;) {
        const int in_ = i + NWAVES, rn = F.bid * rpb + in_; const bool more = (in_ < rpb) && (rn < nrows);
        RowIn nxt;
        if (more) row_load<ADD, XBF>(F, rn, xin.row(rn), Y2, nxt);
        const int modrow = r < NLAT ? (r >> 12) : 8;
        if (modrow != P.modrow) row_params<ADD, FINAL>(F, modrow, g, modl, modadd, ch_sh, ch_sc, P);
        f32x4 v[4];
        row_finish<ADD, FINAL, XBF>(F, cur, P, (char*)xout.row(r), dst + (size_t)r * D, fout + (size_t)r * D, v);
        if (!more) break;
        cur = nxt; r = rn; i = in_;
    }
}
template <bool XBF>
__device__ __forceinline__ void route_phase(Frame& F, int l, const XStream xin, const XStream xout, const bf16* O, int nrows, const float* g, const float* modl, bf16* dst, uint2* info, unsigned* cnt) {
    LAS int* lcnt = (LAS int*)(F.lds + RING_OFF); LAS int* lbase = lcnt + 16; LAS int* rec_e = lcnt + 32; LAS int* rec_p = rec_e + 512; LAS float* rec_w = (LAS float*)(rec_p + 512);
    const int rpb = (nrows + F.G - 1) / F.G;
    if (F.tid < 16) lcnt[F.tid] = 0;
    LAS float* WT = (LAS float*)(F.lds + RING_OFF + 32768);
    LAS float* LG = (LAS float*)(F.lds + RING_OFF + 8192);
    { const float* rwp = F.inp(I_RW); for (int i = F.tid; i < 1024 * 16; i += NT) { const int k = i >> 4, e = i & 15; WT[e * 1024 + k] = rwp[i]; } }
    __syncthreads();
    const float* rbp = F.inp(I_RB);
    RowPar P; P.modrow = -1;
    RowIn cur; bool have = (F.wave < rpb) && (F.bid * rpb + F.wave < nrows);
    if (have) { const int r = F.bid * rpb + F.wave; row_load<2, XBF>(F, r, xin.row(r), O, cur); }
    for (int i = F.wave; have; i += NWAVES) {
        const int r = F.bid * rpb + i;
        const int in_ = i + NWAVES, rn = F.bid * rpb + in_; const bool more = (in_ < rpb) && (rn < nrows);
        RowIn nxt;
        if (more) row_load<2, XBF>(F, rn, xin.row(rn), O, nxt);
        f32x4 v[4];
        { const int modrow = r < NLAT ? (r >> 12) : 8; if (modrow != P.modrow) row_params<2, false>(F, modrow, g, modl, modl, 3, 4, P); }
        row_finish<2, false, XBF>(F, cur, P, (char*)xout.row(r), dst + (size_t)r * D, nullptr, v);
        typedef float f32x2 __attribute__((ext_vector_type(2)));
        f32x2 s2[16];
#pragma unroll
        for (int e = 0; e < 16; ++e) s2[e] = (f32x2){0.f, 0.f};
#pragma unroll
        for (int j = 0; j < 4; ++j) { const f32x2 vlo = (f32x2){v[j].x, v[j].y}, vhi = (f32x2){v[j].z, v[j].w};
#pragma unroll
            for (int e = 0; e < 16; ++e) { const f32x4 w4 = *(const LAS f32x4*)(WT + e * 1024 + 4 * F.lane + 256 * j); s2[e] += vlo * (f32x2){w4.x, w4.y}; s2[e] += vhi * (f32x2){w4.z, w4.w}; } }
        float s16[16];
#pragma unroll
        for (int e = 0; e < 16; ++e) s16[e] = s2[e].x + s2[e].y;
        { float a8[8], a4[4], a2[2]; const bool h5 = F.lane & 32, h4 = F.lane & 16, h3 = F.lane & 8, h2 = F.lane & 4;
#pragma unroll
          for (int k = 0; k < 8; ++k) { const float send = h5 ? s16[k] : s16[k + 8], keep = h5 ? s16[k + 8] : s16[k]; a8[k] = keep + __shfl_xor(send, 32); }
#pragma unroll
          for (int k = 0; k < 4; ++k) { const float send = h4 ? a8[k] : a8[k + 4], keep = h4 ? a8[k + 4] : a8[k]; a4[k] = keep + __shfl_xor(send, 16); }
#pragma unroll
          for (int k = 0; k < 2; ++k) { const float send = h3 ? a4[k] : a4[k + 2], keep = h3 ? a4[k + 2] : a4[k]; a2[k] = keep + __shfl_xor(send, 8); }
          const float send = h2 ? a2[0] : a2[1], keep = h2 ? a2[1] : a2[0]; float a1 = keep + __shfl_xor(send, 4);
          a1 += __shfl_xor(a1, 1); a1 += __shfl_xor(a1, 2);
          if ((F.lane & 3) == 0) LG[i * 17 + 8 * ((F.lane >> 5) & 1) + 4 * ((F.lane >> 4) & 1) + 2 * ((F.lane >> 3) & 1) + ((F.lane >> 2) & 1)] = a1; }
        have = more; cur = nxt;
    }
    __syncthreads();
    for (int i = F.tid; i < rpb; i += NT) { if (F.bid * rpb + i >= nrows) break;
        float s16[16], bs[16];
#pragma unroll
        for (int e = 0; e < 16; ++e) { s16[e] = 1.0f / (1.0f + expf(-LG[i * 17 + e])); bs[e] = s16[e] + rbp[e]; }
        float best = -3.0e38f; int bg = 0;
#pragma unroll
        for (int gq = 0; gq < 4; ++gq) { const float a0 = bs[4 * gq], a1 = bs[4 * gq + 1], a2 = bs[4 * gq + 2], a3 = bs[4 * gq + 3];
            const float gs = fmaxf(fmaxf(fmaxf(a0 + a1, a0 + a2), fmaxf(a0 + a3, a1 + a2)), fmaxf(a1 + a3, a2 + a3));
            if (gs > best) { best = gs; bg = gq; } }
        float cb[4], cs[4];
#pragma unroll
        for (int ii = 0; ii < 4; ++ii) { cb[ii] = 0.f; cs[ii] = 0.f; }
#pragma unroll
        for (int gq = 0; gq < 4; ++gq)
#pragma unroll
            for (int ii = 0; ii < 4; ++ii) { cb[ii] = (gq == bg) ? bs[4 * gq + ii] : cb[ii]; cs[ii] = (gq == bg) ? s16[4 * gq + ii] : cs[ii]; }
        int i1 = 0; float b1 = cb[0], s1 = cs[0];
#pragma unroll
        for (int ii = 1; ii < 4; ++ii) if (cb[ii] > b1) { b1 = cb[ii]; s1 = cs[ii]; i1 = ii; }
        int i2 = -1; float b2 = -3.0e38f, s2 = 0.f;
#pragma unroll
        for (int ii = 0; ii < 4; ++ii) if (ii != i1 && cb[ii] > b2) { b2 = cb[ii]; s2 = cs[ii]; i2 = ii; }
        const float inv = 1.0f / (s1 + s2);
        const int e1 = 4 * bg + i1, e2 = 4 * bg + i2;
        rec_e[2 * i] = e1; rec_p[2 * i] = atomicAdd((int*)&lcnt[e1], 1); rec_w[2 * i] = s1 * inv;
        rec_e[2 * i + 1] = e2; rec_p[2 * i + 1] = atomicAdd((int*)&lcnt[e2], 1); rec_w[2 * i + 1] = s2 * inv;
    }
    __syncthreads();
    if (F.tid < 16) lbase[F.tid] = (int)__hip_atomic_fetch_add(cnt + F.tid, (unsigned)lcnt[F.tid], __ATOMIC_RELAXED, __HIP_MEMORY_SCOPE_AGENT);
    __syncthreads();
    for (int j = F.tid; j < 2 * rpb; j += NT) { const int r = F.bid * rpb + (j >> 1); if (r < nrows) { const int e = rec_e[j];
        info[(size_t)e * CAP + lbase[e] + rec_p[j]] = make_uint2((unsigned)(r * 2 + (j & 1)), __builtin_bit_cast(unsigned, rec_w[j])); } }
}
__device__ __forceinline__ void moe_table(Frame& F, int l) {
    LAS int* tab = (LAS int*)(F.lds + TAB_OFF);
    if (F.tid < 64) {
        const unsigned* cnt = (const unsigned*)(F.ctl + CW_CNT + l * 16);
        const int n = F.tid < 16 ? (int)__hip_atomic_load(cnt + F.tid, __ATOMIC_RELAXED, __HIP_MEMORY_SCOPE_AGENT) : 0;
        const int np = (n + 255) >> 8; int x = np;
#pragma unroll
        for (int d = 1; d < 16; d <<= 1) { const int y = __shfl_up(x, d); if (F.lane >= d) x += y; }
        if (F.tid < 16) { tab[F.tid] = x - np; tab[17 + F.tid] = n; }
        if (F.tid == 15) tab[16] = x;
    }
    __syncthreads();
}

__device__ __forceinline__ void seq_info(int r, int& base, int& t, int& L) {
    if (r < NLAT) { base = r & ~(SEQ - 1); t = r & (SEQ - 1); L = SEQ; } else { const int j = r - NLAT; base = NLAT + (j & ~(CTXL - 1)); t = j & (CTXL - 1); L = CTXL; }
}
typedef unsigned v2u __attribute__((ext_vector_type(2)));
__device__ __forceinline__ unsigned cvtpk(float lo, float hi) { unsigned r; asm volatile("v_cvt_pk_bf16_f32 %0, %1, %2" : "=v"(r) : "v"(lo), "v"(hi)); return r; }
__device__ __forceinline__ bf16x8 mk8(v2u a, v2u b) { v4u w; w.x = a.x; w.y = a.y; w.z = b.x; w.w = b.y; return __builtin_bit_cast(bf16x8, w); }
template <bool LAT>
__device__ __forceinline__ void kv_unit(Frame& F, int bh, int rq, LAS unsigned short* T) {
    const bf16* U = (const bf16*)(F.ws + WS_U);
    const int q = F.lane & 15, g = F.lane >> 4, h = bh & 3;
    const int urow0 = LAT ? ((bh >> 2) * SEQ + rq * 64) : (NLAT + (bh >> 2) * CTXL + rq * 64);
    bf16* kdst = LAT ? (bf16*)(F.ws + WS_KF) + ((size_t)(bh * 64 + rq) * 14) * 512 : (bf16*)(F.ws + WS_KFC) + ((size_t)(bh * 16 + rq * 4) * 2) * 512;
    bf16* vdst = LAT ? (bf16*)(F.ws + WS_VF) + ((size_t)(bh * 64 + rq) * 16) * 512 : (bf16*)(F.ws + WS_VFC) + ((size_t)(bh * 8 + rq * 2) * 4) * 512;
    { const bf16* src = U + (size_t)(urow0 + F.lane) * INC + UC_V + h * HD;
      v4u vw[8];
#pragma unroll
      for (int p = 0; p < 8; ++p) vw[p] = *(const GAS v4u*)(src + 8 * p);
#pragma unroll
      for (int p = 0; p < 8; ++p) { const v4u w = vw[p]; LAS unsigned short* tp = T + (8 * p) * 72 + F.lane;
          tp[0 * 72] = (unsigned short)w.x; tp[1 * 72] = (unsigned short)(w.x >> 16); tp[2 * 72] = (unsigned short)w.y; tp[3 * 72] = (unsigned short)(w.y >> 16);
          tp[4 * 72] = (unsigned short)w.z; tp[5 * 72] = (unsigned short)(w.z >> 16); tp[6 * 72] = (unsigned short)w.w; tp[7 * 72] = (unsigned short)(w.w >> 16); } }
    constexpr int NK = LAT ? 7 : 4, KST = LAT ? 8 : 16;
    { v4u kw[NK][2];
#pragma unroll
      for (int sidx = 0; sidx < NK; ++sidx)
#pragma unroll
          for (int ks = 0; ks < 2; ++ks) kw[sidx][ks] = *(const GAS v4u*)(U + (size_t)(urow0 + KST * sidx + q) * INC + UC_K + h * HD + 32 * ks + 8 * g);
      __builtin_amdgcn_sched_barrier(0);
#pragma unroll
      for (int sidx = 0; sidx < NK; ++sidx)
#pragma unroll
          for (int ks = 0; ks < 2; ++ks) *(GAS v4u*)(kdst + (size_t)(sidx * 2 + ks) * 512 + F.lane * 8) = kw[sidx][ks]; }
    LDS_WAIT(); asm volatile("" ::: "memory");
    constexpr int NV = LAT ? 4 : 2;
#pragma unroll
    for (int w = 0; w < NV; ++w) { const int vst = LAT ? (w == 0 ? 0 : (w == 1 ? 8 : (w == 2 ? 24 : 32))) : 32 * w;
#pragma unroll
        for (int dt = 0; dt < 4; ++dt) { const LAS unsigned short* tp = T + (16 * dt + q) * 72 + vst + 4 * g; const v2u lo = *(const LAS v2u*)tp, hi = *(const LAS v2u*)(tp + 16);
            v4u o; o.x = lo.x; o.y = lo.y; o.z = hi.x; o.w = hi.y; *(GAS v4u*)(vdst + (size_t)(w * 4 + dt) * 512 + F.lane * 8) = o; } }
    LDS_WAIT(); asm volatile("" ::: "memory");
}
__device__ __forceinline__ void kv_prepass(Frame& F) {
    LAS unsigned short* T = (LAS unsigned short*)(F.lds + RING_OFF + F.wave * 16384);
    const int gw = F.bid * NWAVES + F.wave, NGW = F.G * NWAVES;
#pragma unroll 1
    for (int idx = gw; idx < 2048; idx += NGW) kv_unit<true>(F, idx >> 6, idx & 63, T);
#pragma unroll 1
    for (int idx = gw; idx < 128; idx += NGW) kv_unit<false>(F, idx >> 2, idx & 3, T);
}
__device__ __forceinline__ void bias_table(Frame& F, int l) {
    float* BM = (float*)(F.ws + WS_BM); const float* rp = F.inp(I_RPB) + (size_t)l * NHEAD * 15 * 31;
    for (int i = F.bid * NT + F.tid; i < 4 * 4 * 15 * 64 * 8; i += F.G * NT) {
        const int e = i & 7, lane = (i >> 3) & 63, rrel = (i >> 9) % 15, hc = (i >> 9) / 15, cb = hc & 3, h = hc >> 2;
        const int q = lane & 15, g = lane >> 4, seg = e >> 2, ii = e & 3;
        const int wb = cb * 16 - 8 < 0 ? 0 : (cb * 16 - 8 > 32 ? 32 : cb * 16 - 8);
        const int cq = cb * 16 + q, c0 = cq - 8 < 0 ? 0 : (cq - 8 > 48 ? 48 : cq - 8), cc = wb + seg * 16 + 4 * g + ii;
        const bool ok = (cc >= c0) && (cc < c0 + 16);
        BM[i] = ok ? rp[(h * 15 + rrel) * 31 + (cc - cq + 15)] : -3.0e38f;
    }
}
template <bool LAT>
__device__ __forceinline__ void attn_unit(Frame& F, int l, int b, int h, int r, int cb, const LAS float* rpbs) {
    const bf16* U = (const bf16*)(F.ws + WS_U); bf16* Y = (bf16*)(F.ws + WS_H);
    const bf16* KF = (const bf16*)(F.ws + WS_KF); const bf16* VF = (const bf16*)(F.ws + WS_VF); const bf16* KFC = (const bf16*)(F.ws + WS_KFC); const bf16* VFC = (const bf16*)(F.ws + WS_VFC);
    const size_t bh = (size_t)(b * NHEAD + h);
    const int q = F.lane & 15, g = F.lane >> 4;
    constexpr int NT_ = LAT ? 32 : 16, NB = LAT ? 16 : 0;
    const int qrow = LAT ? (b * SEQ + r * GRIDW + cb * 16 + q) : (NLAT + b * CTXL + cb * 16 + q);
    const int r0 = r - 4 < 0 ? 0 : (r - 4 > 56 ? 56 : r - 4);
    const int wb = cb * 16 - 8 < 0 ? 0 : (cb * 16 - 8 > 32 ? 32 : cb * 16 - 8);
    bf16x8 qf[2];
#pragma unroll
    for (int ks = 0; ks < 2; ++ks) qf[ks] = *(const GAS bf16x8*)(U + (size_t)qrow * INC + UC_Q + h * HD + 32 * ks + 8 * g);
    f32x4 s[NT_];
#pragma unroll
    for (int t = 0; t < NT_; ++t) {
        const bf16* kp;
        if (t < NB) { const int kr = t >> 1, seg = t & 1; kp = KF + (((bh * 64 + (r0 + kr)) * 7 + ((wb >> 3) + 2 * seg)) * 2) * 512 + F.lane * 8; } else kp = KFC + ((bh * 16 + (t - NB)) * 2) * 512 + F.lane * 8;
        const bf16x8 k0 = *(const GAS bf16x8*)kp, k1 = *(const GAS bf16x8*)(kp + 512);
        f32x4 a = (f32x4){0.f, 0.f, 0.f, 0.f};
        a = __builtin_amdgcn_mfma_f32_16x16x32_bf16(k0, qf[0], a, 0, 0, 0);
        s[t] = __builtin_amdgcn_mfma_f32_16x16x32_bf16(k1, qf[1], a, 0, 0, 0);
    }
    float m = -3.0e38f;
    if (LAT) {
        const float* bm = (const float*)(F.ws + WS_BM) + ((size_t)((h * 4 + cb) * 15 + (r0 - r + 7)) * 64 + F.lane) * 8;
#pragma unroll
        for (int kr = 0; kr < 8; ++kr) { const f32x4 b0 = *(const GAS f32x4*)(bm + kr * 512), b1 = *(const GAS f32x4*)(bm + kr * 512 + 4);
#pragma unroll
            for (int i = 0; i < 4; ++i) { const float v0 = s[2 * kr][i] * 0.125f + b0[i], v1 = s[2 * kr + 1][i] * 0.125f + b1[i]; s[2 * kr][i] = v0; s[2 * kr + 1][i] = v1; m = fmaxf(m, fmaxf(v0, v1)); } }
    }
#pragma unroll
    for (int t = NB; t < NT_; ++t)
#pragma unroll
        for (int i = 0; i < 4; ++i) { const float v = s[t][i] * 0.125f; s[t][i] = v; m = fmaxf(m, v); }
    m = fmaxf(m, __shfl_xor(m, 16)); m = fmaxf(m, __shfl_xor(m, 32));
    float sum = 0.f;
#pragma unroll
    for (int t = 0; t < NT_; ++t)
#pragma unroll
        for (int i = 0; i < 4; ++i) { const float p = __expf(s[t][i] - m); s[t][i] = p; sum += p; }
    sum += __shfl_xor(sum, 16); sum += __shfl_xor(sum, 32);
    f32x4 o[4];
#pragma unroll
    for (int dt = 0; dt < 4; ++dt) o[dt] = (f32x4){0.f, 0.f, 0.f, 0.f};
#pragma unroll
    for (int kk = 0; kk < NT_ / 2; ++kk) {
        v4u pw; pw.x = cvtpk(s[2 * kk][0], s[2 * kk][1]); pw.y = cvtpk(s[2 * kk][2], s[2 * kk][3]); pw.z = cvtpk(s[2 * kk + 1][0], s[2 * kk + 1][1]); pw.w = cvtpk(s[2 * kk + 1][2], s[2 * kk + 1][3]);
        const bf16x8 pf = __builtin_bit_cast(bf16x8, pw);
        const bf16* vbase;
        if (2 * kk < NB) vbase = VF + (((bh * 64 + (r0 + kk)) * 4 + cb) * 4) * 512 + F.lane * 8; else vbase = VFC + ((bh * 8 + (kk - NB / 2)) * 4) * 512 + F.lane * 8;
#pragma unroll
        for (int dt = 0; dt < 4; ++dt) { const bf16x8 vf = *(const GAS bf16x8*)(vbase + dt * 512);
            o[dt] = __builtin_amdgcn_mfma_f32_16x16x32_bf16(vf, pf, o[dt], 0, 0, 0); }
    }
    const float inv = 1.0f / sum; bf16* yp = Y + (size_t)qrow * D + 512 + h * HD + 4 * g;
#pragma unroll
    for (int dt = 0; dt < 4; ++dt) { v2u w; w.x = cvtpk(o[dt][0] * inv, o[dt][1] * inv); w.y = cvtpk(o[dt][2] * inv, o[dt][3] * inv); *(GAS v2u*)(yp + dt * 16) = w; }
}
__device__ __forceinline__ void attn_phase(Frame& F, int l, bool with_ctx) {
    const LAS float* rpbs = nullptr;
    const int gw = F.bid * NWAVES + F.wave, NGW = F.G * NWAVES;
    {
        const int x = F.bid & 7, lb = F.bid >> 3, nlb = (F.G - x + 7) >> 3;
#pragma unroll 1
        for (int uu = lb * NWAVES + F.wave; uu < 1024; uu += nlb * NWAVES) { const int bh = 4 * x + (uu >> 8), u = uu & 255; attn_unit<true>(F, l, bh >> 2, bh & 3, u >> 2, u & 3, rpbs); } }
    if (with_ctx) for (int uid = gw; uid < BATCH * NHEAD * 16; uid += NGW) { const int cb = uid & 15, h = (uid >> 4) & 3, b = uid >> 6; attn_unit<false>(F, l, b, h, 0, cb, rpbs); }
}
__device__ __forceinline__ void dft64_tables(Frame& F, int off) {
    LAS unsigned short* CT = (LAS unsigned short*)(F.lds + off); LAS unsigned short* ST = CT + 64 * 72;
    for (int i = F.tid; i < 4096; i += NT) { const int j = i >> 6, k = i & 63; float s_, c_; sincospif((float)((j * k) & 63) * (1.0f / 32.0f), &s_, &c_); CT[j * 72 + k] = (unsigned short)f2bf(c_); ST[j * 72 + k] = (unsigned short)f2bf(s_); }
}
__device__ __forceinline__ void fourier_a(Frame& F) {
    const bf16* U = (const bf16*)(F.ws + WS_U); bf16* Zr = (bf16*)(F.ws + WS_Z); bf16* Zi = Zr + NZ;
    constexpr int O_CT = 0, O_TWC = 18432, O_TWS = O_TWC + 16384;
    dft64_tables(F, O_CT);
    { LAS float* twc = (LAS float*)(F.lds + O_TWC); LAS float* tws = (LAS float*)(F.lds + O_TWS);
      for (int i = F.tid; i < 4096; i += NT) { float s_, c_; sincospif((float)i * (1.0f / 2048.0f), &s_, &c_); twc[i] = c_; tws[i] = s_; } }
    __syncthreads();
    const LAS unsigned short* CT = (const LAS unsigned short*)(F.lds + O_CT); const LAS unsigned short* ST = CT + 64 * 72;
    const LAS float* twc = (const LAS float*)(F.lds + O_TWC); const LAS float* tws = (const LAS float*)(F.lds + O_TWS);
    const int q = F.lane & 15, g = F.lane >> 4;
    const int gw = F.bid * NWAVES + F.wave, NGW = F.G * NWAVES;
    for (int un = gw; un < BATCH * NHEAD * 64; un += NGW) {
        const int b = un >> 8, h = (un >> 6) & 3, n2 = un & 63;
        f32x4 xr[4][4], xw[4][4];
#pragma unroll
        for (int mt = 0; mt < 4; ++mt)
#pragma unroll
            for (int ct = 0; ct < 4; ++ct) { xr[mt][ct] = (f32x4){0.f, 0.f, 0.f, 0.f}; xw[mt][ct] = (f32x4){0.f, 0.f, 0.f, 0.f}; }
        bf16x8 tfa[2][4];
#pragma unroll
        for (int ks = 0; ks < 2; ++ks)
#pragma unroll
            for (int mt = 0; mt < 4; ++mt) tfa[ks][mt] = *(const GAS bf16x8*)(U + (size_t)(b * SEQ + 64 * (16 * mt + q) + n2) * INC + UC_F + h * HD + 32 * ks + 8 * g);
        __builtin_amdgcn_sched_barrier(0);
#pragma unroll
        for (int ks = 0; ks < 2; ++ks) {
            bf16x8 tf[4], cf[4], sf[4];
#pragma unroll
            for (int mt = 0; mt < 4; ++mt) tf[mt] = tfa[ks][mt];
#pragma unroll
            for (int ct = 0; ct < 4; ++ct) { cf[ct] = *(const LAS bf16x8*)(CT + (16 * ct + q) * 72 + 32 * ks + 8 * g); sf[ct] = *(const LAS bf16x8*)(ST + (16 * ct + q) * 72 + 32 * ks + 8 * g); }
#pragma unroll
            for (int mt = 0; mt < 4; ++mt)
#pragma unroll
                for (int ct = 0; ct < 4; ++ct) { xr[mt][ct] = __builtin_amdgcn_mfma_f32_16x16x32_bf16(tf[mt], cf[ct], xr[mt][ct], 0, 0, 0); xw[mt][ct] = __builtin_amdgcn_mfma_f32_16x16x32_bf16(tf[mt], sf[ct], xw[mt][ct], 0, 0, 0); }
        }
        __builtin_amdgcn_sched_barrier(0); asm volatile("s_nop 7\n\ts_nop 7" ::: "memory"); __builtin_amdgcn_sched_barrier(0);
        v4u ar[4][2], awn[4][2];
#pragma unroll
        for (int ct = 0; ct < 4; ++ct)
#pragma unroll
            for (int kb = 0; kb < 2; ++kb) {
                ar[ct][kb].x = cvtpk(xr[2 * kb][ct][0], xr[2 * kb][ct][1]); ar[ct][kb].y = cvtpk(xr[2 * kb][ct][2], xr[2 * kb][ct][3]);
                ar[ct][kb].z = cvtpk(xr[2 * kb + 1][ct][0], xr[2 * kb + 1][ct][1]); ar[ct][kb].w = cvtpk(xr[2 * kb + 1][ct][2], xr[2 * kb + 1][ct][3]);
                awn[ct][kb].x = cvtpk(-xw[2 * kb][ct][0], -xw[2 * kb][ct][1]); awn[ct][kb].y = cvtpk(-xw[2 * kb][ct][2], -xw[2 * kb][ct][3]);
                awn[ct][kb].z = cvtpk(-xw[2 * kb + 1][ct][0], -xw[2 * kb + 1][ct][1]); awn[ct][kb].w = cvtpk(-xw[2 * kb + 1][ct][2], -xw[2 * kb + 1][ct][3]); }
#pragma unroll
        for (int rt = 0; rt < 4; ++rt) {
            const int n1p = 16 * rt + q;
            bf16x8 cb_[2], sb_[2];
#pragma unroll
            for (int kb = 0; kb < 2; ++kb) { const LAS unsigned short* cp = CT + n1p * 72 + 32 * kb + 4 * g; const LAS unsigned short* sp = ST + n1p * 72 + 32 * kb + 4 * g;
                cb_[kb] = mk8(*(const LAS v2u*)cp, *(const LAS v2u*)(cp + 16)); sb_[kb] = mk8(*(const LAS v2u*)sp, *(const LAS v2u*)(sp + 16)); }
            const int tix = n2 * n1p; const float cw = twc[tix], sw = tws[tix];
            const size_t zbase = ((((size_t)(b * NHEAD + h) * 64 + n1p) * 64 + n2) * 64) + 4 * g;
#pragma unroll
            for (int ct = 0; ct < 4; ++ct) {
                f32x4 yr = (f32x4){0.f, 0.f, 0.f, 0.f}, yi = (f32x4){0.f, 0.f, 0.f, 0.f};
#pragma unroll
                for (int kb = 0; kb < 2; ++kb) {
                    const bf16x8 a_r = __builtin_bit_cast(bf16x8, ar[ct][kb]), a_wn = __builtin_bit_cast(bf16x8, awn[ct][kb]);
                    v4u nr = ar[ct][kb]; nr.x ^= 0x80008000u; nr.y ^= 0x80008000u; nr.z ^= 0x80008000u; nr.w ^= 0x80008000u; const bf16x8 a_rn = __builtin_bit_cast(bf16x8, nr);
                    yr = __builtin_amdgcn_mfma_f32_16x16x32_bf16(a_r, cb_[kb], yr, 0, 0, 0); yr = __builtin_amdgcn_mfma_f32_16x16x32_bf16(a_wn, sb_[kb], yr, 0, 0, 0);
                    yi = __builtin_amdgcn_mfma_f32_16x16x32_bf16(a_wn, cb_[kb], yi, 0, 0, 0); yi = __builtin_amdgcn_mfma_f32_16x16x32_bf16(a_rn, sb_[kb], yi, 0, 0, 0); }
                v2u wr_, wi_;
                wr_.x = cvtpk(yr[0] * cw + yi[0] * sw, yr[1] * cw + yi[1] * sw); wr_.y = cvtpk(yr[2] * cw + yi[2] * sw, yr[3] * cw + yi[3] * sw);
                wi_.x = cvtpk(yi[0] * cw - yr[0] * sw, yi[1] * cw - yr[1] * sw); wi_.y = cvtpk(yi[2] * cw - yr[2] * sw, yi[3] * cw - yr[3] * sw);
                *(GAS v2u*)(Zr + zbase + 16 * ct) = wr_; *(GAS v2u*)(Zi + zbase + 16 * ct) = wi_;
            }
        }
    }
}
__device__ __forceinline__ void fourier_b(Frame& F, bool with_ctx) {
    bf16* Y = (bf16*)(F.ws + WS_H); const bf16* Zr = (const bf16*)(F.ws + WS_Z);
    dft64_tables(F, 0);
    __syncthreads();
    const LAS unsigned short* CT = (const LAS unsigned short*)(F.lds); const LAS unsigned short* ST = CT + 64 * 72;
    LAS unsigned short* ZT = (LAS unsigned short*)(F.lds + 18432 + F.wave * 9216);
    const int q = F.lane & 15, g = F.lane >> 4;
    const int gw = F.bid * NWAVES + F.wave, NGW = F.G * NWAVES;
    const int nun = BATCH * NHEAD * 64 + (with_ctx ? BATCH * NHEAD * 4 : 0);
    for (int un = gw; un < nun; un += NGW) {
        const bool lat = un < BATCH * NHEAD * 64; const int uc = un - BATCH * NHEAD * 64;
        const int b = lat ? (un >> 8) : (uc >> 4), h = lat ? ((un >> 6) & 3) : ((uc >> 2) & 3), n1p = lat ? (un & 63) : (uc & 3);
        const size_t z0 = lat ? (((size_t)(b * NHEAD + h) * 64 + n1p) * 64) * 64 : 2 * NZ + (((size_t)(b * NHEAD + h) * 4 + n1p) * 64) * 64;
        const size_t zim = lat ? NZ : NZC;
        const int tok0 = lat ? (b * SEQ + n1p) : (NLAT + b * CTXL + n1p), tstride = lat ? 64 : 4; const float oscale = lat ? (1.0f / 512.0f) : (1.0f / 128.0f);
        f32x4 acc[4][4];
#pragma unroll
        for (int ct = 0; ct < 4; ++ct)
#pragma unroll
            for (int nt = 0; nt < 4; ++nt) acc[ct][nt] = (f32x4){0.f, 0.f, 0.f, 0.f};
#pragma unroll
        for (int comp = 0; comp < 2; ++comp) {
            const bf16* zp = Zr + z0 + (comp ? zim : 0); const LAS unsigned short* FT = comp ? ST : CT;
#pragma unroll
            for (int i = 0; i < 8; ++i) { const int p = F.lane + 64 * i, n2 = p >> 3, c8 = p & 7; const v4u w = *(const GAS v4u*)(zp + (size_t)n2 * 64 + 8 * c8); LAS unsigned short* tp = ZT + (8 * c8) * 72 + n2;
                tp[0 * 72] = (unsigned short)w.x; tp[1 * 72] = (unsigned short)(w.x >> 16); tp[2 * 72] = (unsigned short)w.y; tp[3 * 72] = (unsigned short)(w.y >> 16);
                tp[4 * 72] = (unsigned short)w.z; tp[5 * 72] = (unsigned short)(w.z >> 16); tp[6 * 72] = (unsigned short)w.w; tp[7 * 72] = (unsigned short)(w.w >> 16); }
            LDS_WAIT(); asm volatile("" ::: "memory");
#pragma unroll
            for (int ks = 0; ks < 2; ++ks) {
                bf16x8 af[4], bf_[4];
#pragma unroll
                for (int ct = 0; ct < 4; ++ct) af[ct] = *(const LAS bf16x8*)(ZT + (16 * ct + q) * 72 + 32 * ks + 8 * g);
#pragma unroll
                for (int nt = 0; nt < 4; ++nt) bf_[nt] = *(const LAS bf16x8*)(FT + (16 * nt + q) * 72 + 32 * ks + 8 * g);
#pragma unroll
                for (int ct = 0; ct < 4; ++ct)
#pragma unroll
                    for (int nt = 0; nt < 4; ++nt) acc[ct][nt] = __builtin_amdgcn_mfma_f32_16x16x32_bf16(af[ct], bf_[nt], acc[ct][nt], 0, 0, 0);
            }
            LDS_WAIT(); asm volatile("" ::: "memory");
        }
#pragma unroll
        for (int nt = 0; nt < 4; ++nt) { bf16* yp = Y + (size_t)(tok0 + tstride * (16 * nt + q)) * D + 768 + h * HD + 4 * g;
#pragma unroll
            for (int ct = 0; ct < 4; ++ct) { v2u w; w.x = cvtpk(acc[ct][nt][0] * oscale, acc[ct][nt][1] * oscale); w.y = cvtpk(acc[ct][nt][2] * oscale, acc[ct][nt][3] * oscale); *(GAS v2u*)(yp + 16 * ct) = w; } }
    }
}
__device__ __forceinline__ v4u mul_bf8(v4u a, v4u b) { v4u r; r.x = cvtpk(bflo(a.x) * bflo(b.x), bfhi(a.x) * bfhi(b.x)); r.y = cvtpk(bflo(a.y) * bflo(b.y), bfhi(a.y) * bfhi(b.y)); r.z = cvtpk(bflo(a.z) * bflo(b.z), bfhi(a.z) * bfhi(b.z)); r.w = cvtpk(bflo(a.w) * bflo(b.w), bfhi(a.w) * bfhi(b.w)); return r; }
__device__ __forceinline__ void convpool_phase(Frame& F, int l, int nrows) {
    const bf16* __restrict__ U = (const bf16*)(F.ws + WS_U); bf16* __restrict__ Y = (bf16*)(F.ws + WS_H);
    const bf16* PWT = (const bf16*)(F.ws + WS_PWT) + (size_t)l * 4 * 64 * 64;
    const float* cw = F.inp(I_CONVW) + (size_t)l * 3 * GWID; const float* ps = F.inp(I_POOLS) + (size_t)l * GWID;
    LAS unsigned* PX = (LAS unsigned*)(F.lds + RING_OFF + F.wave * 16384);
    LAS unsigned* DT = PX + 32 * 64;
    const int q = F.lane & 15, g = F.lane >> 4;
    const int c8 = F.tid & 31, tt = F.wave >> 1, ch = F.wave & 1;
    const f32x4 w0a = *(const GAS f32x4*)(cw + 8 * c8), w0b = *(const GAS f32x4*)(cw + 8 * c8 + 4), w1a = *(const GAS f32x4*)(cw + GWID + 8 * c8), w1b = *(const GAS f32x4*)(cw + GWID + 8 * c8 + 4),
                w2a = *(const GAS f32x4*)(cw + 2 * GWID + 8 * c8), w2b = *(const GAS f32x4*)(cw + 2 * GWID + 8 * c8 + 4);
    bf16x8 wf[2][4][2]; f32x4 psc[2][4];
#pragma unroll
    for (int gs = 0; gs < 2; ++gs)
#pragma unroll
        for (int dt = 0; dt < 4; ++dt) { const int gi = 2 * ch + gs; psc[gs][dt] = *(const GAS f32x4*)(ps + gi * 64 + 16 * dt + 4 * g);
#pragma unroll
            for (int ks = 0; ks < 2; ++ks) wf[gs][dt][ks] = *(const GAS bf16x8*)(PWT + ((size_t)gi * 64 + 16 * dt + q) * 64 + 32 * ks + 8 * g); }
    for (int tile = F.bid; tile < nrows / 64; tile += F.G) {
        const int r0 = tile * 64; int base, t0, L; seq_info(r0, base, t0, L);
        v4u pw_[8];
#pragma unroll
        for (int i = 0; i < 8; ++i) { const int p = F.lane + 64 * i, rr = p >> 4, c16 = p & 15, t = t0 + 16 * tt - 8 + rr; const bool in_ = (t >= 0) && (t < L); const int tc = in_ ? t : t0;
            const v4u w = *(const GAS v4u*)(U + (size_t)(base + tc) * INC + UC_P + ch * 128 + 8 * c16);
            pw_[i].x = in_ ? w.x : 0u; pw_[i].y = in_ ? w.y : 0u; pw_[i].z = in_ ? w.z : 0u; pw_[i].w = in_ ? w.w : 0u; }
#pragma unroll
        for (int ib = 0; ib < 2; ++ib) {
            v4u ac_[2], av_[2], pc_[2], pv_[2], nc_[2], nv_[2], ab_[2];
#pragma unroll
            for (int k = 0; k < 2; ++k) { const int p = F.tid + NT * (2 * ib + k), tr = p >> 5; const bf16* ur = U + (size_t)(r0 + tr) * INC + 8 * c8;
                ac_[k] = *(const GAS v4u*)(ur + UC_AC); av_[k] = *(const GAS v4u*)(ur + UC_AV); pc_[k] = *(const GAS v4u*)(ur + UC_AC - INC); pv_[k] = *(const GAS v4u*)(ur + UC_AV - INC);
                nc_[k] = *(const GAS v4u*)(ur + UC_AC + INC); nv_[k] = *(const GAS v4u*)(ur + UC_AV + INC); ab_[k] = *(const GAS v4u*)(ur + UC_AB); }
            __builtin_amdgcn_sched_barrier(0);
#pragma unroll
            for (int k = 0; k < 2; ++k) { const int p = F.tid + NT * (2 * ib + k), tr = p >> 5, t = t0 + tr;
                const v4u zc = mul_bf8(ac_[k], av_[k]); v4u zp = mul_bf8(pc_[k], pv_[k]), zn = mul_bf8(nc_[k], nv_[k]); const v4u ab = ab_[k];
                { const bool hp = t > 0, hn = t < L - 1; zp.x = hp ? zp.x : 0u; zp.y = hp ? zp.y : 0u; zp.z = hp ? zp.z : 0u; zp.w = hp ? zp.w : 0u; zn.x = hn ? zn.x : 0u; zn.y = hn ? zn.y : 0u; zn.z = hn ? zn.z : 0u; zn.w = hn ? zn.w : 0u; }
                v4u o;
                o.x = cvtpk(bflo(ab.x) * (w0a.x * bflo(zp.x) + w1a.x * bflo(zc.x) + w2a.x * bflo(zn.x)), bfhi(ab.x) * (w0a.y * bfhi(zp.x) + w1a.y * bfhi(zc.x) + w2a.y * bfhi(zn.x)));
                o.y = cvtpk(bflo(ab.y) * (w0a.z * bflo(zp.y) + w1a.z * bflo(zc.y) + w2a.z * bflo(zn.y)), bfhi(ab.y) * (w0a.w * bfhi(zp.y) + w1a.w * bfhi(zc.y) + w2a.w * bfhi(zn.y)));
                o.z = cvtpk(bflo(ab.z) * (w0b.x * bflo(zp.z) + w1b.x * bflo(zc.z) + w2b.x * bflo(zn.z)), bfhi(ab.z) * (w0b.y * bfhi(zp.z) + w1b.y * bfhi(zc.z) + w2b.y * bfhi(zn.z)));
                o.w = cvtpk(bflo(ab.w) * (w0b.z * bflo(zp.w) + w1b.z * bflo(zc.w) + w2b.z * bflo(zn.w)), bfhi(ab.w) * (w0b.w * bfhi(zp.w) + w1b.w * bfhi(zc.w) + w2b.w * bfhi(zn.w)));
                *(GAS v4u*)(Y + (size_t)(r0 + tr) * D + 8 * c8) = o; }
        }
#pragma unroll
        for (int i = 0; i < 8; ++i) { const int p = F.lane + 64 * i, rr = p >> 4, c16 = p & 15; *(LAS v4u*)(PX + rr * 64 + 4 * c16) = pw_[i]; }
        LDS_WAIT(); asm volatile("" ::: "memory");
        { const int hw = 1 << (2 * ch + (F.lane >> 5));
          float s0 = 0.f, s1 = 0.f;
          for (int k = -hw; k < hw; ++k) { const unsigned w = PX[(8 + k) * 64 + F.lane]; s0 += bflo(w); s1 += bfhi(w); }
          for (int i = 0; i < 16; ++i) { const int t = t0 + 16 * tt + i;
              const int lo = t - hw > 0 ? t - hw : 0, hi = t + hw < L ? t + hw : L; const float rc = 1.0f / (float)(hi - lo);
              const unsigned xc = PX[(i + 8) * 64 + F.lane];
              DT[i * 68 + F.lane] = cvtpk(s0 * rc - bflo(xc), s1 * rc - bfhi(xc));
              const unsigned wa = PX[(i + 8 + hw) * 64 + F.lane], wsb = PX[(i + 8 - hw) * 64 + F.lane];
              s0 += bflo(wa) - bflo(wsb); s1 += bfhi(wa) - bfhi(wsb); } }
        LDS_WAIT(); asm volatile("" ::: "memory");
#pragma unroll
        for (int gs = 0; gs < 2; ++gs) { const int gi = 2 * ch + gs;
            bf16x8 df[2];
#pragma unroll
            for (int ks = 0; ks < 2; ++ks) df[ks] = *(const LAS bf16x8*)(DT + q * 68 + gs * 32 + 16 * ks + 4 * g);
#pragma unroll
            for (int dt = 0; dt < 4; ++dt) { f32x4 a = (f32x4){0.f, 0.f, 0.f, 0.f};
                a = __builtin_amdgcn_mfma_f32_16x16x32_bf16(wf[gs][dt][0], df[0], a, 0, 0, 0); a = __builtin_amdgcn_mfma_f32_16x16x32_bf16(wf[gs][dt][1], df[1], a, 0, 0, 0);
                const int oc = gi * 64 + 16 * dt + 4 * g; const f32x4 sc = psc[gs][dt];
                v2u w; w.x = cvtpk(a[0] * sc.x, a[1] * sc.y); w.y = cvtpk(a[2] * sc.z, a[3] * sc.w);
                *(GAS v2u*)(Y + (size_t)(r0 + 16 * tt + q) * D + 256 + oc) = w; } }
        LDS_WAIT(); asm volatile("" ::: "memory");
    }
    __syncthreads();
}

__device__ __forceinline__ void fourier_ctx_a(Frame& F) {
    const bf16* U = (const bf16*)(F.ws + WS_U); bf16* Zc = (bf16*)(F.ws + WS_Z) + 2 * NZ;
    LAS float* cs = (LAS float*)(F.lds + TAB_OFF); LAS float* sn = cs + 64; LAS float* cs256 = cs + 128; LAS float* sn256 = cs + 384;
    if (F.tid < 64) { float s_, c_; sincospif((float)F.tid * (1.0f / 32.0f), &s_, &c_); cs[F.tid] = c_; sn[F.tid] = s_; }
    if (F.tid < 256) { float s_, c_; sincospif((float)F.tid * (1.0f / 128.0f), &s_, &c_); cs256[F.tid] = c_; sn256[F.tid] = s_; }
    __syncthreads();
    for (int item = F.bid * NT + F.tid; item < BATCH * NHEAD * 64 * 64; item += F.G * NT) {
        const int cp = item & 63, n2 = (item >> 6) & 63, h = (item >> 12) & 3, b = item >> 14;
        float xr[4], xi[4];
#pragma unroll
        for (int n1 = 0; n1 < 4; ++n1) { xr[n1] = 0.f; xi[n1] = 0.f; }
        for (int c8 = 0; c8 < 8; ++c8) {
            float cc[8], ss[8];
#pragma unroll
            for (int e = 0; e < 8; ++e) { const int idx = ((8 * c8 + e) * cp) & 63; cc[e] = cs[idx]; ss[e] = sn[idx]; }
#pragma unroll
            for (int n1 = 0; n1 < 4; ++n1) { const v4u w = *(const GAS v4u*)(U + (size_t)(NLAT + b * CTXL + 64 * n1 + n2) * INC + UC_F + h * HD + 8 * c8);
                const float f0 = bflo(w.x), f1 = bfhi(w.x), f2 = bflo(w.y), f3 = bfhi(w.y), f4 = bflo(w.z), f5 = bfhi(w.z), f6 = bflo(w.w), f7 = bfhi(w.w);
                xr[n1] += f0 * cc[0] + f1 * cc[1] + f2 * cc[2] + f3 * cc[3] + f4 * cc[4] + f5 * cc[5] + f6 * cc[6] + f7 * cc[7];
                xi[n1] -= f0 * ss[0] + f1 * ss[1] + f2 * ss[2] + f3 * ss[3] + f4 * ss[4] + f5 * ss[5] + f6 * ss[6] + f7 * ss[7]; }
        }
        float yr[4], yi[4];
        yr[0] = xr[0] + xr[1] + xr[2] + xr[3];           yi[0] = xi[0] + xi[1] + xi[2] + xi[3];
        yr[1] = xr[0] + xi[1] - xr[2] - xi[3];           yi[1] = xi[0] - xr[1] - xi[2] + xr[3];
        yr[2] = xr[0] - xr[1] + xr[2] - xr[3];           yi[2] = xi[0] - xi[1] + xi[2] - xi[3];
        yr[3] = xr[0] - xi[1] - xr[2] + xi[3];           yi[3] = xi[0] + xr[1] - xi[2] - xr[3];
#pragma unroll
        for (int k = 0; k < 4; ++k) { const int tix = (n2 * k) & 255; const float cw = cs256[tix], sw = sn256[tix];
            const size_t zi = ((((size_t)(b * NHEAD + h) * 4 + k) * 64 + n2) * 64) + cp;
            Zc[zi] = (bf16)f2bf(yr[k] * cw + yi[k] * sw); Zc[NZC + zi] = (bf16)f2bf(yi[k] * cw - yr[k] * sw); }
    }
}

__device__ __forceinline__ void mixa_phase(int l, bool with_ctx) { Frame F = mk_frame();
    const int nrows = with_ctx ? NROW : NLAT;
    convpool_phase(F, l, nrows);
    kv_prepass(F);
    bias_table(F, l);
    __syncthreads();
    fourier_a(F);
    __syncthreads();
    if (with_ctx) fourier_ctx_a(F);
}
__device__ __forceinline__ void mixb_phase(int l, bool with_ctx) { Frame F = mk_frame();
    attn_phase(F, l, with_ctx);
    __syncthreads();
    fourier_b(F, with_ctx);
}

struct WinOrder {
    int G, c, nctx_cols, ctx_pn0;
    __device__ __forceinline__ bool next(int i, pg8::Unit& u) const {
        const long L = (long)i * G + c; const int nlatu = 1024, total = nlatu + 8 * nctx_cols; if (L >= total) return false;
        if (L < nlatu) { int wgid = (int)L; { const int xcd = wgid % 8, off = wgid / 8; wgid = xcd * 128 + off; }
            const int gid = wgid / 64, fm = gid * 8; u.pm = fm + ((wgid % 64) % 8); u.pn = (wgid % 64) / 8; }
        else { const int j = (int)L - nlatu; u.pm = 128 + (j % 8); u.pn = ctx_pn0 + j / 8; }
        u.pb = u.pn; u.lb = 0; u.nv = 256; return true;
    }
    __device__ __forceinline__ void a_ready(const pg8::Unit&) const {}
    __device__ __forceinline__ void done(const pg8::Unit&) const {}
    __device__ __forceinline__ int row_of(const pg8::Unit&, int i) const { return i; }
};

struct Args { const float* in[20]; float* out; unsigned char* ws; int l, e; };
#define PH_PTRS() \
    bf16* H = (bf16*)(F.ws + WS_H); bf16* U = (bf16*)(F.ws + WS_U); bf16* HE = (bf16*)(F.ws + WS_U); bf16* Y2 = (bf16*)(F.ws + WS_S); \
    float* MOD = (float*)(F.ws + WS_MOD); float* XC = (float*)(F.ws + WS_XC); const uint2* INFO = (const uint2*)(F.ws + WS_INFO); \
    const bool first = (l == 0); const int M = first ? NROW : NLAT; const float* modl = MOD + (size_t)l * 9 * 6144; \
    (void)H; (void)U; (void)HE; (void)XC; (void)Y2; (void)INFO; (void)M; (void)modl;

#define XS_IN()  XStream{(const char*)F.inp(I_X), (const char*)F.inp(I_CTX), 4096, 4096}
#define XS_BF()  XStream{(const char*)F.out, (const char*)XC, 4096, 2048}
__device__ __forceinline__ void ph_norm1(int l) { Frame F = mk_frame(); PH_PTRS();
    norm_phase<0, false, false>(F, XS_IN(), XS_IN(), NROW, F.inp(I_N1G), modl, modl, 0, 1, H, nullptr, nullptr); }
__device__ __forceinline__ void ph_next(int l) { Frame F = mk_frame(); PH_PTRS();
    if (first) norm_phase<1, false, true>(F, XS_BF(), XS_BF(), NROW, F.inp(I_N1G) + D, MOD + (size_t)9 * 6144, modl, 0, 1, H, Y2, nullptr);
    else norm_phase<1, true, true>(F, XS_BF(), XS_BF(), NLAT, F.inp(I_FG), modl, modl, 0, 0, nullptr, Y2, F.out); }
__device__ __forceinline__ void ph_route(int l) { Frame F = mk_frame(); PH_PTRS();
    if (first) route_phase<false>(F, l, XS_IN(), XS_BF(), U, M, F.inp(I_N2G) + (size_t)l * D, modl, H, (uint2*)(F.ws + WS_INFO), (unsigned*)(F.ctl + CW_CNT + l * 16));
    else route_phase<true>(F, l, XS_BF(), XS_BF(), U, M, F.inp(I_N2G) + (size_t)l * D, modl, H, (uint2*)(F.ws + WS_INFO), (unsigned*)(F.ctl + CW_CNT + l * 16)); }
__device__ __forceinline__ void ph_win(int l) { Frame F = mk_frame(); PH_PTRS();
    pg8::Gemm g{H, (const bf16*)(F.ws + WS_WIN) + (size_t)l * INC * D, NROW, INC, D};
    WinOrder S{F.G, F.bid, first ? 8 : 2, first ? 0 : 5};
    pg8::EpiBf16 E{U, INC};
    pg8::gemm_phase<pg8::EpiBf16, WinOrder>(F.lds + RING_OFF, g, S, E); }
__device__ __forceinline__ void ph_wout(int l) { Frame F = mk_frame(); PH_PTRS();
    pg8::Gemm g{H, (const bf16*)(F.ws + WS_WOUT) + (size_t)l * D * D, M, D, D};
    pg8::StaticOrder S; S.init(M, D, F.G, F.bid);
    pg8::EpiBf16 E{U, D};
    pg8::gemm_phase<pg8::EpiBf16, pg8::StaticOrder>(F.lds + RING_OFF, g, S, E); }
__device__ __forceinline__ void ph_moe1(int l) { Frame F = mk_frame(); PH_PTRS(); moe_table(F, l);
    pg8::Gemm g{H, (const bf16*)(F.ws + WS_W13) + (size_t)l * NEXP * 1024 * D, M, 1024, D};
    pg8::MoeOrder S{F.G, F.bid, CAP, (const LAS int*)(F.lds + TAB_OFF), INFO};
    pg8::EpiSwiGLU E{HE, MHID};
    pg8::gemm_phase<pg8::EpiSwiGLU, pg8::MoeOrder, true>(F.lds + RING_OFF, g, S, E); }
__device__ __forceinline__ void ph_moe2(int l) { Frame F = mk_frame(); PH_PTRS(); moe_table(F, l);
    pg8::Gemm g{HE, (const bf16*)(F.ws + WS_W2) + (size_t)l * NEXP * D * MHID, M, D, MHID};
    pg8::MoeOrder S{F.G, F.bid, CAP, (const LAS int*)(F.lds + TAB_OFF), INFO};
    pg8::EpiScatter E{Y2, INFO};
    pg8::gemm_phase<pg8::EpiScatter, pg8::MoeOrder, false>(F.lds + RING_OFF, g, S, E); }

__device__ __forceinline__ void grid_bar() {
    Frame F = mk_frame(); XcdBarrier b; b.bar = (unsigned*)(F.ctl + CW_BAR); b.x = xb_xcc_id(); b.st = F.MISC + 8; xcd_barrier(b);
}
#define PMARK(name) asm volatile("; PHASE_MARK " name ::: "memory")
template <int L> __device__ __forceinline__ void layer_phases() {
    PMARK("win"); ph_win(L); grid_bar();
    PMARK("mixa"); mixa_phase(L, L == 0); grid_bar();
    PMARK("mixb"); mixb_phase(L, L == 0); grid_bar();
    PMARK("wout"); ph_wout(L); grid_bar();
    PMARK("route"); ph_route(L); grid_bar();
    PMARK("moe1"); ph_moe1(L); grid_bar();
    PMARK("moe2"); ph_moe2(L); grid_bar();
    PMARK("next"); ph_next(L);
}
__global__ void __launch_bounds__(NT, 2) fwd_all(Args args) {
    { Frame F = mk_frame();
      for (int u = F.tid; u < (LDS_BYTES - LDSCTL_OFF) / 4; u += NT) ((LAS unsigned*)(F.lds + LDSCTL_OFF))[u] = 0u;
      __syncthreads();
      (void)xcd_barrier_post((unsigned*)(F.ctl + CW_BAR), F.MISC + 8); }
    PMARK("pa"); pa_phase(); grid_bar();
    PMARK("norm1"); ph_norm1(0); grid_bar();
    layer_phases<0>(); grid_bar();
    layer_phases<1>();
}

typedef void (*kern_t)(Args);
extern "C" void kernel_launch(void* const* d_in, const int* in_sizes, int n_in, void* d_out, int out_size, void* d_ws, size_t ws_size, hipStream_t stream) {
    static int grid = 0;
    const kern_t kerns[] = {fwd_all};
    if (grid == 0) {
        if (n_in != 20 || out_size != NLAT * D || ws_size < WS_END) { fprintf(stderr, "kernel_launch: unexpected shapes (n_in %d out %d ws %zu)\n", n_in, out_size, ws_size); grid = -1; return; }
        int dev = 0, cus = 0;
        if (hipGetDevice(&dev) != hipSuccess || hipDeviceGetAttribute(&cus, hipDeviceAttributeMultiprocessorCount, dev) != hipSuccess) { grid = -1; return; }
        for (kern_t k : kerns) if (hipFuncSetAttribute((const void*)k, hipFuncAttributeMaxDynamicSharedMemorySize, LDS_BYTES) != hipSuccess) { fprintf(stderr, "kernel_launch: hipFuncSetAttribute failed\n"); grid = -1; return; }
        int per_cu = 0; (void)hipOccupancyMaxActiveBlocksPerMultiprocessor(&per_cu, (const void*)kerns[0], NT, LDS_BYTES); (void)hipGetLastError();
        grid = cus;
    }
    if (grid < 0) return;
    (void)hipMemsetAsync((char*)d_ws + WS_CTL, 0, CTL_ZERO_BYTES, stream);
    Args a{};
    for (int i = 0; i < 20; ++i) a.in[i] = (const float*)d_in[i];
    a.out = (float*)d_out; a.ws = (unsigned char*)d_ws;
    hipLaunchKernelGGL(fwd_all, dim3(grid), dim3(NT), LDS_BYTES, stream, a);
}
```

```cpp
#include <hip/hip_runtime.h>
#include <cstdio>
#include <cstdint>
namespace pg8 {
#define PG8_LAS __attribute__((address_space(3)))
typedef unsigned short bf16_t;
typedef short bf16x8 __attribute__((ext_vector_type(8)));
typedef float f32x4 __attribute__((ext_vector_type(4)));
typedef unsigned u32x4 __attribute__((ext_vector_type(4)));
constexpr int BM = 256, BK = 64, HALF = 128, HTB = HALF * BK * 2  , STAGE_BYTES = 8 * HTB, NXCD = 8, WGM = 8;

__host__ __device__ __forceinline__ int lds_byte(int r, int c) { const int st = (r >> 4) * 2 + (c >> 5), rr = r & 15, cc = c & 31, ob = rr * 64 + cc * 2; return st * 1024 + (ob ^ (((ob >> 9) & 1) << 5)); }
__host__ __device__ __forceinline__ void stage_rc(int b, int& R, int& C) { const int st = b / 1024, sb = b % 1024, swz = sb ^ (((sb >> 9) & 1) << 5); R = (st >> 1) * 16 + swz / 64; C = (st & 1) * 32 + (swz % 64) / 2; }
__host__ __device__ __forceinline__ int perm32(int rho) { const int n = rho >> 4, i = rho & 15; return 8 * (i >> 2) + 4 * n + (i & 3); }

struct Unit { int pm, pn, pb, lb, nv; };
struct Gemm { const bf16_t* A; const bf16_t* Bt; int M, N, K; };

struct StaticOrder {
    int nM, nN, nwg, G, c;
    __host__ __device__ void init(int M, int N, int G_, int c_) { nM = M / BM; nN = N / BM; nwg = nM * nN; G = G_; c = c_; }
    __host__ __device__ bool next(int i, Unit& u) const {
        const long L = (long)i * G + c; if (L >= nwg) return false;
        int wgid = (int)L; { const int q = nwg / NXCD, r = nwg % NXCD, xcd = wgid % NXCD, off = wgid / NXCD; wgid = (xcd < r ? xcd * (q + 1) : r * (q + 1) + (xcd - r) * q) + off; }
        const int nig = WGM * nN, gid = wgid / nig, fm = gid * WGM, gsz = (nM - fm) < WGM ? (nM - fm) : WGM;
        u.pm = fm + ((wgid % nig) % gsz); u.pn = (wgid % nig) / gsz; u.pb = u.pn; u.lb = 0; u.nv = BM; return true;
    }
    __device__ __forceinline__ void a_ready(const Unit&) const {}
    __device__ __forceinline__ int row_of(const Unit&, int i) const { return i; }
    __device__ __forceinline__ void done(const Unit&) const {}
};


__device__ __forceinline__ unsigned cvt_pk_bf16(float lo, float hi) { unsigned r; asm volatile("v_cvt_pk_bf16_f32 %0, %1, %2" : "=v"(r) : "v"(lo), "v"(hi)); return r; }

__device__ __forceinline__ unsigned cvt4_fp8(float a, float b, float c, float d) {
    a = __builtin_amdgcn_fmed3f(a, -448.f, 448.f); b = __builtin_amdgcn_fmed3f(b, -448.f, 448.f); c = __builtin_amdgcn_fmed3f(c, -448.f, 448.f); d = __builtin_amdgcn_fmed3f(d, -448.f, 448.f);
    int w = 0; w = __builtin_amdgcn_cvt_pk_fp8_f32(a, b, w, false); w = __builtin_amdgcn_cvt_pk_fp8_f32(c, d, w, true); return (unsigned)w; }
constexpr float F8_ACT = 8.0f, F8_W = 64.0f;

struct EpiBf16 {
    static constexpr bool PERM = true, AFTER_DRAIN = false;
    bf16_t* O; int ldc;
    __device__ __forceinline__ void operator()(const f32x4 (&acc)[2][2][4][2], const Unit& u, int wr, int wc, int fr, int fq) const {
        const int row0 = u.pm * BM + wr * 64 + fr; const int col0 = u.pn * BM + wc * 32 + 8 * fq;
        float one = 1.0f; asm volatile("" : "+v"(one));
#pragma unroll
        for (int ai = 0; ai < 2; ++ai)
#pragma unroll
            for (int m = 0; m < 4; ++m) { bf16_t* rowp = O + (size_t)(row0 + ai * HALF + m * 16) * ldc + col0;
#pragma unroll
                for (int bj = 0; bj < 2; ++bj) { const f32x4 v0 = acc[ai][bj][m][0] * one, v1 = acc[ai][bj][m][1] * one;
                    u32x4 w; w.x = cvt_pk_bf16(v0[0], v0[1]); w.y = cvt_pk_bf16(v0[2], v0[3]); w.z = cvt_pk_bf16(v1[0], v1[1]); w.w = cvt_pk_bf16(v1[2], v1[3]);
                    *(u32x4*)(rowp + bj * HALF) = w; } }
    }
};
struct EpiSwiGLU {
    static constexpr bool PERM = true, AFTER_DRAIN = false;
    bf16_t* O; int ldc;
    __device__ __forceinline__ void operator()(const f32x4 (&acc)[2][2][4][2], const Unit& u, int wr, int wc, int fr, int fq) const {
        const int row0 = u.pm * BM + wr * 64 + fr; const int col0 = u.pn * HALF + wc * 32 + 8 * fq;
#pragma unroll
        for (int ai = 0; ai < 2; ++ai)
#pragma unroll
            for (int m = 0; m < 4; ++m) { bf16_t* rowp = O + (size_t)(row0 + ai * HALF + m * 16) * ldc + col0;
                float o[8];
#pragma unroll
                for (int n = 0; n < 2; ++n)
#pragma unroll
                    for (int j = 0; j < 4; ++j) { const float a = acc[ai][0][m][n][j], b = acc[ai][1][m][n][j]; o[n * 4 + j] = a * __builtin_amdgcn_rcpf(1.0f + __expf(-a)) * b; }
                u32x4 w; w.x = cvt_pk_bf16(o[0], o[1]); w.y = cvt_pk_bf16(o[2], o[3]); w.z = cvt_pk_bf16(o[4], o[5]); w.w = cvt_pk_bf16(o[6], o[7]);
                *(u32x4*)rowp = w; }
    }
};
struct EpiSwiGLU8 {
    static constexpr bool PERM = true, AFTER_DRAIN = false;
    unsigned char* O; int ldc;
    __device__ __forceinline__ void operator()(const f32x4 (&acc)[2][2][4][2], const Unit& u, int wr, int wc, int fr, int fq) const {
        const int row0 = u.pm * BM + wr * 64 + fr; const int col0 = u.pn * HALF + wc * 32 + 8 * fq;
        constexpr float ds = 1.0f / (F8_ACT * F8_W);
#pragma unroll
        for (int ai = 0; ai < 2; ++ai)
#pragma unroll
            for (int m = 0; m < 4; ++m) { unsigned char* rowp = O + (size_t)(row0 + ai * HALF + m * 16) * ldc + col0;
                float o[8];
                typedef float f32x2_ __attribute__((ext_vector_type(2)));
                constexpr float c1 = -1.44269504f * ds, c2 = ds * ds * F8_ACT;
#pragma unroll
                for (int n = 0; n < 2; ++n)
#pragma unroll
                    for (int jp = 0; jp < 2; ++jp) { const f32x2_ a = (f32x2_){acc[ai][0][m][n][2 * jp], acc[ai][0][m][n][2 * jp + 1]}, b = (f32x2_){acc[ai][1][m][n][2 * jp], acc[ai][1][m][n][2 * jp + 1]};
                        const f32x2_ arg = a * c1; const f32x2_ den = (f32x2_){__builtin_amdgcn_exp2f(arg.x), __builtin_amdgcn_exp2f(arg.y)} + 1.0f;
                        const f32x2_ sg = (f32x2_){__builtin_amdgcn_rcpf(den.x), __builtin_amdgcn_rcpf(den.y)};
                        const f32x2_ r = (a * b) * (sg * c2); o[n * 4 + 2 * jp] = r.x; o[n * 4 + 2 * jp + 1] = r.y; }
                uint2 w; w.x = cvt4_fp8(o[0], o[1], o[2], o[3]); w.y = cvt4_fp8(o[4], o[5], o[6], o[7]);
                *(uint2*)rowp = w; }
    }
};
struct EpiScatter {
    static constexpr bool PERM = true, AFTER_DRAIN = false;
    bf16_t* Y2; const uint2* info; float scale;
    __device__ __forceinline__ void operator()(const f32x4 (&acc)[2][2][4][2], const Unit& u, int wr, int wc, int fr, int fq) const {
        const int col0 = u.pn * BM + wc * 32 + 8 * fq;
        uint2 infs[2][4];
#pragma unroll
        for (int ai = 0; ai < 2; ++ai)
#pragma unroll
            for (int m = 0; m < 4; ++m) { const int i = ai * HALF + wr * 64 + m * 16 + fr; infs[ai][m] = info[u.lb + (i < u.nv ? i : 0)]; }
#pragma unroll
        for (int ai = 0; ai < 2; ++ai)
#pragma unroll
            for (int m = 0; m < 4; ++m) { const int i = ai * HALF + wr * 64 + m * 16 + fr;
                if (i < u.nv) { const uint2 inf = infs[ai][m]; const float w = __builtin_bit_cast(float, inf.y) * scale; bf16_t* rowp = Y2 + (size_t)inf.x * 1024 + col0;
#pragma unroll
                    for (int bj = 0; bj < 2; ++bj) { const f32x4 v0 = acc[ai][bj][m][0] * w, v1 = acc[ai][bj][m][1] * w;
                        u32x4 q; q.x = cvt_pk_bf16(v0[0], v0[1]); q.y = cvt_pk_bf16(v0[2], v0[3]); q.z = cvt_pk_bf16(v1[0], v1[1]); q.w = cvt_pk_bf16(v1[2], v1[3]);
                        *(u32x4*)(rowp + bj * HALF) = q; } } }
    }
};
struct MoeOrder {
    int G, c, cap; const PG8_LAS int* tab; const uint2* info;
    __device__ __forceinline__ bool next(int i, Unit& u) const {
        const int nwg = __builtin_amdgcn_readfirstlane(tab[16]) * 4; const long L = (long)i * G + c; if (L >= nwg) return false;
        int wgid = (int)L; { const int q = nwg / NXCD, r = nwg % NXCD, xcd = wgid % NXCD, off = wgid / NXCD; wgid = (xcd < r ? xcd * (q + 1) : r * (q + 1) + (xcd - r) * q) + off; }
        const int gp = wgid >> 2; int e = 0;
#pragma unroll
        for (int q = 1; q < 16; ++q) e += (gp >= tab[q]) ? 1 : 0;
        e = __builtin_amdgcn_readfirstlane(e);
        const int p = gp - __builtin_amdgcn_readfirstlane(tab[e]); const int ne = __builtin_amdgcn_readfirstlane(tab[17 + e]);
        u.pm = gp; u.pn = wgid & 3; u.pb = e * 4 + u.pn; u.lb = e * cap + 256 * p; u.nv = (ne - 256 * p) < 256 ? (ne - 256 * p) : 256; return true;
    }
    __device__ __forceinline__ void a_ready(const Unit&) const {}
    __device__ __forceinline__ void done(const Unit&) const {}
    __device__ __forceinline__ int row_of(const Unit& u, int i) const { return (int)(info[u.lb + (i < u.nv ? i : 0)].x >> 1); }
};
typedef int v4i_ __attribute__((ext_vector_type(4)));
typedef int v8i_ __attribute__((ext_vector_type(8)));
__device__ __forceinline__ v8i_ cat8(bf16x8 lo, bf16x8 hi) { return __builtin_shufflevector(__builtin_bit_cast(v4i_, lo), __builtin_bit_cast(v4i_, hi), 0, 1, 2, 3, 4, 5, 6, 7); }
template <class Epi, class Sched, bool GATHER = false, bool FP8 = false>
__device__ __forceinline__ void gemm_phase(PG8_LAS unsigned char* lds, const Gemm g, const Sched& S, const Epi& E) {
    int tid_ = threadIdx.x; asm volatile("" : "+v"(tid_));
    const int tid = tid_, wid = __builtin_amdgcn_readfirstlane(tid >> 6), lane = tid & 63, wr = wid >> 2, wc = wid & 3, fr = lane & 15, fq = lane >> 4;
    const int K = g.K, nt = K / BK;
    struct AO { unsigned i0, i1; };
    AO voffB;
    { int R, C; stage_rc(tid * 16, R, C); int Rb = Epi::PERM ? ((R & ~31) + perm32(R & 31)) : R; voffB.i0 = (unsigned)(Rb * K + C) * 2u;
      stage_rc(tid * 16 + 8192, R, C); Rb = Epi::PERM ? ((R & ~31) + perm32(R & 31)) : R; voffB.i1 = (unsigned)(Rb * K + C) * 2u; }
    const size_t kstep = (size_t)(BK * 2);
    const size_t hstep = (size_t)HALF * K * 2;
    const size_t tstep = 2 * hstep;
    const unsigned ldsw = (unsigned)wid * 1024u;
    const int aoff = lds_byte(wr * 64 + fr, fq * 8), boff = lds_byte(wc * 32 + fr, fq * 8);
#define PG8_SA(b, h) (((b) * 2 + (h)) * HTB)
#define PG8_SB(b, h) ((4 + (b) * 2 + (h)) * HTB)
#define PG8_STAGE1(bufoff, gb, vo, piece) do { unsigned _vo = (vo); asm volatile("" : "+v"(_vo));     \
        __builtin_amdgcn_global_load_lds((const unsigned*)((gb) + _vo), (PG8_LAS unsigned*)(lds + (bufoff) + ldsw + (piece) * 8192), 16, 0, 0); } while (0)
#define PG8_STAGE(bufoff, gbase, voff) do { const char* _gb = (const char*)(gbase); asm volatile("" : "+s"(_gb));     \
        PG8_STAGE1(bufoff, _gb, (voff).i0, 0); PG8_STAGE1(bufoff, _gb, (voff).i1, 1); } while (0)
#define PG8_LDA(dst, b, h) do { _Pragma("unroll") for (int m = 0; m < 4; ++m) _Pragma("unroll") for (int k = 0; k < 2; ++k) dst[m][k] = *(const PG8_LAS bf16x8*)(lds + PG8_SA(b, h) + aoff + m * 2048 + k * 1024); } while (0)
#define PG8_LDB(dst, b, h) do { _Pragma("unroll") for (int n = 0; n < 2; ++n) _Pragma("unroll") for (int k = 0; k < 2; ++k) dst[n][k] = *(const PG8_LAS bf16x8*)(lds + PG8_SB(b, h) + boff + n * 2048 + k * 1024); } while (0)
#define PG8_MMA(ai, bj, At, Bt) do { __builtin_amdgcn_s_setprio(1); _Pragma("unroll") for (int m = 0; m < 4; ++m) _Pragma("unroll") for (int n = 0; n < 2; ++n) { \
        if constexpr (FP8) { const v8i_ _b8 = cat8(Bt[n][0], Bt[n][1]), _a8 = cat8(At[m][0], At[m][1]);     \
            asm volatile("v_mfma_f32_16x16x128_f8f6f4 %0, %1, %2, %0" : "+v"(acc[ai][bj][m][n]) : "v"(_b8), "v"(_a8)); } \
        else { _Pragma("unroll") for (int k = 0; k < 2; ++k) acc[ai][bj][m][n] = __builtin_amdgcn_mfma_f32_16x16x32_bf16(Bt[n][k], At[m][k], acc[ai][bj][m][n], 0, 0, 0); } } __builtin_amdgcn_s_setprio(0); } while (0)
#define PG8_WAIT_V(n) asm volatile("s_waitcnt vmcnt(" #n ")" ::: "memory")
#define PG8_WAIT_L(n) asm volatile("s_waitcnt lgkmcnt(" #n ")" ::: "memory")
#define PG8_BAR __builtin_amdgcn_s_barrier()
#define PG8_SCHED __builtin_amdgcn_sched_barrier(0)
#define PG8_AOFF1(dst, u, _h, _i) do { int _R, _C; stage_rc(tid * 16 + (_i) * 8192, _R, _C); const int _row = GATHER ? S.row_of((u), (_h) * HALF + _R) : ((_h) * HALF + _R); (dst) = (unsigned)(_row * K + _C) * 2u; } while (0)
#define PG8_AOFFS(o0, o1, u) do { PG8_AOFF1((o0).i0, u, 0, 0); PG8_AOFF1((o0).i1, u, 0, 1); PG8_AOFF1((o1).i0, u, 1, 0); PG8_AOFF1((o1).i1, u, 1, 1); } while (0)
    Unit cur, nxt; int ui = 0;
    if (!S.next(0, cur)) return;
    f32x4 acc[2][2][4][2];
#pragma unroll
    for (int a = 0; a < 2; ++a)
#pragma unroll
        for (int b = 0; b < 2; ++b)
#pragma unroll
            for (int m = 0; m < 4; ++m)
#pragma unroll
                for (int n = 0; n < 2; ++n) acc[a][b][m][n] = (f32x4){0.f, 0.f, 0.f, 0.f};
    bf16x8 At[4][2], B0[2][2], B1[2][2];
    AO offA0, offA1, noffA0, noffA1;
    const char* cA = (const char*)g.A + (GATHER ? (size_t)0 : (size_t)cur.pm * tstep); const char* cB = (const char*)g.Bt + (size_t)cur.pb * tstep;
    S.a_ready(cur);
    PG8_AOFFS(offA0, offA1, cur); noffA0 = offA0; noffA1 = offA1;
    PG8_STAGE(PG8_SB(0, 0), cB, voffB); PG8_STAGE(PG8_SB(0, 1), cB + hstep, voffB); PG8_STAGE(PG8_SA(0, 0), cA, offA0); PG8_STAGE(PG8_SA(0, 1), cA, offA1);
    if (wr == 1) PG8_BAR;
    PG8_WAIT_V(2); PG8_BAR;
    PG8_STAGE(PG8_SB(1, 0), cB + kstep, voffB); PG8_STAGE(PG8_SA(1, 0), cA + kstep, offA0); PG8_STAGE(PG8_SB(1, 1), cB + hstep + kstep, voffB);
    PG8_WAIT_V(6); PG8_BAR;
    for (;;) {
        const bool has_next = S.next(ui + 1, nxt);
        const char* nA = has_next ? (const char*)g.A + (GATHER ? (size_t)0 : (size_t)nxt.pm * tstep) : cA; const char* nB = has_next ? (const char*)g.Bt + (size_t)nxt.pb * tstep : cB;
#pragma unroll 1
        for (int t = 0; t < nt; t += 2) {
            const bool last = (t == nt - 2);
            const char* a1 = cA + (size_t)(t + 1) * kstep;
            const char* a2 = last ? nA : cA + (size_t)(t + 2) * kstep; const char* b2 = last ? nB : cB + (size_t)(t + 2) * kstep;
            const char* a3 = a2 + kstep; const char* b3 = b2 + kstep;
            if (last && has_next) S.a_ready(nxt);
            AO o20, o21;
            if constexpr (GATHER) {
                if (last) { if (has_next) { PG8_AOFFS(noffA0, noffA1, nxt); } else { noffA0 = offA0; noffA1 = offA1; } }
                o20.i0 = last ? noffA0.i0 : offA0.i0; o20.i1 = last ? noffA0.i1 : offA0.i1; o21.i0 = last ? noffA1.i0 : offA1.i0; o21.i1 = last ? noffA1.i1 : offA1.i1;
            } else { o20 = offA0; o21 = offA1; }
            PG8_LDB(B0, 0, 0); PG8_LDB(B1, 0, 1); PG8_SCHED; PG8_LDA(At, 0, 0); PG8_STAGE(PG8_SA(1, 1), a1, offA1);
            PG8_WAIT_V(8); PG8_WAIT_L(0); PG8_BAR; PG8_MMA(0, 0, At, B0); PG8_MMA(0, 1, At, B1); PG8_BAR; PG8_SCHED;
            PG8_LDA(At, 0, 1); PG8_STAGE(PG8_SB(0, 0), b2, voffB); PG8_STAGE(PG8_SB(0, 1), b2 + hstep, voffB); PG8_STAGE(PG8_SA(0, 0), a2, o20);
            PG8_WAIT_V(8); PG8_WAIT_L(0); PG8_BAR; PG8_MMA(1, 0, At, B0); PG8_MMA(1, 1, At, B1); PG8_BAR; PG8_SCHED;
            PG8_LDB(B0, 1, 0); PG8_LDB(B1, 1, 1); PG8_SCHED; PG8_LDA(At, 1, 0); PG8_STAGE(PG8_SA(0, 1), a2, o21);
            PG8_WAIT_V(8); PG8_WAIT_L(0); PG8_BAR; PG8_MMA(0, 0, At, B0); PG8_MMA(0, 1, At, B1); PG8_BAR; PG8_SCHED;
            PG8_LDA(At, 1, 1); PG8_STAGE(PG8_SB(1, 0), b3, voffB); PG8_STAGE(PG8_SB(1, 1), b3 + hstep, voffB); PG8_STAGE(PG8_SA(1, 0), a3, o20);
            PG8_WAIT_V(8); PG8_WAIT_L(0); PG8_BAR; PG8_MMA(1, 0, At, B0); PG8_MMA(1, 1, At, B1); PG8_BAR; PG8_SCHED;
        }
        if (wr == 0) PG8_BAR;
        if constexpr (FP8) { PG8_SCHED; asm volatile("s_nop 7\n\ts_nop 7\n\ts_nop 3" ::: "memory"); PG8_SCHED; }
        E(acc, cur, wr, wc, fr, fq); S.done(cur);
        if (!has_next) break;
#pragma unroll
        for (int a = 0; a < 2; ++a)
#pragma unroll
            for (int b = 0; b < 2; ++b)
#pragma unroll
                for (int m = 0; m < 4; ++m)
#pragma unroll
                    for (int n = 0; n < 2; ++n) acc[a][b][m][n] = (f32x4){0.f, 0.f, 0.f, 0.f};
        cur = nxt; cA = nA; cB = nB; ++ui;
        if constexpr (GATHER) { offA0 = noffA0; offA1 = noffA1; }
        if (wr == 1) PG8_BAR;
    }
    PG8_WAIT_V(0);
    PG8_BAR;
#undef PG8_SA
#undef PG8_SB
#undef PG8_STAGE
#undef PG8_LDA
#undef PG8_LDB
#undef PG8_MMA
#undef PG8_WAIT_V
#undef PG8_WAIT_L
#undef PG8_BAR
#undef PG8_SCHED
#undef PG8_AOFFS
}
}
#define GAS __attribute__((address_space(1)))
#define LAS __attribute__((address_space(3)))
typedef unsigned short bf16;
typedef unsigned v4u __attribute__((ext_vector_type(4)));
typedef float f32x4 __attribute__((ext_vector_type(4)));
typedef short bf16x8 __attribute__((ext_vector_type(8)));
typedef GAS unsigned gu32;
typedef GAS unsigned long long gu64;
#define RLX_AGENT __ATOMIC_RELAXED, __HIP_MEMORY_SCOPE_AGENT
#define LDS_WAIT() asm volatile("s_waitcnt lgkmcnt(0)" ::: "memory")
#define VM_WAIT() asm volatile("s_waitcnt vmcnt(0)" ::: "memory")
__device__ __forceinline__ unsigned long long rt() { return __builtin_amdgcn_s_memrealtime(); }
__device__ __forceinline__ unsigned f2bf(float f) { unsigned u = __builtin_bit_cast(unsigned, f); return (u + 0x7fffu + ((u >> 16) & 1u)) >> 16; }
__device__ __forceinline__ unsigned pk2(float lo, float hi) { return f2bf(lo) | (f2bf(hi) << 16); }

#define XB_TMO      128
#define XB_XCNT(j)  (256  + 64 * (j))
#define XB_XSUB(j)  (1280 + 64 * (j))
#define XB_XGEN(j)  (2304 + 64 * (j))
#define XB_TOP      3328
#define XB_TOPGEN   3392
#define XCD_BAR_WORDS 3456
#define XB_SPIN_CAP (1u << 18)

__device__ __forceinline__ unsigned xb_ld(unsigned* p)              { return __hip_atomic_load(p, __ATOMIC_RELAXED, __HIP_MEMORY_SCOPE_AGENT); }
__device__ __forceinline__ unsigned xb_add(unsigned* p, unsigned v) { return __hip_atomic_fetch_add(p, v, __ATOMIC_RELAXED, __HIP_MEMORY_SCOPE_AGENT); }
__device__ __forceinline__ unsigned xb_xcc_id() { return (unsigned)__builtin_amdgcn_s_getreg((3 << 11) | 20) & 0xFu; }
#define XB_SPIN(cond, bar) do { unsigned _sp = 0; while (cond) { __builtin_amdgcn_s_sleep(1); \
    if ((++_sp & 255u) == 0u) { if (xb_ld(&(bar)[XB_TMO])) break; if (_sp > XB_SPIN_CAP) { atomicAdd(&(bar)[XB_TMO], 1u); break; } } } } while (0)

struct XcdBarrier {
    unsigned* bar; unsigned x;
    volatile LAS unsigned* st;
};

__device__ __forceinline__ XcdBarrier xcd_barrier_post(unsigned* bar, volatile LAS unsigned* st) {
    XcdBarrier b; b.bar = bar; b.x = xb_xcc_id(); b.st = st;
    if (threadIdx.x == 0) (void)xb_add(&bar[XB_XCNT(b.x)], 1u);
    return b;
}
__device__ __forceinline__ void xcd_barrier_complete(unsigned* bar, unsigned x, unsigned& nloc, unsigned& nx) {
    const unsigned G = gridDim.x * gridDim.y * gridDim.z;
    unsigned sum, cnt, mine, sp = 0u;
    for (;;) {
        sum = 0u; cnt = 0u; mine = 0u;
#pragma unroll
        for (unsigned j = 0; j < 16; ++j) { const unsigned c = xb_ld(&bar[XB_XCNT(j)]); sum += c; cnt += (c > 0u) ? 1u : 0u; mine = (j == x) ? c : mine; }
        if (sum == G) break;
        __builtin_amdgcn_s_sleep(1);
        if ((++sp & 255u) == 0u) { if (xb_ld(&bar[XB_TMO])) break; if (sp > XB_SPIN_CAP) { atomicAdd(&bar[XB_TMO], 1u); break; } }
    }
    nloc = mine > 0u ? mine : 1u; nx = cnt > 0u ? cnt : 1u;
}

__device__ __forceinline__ void xcd_barrier(const XcdBarrier& b) {
    asm volatile("s_waitcnt vmcnt(0)" ::: "memory");
    __syncthreads();
    if (threadIdx.x == 0) {
        unsigned* bar = b.bar;
        __builtin_amdgcn_s_waitcnt(0);
        unsigned nloc = b.st[0], nx = b.st[1];
        if (nloc == 0u) { xcd_barrier_complete(bar, b.x, nloc, nx); b.st[0] = nloc; b.st[1] = nx; }
        const unsigned old = xb_add(&bar[XB_XSUB(b.x)], 1u);
        const unsigned gen = old / nloc;
        if (old + 1u == (gen + 1u) * nloc) {
            __builtin_amdgcn_fence(__ATOMIC_RELEASE, "agent");
            asm volatile("s_waitcnt vmcnt(0)" ::: "memory");
            const unsigned og = xb_add(&bar[XB_TOP], 1u);
            const unsigned tg = og / nx;
            if (og + 1u == (tg + 1u) * nx) xb_add(&bar[XB_TOPGEN], 1u);
            else XB_SPIN(xb_ld(&bar[XB_TOPGEN]) == tg, bar);
            __builtin_amdgcn_fence(__ATOMIC_ACQUIRE, "agent");
            xb_add(&bar[XB_XGEN(b.x)], 1u);
            asm volatile("s_waitcnt vmcnt(0)" ::: "memory");
        } else {
            XB_SPIN(xb_ld(&bar[XB_XGEN(b.x)]) == gen, bar);
            __builtin_amdgcn_fence(__ATOMIC_ACQUIRE, "agent");
            asm volatile("s_waitcnt vmcnt(0)" ::: "memory");
        }
    }
    __syncthreads();
}


constexpr int NWAVES = 8, NT = NWAVES * 64;
constexpr int D = 1024, BATCH = 8, SEQ = 4096, DEPTH = 2, GRIDW = 64, CTXL = 256, GWID = 256, HD = 64, NHEAD = 4;
constexpr int INC = 2048, NEXP = 16, MHID = 512;
constexpr int NLAT = BATCH * SEQ, NCTX = BATCH * CTXL, NROW = NLAT + NCTX;
constexpr float EPS = 1e-6f;
constexpr int UC_AV = 0, UC_AB = 256, UC_AC = 512, UC_P = 768, UC_Q = 1024, UC_K = 1280, UC_V = 1536, UC_F = 1792;

constexpr size_t MiB = 1u << 20;
constexpr size_t WS_CTL = 0, CTL_ZERO_BYTES = 65536;
constexpr size_t WS_MOD  = 1 * MiB;
constexpr size_t WS_PWT  = 1 * MiB + 768 * 1024;
constexpr size_t WS_INFO = 2 * MiB;
constexpr size_t WS_BM   = 7 * MiB;
constexpr size_t WS_WIN  = 8 * MiB;
constexpr size_t WS_WOUT = 16 * MiB;
constexpr size_t WS_W13  = 20 * MiB;
constexpr size_t WS_W2   = 84 * MiB;
constexpr size_t WS_XC   = 116 * MiB;
constexpr size_t WS_H    = 124 * MiB;
constexpr size_t WS_U    = 192 * MiB;
constexpr size_t WS_S    = 328 * MiB;
constexpr size_t WS_END  = 472 * MiB;
constexpr size_t WS_KF   = WS_S;
constexpr size_t WS_VF   = WS_S + 28 * MiB;
constexpr size_t WS_KFC  = WS_S + 60 * MiB;
constexpr size_t WS_VFC  = WS_S + 61 * MiB;
constexpr size_t WS_Z    = WS_S + 64 * MiB;
constexpr size_t NZ = (size_t)BATCH * NHEAD * SEQ * HD;
constexpr size_t NZC = (size_t)BATCH * NHEAD * CTXL * HD;
constexpr int CAP = NROW;

constexpr int CW_CNT = 2048;
constexpr int CW_BAR = 4096;

constexpr int RING_OFF = 0, RING_BYTES = 131072;
constexpr int LDSCTL_OFF = RING_BYTES, MISC_OFF = LDSCTL_OFF + 320;
constexpr int TAB_OFF = RING_BYTES + 1024;
constexpr int LDS_BYTES = 147456;

struct Frame {
    LAS unsigned char* lds;
    volatile LAS unsigned* MISC;
    gu32* ctl;
    int tid, lane, wave, G, bid;
    float* out; unsigned char* ws;
    static __device__ __forceinline__ const void* karg(int off) {
        const __attribute__((address_space(4))) char* ka = (const __attribute__((address_space(4))) char*)__builtin_amdgcn_kernarg_segment_ptr();
        asm volatile("" : "+s"(ka));
        return *(const void* const __attribute__((address_space(4)))*)(ka + off);
    }
    __device__ __forceinline__ const float* inp(int i) const { return (const float*)karg(8 * i); }
};
extern __shared__ __attribute__((aligned(16))) unsigned char dyn_lds[];
__device__ __forceinline__ Frame mk_frame() {
    Frame F; int t_ = threadIdx.x; asm volatile("" : "+v"(t_));
    F.tid = t_; F.lane = F.tid & 63; F.wave = __builtin_amdgcn_readfirstlane(F.tid >> 6); F.G = gridDim.x; F.bid = blockIdx.x;
    F.lds = (LAS unsigned char*)dyn_lds; F.MISC = (volatile LAS unsigned*)(F.lds + MISC_OFF);
    F.out = (float*)Frame::karg(160); F.ws = (unsigned char*)Frame::karg(168); F.ctl = (gu32*)(F.ws + WS_CTL);
    return F;
}
enum { I_X = 0, I_C, I_CTX, I_CCTX, I_ADAW, I_ADAB, I_N1G, I_N2G, I_WIN, I_CONVW, I_POOLW, I_POOLS, I_RPB, I_WOUT, I_RW, I_RB, I_W1, I_W3, I_W2, I_FG };

__device__ __forceinline__ float wave_sum(float v) {
#pragma unroll
    for (int o = 1; o < 64; o <<= 1) v += __shfl_xor(v, o);
    return v;
}
__device__ __forceinline__ float bflo(unsigned w) { return __builtin_bit_cast(float, w << 16); }
__device__ __forceinline__ float bfhi(unsigned w) { return __builtin_bit_cast(float, w & 0xffff0000u); }
__device__ __forceinline__ float bf2f(bf16 b) { return __builtin_bit_cast(float, (unsigned)b << 16); }

__device__ __forceinline__ void tr_item(const float* W, int K, int N, bf16* WT, int k0, int n0, int drow0, LAS float* scr, int lane) {
#pragma unroll
    for (int i = 0; i < 8; ++i) { const int kk = 8 * i + (lane >> 3), n4 = 4 * (lane & 7); const f32x4 w = *(const GAS f32x4*)(W + (size_t)(k0 + kk) * N + n0 + n4);
        LAS float* sp = scr + kk * 33 + n4; sp[0] = w.x; sp[1] = w.y; sp[2] = w.z; sp[3] = w.w; }
    LDS_WAIT(); asm volatile("" ::: "memory");
    const int c = lane & 7;
#pragma unroll
    for (int j = 0; j < 4; ++j) { const int n = (lane >> 3) + 8 * j; const LAS float* s = scr + (8 * c) * 33 + n;
        v4u o; o.x = pk2(s[0 * 33], s[1 * 33]); o.y = pk2(s[2 * 33], s[3 * 33]); o.z = pk2(s[4 * 33], s[5 * 33]); o.w = pk2(s[6 * 33], s[7 * 33]);
        *(GAS v4u*)(WT + (size_t)(drow0 + n) * K + k0 + 8 * c) = o; }
    LDS_WAIT(); asm volatile("" ::: "memory");
}
__device__ __forceinline__ void tr_item8(const float* W, int K, int N, unsigned char* WT, int k0, int n0, int drow0, LAS float* scr, int lane) {
#pragma unroll
    for (int i = 0; i < 8; ++i) { const int kk = 8 * i + (lane >> 3), n4 = 4 * (lane & 7); const f32x4 w = *(const GAS f32x4*)(W + (size_t)(k0 + kk) * N + n0 + n4);
        LAS float* sp = scr + kk * 33 + n4; sp[0] = w.x; sp[1] = w.y; sp[2] = w.z; sp[3] = w.w; }
    LDS_WAIT(); asm volatile("" ::: "memory");
    const int c = lane & 7;
#pragma unroll
    for (int j = 0; j < 4; ++j) { const int n = (lane >> 3) + 8 * j; const LAS float* s = scr + (8 * c) * 33 + n; constexpr float f = pg8::F8_W;
        const unsigned long long o = (unsigned long long)pg8::cvt4_fp8(s[0 * 33] * f, s[1 * 33] * f, s[2 * 33] * f, s[3 * 33] * f) | ((unsigned long long)pg8::cvt4_fp8(s[4 * 33] * f, s[5 * 33] * f, s[6 * 33] * f, s[7 * 33] * f) << 32);
        *(GAS unsigned long long*)(WT + (size_t)(drow0 + n) * K + k0 + 8 * c) = o; }
    LDS_WAIT(); asm volatile("" ::: "memory");
}
__device__ __forceinline__ void bias_table(Frame& F, int l);
__device__ __forceinline__ void pa_phase() { Frame F = mk_frame();
    bias_table(F, 0); bias_table(F, 1);
    LAS float* scr = (LAS float*)(F.lds + RING_OFF + F.wave * 16384);
    const int gw = F.bid * NWAVES + F.wave, NGW = F.G * NWAVES;
    bf16* WIN = (bf16*)(F.ws + WS_WIN); bf16* WOUT = (bf16*)(F.ws + WS_WOUT); unsigned char* W13 = F.ws + WS_W13; unsigned char* W2 = F.ws + WS_W2;
    constexpr int I_IN = 2 * 16 * 64, I_OUT = 2 * 16 * 32, I_1 = 32 * 16 * 16, I_2 = 32 * 8 * 32;
    constexpr int NITEMS = I_IN + I_OUT + 2 * I_1 + I_2;
    const bool bal = (F.G == 256); const int nstr = bal ? 13 * NGW : NITEMS;
    for (int k = 0; ; ++k) {
        int it;
        if (k * NGW + gw < nstr) it = k * NGW + gw;
        else { if (!bal || F.bid < 192) break; const int k2 = k - 13; if (k2 >= 2) break; it = nstr + k2 * 512 + (gw - 192 * NWAVES); if (it >= NITEMS) break; }
        int r = it;
        if (r < I_IN) { const int l = r / 1024, q = r % 1024, kb = q / 64, nb = q % 64;
            tr_item(F.inp(I_WIN) + (size_t)l * D * INC, D, INC, WIN + (size_t)l * INC * D, 64 * kb, 32 * nb, 32 * nb, scr, F.lane); continue; } r -= I_IN;
        if (r < I_OUT) { const int l = r / 512, q = r % 512, kb = q / 32, nb = q % 32;
            tr_item(F.inp(I_WOUT) + (size_t)l * D * D, D, D, WOUT + (size_t)l * D * D, 64 * kb, 32 * nb, 32 * nb, scr, F.lane); continue; } r -= I_OUT;
        if (r < 2 * I_1) { const int which = r / I_1; const int q0 = r % I_1; const int le = q0 / 256, q = q0 % 256, kb = q / 16, nb = q % 16;
            const int n0 = 32 * nb; const int drow0 = 256 * (n0 / 128) + 128 * which + (n0 % 128);
            tr_item8(F.inp(which ? I_W3 : I_W1) + (size_t)le * D * MHID, D, MHID, W13 + (size_t)le * 1024 * D, 64 * kb, n0, drow0, scr, F.lane); continue; } r -= 2 * I_1;
        { const int le = r / 256, q = r % 256, kb = q / 32, nb = q % 32;
            tr_item8(F.inp(I_W2) + (size_t)le * MHID * D, MHID, D, W2 + (size_t)le * D * MHID, 64 * kb, 32 * nb, 32 * nb, scr, F.lane); }
    }
    { bf16* PWT = (bf16*)(F.ws + WS_PWT); const float* pw = F.inp(I_POOLW);
      for (int i = F.bid * NT + F.tid; i < 2 * 4 * 64 * 64; i += F.G * NT) { const int c = i & 63, dd = (i >> 6) & 63, lg = i >> 12; PWT[i] = (bf16)f2bf(pw[((size_t)lg * 64 + c) * 64 + dd]); } }
    __syncthreads();
    LAS float* sc = (LAS float*)(F.lds + RING_OFF);
    LAS float* part = (LAS float*)(F.lds + RING_OFF + 40960);
    float* MOD = (float*)(F.ws + WS_MOD);
    bool have_sc = false;
    for (int it = F.bid; it < 2 * 96; it += F.G) {
        if (!have_sc) { for (int i = F.tid; i < 9 * 1024; i += NT) { const float v = i < 8192 ? F.inp(I_C)[i] : F.inp(I_CCTX)[i - 8192]; sc[i] = v / (1.0f + __expf(-v)); } have_sc = true; }
        __syncthreads();
        const int l = it / 96, cb = it % 96, col = cb * 64 + F.lane;
        const float* aw = F.inp(I_ADAW) + (size_t)l * D * 6144 + col;
        float acc[9];
#pragma unroll
        for (int r = 0; r < 9; ++r) acc[r] = 0.f;
        for (int k0 = F.wave * 128; k0 < F.wave * 128 + 128; k0 += 16) { float wv[16];
#pragma unroll
            for (int kk = 0; kk < 16; ++kk) wv[kk] = aw[(size_t)(k0 + kk) * 6144];
#pragma unroll
            for (int kk = 0; kk < 16; ++kk)
#pragma unroll
                for (int r = 0; r < 9; ++r) acc[r] += sc[r * 1024 + k0 + kk] * wv[kk]; }
#pragma unroll
        for (int r = 0; r < 9; ++r) part[(F.wave * 9 + r) * 64 + F.lane] = acc[r];
        __syncthreads();
        for (int i = F.tid; i < 9 * 64; i += NT) { const int r = i >> 6, ln = i & 63; float s = F.inp(I_ADAB)[(size_t)l * 6144 + cb * 64 + ln];
#pragma unroll
            for (int w = 0; w < 8; ++w) s += part[(w * 9 + r) * 64 + ln];
            MOD[((size_t)l * 9 + r) * 6144 + cb * 64 + ln] = s; }
        __syncthreads();
    }
}

typedef unsigned v2u_ __attribute__((ext_vector_type(2)));
__device__ __forceinline__ unsigned cvt_pk_bf(float lo, float hi) { unsigned r; asm volatile("v_cvt_pk_bf16_f32 %0, %1, %2" : "=v"(r) : "v"(lo), "v"(hi)); return r; }
struct XStream { const char* lat; const char* ctx; int lat_stride, ctx_stride;
    __device__ __forceinline__ const char* row(int r) const { return r < NLAT ? lat + (size_t)r * lat_stride : ctx + (size_t)(r - NLAT) * ctx_stride; } };
struct RowIn { f32x4 x[4]; v4u xb[2], ya[2], yb[2]; };
__device__ __forceinline__ f32x4 unpk_h(v4u a, int h) { const unsigned w0 = h ? a.z : a.x, w1 = h ? a.w : a.y; f32x4 y; y.x = bflo(w0); y.y = bfhi(w0); y.z = bflo(w1); y.w = bfhi(w1); return y; }
template <int ADD, bool XBF>
__device__ __forceinline__ void row_load(Frame& F, int r, const char* xr, const bf16* Y2, RowIn& in) {
#pragma unroll
    for (int j = 0; j < 2; ++j) { const int c = 8 * F.lane + 512 * j;
        if (XBF) in.xb[j] = __builtin_nontemporal_load((const GAS v4u*)(xr + 2 * c)); else { in.x[2 * j] = __builtin_nontemporal_load((const GAS f32x4*)(xr + 4 * c)); in.x[2 * j + 1] = __builtin_nontemporal_load((const GAS f32x4*)(xr + 4 * c + 16)); }
        if (ADD == 1) { in.ya[j] = __builtin_nontemporal_load((const GAS v4u*)(Y2 + (size_t)r * 2048 + c)); in.yb[j] = __builtin_nontemporal_load((const GAS v4u*)(Y2 + (size_t)r * 2048 + 1024 + c)); }
        if (ADD == 2) { in.ya[j] = __builtin_nontemporal_load((const GAS v4u*)(Y2 + (size_t)r * 1024 + c)); } }
}
struct RowPar { f32x4 a[4], b[4], gt[4]; int modrow; };
template <int ADD, bool FINAL>
__device__ __forceinline__ void row_params(Frame& F, int modrow, const float* g, const float* modl, const float* modadd, int ch_sh, int ch_sc, RowPar& P) {
    P.modrow = modrow;
#pragma unroll
    for (int k = 0; k < 4; ++k) { const int c = 8 * F.lane + 512 * (k >> 1) + 4 * (k & 1); const f32x4 gv = *(const GAS f32x4*)(g + c);
        if (FINAL) { P.a[k] = gv; P.b[k] = (f32x4){0.f, 0.f, 0.f, 0.f}; }
        else { const float* mrow = modl + (size_t)modrow * 6144; P.a[k] = gv * (*(const GAS f32x4*)(mrow + ch_sc * 1024 + c) + 1.0f); P.b[k] = *(const GAS f32x4*)(mrow + ch_sh * 1024 + c); }
        if (ADD) P.gt[k] = *(const GAS f32x4*)(modadd + (size_t)modrow * 6144 + (ADD == 1 ? 5 : 2) * 1024 + c); else P.gt[k] = (f32x4){0.f, 0.f, 0.f, 0.f}; }
#pragma unroll
    for (int k = 0; k < 4; ++k) asm volatile("" : "+v"(P.a[k]), "+v"(P.b[k]), "+v"(P.gt[k]));
}
__device__ __forceinline__ v4u pk8_bf(const f32x4 a, const f32x4 b) { v4u w; w.x = cvt_pk_bf(a.x, a.y); w.y = cvt_pk_bf(a.z, a.w); w.z = cvt_pk_bf(b.x, b.y); w.w = cvt_pk_bf(b.z, b.w); return w; }
template <int ADD, bool FINAL, bool XBF, bool DST8 = false>
__device__ __forceinline__ void row_finish(Frame& F, const RowIn& in, const RowPar& P, char* xw, bf16* dst, float* fout, f32x4 (&v)[4]) {
    float ss = 0.f;
#pragma unroll
    for (int j = 0; j < 2; ++j) { const int c = 8 * F.lane + 512 * j;
#pragma unroll
        for (int h = 0; h < 2; ++h) { const int k = 2 * j + h; v[k] = XBF ? unpk_h(in.xb[j], h) : in.x[k];
            if (ADD) { f32x4 ya = unpk_h(in.ya[j], h); if (ADD == 1) ya = ya + unpk_h(in.yb[j], h);
                v[k] = v[k] + P.gt[k] * ya; }
            ss += (v[k].x * v[k].x + v[k].y * v[k].y) + (v[k].z * v[k].z + v[k].w * v[k].w); }
        if (ADD && !FINAL) *(GAS v4u*)(xw + 2 * c) = pk8_bf(v[2 * j], v[2 * j + 1]); }
    ss = wave_sum(ss);
    const float rstd = 1.0f / sqrtf(ss * (1.0f / D) + EPS);
#pragma unroll
    for (int j = 0; j < 2; ++j) { const int c = 8 * F.lane + 512 * j;
        if (FINAL) { *(GAS f32x4*)(fout + c) = v[2 * j] * rstd * P.a[2 * j]; *(GAS f32x4*)(fout + c + 4) = v[2 * j + 1] * rstd * P.a[2 * j + 1]; }
        else { v[2 * j] = v[2 * j] * rstd * P.a[2 * j] + P.b[2 * j]; v[2 * j + 1] = v[2 * j + 1] * rstd * P.a[2 * j + 1] + P.b[2 * j + 1];
            if (DST8) { const f32x4 s0 = v[2 * j] * pg8::F8_ACT, s1 = v[2 * j + 1] * pg8::F8_ACT;
                *(GAS v2u_*)((char*)dst + c) = (v2u_){pg8::cvt4_fp8(s0.x, s0.y, s0.z, s0.w), pg8::cvt4_fp8(s1.x, s1.y, s1.z, s1.w)}; }
            else *(GAS v4u*)(dst + c) = pk8_bf(v[2 * j], v[2 * j + 1]); } }
}
template <int ADD, bool FINAL, bool XBF>
__device__ __forceinline__ void norm_phase(Frame& F, const XStream xin, const XStream xout, int nrows, const float* g, const float* modl, const float* modadd, int ch_sh, int ch_sc, bf16* dst, const bf16* Y2, float* fout) {
    const int rpb = (nrows + F.G - 1) / F.G;
    int i = F.wave; int r = F.bid * rpb + i; if (i >= rpb || r >= nrows) return;
    RowPar P; P.modrow = -1;
    const int last_i = (rpb - 1 < nrows - 1 - F.bid * rpb) ? rpb - 1 : nrows - 1 - F.bid * rpb;
    auto rowof = [&](int ii) { return F.bid * rpb + (ii <= last_i ? ii : i); };
    RowIn ra, rb, rc;
    row_load<ADD, XBF>(F, r, xin.row(r), Y2, ra);
    { const int r1 = rowof(i + NWAVES); row_load<ADD, XBF>(F, r1, xin.row(r1), Y2, rb); }
    auto step = [&](RowIn& cur, RowIn& fill) __attribute__((always_inline)) {
        const int rr = F.bid * rpb + i;
        const int modrow = rr < NLAT ? (rr >> 12) : 8;
        if (modrow != P.modrow) row_params<ADD, FINAL>(F, modrow, g, modl, modadd, ch_sh, ch_sc, P);
        const int r2 = rowof(i + 2 * NWAVES);
        row_load<ADD, XBF>(F, r2, xin.row(r2), Y2, fill);
        f32x4 v[4];
        row_finish<ADD, FINAL, XBF>(F, cur, P, (char*)xout.row(rr), dst + (size_t)rr * D, fout + (size_t)rr * D, v);
    };
    for (;;) {
        step(ra, rc); i += NWAVES; if (i > last_i) break;
        step(rb, ra); i += NWAVES; if (i > last_i) break;
        step(rc, rb); i += NWAVES; if (i > last_i) break;
    }
}
template <bool XBF>
__device__ __forceinline__ void route_phase(Frame& F, int l, const XStream xin, const XStream xout, const bf16* O, int nrows, const float* g, const float* modl, bf16* dst, uint2* info, unsigned* cnt) {
    LAS int* lcnt = (LAS int*)(F.lds + TAB_OFF); LAS int* lbase = lcnt + 16; LAS int* rec_e = lcnt + 32; LAS int* rec_p = rec_e + 512; LAS float* rec_w = (LAS float*)(rec_p + 512);
    const int rpb = (nrows + F.G - 1) / F.G;
    if (F.tid < 16) lcnt[F.tid] = 0;
    constexpr int RPITCH = 2064;
    LAS float* LG = (LAS float*)(F.lds + RING_OFF);
    LAS unsigned char* WTb = F.lds + RING_OFF + 17408;
    LAS unsigned char* RB = F.lds + RING_OFF + 17408 + 16 * RPITCH + F.wave * (4 * RPITCH);
    { const float* rwp = F.inp(I_RW); for (int i = F.tid; i < 1024 * 16; i += NT) { const int k = i >> 4, e = i & 15; *(LAS unsigned short*)(WTb + e * RPITCH + 2 * k) = (unsigned short)f2bf(rwp[i]); } }
    __syncthreads();
    const float* rbp = F.inp(I_RB);
    RowPar P; P.modrow = -1; int slot = 0, i0 = 0;
    RowIn cur; bool have = (F.wave < rpb) && (F.bid * rpb + F.wave < nrows);
    if (have) { const int r = F.bid * rpb + F.wave; row_load<2, XBF>(F, r, xin.row(r), O, cur); }
    for (int i = F.wave; have; i += NWAVES) {
        const int r = F.bid * rpb + i;
        const int in_ = i + NWAVES, rn = F.bid * rpb + in_; const bool more = (in_ < rpb) && (rn < nrows);
        RowIn nxt;
        if (more) row_load<2, XBF>(F, rn, xin.row(rn), O, nxt);
        f32x4 v[4];
        { const int modrow = r < NLAT ? (r >> 12) : 8; if (modrow != P.modrow) row_params<2, false>(F, modrow, g, modl, modl, 3, 4, P); }
        row_finish<2, false, XBF, true>(F, cur, P, (char*)xout.row(r), (bf16*)((char*)dst + (size_t)r * D), nullptr, v);
        { LAS unsigned char* rb = RB + slot * RPITCH + 16 * F.lane;
#pragma unroll
          for (int j = 0; j < 2; ++j) *(LAS v4u*)(rb + 1024 * j) = pk8_bf(v[2 * j], v[2 * j + 1]); }
        if (slot == 0) i0 = i;
        ++slot;
        if (slot == 4 || !more) {
            LDS_WAIT(); asm volatile("" ::: "memory");
            const int q = F.lane & 15, g = F.lane >> 4;
            const LAS unsigned char* ap = RB + (q & 3) * RPITCH + 16 * g; const LAS unsigned char* bp = WTb + q * RPITCH + 16 * g;
            f32x4 lacc[4];
#pragma unroll
            for (int c = 0; c < 4; ++c) lacc[c] = (f32x4){0.f, 0.f, 0.f, 0.f};
#pragma unroll
            for (int ks = 0; ks < 32; ++ks) lacc[ks & 3] = __builtin_amdgcn_mfma_f32_16x16x32_bf16(*(const LAS bf16x8*)(ap + 64 * ks), *(const LAS bf16x8*)(bp + 64 * ks), lacc[ks & 3], 0, 0, 0);
            const f32x4 lg = (lacc[0] + lacc[1]) + (lacc[2] + lacc[3]);
            if (F.lane < 16) {
#pragma unroll
                for (int k = 0; k < 4; ++k) if (k < slot) LG[(i0 + 8 * k) * 17 + F.lane] = lg[k]; }
            LDS_WAIT(); asm volatile("" ::: "memory");
            slot = 0;
        }
        have = more; cur = nxt;
    }
    __syncthreads();
    for (int i = F.tid; i < rpb; i += NT) { if (F.bid * rpb + i >= nrows) break;
        float s16[16], bs[16];
#pragma unroll
        for (int e = 0; e < 16; ++e) { s16[e] = 1.0f / (1.0f + expf(-LG[i * 17 + e])); bs[e] = s16[e] + rbp[e]; }
        float best = -3.0e38f; int bg = 0;
#pragma unroll
        for (int gq = 0; gq < 4; ++gq) { const float a0 = bs[4 * gq], a1 = bs[4 * gq + 1], a2 = bs[4 * gq + 2], a3 = bs[4 * gq + 3];
            const float gs = fmaxf(fmaxf(fmaxf(a0 + a1, a0 + a2), fmaxf(a0 + a3, a1 + a2)), fmaxf(a1 + a3, a2 + a3));
            if (gs > best) { best = gs; bg = gq; } }
        float cb[4], cs[4];
#pragma unroll
        for (int ii = 0; ii < 4; ++ii) { cb[ii] = 0.f; cs[ii] = 0.f; }
#pragma unroll
        for (int gq = 0; gq < 4; ++gq)
#pragma unroll
            for (int ii = 0; ii < 4; ++ii) { cb[ii] = (gq == bg) ? bs[4 * gq + ii] : cb[ii]; cs[ii] = (gq == bg) ? s16[4 * gq + ii] : cs[ii]; }
        int i1 = 0; float b1 = cb[0], s1 = cs[0];
#pragma unroll
        for (int ii = 1; ii < 4; ++ii) if (cb[ii] > b1) { b1 = cb[ii]; s1 = cs[ii]; i1 = ii; }
        int i2 = -1; float b2 = -3.0e38f, s2 = 0.f;
#pragma unroll
        for (int ii = 0; ii < 4; ++ii) if (ii != i1 && cb[ii] > b2) { b2 = cb[ii]; s2 = cs[ii]; i2 = ii; }
        const float inv = 1.0f / (s1 + s2);
        const int e1 = 4 * bg + i1, e2 = 4 * bg + i2;
        rec_e[2 * i] = e1; rec_p[2 * i] = atomicAdd((int*)&lcnt[e1], 1); rec_w[2 * i] = s1 * inv;
        rec_e[2 * i + 1] = e2; rec_p[2 * i + 1] = atomicAdd((int*)&lcnt[e2], 1); rec_w[2 * i + 1] = s2 * inv;
    }
    __syncthreads();
    if (F.tid < 16) lbase[F.tid] = (int)__hip_atomic_fetch_add(cnt + F.tid, (unsigned)lcnt[F.tid], __ATOMIC_RELAXED, __HIP_MEMORY_SCOPE_AGENT);
    __syncthreads();
    for (int j = F.tid; j < 2 * rpb; j += NT) { const int r = F.bid * rpb + (j >> 1); if (r < nrows) { const int e = rec_e[j];
        info[(size_t)e * CAP + lbase[e] + rec_p[j]] = make_uint2((unsigned)(r * 2 + (j & 1)), __builtin_bit_cast(unsigned, rec_w[j])); } }
}
__device__ __forceinline__ void moe_table(Frame& F, int l) {
    LAS int* tab = (LAS int*)(F.lds + TAB_OFF);
    if (F.tid < 64) {
        const unsigned* cnt = (const unsigned*)(F.ctl + CW_CNT + l * 16);
        const int n = F.tid < 16 ? (int)__hip_atomic_load(cnt + F.tid, __ATOMIC_RELAXED, __HIP_MEMORY_SCOPE_AGENT) : 0;
        const int np = (n + 255) >> 8; int x = np;
#pragma unroll
        for (int d = 1; d < 16; d <<= 1) { const int y = __shfl_up(x, d); if (F.lane >= d) x += y; }
        if (F.tid < 16) { tab[F.tid] = x - np; tab[17 + F.tid] = n; }
        if (F.tid == 15) tab[16] = x;
    }
    __syncthreads();
}

__device__ __forceinline__ void seq_info(int r, int& base, int& t, int& L) {
    if (r < NLAT) { base = r & ~(SEQ - 1); t = r & (SEQ - 1); L = SEQ; } else { const int j = r - NLAT; base = NLAT + (j & ~(CTXL - 1)); t = j & (CTXL - 1); L = CTXL; }
}
typedef unsigned v2u __attribute__((ext_vector_type(2)));
__device__ __forceinline__ unsigned cvtpk(float lo, float hi) { unsigned r; asm volatile("v_cvt_pk_bf16_f32 %0, %1, %2" : "=v"(r) : "v"(lo), "v"(hi)); return r; }
__device__ __forceinline__ bf16x8 mk8(v2u a, v2u b) { v4u w; w.x = a.x; w.y = a.y; w.z = b.x; w.w = b.y; return __builtin_bit_cast(bf16x8, w); }
constexpr float A8_S = 16.0f;
__device__ __forceinline__ v2u bf8_to_fp8(v4u w) {
    v2u r; r.x = pg8::cvt4_fp8(bflo(w.x) * A8_S, bfhi(w.x) * A8_S, bflo(w.y) * A8_S, bfhi(w.y) * A8_S); r.y = pg8::cvt4_fp8(bflo(w.z) * A8_S, bfhi(w.z) * A8_S, bflo(w.w) * A8_S, bfhi(w.w) * A8_S); return r; }
template <bool LAT>
__device__ __forceinline__ void kv_unit(Frame& F, int bh, int rq, LAS unsigned short* T) {
    const bf16* U = (const bf16*)(F.ws + WS_U);
    const int q = F.lane & 15, g = F.lane >> 4, h = bh & 3;
    const int urow0 = LAT ? ((bh >> 2) * SEQ + rq * 64) : (NLAT + (bh >> 2) * CTXL + rq * 64);
    unsigned char* kdst = LAT ? F.ws + WS_KF + ((size_t)(bh * 64 + rq) * 7) * 1024 : F.ws + WS_KFC + ((size_t)(bh * 16 + rq * 4)) * 1024;
    unsigned char* vdst = LAT ? F.ws + WS_VF + ((size_t)(bh * 64 + rq) * 8) * 1024 : F.ws + WS_VFC + ((size_t)(bh * 8 + rq * 2) * 2) * 1024;
    { const bf16* src = U + (size_t)(urow0 + F.lane) * INC + UC_V + h * HD;
      v4u vw[8];
#pragma unroll
      for (int p = 0; p < 8; ++p) vw[p] = *(const GAS v4u*)(src + 8 * p);
#pragma unroll
      for (int p = 0; p < 8; ++p) { const v4u w = vw[p]; LAS unsigned short* tp = T + (8 * p) * 72 + F.lane;
          tp[0 * 72] = (unsigned short)w.x; tp[1 * 72] = (unsigned short)(w.x >> 16); tp[2 * 72] = (unsigned short)w.y; tp[3 * 72] = (unsigned short)(w.y >> 16);
          tp[4 * 72] = (unsigned short)w.z; tp[5 * 72] = (unsigned short)(w.z >> 16); tp[6 * 72] = (unsigned short)w.w; tp[7 * 72] = (unsigned short)(w.w >> 16); } }
    constexpr int NK = LAT ? 7 : 4, KST = LAT ? 8 : 16;
    { v4u kw[NK][2];
#pragma unroll
      for (int sidx = 0; sidx < NK; ++sidx)
#pragma unroll
          for (int ks = 0; ks < 2; ++ks) kw[sidx][ks] = *(const GAS v4u*)(U + (size_t)(urow0 + KST * sidx + q) * INC + UC_K + h * HD + 32 * ks + 8 * g);
      __builtin_amdgcn_sched_barrier(0);
#pragma unroll
      for (int sidx = 0; sidx < NK; ++sidx) { const v2u a = bf8_to_fp8(kw[sidx][0]), b = bf8_to_fp8(kw[sidx][1]); v4u o; o.x = a.x; o.y = a.y; o.z = b.x; o.w = b.y;
          *(GAS v4u*)(kdst + (size_t)sidx * 1024 + F.lane * 16) = o; } }
    LDS_WAIT(); asm volatile("" ::: "memory");
    constexpr int NV = LAT ? 4 : 2;
#pragma unroll
    for (int w = 0; w < NV; ++w) { const int vst = LAT ? (w == 0 ? 0 : (w == 1 ? 8 : (w == 2 ? 24 : 32))) : 32 * w;
#pragma unroll
        for (int dtp = 0; dtp < 2; ++dtp) { v4u o;
#pragma unroll
            for (int e = 0; e < 2; ++e) { const int dt = 2 * dtp + e; const LAS unsigned short* tp = T + (16 * dt + q) * 72 + vst + 4 * g; const v2u lo = *(const LAS v2u*)tp, hi = *(const LAS v2u*)(tp + 16);
                v4u w8; w8.x = lo.x; w8.y = lo.y; w8.z = hi.x; w8.w = hi.y; const v2u c = bf8_to_fp8(w8); if (e == 0) { o.x = c.x; o.y = c.y; } else { o.z = c.x; o.w = c.y; } }
            *(GAS v4u*)(vdst + (size_t)(w * 2 + dtp) * 1024 + F.lane * 16) = o; } }
    LDS_WAIT(); asm volatile("" ::: "memory");
}
__device__ __forceinline__ void kv_prepass(Frame& F) {
    LAS unsigned short* T = (LAS unsigned short*)(F.lds + RING_OFF + F.wave * 16384);
    const int gw = F.bid * NWAVES + F.wave, NGW = F.G * NWAVES;
#pragma unroll 1
    for (int idx = gw; idx < 2048; idx += NGW) kv_unit<true>(F, idx >> 6, idx & 63, T);
#pragma unroll 1
    for (int idx = (gw + NGW - (32 * NWAVES) % NGW) % NGW; idx < 128; idx += NGW) kv_unit<false>(F, idx >> 2, idx & 3, T);
}
__device__ __forceinline__ void bias_table(Frame& F, int l) {
    bf16* BM = (bf16*)(F.ws + WS_BM) + (size_t)l * 245760; const float* rp = F.inp(I_RPB) + (size_t)l * NHEAD * 15 * 31;
    for (int i = F.bid * NT + F.tid; i < 4 * 4 * 15 * 64 * 8; i += F.G * NT) {
        const int e = i & 7, lane = (i >> 3) & 63, rrel = (i >> 9) % 15, hc = (i >> 9) / 15, cb = hc & 3, h = hc >> 2;
        const int q = lane & 15, g = lane >> 4, seg = e >> 2, ii = e & 3;
        const int wb = cb * 16 - 8 < 0 ? 0 : (cb * 16 - 8 > 32 ? 32 : cb * 16 - 8);
        const int cq = cb * 16 + q, c0 = cq - 8 < 0 ? 0 : (cq - 8 > 48 ? 48 : cq - 8), cc = wb + seg * 16 + 4 * g + ii;
        const bool ok = (cc >= c0) && (cc < c0 + 16);
        BM[i] = (bf16)f2bf(ok ? rp[(h * 15 + rrel) * 31 + (cc - cq + 15)] : -3.0e38f);
    }
}
template <bool LAT>
__device__ __forceinline__ void attn_unit(Frame& F, int l, int b, int h, int r, int cb, const LAS float* rpbs) {
    const bf16* U = (const bf16*)(F.ws + WS_U); bf16* Y = (bf16*)(F.ws + WS_H);
    const unsigned char* KF = F.ws + WS_KF; const unsigned char* VF = F.ws + WS_VF; const unsigned char* KFC = F.ws + WS_KFC; const unsigned char* VFC = F.ws + WS_VFC;
    const size_t bh = (size_t)(b * NHEAD + h);
    const int q = F.lane & 15, g = F.lane >> 4;
    constexpr int NT_ = LAT ? 32 : 16, NB = LAT ? 16 : 0;
    const int qrow = LAT ? (b * SEQ + r * GRIDW + cb * 16 + q) : (NLAT + b * CTXL + cb * 16 + q);
    const int r0 = r - 4 < 0 ? 0 : (r - 4 > 56 ? 56 : r - 4);
    const int wb = cb * 16 - 8 < 0 ? 0 : (cb * 16 - 8 > 32 ? 32 : cb * 16 - 8);
    long qf[2];
#pragma unroll
    for (int ks = 0; ks < 2; ++ks) { const v2u c = bf8_to_fp8(*(const GAS v4u*)(U + (size_t)qrow * INC + UC_Q + h * HD + 32 * ks + 8 * g)); qf[ks] = (long)(((unsigned long long)c.y << 32) | c.x); }
    f32x4 s[NT_];
#pragma unroll
    for (int t = 0; t < NT_; ++t) {
        const unsigned char* kp;
        if (t < NB) { const int kr = t >> 1, seg = t & 1; kp = KF + ((bh * 64 + (r0 + kr)) * 7 + ((wb >> 3) + 2 * seg)) * 1024 + F.lane * 16; } else kp = KFC + (bh * 16 + (t - NB)) * 1024 + F.lane * 16;
        const v4u kk2 = *(const GAS v4u*)kp;
        f32x4 a = (f32x4){0.f, 0.f, 0.f, 0.f};
        a = __builtin_amdgcn_mfma_f32_16x16x32_fp8_fp8((long)(((unsigned long long)kk2.y << 32) | kk2.x), qf[0], a, 0, 0, 0);
        s[t] = __builtin_amdgcn_mfma_f32_16x16x32_fp8_fp8((long)(((unsigned long long)kk2.w << 32) | kk2.z), qf[1], a, 0, 0, 0);
    }
    constexpr float SC = 0.125f / (A8_S * A8_S);
    float m = -3.0e38f;
    if (LAT) {
        const bf16* bm = (const bf16*)(F.ws + WS_BM) + (size_t)l * 245760 + ((size_t)((h * 4 + cb) * 15 + (r0 - r + 7)) * 64 + F.lane) * 8;
#pragma unroll
        for (int kr = 0; kr < 8; ++kr) { const v4u bw = *(const GAS v4u*)(bm + kr * 512);
            const f32x4 b0 = (f32x4){bflo(bw.x), bfhi(bw.x), bflo(bw.y), bfhi(bw.y)}, b1 = (f32x4){bflo(bw.z), bfhi(bw.z), bflo(bw.w), bfhi(bw.w)};
#pragma unroll
            for (int i = 0; i < 4; ++i) { const float v0 = s[2 * kr][i] * SC + b0[i], v1 = s[2 * kr + 1][i] * SC + b1[i]; s[2 * kr][i] = v0; s[2 * kr + 1][i] = v1; m = fmaxf(m, fmaxf(v0, v1)); } }
    }
#pragma unroll
    for (int t = NB; t < NT_; ++t)
#pragma unroll
        for (int i = 0; i < 4; ++i) { const float v = s[t][i] * SC; s[t][i] = v; m = fmaxf(m, v); }
    m = fmaxf(m, __shfl_xor(m, 16)); m = fmaxf(m, __shfl_xor(m, 32));
    m -= 5.545177444f;
    float sum = 0.f;
#pragma unroll
    for (int t = 0; t < NT_; ++t)
#pragma unroll
        for (int i = 0; i < 4; ++i) { const float p = __expf(s[t][i] - m); s[t][i] = p; sum += p; }
    sum += __shfl_xor(sum, 16); sum += __shfl_xor(sum, 32);
    f32x4 o[4];
#pragma unroll
    for (int dt = 0; dt < 4; ++dt) o[dt] = (f32x4){0.f, 0.f, 0.f, 0.f};
#pragma unroll
    for (int kk = 0; kk < NT_ / 2; ++kk) {
        const unsigned plo = pg8::cvt4_fp8(s[2 * kk][0], s[2 * kk][1], s[2 * kk][2], s[2 * kk][3]), phi = pg8::cvt4_fp8(s[2 * kk + 1][0], s[2 * kk + 1][1], s[2 * kk + 1][2], s[2 * kk + 1][3]);
        const long pf = (long)(((unsigned long long)phi << 32) | plo);
        const unsigned char* vbase;
        if (2 * kk < NB) vbase = VF + (((bh * 64 + (r0 + kk)) * 4 + cb) * 2) * 1024 + F.lane * 16; else vbase = VFC + ((bh * 8 + (kk - NB / 2)) * 2) * 1024 + F.lane * 16;
#pragma unroll
        for (int dtp = 0; dtp < 2; ++dtp) { const v4u vv = *(const GAS v4u*)(vbase + dtp * 1024);
            o[2 * dtp] = __builtin_amdgcn_mfma_f32_16x16x32_fp8_fp8((long)(((unsigned long long)vv.y << 32) | vv.x), pf, o[2 * dtp], 0, 0, 0);
            o[2 * dtp + 1] = __builtin_amdgcn_mfma_f32_16x16x32_fp8_fp8((long)(((unsigned long long)vv.w << 32) | vv.z), pf, o[2 * dtp + 1], 0, 0, 0); }
    }
    const float inv = 1.0f / (sum * A8_S); bf16* yp = Y + (size_t)qrow * D + 512 + h * HD + 4 * g;
#pragma unroll
    for (int dt = 0; dt < 4; ++dt) { v2u w; w.x = cvtpk(o[dt][0] * inv, o[dt][1] * inv); w.y = cvtpk(o[dt][2] * inv, o[dt][3] * inv); *(GAS v2u*)(yp + dt * 16) = w; }
}
__device__ __forceinline__ void attn_phase(Frame& F, int l, bool with_ctx) {
    const LAS float* rpbs = nullptr;
    const int gw = F.bid * NWAVES + F.wave, NGW = F.G * NWAVES;
    {
        const int x = F.bid & 7, lb = F.bid >> 3, nlb = (F.G - x + 7) >> 3;
#pragma unroll 1
        for (int uu = lb * NWAVES + F.wave; uu < 1024; uu += nlb * NWAVES) { const int bh = 4 * x + (uu >> 8), u = uu & 255; attn_unit<true>(F, l, bh >> 2, bh & 3, u >> 2, u & 3, rpbs); } }
    if (with_ctx) for (int uid = gw; uid < BATCH * NHEAD * 16; uid += NGW) { const int cb = uid & 15, h = (uid >> 4) & 3, b = uid >> 6; attn_unit<false>(F, l, b, h, 0, cb, rpbs); }
}
__device__ __forceinline__ void dft64_tables(Frame& F, int off) {
    LAS unsigned short* CT = (LAS unsigned short*)(F.lds + off); LAS unsigned short* ST = CT + 64 * 72;
    for (int i = F.tid; i < 4096; i += NT) { const int j = i >> 6, k = i & 63; float s_, c_; sincospif((float)((j * k) & 63) * (1.0f / 32.0f), &s_, &c_); CT[j * 72 + k] = (unsigned short)f2bf(c_); ST[j * 72 + k] = (unsigned short)f2bf(s_); }
}
__device__ __forceinline__ void fourier_a(Frame& F) {
    const bf16* U = (const bf16*)(F.ws + WS_U); bf16* Zr = (bf16*)(F.ws + WS_Z); bf16* Zi = Zr + NZ;
    constexpr int O_CT = 0, O_TWC = 18432, O_TWS = O_TWC + 16384;
    const int q = F.lane & 15, g = F.lane >> 4;
    const int gw = F.bid * NWAVES + F.wave, NGW = F.G * NWAVES;
    bf16x8 tfa[2][4];
    auto tf_load = [&](int un) { const int b = un >> 8, h = (un >> 6) & 3, n2 = un & 63;
#pragma unroll
        for (int ks = 0; ks < 2; ++ks)
#pragma unroll
            for (int mt = 0; mt < 4; ++mt) tfa[ks][mt] = *(const GAS bf16x8*)(U + (size_t)(b * SEQ + 64 * (16 * mt + q) + n2) * INC + UC_F + h * HD + 32 * ks + 8 * g); };
    if (gw < BATCH * NHEAD * 64) tf_load(gw);
    dft64_tables(F, O_CT);
    { LAS float* twc = (LAS float*)(F.lds + O_TWC); LAS float* tws = (LAS float*)(F.lds + O_TWS);
      for (int i = F.tid; i < 4096; i += NT) { float s_, c_; sincospif((float)i * (1.0f / 2048.0f), &s_, &c_); twc[i] = c_; tws[i] = s_; } }
    __syncthreads();
    const LAS unsigned short* CT = (const LAS unsigned short*)(F.lds + O_CT); const LAS unsigned short* ST = CT + 64 * 72;
    const LAS float* twc = (const LAS float*)(F.lds + O_TWC); const LAS float* tws = (const LAS float*)(F.lds + O_TWS);
    for (int un = gw; un < BATCH * NHEAD * 64; un += NGW) {
        if (un != gw) tf_load(un);
        const int b = un >> 8, h = (un >> 6) & 3, n2 = un & 63;
        f32x4 xr[4][4], xw[4][4];
#pragma unroll
        for (int mt = 0; mt < 4; ++mt)
#pragma unroll
            for (int ct = 0; ct < 4; ++ct) { xr[mt][ct] = (f32x4){0.f, 0.f, 0.f, 0.f}; xw[mt][ct] = (f32x4){0.f, 0.f, 0.f, 0.f}; }
        __builtin_amdgcn_sched_barrier(0);
#pragma unroll
        for (int ks = 0; ks < 2; ++ks) {
            bf16x8 tf[4], cf[4], sf[4];
#pragma unroll
            for (int mt = 0; mt < 4; ++mt) tf[mt] = tfa[ks][mt];
#pragma unroll
            for (int ct = 0; ct < 4; ++ct) { cf[ct] = *(const LAS bf16x8*)(CT + (16 * ct + q) * 72 + 32 * ks + 8 * g); sf[ct] = *(const LAS bf16x8*)(ST + (16 * ct + q) * 72 + 32 * ks + 8 * g); }
#pragma unroll
            for (int mt = 0; mt < 4; ++mt)
#pragma unroll
                for (int ct = 0; ct < 4; ++ct) { xr[mt][ct] = __builtin_amdgcn_mfma_f32_16x16x32_bf16(tf[mt], cf[ct], xr[mt][ct], 0, 0, 0); xw[mt][ct] = __builtin_amdgcn_mfma_f32_16x16x32_bf16(tf[mt], sf[ct], xw[mt][ct], 0, 0, 0); }
        }
        __builtin_amdgcn_sched_barrier(0); asm volatile("s_nop 7\n\ts_nop 7" ::: "memory"); __builtin_amdgcn_sched_barrier(0);
        v4u ar[4][2], awn[4][2];
#pragma unroll
        for (int ct = 0; ct < 4; ++ct)
#pragma unroll
            for (int kb = 0; kb < 2; ++kb) {
                ar[ct][kb].x = cvtpk(xr[2 * kb][ct][0], xr[2 * kb][ct][1]); ar[ct][kb].y = cvtpk(xr[2 * kb][ct][2], xr[2 * kb][ct][3]);
                ar[ct][kb].z = cvtpk(xr[2 * kb + 1][ct][0], xr[2 * kb + 1][ct][1]); ar[ct][kb].w = cvtpk(xr[2 * kb + 1][ct][2], xr[2 * kb + 1][ct][3]);
                awn[ct][kb].x = cvtpk(-xw[2 * kb][ct][0], -xw[2 * kb][ct][1]); awn[ct][kb].y = cvtpk(-xw[2 * kb][ct][2], -xw[2 * kb][ct][3]);
                awn[ct][kb].z = cvtpk(-xw[2 * kb + 1][ct][0], -xw[2 * kb + 1][ct][1]); awn[ct][kb].w = cvtpk(-xw[2 * kb + 1][ct][2], -xw[2 * kb + 1][ct][3]); }
#pragma unroll
        for (int rt = 0; rt < 4; ++rt) {
            const int n1p = 16 * rt + q;
            bf16x8 cb_[2], sb_[2];
#pragma unroll
            for (int kb = 0; kb < 2; ++kb) { const LAS unsigned short* cp = CT + n1p * 72 + 32 * kb + 4 * g; const LAS unsigned short* sp = ST + n1p * 72 + 32 * kb + 4 * g;
                cb_[kb] = mk8(*(const LAS v2u*)cp, *(const LAS v2u*)(cp + 16)); sb_[kb] = mk8(*(const LAS v2u*)sp, *(const LAS v2u*)(sp + 16)); }
            const int tix = n2 * n1p; const float cw = twc[tix], sw = tws[tix];
            const size_t zbase = ((((size_t)(b * NHEAD + h) * 64 + n1p) * 64 + n2) * 64) + 4 * g;
#pragma unroll
            for (int ct = 0; ct < 4; ++ct) {
                f32x4 yr = (f32x4){0.f, 0.f, 0.f, 0.f}, yi = (f32x4){0.f, 0.f, 0.f, 0.f};
#pragma unroll
                for (int kb = 0; kb < 2; ++kb) {
                    const bf16x8 a_r = __builtin_bit_cast(bf16x8, ar[ct][kb]), a_wn = __builtin_bit_cast(bf16x8, awn[ct][kb]);
                    v4u nr = ar[ct][kb]; nr.x ^= 0x80008000u; nr.y ^= 0x80008000u; nr.z ^= 0x80008000u; nr.w ^= 0x80008000u; const bf16x8 a_rn = __builtin_bit_cast(bf16x8, nr);
                    yr = __builtin_amdgcn_mfma_f32_16x16x32_bf16(a_r, cb_[kb], yr, 0, 0, 0); yr = __builtin_amdgcn_mfma_f32_16x16x32_bf16(a_wn, sb_[kb], yr, 0, 0, 0);
                    yi = __builtin_amdgcn_mfma_f32_16x16x32_bf16(a_wn, cb_[kb], yi, 0, 0, 0); yi = __builtin_amdgcn_mfma_f32_16x16x32_bf16(a_rn, sb_[kb], yi, 0, 0, 0); }
                v2u wr_, wi_;
                wr_.x = cvtpk(yr[0] * cw + yi[0] * sw, yr[1] * cw + yi[1] * sw); wr_.y = cvtpk(yr[2] * cw + yi[2] * sw, yr[3] * cw + yi[3] * sw);
                wi_.x = cvtpk(yi[0] * cw - yr[0] * sw, yi[1] * cw - yr[1] * sw); wi_.y = cvtpk(yi[2] * cw - yr[2] * sw, yi[3] * cw - yr[3] * sw);
                *(GAS v2u*)(Zr + zbase + 16 * ct) = wr_; *(GAS v2u*)(Zi + zbase + 16 * ct) = wi_;
            }
        }
    }
}
__device__ __forceinline__ void fourier_b(Frame& F, bool with_ctx) {
    bf16* Y = (bf16*)(F.ws + WS_H); const bf16* Zr = (const bf16*)(F.ws + WS_Z);
    const LAS unsigned short* CT = (const LAS unsigned short*)(F.lds); const LAS unsigned short* ST = CT + 64 * 72;
    LAS unsigned short* ZT = (LAS unsigned short*)(F.lds + 18432 + F.wave * 9216);
    const int q = F.lane & 15, g = F.lane >> 4;
    const int gw = F.bid * NWAVES + F.wave, NGW = F.G * NWAVES;
    const int nun = BATCH * NHEAD * 64 + (with_ctx ? BATCH * NHEAD * 4 : 0);
    const bool bal = (F.G == 256) && with_ctx;
    for (int it = 0; ; ++it) {
        int un;
        if (!bal) { un = gw + it * NGW; if (un >= nun) break; }
        else if (it == 0) un = gw;
        else if (it == 1 && gw >= 64 * NWAVES && gw < 64 * NWAVES + BATCH * NHEAD * 4) un = BATCH * NHEAD * 64 + (gw - 64 * NWAVES);
        else break;
        const bool lat = un < BATCH * NHEAD * 64; const int uc = un - BATCH * NHEAD * 64;
        const int b = lat ? (un >> 8) : (uc >> 4), h = lat ? ((un >> 6) & 3) : ((uc >> 2) & 3), n1p = lat ? (un & 63) : (uc & 3);
        const size_t z0 = lat ? (((size_t)(b * NHEAD + h) * 64 + n1p) * 64) * 64 : 2 * NZ + (((size_t)(b * NHEAD + h) * 4 + n1p) * 64) * 64;
        const size_t zim = lat ? NZ : NZC;
        const int tok0 = lat ? (b * SEQ + n1p) : (NLAT + b * CTXL + n1p), tstride = lat ? 64 : 4; const float oscale = lat ? (1.0f / 512.0f) : (1.0f / 128.0f);
        f32x4 acc[4][4];
#pragma unroll
        for (int ct = 0; ct < 4; ++ct)
#pragma unroll
            for (int nt = 0; nt < 4; ++nt) acc[ct][nt] = (f32x4){0.f, 0.f, 0.f, 0.f};
#pragma unroll
        for (int comp = 0; comp < 2; ++comp) {
            const bf16* zp = Zr + z0 + (comp ? zim : 0); const LAS unsigned short* FT = comp ? ST : CT;
#pragma unroll
            for (int i = 0; i < 8; ++i) { const int p = F.lane + 64 * i, n2 = p >> 3, c8 = p & 7; const v4u w = *(const GAS v4u*)(zp + (size_t)n2 * 64 + 8 * c8); LAS unsigned short* tp = ZT + (8 * c8) * 72 + n2;
                tp[0 * 72] = (unsigned short)w.x; tp[1 * 72] = (unsigned short)(w.x >> 16); tp[2 * 72] = (unsigned short)w.y; tp[3 * 72] = (unsigned short)(w.y >> 16);
                tp[4 * 72] = (unsigned short)w.z; tp[5 * 72] = (unsigned short)(w.z >> 16); tp[6 * 72] = (unsigned short)w.w; tp[7 * 72] = (unsigned short)(w.w >> 16); }
            LDS_WAIT(); asm volatile("" ::: "memory");
#pragma unroll
            for (int ks = 0; ks < 2; ++ks) {
                bf16x8 af[4], bf_[4];
#pragma unroll
                for (int ct = 0; ct < 4; ++ct) af[ct] = *(const LAS bf16x8*)(ZT + (16 * ct + q) * 72 + 32 * ks + 8 * g);
#pragma unroll
                for (int nt = 0; nt < 4; ++nt) bf_[nt] = *(const LAS bf16x8*)(FT + (16 * nt + q) * 72 + 32 * ks + 8 * g);
#pragma unroll
                for (int ct = 0; ct < 4; ++ct)
#pragma unroll
                    for (int nt = 0; nt < 4; ++nt) acc[ct][nt] = __builtin_amdgcn_mfma_f32_16x16x32_bf16(af[ct], bf_[nt], acc[ct][nt], 0, 0, 0);
            }
            LDS_WAIT(); asm volatile("" ::: "memory");
        }
#pragma unroll
        for (int nt = 0; nt < 4; ++nt) { bf16* yp = Y + (size_t)(tok0 + tstride * (16 * nt + q)) * D + 768 + h * HD + 4 * g;
#pragma unroll
            for (int ct = 0; ct < 4; ++ct) { v2u w; w.x = cvtpk(acc[ct][nt][0] * oscale, acc[ct][nt][1] * oscale); w.y = cvtpk(acc[ct][nt][2] * oscale, acc[ct][nt][3] * oscale); *(GAS v2u*)(yp + 16 * ct) = w; } }
    }
}
__device__ __forceinline__ v4u mul_bf8(v4u a, v4u b) { v4u r; r.x = cvtpk(bflo(a.x) * bflo(b.x), bfhi(a.x) * bfhi(b.x)); r.y = cvtpk(bflo(a.y) * bflo(b.y), bfhi(a.y) * bfhi(b.y)); r.z = cvtpk(bflo(a.z) * bflo(b.z), bfhi(a.z) * bfhi(b.z)); r.w = cvtpk(bflo(a.w) * bflo(b.w), bfhi(a.w) * bfhi(b.w)); return r; }
__device__ __forceinline__ void convpool_phase(Frame& F, int l, int nrows) {
    const bf16* __restrict__ U = (const bf16*)(F.ws + WS_U); bf16* __restrict__ Y = (bf16*)(F.ws + WS_H);
    const bf16* PWT = (const bf16*)(F.ws + WS_PWT) + (size_t)l * 4 * 64 * 64;
    const float* cw = F.inp(I_CONVW) + (size_t)l * 3 * GWID; const float* ps = F.inp(I_POOLS) + (size_t)l * GWID;
    LAS unsigned* PX = (LAS unsigned*)(F.lds + RING_OFF + F.wave * 16384);
    LAS unsigned* DT = PX + 32 * 64;
    const int q = F.lane & 15, g = F.lane >> 4;
    const int c8 = F.tid & 31, tt = F.wave >> 1, ch = F.wave & 1;
    const f32x4 w0a = *(const GAS f32x4*)(cw + 8 * c8), w0b = *(const GAS f32x4*)(cw + 8 * c8 + 4), w1a = *(const GAS f32x4*)(cw + GWID + 8 * c8), w1b = *(const GAS f32x4*)(cw + GWID + 8 * c8 + 4),
                w2a = *(const GAS f32x4*)(cw + 2 * GWID + 8 * c8), w2b = *(const GAS f32x4*)(cw + 2 * GWID + 8 * c8 + 4);
    bf16x8 wf[2][4][2]; f32x4 psc[2][4];
#pragma unroll
    for (int gs = 0; gs < 2; ++gs)
#pragma unroll
        for (int dt = 0; dt < 4; ++dt) { const int gi = 2 * ch + gs; psc[gs][dt] = *(const GAS f32x4*)(ps + gi * 64 + 16 * dt + 4 * g);
#pragma unroll
            for (int ks = 0; ks < 2; ++ks) wf[gs][dt][ks] = *(const GAS bf16x8*)(PWT + ((size_t)gi * 64 + 16 * dt + q) * 64 + 32 * ks + 8 * g); }
    for (int tile = F.bid; tile < nrows / 64; tile += F.G) {
        const int r0 = tile * 64; int base, t0, L; seq_info(r0, base, t0, L);
        v4u pw_[8];
#pragma unroll
        for (int i = 0; i < 8; ++i) { const int p = F.lane + 64 * i, rr = p >> 4, c16 = p & 15, t = t0 + 16 * tt - 8 + rr; const bool in_ = (t >= 0) && (t < L); const int tc = in_ ? t : t0;
            const v4u w = *(const GAS v4u*)(U + (size_t)(base + tc) * INC + UC_P + ch * 128 + 8 * c16);
            pw_[i].x = in_ ? w.x : 0u; pw_[i].y = in_ ? w.y : 0u; pw_[i].z = in_ ? w.z : 0u; pw_[i].w = in_ ? w.w : 0u; }
        { const int rg = F.tid >> 5; const bf16* ub = U + (size_t)(r0 + 4 * rg) * INC + 8 * c8;
          v4u z[6];
#pragma unroll
          for (int hb = 0; hb < 2; ++hb) {
            constexpr int dummy = 0; (void)dummy;
            v4u zc_[4], zv_[4], ab_[2];
            const int i0 = hb == 0 ? 0 : 4, ni = hb == 0 ? 4 : 2;
#pragma unroll
            for (int i = 0; i < 4; ++i) if (i < ni) { zc_[i] = *(const GAS v4u*)(ub + (ptrdiff_t)(i0 + i - 1) * INC + UC_AC); zv_[i] = *(const GAS v4u*)(ub + (ptrdiff_t)(i0 + i - 1) * INC + UC_AV); }
#pragma unroll
            for (int j = 0; j < 2; ++j) ab_[j] = *(const GAS v4u*)(ub + (size_t)(2 * hb + j) * INC + UC_AB);
            __builtin_amdgcn_sched_barrier(0);
#pragma unroll
            for (int i = 0; i < 4; ++i) if (i < ni) z[i0 + i] = mul_bf8(zc_[i], zv_[i]);
#pragma unroll
            for (int jj = 0; jj < 2; ++jj) { const int j = 2 * hb + jj, tr = 4 * rg + j, t = t0 + tr;
                const v4u zc = z[j + 1]; v4u zp = z[j], zn = z[j + 2]; const v4u ab = ab_[jj];
                { const bool hp = t > 0, hn = t < L - 1; zp.x = hp ? zp.x : 0u; zp.y = hp ? zp.y : 0u; zp.z = hp ? zp.z : 0u; zp.w = hp ? zp.w : 0u; zn.x = hn ? zn.x : 0u; zn.y = hn ? zn.y : 0u; zn.z = hn ? zn.z : 0u; zn.w = hn ? zn.w : 0u; }
                v4u o;
                o.x = cvtpk(bflo(ab.x) * (w0a.x * bflo(zp.x) + w1a.x * bflo(zc.x) + w2a.x * bflo(zn.x)), bfhi(ab.x) * (w0a.y * bfhi(zp.x) + w1a.y * bfhi(zc.x) + w2a.y * bfhi(zn.x)));
                o.y = cvtpk(bflo(ab.y) * (w0a.z * bflo(zp.y) + w1a.z * bflo(zc.y) + w2a.z * bflo(zn.y)), bfhi(ab.y) * (w0a.w * bfhi(zp.y) + w1a.w * bfhi(zc.y) + w2a.w * bfhi(zn.y)));
                o.z = cvtpk(bflo(ab.z) * (w0b.x * bflo(zp.z) + w1b.x * bflo(zc.z) + w2b.x * bflo(zn.z)), bfhi(ab.z) * (w0b.y * bfhi(zp.z) + w1b.y * bfhi(zc.z) + w2b.y * bfhi(zn.z)));
                o.w = cvtpk(bflo(ab.w) * (w0b.z * bflo(zp.w) + w1b.z * bflo(zc.w) + w2b.z * bflo(zn.w)), bfhi(ab.w) * (w0b.w * bfhi(zp.w) + w1b.w * bfhi(zc.w) + w2b.w * bfhi(zn.w)));
                *(GAS v4u*)(Y + (size_t)(r0 + tr) * D + 8 * c8) = o; }
            __builtin_amdgcn_sched_barrier(0);
          }
        }
#pragma unroll
        for (int i = 0; i < 8; ++i) { const int p = F.lane + 64 * i, rr = p >> 4, c16 = p & 15; *(LAS v4u*)(PX + rr * 64 + 4 * c16) = pw_[i]; }
        LDS_WAIT(); asm volatile("" ::: "memory");
        { const int hw = 1 << (2 * ch + (F.lane >> 5));
          float s0 = 0.f, s1 = 0.f;
          for (int k = -hw; k < hw; ++k) { const unsigned w = PX[(8 + k) * 64 + F.lane]; s0 += bflo(w); s1 += bfhi(w); }
          for (int i = 0; i < 16; ++i) { const int t = t0 + 16 * tt + i;
              const int lo = t - hw > 0 ? t - hw : 0, hi = t + hw < L ? t + hw : L; const float rc = 1.0f / (float)(hi - lo);
              const unsigned xc = PX[(i + 8) * 64 + F.lane];
              DT[i * 68 + F.lane] = cvtpk(s0 * rc - bflo(xc), s1 * rc - bfhi(xc));
              const unsigned wa = PX[(i + 8 + hw) * 64 + F.lane], wsb = PX[(i + 8 - hw) * 64 + F.lane];
              s0 += bflo(wa) - bflo(wsb); s1 += bfhi(wa) - bfhi(wsb); } }
        LDS_WAIT(); asm volatile("" ::: "memory");
#pragma unroll
        for (int gs = 0; gs < 2; ++gs) { const int gi = 2 * ch + gs;
            bf16x8 df[2];
#pragma unroll
            for (int ks = 0; ks < 2; ++ks) df[ks] = *(const LAS bf16x8*)(DT + q * 68 + gs * 32 + 16 * ks + 4 * g);
#pragma unroll
            for (int dt = 0; dt < 4; ++dt) { f32x4 a = (f32x4){0.f, 0.f, 0.f, 0.f};
                a = __builtin_amdgcn_mfma_f32_16x16x32_bf16(wf[gs][dt][0], df[0], a, 0, 0, 0); a = __builtin_amdgcn_mfma_f32_16x16x32_bf16(wf[gs][dt][1], df[1], a, 0, 0, 0);
                const int oc = gi * 64 + 16 * dt + 4 * g; const f32x4 sc = psc[gs][dt];
                v2u w; w.x = cvtpk(a[0] * sc.x, a[1] * sc.y); w.y = cvtpk(a[2] * sc.z, a[3] * sc.w);
                *(GAS v2u*)(Y + (size_t)(r0 + 16 * tt + q) * D + 256 + oc) = w; } }
        LDS_WAIT(); asm volatile("" ::: "memory");
    }
    __syncthreads();
}

__device__ __forceinline__ void fourier_ctx_a(Frame& F) {
    const bf16* U = (const bf16*)(F.ws + WS_U); bf16* Zc = (bf16*)(F.ws + WS_Z) + 2 * NZ;
    LAS float* cs = (LAS float*)(F.lds + TAB_OFF); LAS float* sn = cs + 64; LAS float* cs256 = cs + 128; LAS float* sn256 = cs + 384;
    if (F.tid < 64) { float s_, c_; sincospif((float)F.tid * (1.0f / 32.0f), &s_, &c_); cs[F.tid] = c_; sn[F.tid] = s_; }
    if (F.tid < 256) { float s_, c_; sincospif((float)F.tid * (1.0f / 128.0f), &s_, &c_); cs256[F.tid] = c_; sn256[F.tid] = s_; }
    __syncthreads();
    for (int item = F.bid * NT + F.tid; item < BATCH * NHEAD * 64 * 64; item += F.G * NT) {
        const int cp = item & 63, n2 = (item >> 6) & 63, h = (item >> 12) & 3, b = item >> 14;
        float xr[4], xi[4];
#pragma unroll
        for (int n1 = 0; n1 < 4; ++n1) { xr[n1] = 0.f; xi[n1] = 0.f; }
        for (int c8 = 0; c8 < 8; ++c8) {
            float cc[8], ss[8];
#pragma unroll
            for (int e = 0; e < 8; ++e) { const int idx = ((8 * c8 + e) * cp) & 63; cc[e] = cs[idx]; ss[e] = sn[idx]; }
#pragma unroll
            for (int n1 = 0; n1 < 4; ++n1) { const v4u w = *(const GAS v4u*)(U + (size_t)(NLAT + b * CTXL + 64 * n1 + n2) * INC + UC_F + h * HD + 8 * c8);
                const float f0 = bflo(w.x), f1 = bfhi(w.x), f2 = bflo(w.y), f3 = bfhi(w.y), f4 = bflo(w.z), f5 = bfhi(w.z), f6 = bflo(w.w), f7 = bfhi(w.w);
                xr[n1] += f0 * cc[0] + f1 * cc[1] + f2 * cc[2] + f3 * cc[3] + f4 * cc[4] + f5 * cc[5] + f6 * cc[6] + f7 * cc[7];
                xi[n1] -= f0 * ss[0] + f1 * ss[1] + f2 * ss[2] + f3 * ss[3] + f4 * ss[4] + f5 * ss[5] + f6 * ss[6] + f7 * ss[7]; }
        }
        float yr[4], yi[4];
        yr[0] = xr[0] + xr[1] + xr[2] + xr[3];           yi[0] = xi[0] + xi[1] + xi[2] + xi[3];
        yr[1] = xr[0] + xi[1] - xr[2] - xi[3];           yi[1] = xi[0] - xr[1] - xi[2] + xr[3];
        yr[2] = xr[0] - xr[1] + xr[2] - xr[3];           yi[2] = xi[0] - xi[1] + xi[2] - xi[3];
        yr[3] = xr[0] - xi[1] - xr[2] + xi[3];           yi[3] = xi[0] + xr[1] - xi[2] - xr[3];
#pragma unroll
        for (int k = 0; k < 4; ++k) { const int tix = (n2 * k) & 255; const float cw = cs256[tix], sw = sn256[tix];
            const size_t zi = ((((size_t)(b * NHEAD + h) * 4 + k) * 64 + n2) * 64) + cp;
            Zc[zi] = (bf16)f2bf(yr[k] * cw + yi[k] * sw); Zc[NZC + zi] = (bf16)f2bf(yi[k] * cw - yr[k] * sw); }
    }
}

__device__ __forceinline__ void mixa_phase(int l, bool with_ctx) { Frame F = mk_frame();
    const int nrows = with_ctx ? NROW : NLAT;
    convpool_phase(F, l, nrows);
    kv_prepass(F);
    __syncthreads();
    fourier_a(F);
    __syncthreads();
    if (with_ctx) fourier_ctx_a(F);
}
__device__ __forceinline__ void mixb_phase(int l, bool with_ctx) { Frame F = mk_frame();
    dft64_tables(F, 0);
    attn_phase(F, l, with_ctx);
    __syncthreads();
    fourier_b(F, with_ctx);
}

struct WinOrder {
    int G, c, nctx_cols, ctx_pn0;
    __device__ __forceinline__ bool next(int i, pg8::Unit& u) const {
        const long L = (long)i * G + c; const int nlatu = 1024, total = nlatu + 8 * nctx_cols; if (L >= total) return false;
        if (L < nlatu) { int wgid = (int)L; { const int xcd = wgid % 8, off = wgid / 8; wgid = xcd * 128 + off; }
            const int gid = wgid / 64, fm = gid * 8; u.pm = fm + ((wgid % 64) % 8); u.pn = (wgid % 64) / 8; }
        else { const int j = (int)L - nlatu; u.pm = 128 + (j % 8); u.pn = ctx_pn0 + j / 8; }
        u.pb = u.pn; u.lb = 0; u.nv = 256; return true;
    }
    __device__ __forceinline__ void a_ready(const pg8::Unit&) const {}
    __device__ __forceinline__ void done(const pg8::Unit&) const {}
    __device__ __forceinline__ int row_of(const pg8::Unit&, int i) const { return i; }
};

__device__ __forceinline__ void mini_gemm(Frame& F, const bf16* Arows, const bf16* Bt, bf16* Orows, int ldc, int col0, int nct) {
    LAS unsigned char* T = F.lds + RING_OFF;
    const int q = F.lane & 15, g = F.lane >> 4;
    bf16x8 bw[32];
    { const bf16* bp = Bt + (size_t)(col0 + F.wave * 16 + q) * D + 8 * g;
#pragma unroll
      for (int s2 = 0; s2 < 32; ++s2) bw[s2] = *(const GAS bf16x8*)(bp + s2 * 32); }
    __builtin_amdgcn_sched_barrier(0);
    __syncthreads();
#pragma unroll
    for (int hb = 0; hb < 2; ++hb) { v4u t[8];
#pragma unroll
      for (int i = 0; i < 8; ++i) { const int id = F.tid + NT * (hb * 8 + i); t[i] = *(const GAS v4u*)(Arows + (size_t)(id >> 7) * D + (id & 127) * 8); }
      __builtin_amdgcn_sched_barrier(0);
#pragma unroll
      for (int i = 0; i < 8; ++i) { const int id = F.tid + NT * (hb * 8 + i), r = id >> 7, c = id & 127; *(LAS v4u*)(T + r * 2048 + ((c ^ (r & 7)) << 4)) = t[i]; }
      __builtin_amdgcn_sched_barrier(0); }
    __syncthreads();
    float one = 1.0f; asm volatile("" : "+v"(one));
    const LAS unsigned char* TE = T + q * 2048 + (((((q >> 2) & 1) << 2) | (g ^ (q & 3))) << 4);
    const LAS unsigned char* TO = T + q * 2048 + ((((((q >> 2) & 1) ^ 1) << 2) | (g ^ (q & 3))) << 4);
#pragma unroll 1
    for (int ct = 0; ct < nct; ++ct) {
        const int cw = col0 + ct * 128 + F.wave * 16;
        f32x4 acc[4];
#pragma unroll
        for (int mt = 0; mt < 4; ++mt) acc[mt] = (f32x4){0.f, 0.f, 0.f, 0.f};
#pragma unroll
        for (int grp = 0; grp < 8; ++grp) {
            bf16x8 af[4][4];
#pragma unroll
            for (int k4 = 0; k4 < 4; ++k4) { const int s2 = grp * 4 + k4; const LAS unsigned char* ap = ((s2 & 1) ? TO : TE) + (s2 >> 1) * 128;
#pragma unroll
                for (int mt = 0; mt < 4; ++mt) af[k4][mt] = *(const LAS bf16x8*)(ap + (mt & 1) * 32768 + (mt >> 1) * 65536); }
            __builtin_amdgcn_sched_barrier(0);
#pragma unroll
            for (int k4 = 0; k4 < 4; ++k4)
#pragma unroll
                for (int mt = 0; mt < 4; ++mt) acc[mt] = __builtin_amdgcn_mfma_f32_16x16x32_bf16(bw[grp * 4 + k4], af[k4][mt], acc[mt], 0, 0, 0);
            __builtin_amdgcn_sched_barrier(0);
        }
        if (ct + 1 < nct) { const bf16* bp = Bt + (size_t)(cw + 128 + q) * D + 8 * g;
#pragma unroll
            for (int s2 = 0; s2 < 32; ++s2) bw[s2] = *(const GAS bf16x8*)(bp + s2 * 32); }
#pragma unroll
        for (int mt = 0; mt < 4; ++mt) { const f32x4 v = acc[mt] * one; v2u w; w.x = cvtpk(v[0], v[1]); w.y = cvtpk(v[2], v[3]);
            *(GAS v2u*)(Orows + (size_t)(mt * 16 + q) * ldc + cw + 4 * g) = w; }
        __builtin_amdgcn_sched_barrier(0);
    }
    __syncthreads();
}

struct Args { const float* in[20]; float* out; unsigned char* ws; int l, e; };
#define PH_PTRS() \
    bf16* H = (bf16*)(F.ws + WS_H); bf16* U = (bf16*)(F.ws + WS_U); bf16* HE = (bf16*)(F.ws + WS_U); bf16* Y2 = (bf16*)(F.ws + WS_S); \
    float* MOD = (float*)(F.ws + WS_MOD); float* XC = (float*)(F.ws + WS_XC); const uint2* INFO = (const uint2*)(F.ws + WS_INFO); \
    const bool first = (l == 0); const int M = first ? NROW : NLAT; const float* modl = MOD + (size_t)l * 9 * 6144; \
    (void)H; (void)U; (void)HE; (void)XC; (void)Y2; (void)INFO; (void)M; (void)modl;

#define XS_IN()  XStream{(const char*)F.inp(I_X), (const char*)F.inp(I_CTX), 4096, 4096}
#define XS_BF()  XStream{(const char*)F.out, (const char*)XC, 4096, 2048}
__device__ __forceinline__ void ph_norm1(int l) { Frame F = mk_frame(); PH_PTRS();
    norm_phase<0, false, false>(F, XS_IN(), XS_IN(), NROW, F.inp(I_N1G), modl, modl, 0, 1, H, nullptr, nullptr); }
__device__ __forceinline__ void ph_next(int l) { Frame F = mk_frame(); PH_PTRS();
    if (first) norm_phase<1, false, true>(F, XS_BF(), XS_BF(), NROW, F.inp(I_N1G) + D, MOD + (size_t)9 * 6144, modl, 0, 1, H, Y2, nullptr);
    else norm_phase<1, true, true>(F, XS_BF(), XS_BF(), NLAT, F.inp(I_FG), modl, modl, 0, 0, nullptr, Y2, F.out); }
__device__ __forceinline__ void ph_route(int l) { Frame F = mk_frame(); PH_PTRS();
    if (first) route_phase<false>(F, l, XS_IN(), XS_BF(), U, M, F.inp(I_N2G) + (size_t)l * D, modl, H, (uint2*)(F.ws + WS_INFO), (unsigned*)(F.ctl + CW_CNT + l * 16));
    else route_phase<true>(F, l, XS_BF(), XS_BF(), U, M, F.inp(I_N2G) + (size_t)l * D, modl, H, (uint2*)(F.ws + WS_INFO), (unsigned*)(F.ctl + CW_CNT + l * 16)); }
__device__ __forceinline__ void ph_win(int l) { Frame F = mk_frame(); PH_PTRS();
    pg8::Gemm g{H, (const bf16*)(F.ws + WS_WIN) + (size_t)l * INC * D, NROW, INC, D};
    const int rb = first ? (F.bid >> 3) : (F.bid >> 2); const int c0 = first ? (F.bid & 7) * 256 : UC_K + (F.bid & 3) * 128; const int nct = first ? 2 : 1;
    const bool have = rb < 32, early = have && (F.bid & 1) != 0;
    if (early) mini_gemm(F, H + (size_t)(NLAT + rb * 64) * D, g.Bt, U + (size_t)(NLAT + rb * 64) * INC, INC, c0, nct);
    WinOrder S{F.G, F.bid, 0, 0};
    pg8::EpiBf16 E{U, INC};
    pg8::gemm_phase<pg8::EpiBf16, WinOrder>(F.lds + RING_OFF, g, S, E);
    if (have && !early) mini_gemm(F, H + (size_t)(NLAT + rb * 64) * D, g.Bt, U + (size_t)(NLAT + rb * 64) * INC, INC, c0, nct); }
__device__ __forceinline__ void ph_wout(int l) { Frame F = mk_frame(); PH_PTRS();
    pg8::Gemm g{H, (const bf16*)(F.ws + WS_WOUT) + (size_t)l * D * D, NLAT, D, D};
    const int rb = F.bid >> 3; const bool have = first && rb < 32, early = have && (F.bid & 1) != 0;
    if (early) mini_gemm(F, H + (size_t)(NLAT + rb * 64) * D, g.Bt, U + (size_t)(NLAT + rb * 64) * D, D, (F.bid & 7) * 128, 1);
    pg8::StaticOrder S; S.init(NLAT, D, F.G, F.bid);
    pg8::EpiBf16 E{U, D};
    pg8::gemm_phase<pg8::EpiBf16, pg8::StaticOrder>(F.lds + RING_OFF, g, S, E);
    if (have && !early) mini_gemm(F, H + (size_t)(NLAT + rb * 64) * D, g.Bt, U + (size_t)(NLAT + rb * 64) * D, D, (F.bid & 7) * 128, 1); }
__device__ __forceinline__ void ph_moe1(int l) { Frame F = mk_frame(); PH_PTRS(); moe_table(F, l);
    pg8::Gemm g{H, (const bf16*)(F.ws + WS_W13 + (size_t)l * NEXP * 1024 * D), M, 1024, D / 2};
    pg8::MoeOrder S{F.G, F.bid, CAP, (const LAS int*)(F.lds + TAB_OFF), INFO};
    pg8::EpiSwiGLU8 E{(unsigned char*)HE, MHID};
    pg8::gemm_phase<pg8::EpiSwiGLU8, pg8::MoeOrder, true, true>(F.lds + RING_OFF, g, S, E); }
__device__ __forceinline__ void ph_moe2(int l) { Frame F = mk_frame(); PH_PTRS(); moe_table(F, l);
    pg8::Gemm g{HE, (const bf16*)(F.ws + WS_W2 + (size_t)l * NEXP * D * MHID), M, D, MHID / 2};
    pg8::MoeOrder S{F.G, F.bid, CAP, (const LAS int*)(F.lds + TAB_OFF), INFO};
    pg8::EpiScatter E{Y2, INFO, 1.0f / (pg8::F8_ACT * pg8::F8_W)};
    pg8::gemm_phase<pg8::EpiScatter, pg8::MoeOrder, false, true>(F.lds + RING_OFF, g, S, E); }

__device__ __forceinline__ void grid_bar() {
    Frame F = mk_frame(); XcdBarrier b; b.bar = (unsigned*)(F.ctl + CW_BAR); b.x = xb_xcc_id(); b.st = F.MISC + 8; xcd_barrier(b);
}
#define PMARK(name) asm volatile("; PHASE_MARK " name ::: "memory")
template <int L> __device__ __forceinline__ void layer_phases() {
    PMARK("win"); ph_win(L); grid_bar();
    PMARK("mixa"); mixa_phase(L, L == 0); grid_bar();
    PMARK("mixb"); mixb_phase(L, L == 0); grid_bar();
    PMARK("wout"); ph_wout(L); grid_bar();
    PMARK("route"); ph_route(L); grid_bar();
    PMARK("moe1"); ph_moe1(L); grid_bar();
    PMARK("moe2"); ph_moe2(L); grid_bar();
    PMARK("next"); ph_next(L);
}
__global__ void __launch_bounds__(NT, 2) fwd_all(Args args) {
    { Frame F = mk_frame();
      for (int u = F.tid; u < (LDS_BYTES - LDSCTL_OFF) / 4; u += NT) ((LAS unsigned*)(F.lds + LDSCTL_OFF))[u] = 0u;
      __syncthreads();
      (void)xcd_barrier_post((unsigned*)(F.ctl + CW_BAR), F.MISC + 8); }
    PMARK("pa"); pa_phase(); grid_bar();
    PMARK("norm1"); ph_norm1(0); grid_bar();
    layer_phases<0>(); grid_bar();
    layer_phases<1>();
}

typedef void (*kern_t)(Args);
extern "C" void kernel_launch(void* const* d_in, const int* in_sizes, int n_in, void* d_out, int out_size, void* d_ws, size_t ws_size, hipStream_t stream) {
    static int grid = 0;
    const kern_t kerns[] = {fwd_all};
    if (grid == 0) {
        if (n_in != 20 || out_size != NLAT * D || ws_size < WS_END) { fprintf(stderr, "kernel_launch: unexpected shapes (n_in %d out %d ws %zu)\n", n_in, out_size, ws_size); grid = -1; return; }
        int dev = 0, cus = 0;
        if (hipGetDevice(&dev) != hipSuccess || hipDeviceGetAttribute(&cus, hipDeviceAttributeMultiprocessorCount, dev) != hipSuccess) { grid = -1; return; }
        for (kern_t k : kerns) if (hipFuncSetAttribute((const void*)k, hipFuncAttributeMaxDynamicSharedMemorySize, LDS_BYTES) != hipSuccess) { fprintf(stderr, "kernel_launch: hipFuncSetAttribute failed\n"); grid = -1; return; }
        int per_cu = 0; (void)hipOccupancyMaxActiveBlocksPerMultiprocessor(&per_cu, (const void*)kerns[0], NT, LDS_BYTES); (void)hipGetLastError();
        grid = cus;
    }
    if (grid < 0) return;
    (void)hipMemsetAsync((char*)d_ws + WS_CTL, 0, CTL_ZERO_BYTES, stream);
    Args a{};
    for (int i = 0; i < 20; ++i) a.in[i] = (const float*)d_in[i];
    a.out = (float*)d_out; a.ws = (unsigned char*)d_ws;
    hipLaunchKernelGGL(fwd_all, dim3(grid), dim3(NT), LDS_BYTES, stream, a);
}
```

```cpp
#include <hip/hip_runtime.h>
#include <cstdio>
#include <cstdint>
namespace pg8 {
#define PG8_LAS __attribute__((address_space(3)))
typedef unsigned short bf16_t;
typedef short bf16x8 __attribute__((ext_vector_type(8)));
typedef float f32x4 __attribute__((ext_vector_type(4)));
typedef unsigned u32x4 __attribute__((ext_vector_type(4)));
constexpr int BM = 256, BK = 64, HALF = 128, HTB = HALF * BK * 2  , STAGE_BYTES = 8 * HTB, NXCD = 8, WGM = 8;

__host__ __device__ __forceinline__ int lds_byte(int r, int c) { const int st = (r >> 4) * 2 + (c >> 5), rr = r & 15, cc = c & 31, ob = rr * 64 + cc * 2; return st * 1024 + (ob ^ (((ob >> 9) & 1) << 5)); }
__host__ __device__ __forceinline__ void stage_rc(int b, int& R, int& C) { const int st = b / 1024, sb = b % 1024, swz = sb ^ (((sb >> 9) & 1) << 5); R = (st >> 1) * 16 + swz / 64; C = (st & 1) * 32 + (swz % 64) / 2; }
__host__ __device__ __forceinline__ int perm32(int rho) { const int n = rho >> 4, i = rho & 15; return 8 * (i >> 2) + 4 * n + (i & 3); }

struct Unit { int pm, pn, pb, lb, nv; };
struct Gemm { const bf16_t* A; const bf16_t* Bt; int M, N, K; };

struct StaticOrder {
    int nM, nN, nwg, G, c;
    __host__ __device__ void init(int M, int N, int G_, int c_) { nM = M / BM; nN = N / BM; nwg = nM * nN; G = G_; c = c_; }
    __host__ __device__ bool next(int i, Unit& u) const {
        const long L = (long)i * G + c; if (L >= nwg) return false;
        int wgid = (int)L; { const int q = nwg / NXCD, r = nwg % NXCD, xcd = wgid % NXCD, off = wgid / NXCD; wgid = (xcd < r ? xcd * (q + 1) : r * (q + 1) + (xcd - r) * q) + off; }
        const int nig = WGM * nN, gid = wgid / nig, fm = gid * WGM, gsz = (nM - fm) < WGM ? (nM - fm) : WGM;
        u.pm = fm + ((wgid % nig) % gsz); u.pn = (wgid % nig) / gsz; u.pb = u.pn; u.lb = 0; u.nv = BM; return true;
    }
    __device__ __forceinline__ void a_ready(const Unit&) const {}
    __device__ __forceinline__ int row_of(const Unit&, int i) const { return i; }
    __device__ __forceinline__ void done(const Unit&) const {}
};


__device__ __forceinline__ unsigned cvt_pk_bf16(float lo, float hi) { unsigned r; asm volatile("v_cvt_pk_bf16_f32 %0, %1, %2" : "=v"(r) : "v"(lo), "v"(hi)); return r; }

__device__ __forceinline__ unsigned cvt4_fp8(float a, float b, float c, float d) {
    a = __builtin_amdgcn_fmed3f(a, -448.f, 448.f); b = __builtin_amdgcn_fmed3f(b, -448.f, 448.f); c = __builtin_amdgcn_fmed3f(c, -448.f, 448.f); d = __builtin_amdgcn_fmed3f(d, -448.f, 448.f);
    int w = 0; w = __builtin_amdgcn_cvt_pk_fp8_f32(a, b, w, false); w = __builtin_amdgcn_cvt_pk_fp8_f32(c, d, w, true); return (unsigned)w; }
constexpr float F8_ACT = 8.0f, F8_W = 64.0f;

struct EpiBf16 {
    static constexpr bool PERM = true, AFTER_DRAIN = false;
    struct Pf {}; __device__ __forceinline__ void prefetch(const Unit&, int, int, Pf&) const {}
    bf16_t* O; int ldc;
    __device__ __forceinline__ void operator()(const f32x4 (&acc)[2][2][4][2], const Unit& u, int wr, int wc, int fr, int fq, const Pf&) const {
        const int row0 = u.pm * BM + wr * 64 + fr; const int col0 = u.pn * BM + wc * 32 + 8 * fq;
        float one = 1.0f; asm volatile("" : "+v"(one));
#pragma unroll
        for (int ai = 0; ai < 2; ++ai)
#pragma unroll
            for (int m = 0; m < 4; ++m) { bf16_t* rowp = O + (size_t)(row0 + ai * HALF + m * 16) * ldc + col0;
#pragma unroll
                for (int bj = 0; bj < 2; ++bj) { const f32x4 v0 = acc[ai][bj][m][0] * one, v1 = acc[ai][bj][m][1] * one;
                    u32x4 w; w.x = cvt_pk_bf16(v0[0], v0[1]); w.y = cvt_pk_bf16(v0[2], v0[3]); w.z = cvt_pk_bf16(v1[0], v1[1]); w.w = cvt_pk_bf16(v1[2], v1[3]);
                    *(u32x4*)(rowp + bj * HALF) = w; } }
    }
};
struct EpiSwiGLU {
    static constexpr bool PERM = true, AFTER_DRAIN = false;
    struct Pf {}; __device__ __forceinline__ void prefetch(const Unit&, int, int, Pf&) const {}
    bf16_t* O; int ldc;
    __device__ __forceinline__ void operator()(const f32x4 (&acc)[2][2][4][2], const Unit& u, int wr, int wc, int fr, int fq, const Pf&) const {
        const int row0 = u.pm * BM + wr * 64 + fr; const int col0 = u.pn * HALF + wc * 32 + 8 * fq;
#pragma unroll
        for (int ai = 0; ai < 2; ++ai)
#pragma unroll
            for (int m = 0; m < 4; ++m) { bf16_t* rowp = O + (size_t)(row0 + ai * HALF + m * 16) * ldc + col0;
                float o[8];
#pragma unroll
                for (int n = 0; n < 2; ++n)
#pragma unroll
                    for (int j = 0; j < 4; ++j) { const float a = acc[ai][0][m][n][j], b = acc[ai][1][m][n][j]; o[n * 4 + j] = a * __builtin_amdgcn_rcpf(1.0f + __expf(-a)) * b; }
                u32x4 w; w.x = cvt_pk_bf16(o[0], o[1]); w.y = cvt_pk_bf16(o[2], o[3]); w.z = cvt_pk_bf16(o[4], o[5]); w.w = cvt_pk_bf16(o[6], o[7]);
                *(u32x4*)rowp = w; }
    }
};
struct EpiSwiGLU8 {
    static constexpr bool PERM = true, AFTER_DRAIN = false;
    struct Pf {}; __device__ __forceinline__ void prefetch(const Unit&, int, int, Pf&) const {}
    unsigned char* O; int ldc;
    __device__ __forceinline__ void operator()(const f32x4 (&acc)[2][2][4][2], const Unit& u, int wr, int wc, int fr, int fq, const Pf&) const {
        const int row0 = u.pm * BM + wr * 64 + fr; const int col0 = u.pn * HALF + wc * 32 + 8 * fq;
        constexpr float ds = 1.0f / (F8_ACT * F8_W);
#pragma unroll
        for (int ai = 0; ai < 2; ++ai)
#pragma unroll
            for (int m = 0; m < 4; ++m) { unsigned char* rowp = O + (size_t)(row0 + ai * HALF + m * 16) * ldc + col0;
                float o[8];
                typedef float f32x2_ __attribute__((ext_vector_type(2)));
                constexpr float c1 = -1.44269504f * ds, c2 = ds * ds * F8_ACT;
#pragma unroll
                for (int n = 0; n < 2; ++n)
#pragma unroll
                    for (int jp = 0; jp < 2; ++jp) { const f32x2_ a = (f32x2_){acc[ai][0][m][n][2 * jp], acc[ai][0][m][n][2 * jp + 1]}, b = (f32x2_){acc[ai][1][m][n][2 * jp], acc[ai][1][m][n][2 * jp + 1]};
                        const f32x2_ arg = a * c1; const f32x2_ den = (f32x2_){__builtin_amdgcn_exp2f(arg.x), __builtin_amdgcn_exp2f(arg.y)} + 1.0f;
                        const f32x2_ sg = (f32x2_){__builtin_amdgcn_rcpf(den.x), __builtin_amdgcn_rcpf(den.y)};
                        const f32x2_ r = (a * b) * (sg * c2); o[n * 4 + 2 * jp] = r.x; o[n * 4 + 2 * jp + 1] = r.y; }
                uint2 w; w.x = cvt4_fp8(o[0], o[1], o[2], o[3]); w.y = cvt4_fp8(o[4], o[5], o[6], o[7]);
                *(uint2*)rowp = w; }
    }
};
struct EpiScatter {
    static constexpr bool PERM = true, AFTER_DRAIN = false;
    struct Pf { uint2 r[2][4]; };
    __device__ __forceinline__ void prefetch(const Unit& u, int wr, int fr, Pf& pf) const {
#pragma unroll
        for (int ai = 0; ai < 2; ++ai)
#pragma unroll
            for (int m = 0; m < 4; ++m) { const int i = ai * HALF + wr * 64 + m * 16 + fr; pf.r[ai][m] = info[u.lb + (i < u.nv ? i : 0)]; } }
    bf16_t* Y2; const uint2* info; float scale;
    __device__ __forceinline__ void operator()(const f32x4 (&acc)[2][2][4][2], const Unit& u, int wr, int wc, int fr, int fq, const Pf& pf) const {
        const int col0 = u.pn * BM + wc * 32 + 8 * fq;
#pragma unroll
        for (int ai = 0; ai < 2; ++ai)
#pragma unroll
            for (int m = 0; m < 4; ++m) { const int i = ai * HALF + wr * 64 + m * 16 + fr;
                if (i < u.nv) { const uint2 inf = pf.r[ai][m]; const float w = __builtin_bit_cast(float, inf.y) * scale; bf16_t* rowp = Y2 + (size_t)inf.x * 1024 + col0;
#pragma unroll
                    for (int bj = 0; bj < 2; ++bj) { const f32x4 v0 = acc[ai][bj][m][0] * w, v1 = acc[ai][bj][m][1] * w;
                        u32x4 q; q.x = cvt_pk_bf16(v0[0], v0[1]); q.y = cvt_pk_bf16(v0[2], v0[3]); q.z = cvt_pk_bf16(v1[0], v1[1]); q.w = cvt_pk_bf16(v1[2], v1[3]);
                        *(u32x4*)(rowp + bj * HALF) = q; } } }
    }
};
struct MoeOrder {
    int G, c, cap; const PG8_LAS int* tab; const uint2* info;
    int pre[17], cnt[16];
    __device__ __forceinline__ void load() {
#pragma unroll
        for (int q = 0; q < 17; ++q) pre[q] = __builtin_amdgcn_readfirstlane(tab[q]);
#pragma unroll
        for (int q = 0; q < 16; ++q) cnt[q] = __builtin_amdgcn_readfirstlane(tab[17 + q]); }
    __device__ __forceinline__ bool next(int i, Unit& u) const {
        const int nwg = pre[16] * 4; const long L = (long)i * G + c; if (L >= nwg) return false;
        int wgid = (int)L; { const int q = nwg / NXCD, r = nwg % NXCD, xcd = wgid % NXCD, off = wgid / NXCD; wgid = (xcd < r ? xcd * (q + 1) : r * (q + 1) + (xcd - r) * q) + off; }
        const int gp = wgid >> 2; int e = 0;
#pragma unroll
        for (int q = 1; q < 16; ++q) e += (gp >= pre[q]) ? 1 : 0;
        int pe = pre[0], ne = cnt[0];
#pragma unroll
        for (int q = 1; q < 16; ++q) { pe = (e == q) ? pre[q] : pe; ne = (e == q) ? cnt[q] : ne; }
        const int p = gp - pe;
        u.pm = gp; u.pn = wgid & 3; u.pb = e * 4 + u.pn; u.lb = e * cap + 256 * p; u.nv = (ne - 256 * p) < 256 ? (ne - 256 * p) : 256; return true;
    }
    __device__ __forceinline__ void a_ready(const Unit&) const {}
    __device__ __forceinline__ void done(const Unit&) const {}
    __device__ __forceinline__ int row_of(const Unit& u, int i) const { return (int)(info[u.lb + (i < u.nv ? i : 0)].x >> 1); }
};
typedef int v4i_ __attribute__((ext_vector_type(4)));
typedef int v8i_ __attribute__((ext_vector_type(8)));
__device__ __forceinline__ v8i_ cat8(bf16x8 lo, bf16x8 hi) { return __builtin_shufflevector(__builtin_bit_cast(v4i_, lo), __builtin_bit_cast(v4i_, hi), 0, 1, 2, 3, 4, 5, 6, 7); }
template <class Epi, class Sched, bool GATHER = false, bool FP8 = false>
__device__ __forceinline__ void gemm_phase(PG8_LAS unsigned char* lds, const Gemm g, const Sched& S, const Epi& E) {
    int tid_ = threadIdx.x; asm volatile("" : "+v"(tid_));
    const int tid = tid_, wid = __builtin_amdgcn_readfirstlane(tid >> 6), lane = tid & 63, wr = wid >> 2, wc = wid & 3, fr = lane & 15, fq = lane >> 4;
    const int K = g.K, nt = K / BK;
    struct AO { unsigned i0, i1; };
    AO voffB;
    { int R, C; stage_rc(tid * 16, R, C); int Rb = Epi::PERM ? ((R & ~31) + perm32(R & 31)) : R; voffB.i0 = (unsigned)(Rb * K + C) * 2u;
      stage_rc(tid * 16 + 8192, R, C); Rb = Epi::PERM ? ((R & ~31) + perm32(R & 31)) : R; voffB.i1 = (unsigned)(Rb * K + C) * 2u; }
    const size_t kstep = (size_t)(BK * 2);
    const size_t hstep = (size_t)HALF * K * 2;
    const size_t tstep = 2 * hstep;
    const unsigned ldsw = (unsigned)wid * 1024u;
    const int aoff = lds_byte(wr * 64 + fr, fq * 8), boff = lds_byte(wc * 32 + fr, fq * 8);
#define PG8_SA(b, h) (((b) * 2 + (h)) * HTB)
#define PG8_SB(b, h) ((4 + (b) * 2 + (h)) * HTB)
#define PG8_STAGE1(bufoff, gb, vo, piece) do { unsigned _vo = (vo); asm volatile("" : "+v"(_vo));     \
        __builtin_amdgcn_global_load_lds((const unsigned*)((gb) + _vo), (PG8_LAS unsigned*)(lds + (bufoff) + ldsw + (piece) * 8192), 16, 0, 0); } while (0)
#define PG8_STAGE(bufoff, gbase, voff) do { const char* _gb = (const char*)(gbase); asm volatile("" : "+s"(_gb));     \
        PG8_STAGE1(bufoff, _gb, (voff).i0, 0); PG8_STAGE1(bufoff, _gb, (voff).i1, 1); } while (0)
#define PG8_LDA(dst, b, h) do { _Pragma("unroll") for (int m = 0; m < 4; ++m) _Pragma("unroll") for (int k = 0; k < 2; ++k) dst[m][k] = *(const PG8_LAS bf16x8*)(lds + PG8_SA(b, h) + aoff + m * 2048 + k * 1024); } while (0)
#define PG8_LDB(dst, b, h) do { _Pragma("unroll") for (int n = 0; n < 2; ++n) _Pragma("unroll") for (int k = 0; k < 2; ++k) dst[n][k] = *(const PG8_LAS bf16x8*)(lds + PG8_SB(b, h) + boff + n * 2048 + k * 1024); } while (0)
#define PG8_MMA(ai, bj, At, Bt) do { __builtin_amdgcn_s_setprio(1); _Pragma("unroll") for (int m = 0; m < 4; ++m) _Pragma("unroll") for (int n = 0; n < 2; ++n) { \
        if constexpr (FP8) { const v8i_ _b8 = cat8(Bt[n][0], Bt[n][1]), _a8 = cat8(At[m][0], At[m][1]);     \
            asm volatile("v_mfma_f32_16x16x128_f8f6f4 %0, %1, %2, %0" : "+v"(acc[ai][bj][m][n]) : "v"(_b8), "v"(_a8)); } \
        else { _Pragma("unroll") for (int k = 0; k < 2; ++k) acc[ai][bj][m][n] = __builtin_amdgcn_mfma_f32_16x16x32_bf16(Bt[n][k], At[m][k], acc[ai][bj][m][n], 0, 0, 0); } } __builtin_amdgcn_s_setprio(0); } while (0)
#define PG8_WAIT_V(n) asm volatile("s_waitcnt vmcnt(" #n ")" ::: "memory")
#define PG8_WAIT_L(n) asm volatile("s_waitcnt lgkmcnt(" #n ")" ::: "memory")
#define PG8_BAR __builtin_amdgcn_s_barrier()
#define PG8_SCHED __builtin_amdgcn_sched_barrier(0)
#define PG8_AOFF1(dst, u, _h, _i) do { int _R, _C; stage_rc(tid * 16 + (_i) * 8192, _R, _C); const int _row = GATHER ? S.row_of((u), (_h) * HALF + _R) : ((_h) * HALF + _R); (dst) = (unsigned)(_row * K + _C) * 2u; } while (0)
#define PG8_AOFFS(o0, o1, u) do { PG8_AOFF1((o0).i0, u, 0, 0); PG8_AOFF1((o0).i1, u, 0, 1); PG8_AOFF1((o1).i0, u, 1, 0); PG8_AOFF1((o1).i1, u, 1, 1); } while (0)
    Unit cur, nxt; int ui = 0;
    if (!S.next(0, cur)) return;
    typename Epi::Pf pf; E.prefetch(cur, wid >> 2, lane & 15, pf);
    f32x4 acc[2][2][4][2];
#pragma unroll
    for (int a = 0; a < 2; ++a)
#pragma unroll
        for (int b = 0; b < 2; ++b)
#pragma unroll
            for (int m = 0; m < 4; ++m)
#pragma unroll
                for (int n = 0; n < 2; ++n) acc[a][b][m][n] = (f32x4){0.f, 0.f, 0.f, 0.f};
    bf16x8 At[4][2], B0[2][2], B1[2][2];
    AO offA0, offA1, noffA0, noffA1;
    const char* cA = (const char*)g.A + (GATHER ? (size_t)0 : (size_t)cur.pm * tstep); const char* cB = (const char*)g.Bt + (size_t)cur.pb * tstep;
    S.a_ready(cur);
    PG8_AOFFS(offA0, offA1, cur); noffA0 = offA0; noffA1 = offA1;
    PG8_STAGE(PG8_SB(0, 0), cB, voffB); PG8_STAGE(PG8_SB(0, 1), cB + hstep, voffB); PG8_STAGE(PG8_SA(0, 0), cA, offA0); PG8_STAGE(PG8_SA(0, 1), cA, offA1);
    if (wr == 1) PG8_BAR;
    PG8_WAIT_V(2); PG8_BAR;
    PG8_STAGE(PG8_SB(1, 0), cB + kstep, voffB); PG8_STAGE(PG8_SA(1, 0), cA + kstep, offA0); PG8_STAGE(PG8_SB(1, 1), cB + hstep + kstep, voffB);
    PG8_WAIT_V(6); PG8_BAR;
    for (;;) {
        const bool has_next = S.next(ui + 1, nxt);
        const char* nA = has_next ? (const char*)g.A + (GATHER ? (size_t)0 : (size_t)nxt.pm * tstep) : cA; const char* nB = has_next ? (const char*)g.Bt + (size_t)nxt.pb * tstep : cB;
#pragma unroll 1
        for (int t = 0; t < nt; t += 2) {
            const bool last = (t == nt - 2);
            const char* a1 = cA + (size_t)(t + 1) * kstep;
            const char* a2 = last ? nA : cA + (size_t)(t + 2) * kstep; const char* b2 = last ? nB : cB + (size_t)(t + 2) * kstep;
            const char* a3 = a2 + kstep; const char* b3 = b2 + kstep;
            if (last && has_next) S.a_ready(nxt);
            AO o20, o21;
            if constexpr (GATHER) {
                if (last) { if (has_next) { PG8_AOFFS(noffA0, noffA1, nxt); } else { noffA0 = offA0; noffA1 = offA1; } }
                o20.i0 = last ? noffA0.i0 : offA0.i0; o20.i1 = last ? noffA0.i1 : offA0.i1; o21.i0 = last ? noffA1.i0 : offA1.i0; o21.i1 = last ? noffA1.i1 : offA1.i1;
            } else { o20 = offA0; o21 = offA1; }
            PG8_LDB(B0, 0, 0); PG8_LDB(B1, 0, 1); PG8_SCHED; PG8_LDA(At, 0, 0); PG8_STAGE(PG8_SA(1, 1), a1, offA1);
            PG8_WAIT_V(8); PG8_WAIT_L(0); PG8_BAR; PG8_MMA(0, 0, At, B0); PG8_MMA(0, 1, At, B1); PG8_BAR; PG8_SCHED;
            PG8_LDA(At, 0, 1); PG8_STAGE(PG8_SB(0, 0), b2, voffB); PG8_STAGE(PG8_SB(0, 1), b2 + hstep, voffB); PG8_STAGE(PG8_SA(0, 0), a2, o20);
            PG8_WAIT_V(8); PG8_WAIT_L(0); PG8_BAR; PG8_MMA(1, 0, At, B0); PG8_MMA(1, 1, At, B1); PG8_BAR; PG8_SCHED;
            PG8_LDB(B0, 1, 0); PG8_LDB(B1, 1, 1); PG8_SCHED; PG8_LDA(At, 1, 0); PG8_STAGE(PG8_SA(0, 1), a2, o21);
            PG8_WAIT_V(8); PG8_WAIT_L(0); PG8_BAR; PG8_MMA(0, 0, At, B0); PG8_MMA(0, 1, At, B1); PG8_BAR; PG8_SCHED;
            PG8_LDA(At, 1, 1); PG8_STAGE(PG8_SB(1, 0), b3, voffB); PG8_STAGE(PG8_SB(1, 1), b3 + hstep, voffB); PG8_STAGE(PG8_SA(1, 0), a3, o20);
            PG8_WAIT_V(8); PG8_WAIT_L(0); PG8_BAR; PG8_MMA(1, 0, At, B0); PG8_MMA(1, 1, At, B1); PG8_BAR; PG8_SCHED;
        }
        if (wr == 0) PG8_BAR;
        if constexpr (FP8) { PG8_SCHED; asm volatile("s_nop 7\n\ts_nop 7\n\ts_nop 3" ::: "memory"); PG8_SCHED; }
        E(acc, cur, wr, wc, fr, fq, pf); S.done(cur);
        if (has_next) E.prefetch(nxt, wr, fr, pf);
        if (!has_next) break;
#pragma unroll
        for (int a = 0; a < 2; ++a)
#pragma unroll
            for (int b = 0; b < 2; ++b)
#pragma unroll
                for (int m = 0; m < 4; ++m)
#pragma unroll
                    for (int n = 0; n < 2; ++n) acc[a][b][m][n] = (f32x4){0.f, 0.f, 0.f, 0.f};
        cur = nxt; cA = nA; cB = nB; ++ui;
        if constexpr (GATHER) { offA0 = noffA0; offA1 = noffA1; }
        if (wr == 1) PG8_BAR;
    }
    PG8_WAIT_V(0);
    PG8_BAR;
#undef PG8_SA
#undef PG8_SB
#undef PG8_STAGE
#undef PG8_LDA
#undef PG8_LDB
#undef PG8_MMA
#undef PG8_WAIT_V
#undef PG8_WAIT_L
#undef PG8_BAR
#undef PG8_SCHED
#undef PG8_AOFFS
}
}
#define GAS __attribute__((address_space(1)))
#define LAS __attribute__((address_space(3)))
typedef unsigned short bf16;
typedef unsigned v4u __attribute__((ext_vector_type(4)));
typedef float f32x4 __attribute__((ext_vector_type(4)));
typedef short bf16x8 __attribute__((ext_vector_type(8)));
typedef GAS unsigned gu32;
typedef GAS unsigned long long gu64;
#define RLX_AGENT __ATOMIC_RELAXED, __HIP_MEMORY_SCOPE_AGENT
#define LDS_WAIT() asm volatile("s_waitcnt lgkmcnt(0)" ::: "memory")
#define VM_WAIT() asm volatile("s_waitcnt vmcnt(0)" ::: "memory")
__device__ __forceinline__ unsigned long long rt() { return __builtin_amdgcn_s_memrealtime(); }
__device__ __forceinline__ unsigned f2bf(float f) { unsigned u = __builtin_bit_cast(unsigned, f); return (u + 0x7fffu + ((u >> 16) & 1u)) >> 16; }
__device__ __forceinline__ unsigned pk2(float lo, float hi) { return f2bf(lo) | (f2bf(hi) << 16); }

#define XB_TMO      128
#define XB_XCNT(j)  (256  + 64 * (j))
#define XB_XSUB(j)  (1280 + 64 * (j))
#define XB_XGEN(j)  (2304 + 64 * (j))
#define XB_TOP      3328
#define XB_TOPGEN   3392
#define XCD_BAR_WORDS 3456
#define XB_SPIN_CAP (1u << 18)

__device__ __forceinline__ unsigned xb_ld(unsigned* p)              { return __hip_atomic_load(p, __ATOMIC_RELAXED, __HIP_MEMORY_SCOPE_AGENT); }
__device__ __forceinline__ unsigned xb_add(unsigned* p, unsigned v) { return __hip_atomic_fetch_add(p, v, __ATOMIC_RELAXED, __HIP_MEMORY_SCOPE_AGENT); }
__device__ __forceinline__ unsigned xb_xcc_id() { return (unsigned)__builtin_amdgcn_s_getreg((3 << 11) | 20) & 0xFu; }
#define XB_SPIN(cond, bar) do { unsigned _sp = 0; while (cond) { __builtin_amdgcn_s_sleep(1); \
    if ((++_sp & 255u) == 0u) { if (xb_ld(&(bar)[XB_TMO])) break; if (_sp > XB_SPIN_CAP) { atomicAdd(&(bar)[XB_TMO], 1u); break; } } } } while (0)

struct XcdBarrier {
    unsigned* bar; unsigned x;
    volatile LAS unsigned* st;
};

__device__ __forceinline__ XcdBarrier xcd_barrier_post(unsigned* bar, volatile LAS unsigned* st) {
    XcdBarrier b; b.bar = bar; b.x = xb_xcc_id(); b.st = st;
    if (threadIdx.x == 0) (void)xb_add(&bar[XB_XCNT(b.x)], 1u);
    return b;
}
__device__ __forceinline__ void xcd_barrier_complete(unsigned* bar, unsigned x, unsigned& nloc, unsigned& nx) {
    const unsigned G = gridDim.x * gridDim.y * gridDim.z;
    unsigned sum, cnt, mine, sp = 0u;
    for (;;) {
        sum = 0u; cnt = 0u; mine = 0u;
#pragma unroll
        for (unsigned j = 0; j < 16; ++j) { const unsigned c = xb_ld(&bar[XB_XCNT(j)]); sum += c; cnt += (c > 0u) ? 1u : 0u; mine = (j == x) ? c : mine; }
        if (sum == G) break;
        __builtin_amdgcn_s_sleep(1);
        if ((++sp & 255u) == 0u) { if (xb_ld(&bar[XB_TMO])) break; if (sp > XB_SPIN_CAP) { atomicAdd(&bar[XB_TMO], 1u); break; } }
    }
    nloc = mine > 0u ? mine : 1u; nx = cnt > 0u ? cnt : 1u;
}

__device__ __forceinline__ void xcd_barrier(const XcdBarrier& b) {
    asm volatile("s_waitcnt vmcnt(0)" ::: "memory");
    __syncthreads();
    if (threadIdx.x == 0) {
        unsigned* bar = b.bar;
        __builtin_amdgcn_s_waitcnt(0);
        unsigned nloc = b.st[0], nx = b.st[1];
        if (nloc == 0u) { xcd_barrier_complete(bar, b.x, nloc, nx); b.st[0] = nloc; b.st[1] = nx; }
        const unsigned old = xb_add(&bar[XB_XSUB(b.x)], 1u);
        const unsigned gen = old / nloc;
        if (old + 1u == (gen + 1u) * nloc) {
            __builtin_amdgcn_fence(__ATOMIC_RELEASE, "agent");
            asm volatile("s_waitcnt vmcnt(0)" ::: "memory");
            const unsigned og = xb_add(&bar[XB_TOP], 1u);
            const unsigned tg = og / nx;
            if (og + 1u == (tg + 1u) * nx) xb_add(&bar[XB_TOPGEN], 1u);
            else XB_SPIN(xb_ld(&bar[XB_TOPGEN]) == tg, bar);
            __builtin_amdgcn_fence(__ATOMIC_ACQUIRE, "agent");
            xb_add(&bar[XB_XGEN(b.x)], 1u);
            asm volatile("s_waitcnt vmcnt(0)" ::: "memory");
        } else {
            XB_SPIN(xb_ld(&bar[XB_XGEN(b.x)]) == gen, bar);
            __builtin_amdgcn_fence(__ATOMIC_ACQUIRE, "agent");
            asm volatile("s_waitcnt vmcnt(0)" ::: "memory");
        }
    }
    __syncthreads();
}


constexpr int NWAVES = 8, NT = NWAVES * 64;
constexpr int D = 1024, BATCH = 8, SEQ = 4096, DEPTH = 2, GRIDW = 64, CTXL = 256, GWID = 256, HD = 64, NHEAD = 4;
constexpr int INC = 2048, NEXP = 16, MHID = 512;
constexpr int NLAT = BATCH * SEQ, NCTX = BATCH * CTXL, NROW = NLAT + NCTX;
constexpr float EPS = 1e-6f;
constexpr int UC_AV = 0, UC_AB = 256, UC_AC = 512, UC_P = 768, UC_Q = 1024, UC_K = 1280, UC_V = 1536, UC_F = 1792;

constexpr size_t MiB = 1u << 20;
constexpr size_t WS_CTL = 0, CTL_ZERO_BYTES = 65536;
constexpr size_t WS_MOD  = 1 * MiB;
constexpr size_t WS_RWT  = 1 * MiB + 896 * 1024;
constexpr size_t WS_PWT  = 1 * MiB + 768 * 1024;
constexpr size_t WS_INFO = 2 * MiB;
constexpr size_t WS_BM   = 7 * MiB;
constexpr size_t WS_WIN  = 8 * MiB;
constexpr size_t WS_WOUT = 16 * MiB;
constexpr size_t WS_W13  = 20 * MiB;
constexpr size_t WS_W2   = 84 * MiB;
constexpr size_t WS_XC   = 116 * MiB;
constexpr size_t WS_H    = 124 * MiB;
constexpr size_t WS_U    = 192 * MiB;
constexpr size_t WS_S    = 328 * MiB;
constexpr size_t WS_END  = 472 * MiB;
constexpr size_t WS_KF   = WS_S;
constexpr size_t WS_VF   = WS_S + 28 * MiB;
constexpr size_t WS_KFC  = WS_S + 60 * MiB;
constexpr size_t WS_VFC  = WS_S + 61 * MiB;
constexpr size_t WS_Z    = WS_S + 64 * MiB;
constexpr size_t NZ = (size_t)BATCH * NHEAD * SEQ * HD;
constexpr size_t NZC = (size_t)BATCH * NHEAD * CTXL * HD;
constexpr int CAP = NROW;

constexpr int CW_CNT = 2048;
constexpr int CW_BAR = 4096;

constexpr int RING_OFF = 0, RING_BYTES = 131072;
constexpr int LDSCTL_OFF = RING_BYTES, MISC_OFF = LDSCTL_OFF + 320;
constexpr int TAB_OFF = RING_BYTES + 1024;
constexpr int LDS_BYTES = 147456;

struct Frame {
    LAS unsigned char* lds;
    volatile LAS unsigned* MISC;
    gu32* ctl;
    int tid, lane, wave, G, bid;
    float* out; unsigned char* ws;
    static __device__ __forceinline__ const void* karg(int off) {
        const __attribute__((address_space(4))) char* ka = (const __attribute__((address_space(4))) char*)__builtin_amdgcn_kernarg_segment_ptr();
        asm volatile("" : "+s"(ka));
        return *(const void* const __attribute__((address_space(4)))*)(ka + off);
    }
    __device__ __forceinline__ const float* inp(int i) const { return (const float*)karg(8 * i); }
};
extern __shared__ __attribute__((aligned(16))) unsigned char dyn_lds[];
__device__ __forceinline__ Frame mk_frame() {
    Frame F; int t_ = threadIdx.x; asm volatile("" : "+v"(t_));
    F.tid = t_; F.lane = F.tid & 63; F.wave = __builtin_amdgcn_readfirstlane(F.tid >> 6); F.G = gridDim.x; F.bid = blockIdx.x;
    F.lds = (LAS unsigned char*)dyn_lds; F.MISC = (volatile LAS unsigned*)(F.lds + MISC_OFF);
    F.out = (float*)Frame::karg(160); F.ws = (unsigned char*)Frame::karg(168); F.ctl = (gu32*)(F.ws + WS_CTL);
    return F;
}
enum { I_X = 0, I_C, I_CTX, I_CCTX, I_ADAW, I_ADAB, I_N1G, I_N2G, I_WIN, I_CONVW, I_POOLW, I_POOLS, I_RPB, I_WOUT, I_RW, I_RB, I_W1, I_W3, I_W2, I_FG };

__device__ __forceinline__ float wave_sum(float v) {
#pragma unroll
    for (int o = 1; o < 64; o <<= 1) v += __shfl_xor(v, o);
    return v;
}
__device__ __forceinline__ float bflo(unsigned w) { return __builtin_bit_cast(float, w << 16); }
__device__ __forceinline__ float bfhi(unsigned w) { return __builtin_bit_cast(float, w & 0xffff0000u); }
__device__ __forceinline__ float bf2f(bf16 b) { return __builtin_bit_cast(float, (unsigned)b << 16); }

__device__ __forceinline__ void tr_item(const float* W, int K, int N, bf16* WT, int k0, int n0, int drow0, LAS float* scr, int lane) {
#pragma unroll
    for (int i = 0; i < 8; ++i) { const int kk = 8 * i + (lane >> 3), n4 = 4 * (lane & 7); const f32x4 w = __builtin_nontemporal_load((const GAS f32x4*)(W + (size_t)(k0 + kk) * N + n0 + n4));
        LAS float* sp = scr + kk * 33 + n4; sp[0] = w.x; sp[1] = w.y; sp[2] = w.z; sp[3] = w.w; }
    LDS_WAIT(); asm volatile("" ::: "memory");
    const int c = lane & 7;
#pragma unroll
    for (int j = 0; j < 4; ++j) { const int n = (lane >> 3) + 8 * j; const LAS float* s = scr + (8 * c) * 33 + n;
        v4u o; o.x = pk2(s[0 * 33], s[1 * 33]); o.y = pk2(s[2 * 33], s[3 * 33]); o.z = pk2(s[4 * 33], s[5 * 33]); o.w = pk2(s[6 * 33], s[7 * 33]);
        *(GAS v4u*)(WT + (size_t)(drow0 + n) * K + k0 + 8 * c) = o; }
    LDS_WAIT(); asm volatile("" ::: "memory");
}
__device__ __forceinline__ void tr_item8(const float* W, int K, int N, unsigned char* WT, int k0, int n0, int drow0, LAS float* scr, int lane) {
#pragma unroll
    for (int i = 0; i < 8; ++i) { const int kk = 8 * i + (lane >> 3), n4 = 4 * (lane & 7); const f32x4 w = __builtin_nontemporal_load((const GAS f32x4*)(W + (size_t)(k0 + kk) * N + n0 + n4));
        LAS float* sp = scr + kk * 33 + n4; sp[0] = w.x; sp[1] = w.y; sp[2] = w.z; sp[3] = w.w; }
    LDS_WAIT(); asm volatile("" ::: "memory");
    const int c = lane & 7;
#pragma unroll
    for (int j = 0; j < 4; ++j) { const int n = (lane >> 3) + 8 * j; const LAS float* s = scr + (8 * c) * 33 + n; constexpr float f = pg8::F8_W;
        const unsigned long long o = (unsigned long long)pg8::cvt4_fp8(s[0 * 33] * f, s[1 * 33] * f, s[2 * 33] * f, s[3 * 33] * f) | ((unsigned long long)pg8::cvt4_fp8(s[4 * 33] * f, s[5 * 33] * f, s[6 * 33] * f, s[7 * 33] * f) << 32);
        __builtin_nontemporal_store(o, (GAS unsigned long long*)(WT + (size_t)(drow0 + n) * K + k0 + 8 * c)); }
    LDS_WAIT(); asm volatile("" ::: "memory");
}
__device__ __forceinline__ void bias_table(Frame& F, int l);
__device__ __forceinline__ void pa_phase() { Frame F = mk_frame();
    bias_table(F, 0); bias_table(F, 1);
    LAS float* scr = (LAS float*)(F.lds + RING_OFF + F.wave * 16384);
    const int gw = F.bid * NWAVES + F.wave, NGW = F.G * NWAVES;
    bf16* WIN = (bf16*)(F.ws + WS_WIN); bf16* WOUT = (bf16*)(F.ws + WS_WOUT); unsigned char* W13 = F.ws + WS_W13; unsigned char* W2 = F.ws + WS_W2;
    constexpr int I_IN = 2 * 16 * 64, I_OUT = 2 * 16 * 32, I_1 = 32 * 16 * 16, I_2 = 32 * 8 * 32;
    constexpr int NITEMS = I_IN + I_OUT + 2 * I_1 + I_2;
    const bool bal = (F.G == 256); const int nstr = bal ? 13 * NGW : NITEMS;
    for (int k = 0; ; ++k) {
        int it;
        if (k * NGW + gw < nstr) it = k * NGW + gw;
        else { if (!bal || F.bid < 192) break; const int k2 = k - 13; if (k2 >= 2) break; it = nstr + k2 * 512 + (gw - 192 * NWAVES); if (it >= NITEMS) break; }
        int r = it;
        if (r < I_IN) { const int l = r / 1024, q = r % 1024, kb = q / 64, nb = q % 64;
            tr_item(F.inp(I_WIN) + (size_t)l * D * INC, D, INC, WIN + (size_t)l * INC * D, 64 * kb, 32 * nb, 32 * nb, scr, F.lane); continue; } r -= I_IN;
        if (r < I_OUT) { const int l = r / 512, q = r % 512, kb = q / 32, nb = q % 32;
            tr_item(F.inp(I_WOUT) + (size_t)l * D * D, D, D, WOUT + (size_t)l * D * D, 64 * kb, 32 * nb, 32 * nb, scr, F.lane); continue; } r -= I_OUT;
        if (r < 2 * I_1) { const int which = r / I_1; const int q0 = r % I_1; const int le = q0 / 256, q = q0 % 256, kb = q / 16, nb = q % 16;
            const int n0 = 32 * nb; const int drow0 = 256 * (n0 / 128) + 128 * which + (n0 % 128);
            tr_item8(F.inp(which ? I_W3 : I_W1) + (size_t)le * D * MHID, D, MHID, W13 + (size_t)le * 1024 * D, 64 * kb, n0, drow0, scr, F.lane); continue; } r -= 2 * I_1;
        { const int le = r / 256, q = r % 256, kb = q / 32, nb = q % 32;
            tr_item8(F.inp(I_W2) + (size_t)le * MHID * D, MHID, D, W2 + (size_t)le * D * MHID, 64 * kb, 32 * nb, 32 * nb, scr, F.lane); }
    }
    { bf16* RWT = (bf16*)(F.ws + WS_RWT); const float* rwp = F.inp(I_RW);
      for (int i = F.bid * NT + F.tid; i < 16 * 1032; i += F.G * NT) { const int e = i / 1032, k = i % 1032; RWT[i] = k < 1024 ? (bf16)f2bf(rwp[k * 16 + e]) : (bf16)0; } }
    { bf16* PWT = (bf16*)(F.ws + WS_PWT); const float* pw = F.inp(I_POOLW);
      for (int i = F.bid * NT + F.tid; i < 2 * 4 * 64 * 64; i += F.G * NT) { const int c = i & 63, dd = (i >> 6) & 63, lg = i >> 12; PWT[i] = (bf16)f2bf(pw[((size_t)lg * 64 + c) * 64 + dd]); } }
    __syncthreads();
    LAS float* sc = (LAS float*)(F.lds + RING_OFF);
    LAS float* part = (LAS float*)(F.lds + RING_OFF + 40960);
    float* MOD = (float*)(F.ws + WS_MOD);
    bool have_sc = false;
    for (int it = F.bid; it < 2 * 96; it += F.G) {
        if (!have_sc) { for (int i = F.tid; i < 9 * 1024; i += NT) { const float v = i < 8192 ? F.inp(I_C)[i] : F.inp(I_CCTX)[i - 8192]; sc[i] = v / (1.0f + __expf(-v)); } have_sc = true; }
        __syncthreads();
        const int l = it / 96, cb = it % 96, col = cb * 64 + F.lane;
        const float* aw = F.inp(I_ADAW) + (size_t)l * D * 6144 + col;
        float acc[9];
#pragma unroll
        for (int r = 0; r < 9; ++r) acc[r] = 0.f;
        for (int k0 = F.wave * 128; k0 < F.wave * 128 + 128; k0 += 16) { float wv[16];
#pragma unroll
            for (int kk = 0; kk < 16; ++kk) wv[kk] = __builtin_nontemporal_load(aw + (size_t)(k0 + kk) * 6144);
#pragma unroll
            for (int kk = 0; kk < 16; ++kk)
#pragma unroll
                for (int r = 0; r < 9; ++r) acc[r] += sc[r * 1024 + k0 + kk] * wv[kk]; }
#pragma unroll
        for (int r = 0; r < 9; ++r) part[(F.wave * 9 + r) * 64 + F.lane] = acc[r];
        __syncthreads();
        for (int i = F.tid; i < 9 * 64; i += NT) { const int r = i >> 6, ln = i & 63; float s = F.inp(I_ADAB)[(size_t)l * 6144 + cb * 64 + ln];
#pragma unroll
            for (int w = 0; w < 8; ++w) s += part[(w * 9 + r) * 64 + ln];
            MOD[((size_t)l * 9 + r) * 6144 + cb * 64 + ln] = s; }
        __syncthreads();
    }
}

typedef unsigned v2u_ __attribute__((ext_vector_type(2)));
__device__ __forceinline__ unsigned cvt_pk_bf(float lo, float hi) { unsigned r; asm volatile("v_cvt_pk_bf16_f32 %0, %1, %2" : "=v"(r) : "v"(lo), "v"(hi)); return r; }
struct XStream { const char* lat; const char* ctx; int lat_stride, ctx_stride;
    __device__ __forceinline__ const char* row(int r) const { return r < NLAT ? lat + (size_t)r * lat_stride : ctx + (size_t)(r - NLAT) * ctx_stride; } };
struct RowIn { f32x4 x[4]; v4u xb[2], ya[2], yb[2]; };
__device__ __forceinline__ f32x4 unpk_h(v4u a, int h) { const unsigned w0 = h ? a.z : a.x, w1 = h ? a.w : a.y; f32x4 y; y.x = bflo(w0); y.y = bfhi(w0); y.z = bflo(w1); y.w = bfhi(w1); return y; }
template <int ADD, bool XBF>
__device__ __forceinline__ void row_load(Frame& F, int r, const char* xr, const bf16* Y2, RowIn& in) {
#pragma unroll
    for (int j = 0; j < 2; ++j) { const int c = 8 * F.lane + 512 * j;
        if (XBF) in.xb[j] = __builtin_nontemporal_load((const GAS v4u*)(xr + 2 * c)); else { in.x[2 * j] = __builtin_nontemporal_load((const GAS f32x4*)(xr + 4 * c)); in.x[2 * j + 1] = __builtin_nontemporal_load((const GAS f32x4*)(xr + 4 * c + 16)); }
        if (ADD == 1) { in.ya[j] = __builtin_nontemporal_load((const GAS v4u*)(Y2 + (size_t)r * 2048 + c)); in.yb[j] = __builtin_nontemporal_load((const GAS v4u*)(Y2 + (size_t)r * 2048 + 1024 + c)); }
        if (ADD == 2) { in.ya[j] = __builtin_nontemporal_load((const GAS v4u*)(Y2 + (size_t)r * 1024 + c)); } }
}
struct RowPar { f32x4 a[4], b[4], gt[4]; int modrow; };
template <int ADD, bool FINAL>
__device__ __forceinline__ void row_params(Frame& F, int modrow, const float* g, const float* modl, const float* modadd, int ch_sh, int ch_sc, RowPar& P) {
    P.modrow = modrow;
#pragma unroll
    for (int k = 0; k < 4; ++k) { const int c = 8 * F.lane + 512 * (k >> 1) + 4 * (k & 1); const f32x4 gv = *(const GAS f32x4*)(g + c);
        if (FINAL) { P.a[k] = gv; P.b[k] = (f32x4){0.f, 0.f, 0.f, 0.f}; }
        else { const float* mrow = modl + (size_t)modrow * 6144; P.a[k] = gv * (*(const GAS f32x4*)(mrow + ch_sc * 1024 + c) + 1.0f); P.b[k] = *(const GAS f32x4*)(mrow + ch_sh * 1024 + c); }
        if (ADD) P.gt[k] = *(const GAS f32x4*)(modadd + (size_t)modrow * 6144 + (ADD == 1 ? 5 : 2) * 1024 + c); else P.gt[k] = (f32x4){0.f, 0.f, 0.f, 0.f}; }
#pragma unroll
    for (int k = 0; k < 4; ++k) asm volatile("" : "+v"(P.a[k]), "+v"(P.b[k]), "+v"(P.gt[k]));
}
__device__ __forceinline__ v4u pk8_bf(const f32x4 a, const f32x4 b) { v4u w; w.x = cvt_pk_bf(a.x, a.y); w.y = cvt_pk_bf(a.z, a.w); w.z = cvt_pk_bf(b.x, b.y); w.w = cvt_pk_bf(b.z, b.w); return w; }
template <int ADD, bool FINAL, bool XBF, bool DST8 = false>
__device__ __forceinline__ void row_finish(Frame& F, const RowIn& in, const RowPar& P, char* xw, bf16* dst, float* fout, f32x4 (&v)[4]) {
    float ss = 0.f;
#pragma unroll
    for (int j = 0; j < 2; ++j) { const int c = 8 * F.lane + 512 * j;
#pragma unroll
        for (int h = 0; h < 2; ++h) { const int k = 2 * j + h; v[k] = XBF ? unpk_h(in.xb[j], h) : in.x[k];
            if (ADD) { f32x4 ya = unpk_h(in.ya[j], h); if (ADD == 1) ya = ya + unpk_h(in.yb[j], h);
                v[k] = v[k] + P.gt[k] * ya; }
            ss += (v[k].x * v[k].x + v[k].y * v[k].y) + (v[k].z * v[k].z + v[k].w * v[k].w); }
        if (ADD && !FINAL) *(GAS v4u*)(xw + 2 * c) = pk8_bf(v[2 * j], v[2 * j + 1]); }
    ss = wave_sum(ss);
    const float rstd = 1.0f / sqrtf(ss * (1.0f / D) + EPS);
#pragma unroll
    for (int j = 0; j < 2; ++j) { const int c = 8 * F.lane + 512 * j;
        if (FINAL) { *(GAS f32x4*)(fout + c) = v[2 * j] * rstd * P.a[2 * j]; *(GAS f32x4*)(fout + c + 4) = v[2 * j + 1] * rstd * P.a[2 * j + 1]; }
        else { v[2 * j] = v[2 * j] * rstd * P.a[2 * j] + P.b[2 * j]; v[2 * j + 1] = v[2 * j + 1] * rstd * P.a[2 * j + 1] + P.b[2 * j + 1];
            if (DST8) { const f32x4 s0 = v[2 * j] * pg8::F8_ACT, s1 = v[2 * j + 1] * pg8::F8_ACT;
                *(GAS v2u_*)((char*)dst + c) = (v2u_){pg8::cvt4_fp8(s0.x, s0.y, s0.z, s0.w), pg8::cvt4_fp8(s1.x, s1.y, s1.z, s1.w)}; }
            else *(GAS v4u*)(dst + c) = pk8_bf(v[2 * j], v[2 * j + 1]); } }
}
template <int ADD, bool FINAL, bool XBF>
__device__ __forceinline__ void norm_phase(Frame& F, const XStream xin, const XStream xout, int nrows, const float* g, const float* modl, const float* modadd, int ch_sh, int ch_sc, bf16* dst, const bf16* Y2, float* fout) {
    const int rpb = (nrows + F.G - 1) / F.G;
    int i = F.wave; int r = F.bid * rpb + i; if (i >= rpb || r >= nrows) return;
    RowPar P; P.modrow = -1;
    const int last_i = (rpb - 1 < nrows - 1 - F.bid * rpb) ? rpb - 1 : nrows - 1 - F.bid * rpb;
    auto rowof = [&](int ii) { return F.bid * rpb + (ii <= last_i ? ii : i); };
    RowIn ra, rb, rc;
    row_load<ADD, XBF>(F, r, xin.row(r), Y2, ra);
    { const int r1 = rowof(i + NWAVES); row_load<ADD, XBF>(F, r1, xin.row(r1), Y2, rb); }
    auto step = [&](RowIn& cur, RowIn& fill) __attribute__((always_inline)) {
        const int rr = F.bid * rpb + i;
        const int modrow = rr < NLAT ? (rr >> 12) : 8;
        if (modrow != P.modrow) row_params<ADD, FINAL>(F, modrow, g, modl, modadd, ch_sh, ch_sc, P);
        const int r2 = rowof(i + 2 * NWAVES);
        row_load<ADD, XBF>(F, r2, xin.row(r2), Y2, fill);
        f32x4 v[4];
        row_finish<ADD, FINAL, XBF>(F, cur, P, (char*)xout.row(rr), dst + (size_t)rr * D, fout + (size_t)rr * D, v);
    };
    const bool lockstep = (rpb % NWAVES == 0) && ((F.bid + 1) * rpb <= nrows);
    for (;;) {
        if (lockstep) __syncthreads(); step(ra, rc); i += NWAVES; if (i > last_i) break;
        if (lockstep) __syncthreads(); step(rb, ra); i += NWAVES; if (i > last_i) break;
        if (lockstep) __syncthreads(); step(rc, rb); i += NWAVES; if (i > last_i) break;
    }
}
template <bool XBF>
__device__ __forceinline__ void route_phase(Frame& F, int l, const XStream xin, const XStream xout, const bf16* O, int nrows, const float* g, const float* modl, bf16* dst, uint2* info, unsigned* cnt) {
    LAS int* lcnt = (LAS int*)(F.lds + TAB_OFF); LAS int* lbase = lcnt + 16; LAS int* rec_e = lcnt + 32; LAS int* rec_p = rec_e + 512; LAS float* rec_w = (LAS float*)(rec_p + 512);
    const int rpb = (nrows + F.G - 1) / F.G;
    if (F.tid < 16) lcnt[F.tid] = 0;
    constexpr int RPITCH = 2064;
    LAS float* LG = (LAS float*)(F.lds + RING_OFF);
    LAS unsigned char* WTb = F.lds + RING_OFF + 17408;
    LAS unsigned char* RB = F.lds + RING_OFF + 17408 + 16 * RPITCH + F.wave * (4 * RPITCH);
    { const unsigned char* rwt = F.ws + WS_RWT; for (int c = F.tid; c < 16 * RPITCH / 16; c += NT) *(LAS v4u*)(WTb + c * 16) = *(const GAS v4u*)(rwt + (size_t)c * 16); }
    __syncthreads();
    const float* rbp = F.inp(I_RB);
    RowPar P; P.modrow = -1; int slot = 0, i0 = 0;
    RowIn cur; bool have = (F.wave < rpb) && (F.bid * rpb + F.wave < nrows);
    if (have) { const int r = F.bid * rpb + F.wave; row_load<2, XBF>(F, r, xin.row(r), O, cur); }
    for (int i = F.wave; have; i += NWAVES) {
        const int r = F.bid * rpb + i;
        const int in_ = i + NWAVES, rn = F.bid * rpb + in_; const bool more = (in_ < rpb) && (rn < nrows);
        RowIn nxt;
        if (more) row_load<2, XBF>(F, rn, xin.row(rn), O, nxt);
        f32x4 v[4];
        { const int modrow = r < NLAT ? (r >> 12) : 8; if (modrow != P.modrow) row_params<2, false>(F, modrow, g, modl, modl, 3, 4, P); }
        row_finish<2, false, XBF, true>(F, cur, P, (char*)xout.row(r), (bf16*)((char*)dst + (size_t)r * D), nullptr, v);
        { LAS unsigned char* rb = RB + slot * RPITCH + 16 * F.lane;
#pragma unroll
          for (int j = 0; j < 2; ++j) *(LAS v4u*)(rb + 1024 * j) = pk8_bf(v[2 * j], v[2 * j + 1]); }
        if (slot == 0) i0 = i;
        ++slot;
        if (slot == 4 || !more) {
            LDS_WAIT(); asm volatile("" ::: "memory");
            const int q = F.lane & 15, g = F.lane >> 4;
            const LAS unsigned char* ap = RB + (q & 3) * RPITCH + 16 * g; const LAS unsigned char* bp = WTb + q * RPITCH + 16 * g;
            f32x4 lacc[4];
#pragma unroll
            for (int c = 0; c < 4; ++c) lacc[c] = (f32x4){0.f, 0.f, 0.f, 0.f};
#pragma unroll
            for (int ks = 0; ks < 32; ++ks) lacc[ks & 3] = __builtin_amdgcn_mfma_f32_16x16x32_bf16(*(const LAS bf16x8*)(ap + 64 * ks), *(const LAS bf16x8*)(bp + 64 * ks), lacc[ks & 3], 0, 0, 0);
            const f32x4 lg = (lacc[0] + lacc[1]) + (lacc[2] + lacc[3]);
            if (F.lane < 16) {
#pragma unroll
                for (int k = 0; k < 4; ++k) if (k < slot) LG[(i0 + 8 * k) * 17 + F.lane] = lg[k]; }
            LDS_WAIT(); asm volatile("" ::: "memory");
            slot = 0;
        }
        have = more; cur = nxt;
    }
    __syncthreads();
    for (int i = F.tid; i < rpb; i += NT) { if (F.bid * rpb + i >= nrows) break;
        float s16[16], bs[16];
#pragma unroll
        for (int e = 0; e < 16; ++e) { s16[e] = __builtin_amdgcn_rcpf(1.0f + __expf(-LG[i * 17 + e])); bs[e] = s16[e] + rbp[e]; }
        float best = -3.0e38f; int bg = 0;
#pragma unroll
        for (int gq = 0; gq < 4; ++gq) { const float a0 = bs[4 * gq], a1 = bs[4 * gq + 1], a2 = bs[4 * gq + 2], a3 = bs[4 * gq + 3];
            const float gs = fmaxf(fmaxf(fmaxf(a0 + a1, a0 + a2), fmaxf(a0 + a3, a1 + a2)), fmaxf(a1 + a3, a2 + a3));
            if (gs > best) { best = gs; bg = gq; } }
        float cb[4], cs[4];
#pragma unroll
        for (int ii = 0; ii < 4; ++ii) { cb[ii] = 0.f; cs[ii] = 0.f; }
#pragma unroll
        for (int gq = 0; gq < 4; ++gq)
#pragma unroll
            for (int ii = 0; ii < 4; ++ii) { cb[ii] = (gq == bg) ? bs[4 * gq + ii] : cb[ii]; cs[ii] = (gq == bg) ? s16[4 * gq + ii] : cs[ii]; }
        int i1 = 0; float b1 = cb[0], s1 = cs[0];
#pragma unroll
        for (int ii = 1; ii < 4; ++ii) if (cb[ii] > b1) { b1 = cb[ii]; s1 = cs[ii]; i1 = ii; }
        int i2 = -1; float b2 = -3.0e38f, s2 = 0.f;
#pragma unroll
        for (int ii = 0; ii < 4; ++ii) if (ii != i1 && cb[ii] > b2) { b2 = cb[ii]; s2 = cs[ii]; i2 = ii; }
        const float inv = 1.0f / (s1 + s2);
        const int e1 = 4 * bg + i1, e2 = 4 * bg + i2;
        rec_e[2 * i] = e1; rec_p[2 * i] = atomicAdd((int*)&lcnt[e1], 1); rec_w[2 * i] = s1 * inv;
        rec_e[2 * i + 1] = e2; rec_p[2 * i + 1] = atomicAdd((int*)&lcnt[e2], 1); rec_w[2 * i + 1] = s2 * inv;
    }
    __syncthreads();
    if (F.tid < 16) lbase[F.tid] = (int)__hip_atomic_fetch_add(cnt + F.tid, (unsigned)lcnt[F.tid], __ATOMIC_RELAXED, __HIP_MEMORY_SCOPE_AGENT);
    __syncthreads();
    for (int j = F.tid; j < 2 * rpb; j += NT) { const int r = F.bid * rpb + (j >> 1); if (r < nrows) { const int e = rec_e[j];
        info[(size_t)e * CAP + lbase[e] + rec_p[j]] = make_uint2((unsigned)(r * 2 + (j & 1)), __builtin_bit_cast(unsigned, rec_w[j])); } }
}
__device__ __forceinline__ void moe_table(Frame& F, int l) {
    LAS int* tab = (LAS int*)(F.lds + TAB_OFF);
    if (F.tid < 64) {
        const unsigned* cnt = (const unsigned*)(F.ctl + CW_CNT + l * 16);
        const int n = F.tid < 16 ? (int)__hip_atomic_load(cnt + F.tid, __ATOMIC_RELAXED, __HIP_MEMORY_SCOPE_AGENT) : 0;
        const int np = (n + 255) >> 8; int x = np;
#pragma unroll
        for (int d = 1; d < 16; d <<= 1) { const int y = __shfl_up(x, d); if (F.lane >= d) x += y; }
        if (F.tid < 16) { tab[F.tid] = x - np; tab[17 + F.tid] = n; }
        if (F.tid == 15) tab[16] = x;
    }
    __syncthreads();
}

__device__ __forceinline__ void seq_info(int r, int& base, int& t, int& L) {
    if (r < NLAT) { base = r & ~(SEQ - 1); t = r & (SEQ - 1); L = SEQ; } else { const int j = r - NLAT; base = NLAT + (j & ~(CTXL - 1)); t = j & (CTXL - 1); L = CTXL; }
}
typedef unsigned v2u __attribute__((ext_vector_type(2)));
__device__ __forceinline__ unsigned cvtpk(float lo, float hi) { unsigned r; asm volatile("v_cvt_pk_bf16_f32 %0, %1, %2" : "=v"(r) : "v"(lo), "v"(hi)); return r; }
__device__ __forceinline__ bf16x8 mk8(v2u a, v2u b) { v4u w; w.x = a.x; w.y = a.y; w.z = b.x; w.w = b.y; return __builtin_bit_cast(bf16x8, w); }
constexpr float A8_S = 16.0f;
__device__ __forceinline__ v2u bf8_to_fp8(v4u w) {
    v2u r; r.x = pg8::cvt4_fp8(bflo(w.x) * A8_S, bfhi(w.x) * A8_S, bflo(w.y) * A8_S, bfhi(w.y) * A8_S); r.y = pg8::cvt4_fp8(bflo(w.z) * A8_S, bfhi(w.z) * A8_S, bflo(w.w) * A8_S, bfhi(w.w) * A8_S); return r; }
template <bool LAT>
__device__ __forceinline__ void kv_unit(Frame& F, int bh, int rq, LAS unsigned short* T) {
    const bf16* U = (const bf16*)(F.ws + WS_U);
    const int q = F.lane & 15, g = F.lane >> 4, h = bh & 3;
    const int urow0 = LAT ? ((bh >> 2) * SEQ + rq * 64) : (NLAT + (bh >> 2) * CTXL + rq * 64);
    unsigned char* kdst = LAT ? F.ws + WS_KF + ((size_t)(bh * 64 + rq) * 7) * 1024 : F.ws + WS_KFC + ((size_t)(bh * 16 + rq * 4)) * 1024;
    unsigned char* vdst = LAT ? F.ws + WS_VF + ((size_t)(bh * 64 + rq) * 8) * 1024 : F.ws + WS_VFC + ((size_t)(bh * 8 + rq * 2) * 2) * 1024;
    { const bf16* src = U + (size_t)(urow0 + F.lane) * INC + UC_V + h * HD;
      v4u vw[8];
#pragma unroll
      for (int p = 0; p < 8; ++p) vw[p] = *(const GAS v4u*)(src + 8 * p);
#pragma unroll
      for (int p = 0; p < 8; ++p) { const v4u w = vw[p]; LAS unsigned short* tp = T + (8 * p) * 72 + F.lane;
          tp[0 * 72] = (unsigned short)w.x; tp[1 * 72] = (unsigned short)(w.x >> 16); tp[2 * 72] = (unsigned short)w.y; tp[3 * 72] = (unsigned short)(w.y >> 16);
          tp[4 * 72] = (unsigned short)w.z; tp[5 * 72] = (unsigned short)(w.z >> 16); tp[6 * 72] = (unsigned short)w.w; tp[7 * 72] = (unsigned short)(w.w >> 16); } }
    constexpr int NK = LAT ? 7 : 4, KST = LAT ? 8 : 16;
    { v4u kw[NK][2];
#pragma unroll
      for (int sidx = 0; sidx < NK; ++sidx)
#pragma unroll
          for (int ks = 0; ks < 2; ++ks) kw[sidx][ks] = *(const GAS v4u*)(U + (size_t)(urow0 + KST * sidx + q) * INC + UC_K + h * HD + 32 * ks + 8 * g);
      __builtin_amdgcn_sched_barrier(0);
#pragma unroll
      for (int sidx = 0; sidx < NK; ++sidx) { const v2u a = bf8_to_fp8(kw[sidx][0]), b = bf8_to_fp8(kw[sidx][1]); v4u o; o.x = a.x; o.y = a.y; o.z = b.x; o.w = b.y;
          *(GAS v4u*)(kdst + (size_t)sidx * 1024 + F.lane * 16) = o; } }
    LDS_WAIT(); asm volatile("" ::: "memory");
    constexpr int NV = LAT ? 4 : 2;
#pragma unroll
    for (int w = 0; w < NV; ++w) { const int vst = LAT ? (w == 0 ? 0 : (w == 1 ? 8 : (w == 2 ? 24 : 32))) : 32 * w;
#pragma unroll
        for (int dtp = 0; dtp < 2; ++dtp) { v4u o;
#pragma unroll
            for (int e = 0; e < 2; ++e) { const int dt = 2 * dtp + e; const LAS unsigned short* tp = T + (16 * dt + q) * 72 + vst + 4 * g; const v2u lo = *(const LAS v2u*)tp, hi = *(const LAS v2u*)(tp + 16);
                v4u w8; w8.x = lo.x; w8.y = lo.y; w8.z = hi.x; w8.w = hi.y; const v2u c = bf8_to_fp8(w8); if (e == 0) { o.x = c.x; o.y = c.y; } else { o.z = c.x; o.w = c.y; } }
            *(GAS v4u*)(vdst + (size_t)(w * 2 + dtp) * 1024 + F.lane * 16) = o; } }
    LDS_WAIT(); asm volatile("" ::: "memory");
}
__device__ __forceinline__ void kv_prepass(Frame& F) {
    LAS unsigned short* T = (LAS unsigned short*)(F.lds + RING_OFF + F.wave * 16384);
    const int gw = F.bid * NWAVES + F.wave, NGW = F.G * NWAVES;
#pragma unroll 1
    for (int idx = gw; idx < 2048; idx += NGW) kv_unit<true>(F, idx >> 6, idx & 63, T);
#pragma unroll 1
    for (int idx = (gw + NGW - (32 * NWAVES) % NGW) % NGW; idx < 128; idx += NGW) kv_unit<false>(F, idx >> 2, idx & 3, T);
}
__device__ __forceinline__ void bias_table(Frame& F, int l) {
    bf16* BM = (bf16*)(F.ws + WS_BM) + (size_t)l * 245760; const float* rp = F.inp(I_RPB) + (size_t)l * NHEAD * 15 * 31;
    for (int i = F.bid * NT + F.tid; i < 4 * 4 * 15 * 64 * 8; i += F.G * NT) {
        const int e = i & 7, lane = (i >> 3) & 63, rrel = (i >> 9) % 15, hc = (i >> 9) / 15, cb = hc & 3, h = hc >> 2;
        const int q = lane & 15, g = lane >> 4, seg = e >> 2, ii = e & 3;
        const int wb = cb * 16 - 8 < 0 ? 0 : (cb * 16 - 8 > 32 ? 32 : cb * 16 - 8);
        const int cq = cb * 16 + q, c0 = cq - 8 < 0 ? 0 : (cq - 8 > 48 ? 48 : cq - 8), cc = wb + seg * 16 + 4 * g + ii;
        const bool ok = (cc >= c0) && (cc < c0 + 16);
        BM[i] = (bf16)f2bf(ok ? rp[(h * 15 + rrel) * 31 + (cc - cq + 15)] * 1.44269504f : -1.0e30f);
    }
}
template <bool LAT>
__device__ __forceinline__ void attn_unit(Frame& F, int l, int b, int h, int r, int cb, const LAS float* rpbs) {
    const bf16* U = (const bf16*)(F.ws + WS_U); bf16* Y = (bf16*)(F.ws + WS_H);
    const unsigned char* KF = F.ws + WS_KF; const unsigned char* VF = F.ws + WS_VF; const unsigned char* KFC = F.ws + WS_KFC; const unsigned char* VFC = F.ws + WS_VFC;
    const size_t bh = (size_t)(b * NHEAD + h);
    const int q = F.lane & 15, g = F.lane >> 4;
    constexpr int NT_ = LAT ? 32 : 16, NB = LAT ? 16 : 0;
    const int qrow = LAT ? (b * SEQ + r * GRIDW + cb * 16 + q) : (NLAT + b * CTXL + cb * 16 + q);
    const int r0 = r - 4 < 0 ? 0 : (r - 4 > 56 ? 56 : r - 4);
    const int wb = cb * 16 - 8 < 0 ? 0 : (cb * 16 - 8 > 32 ? 32 : cb * 16 - 8);
    long qf[2];
#pragma unroll
    for (int ks = 0; ks < 2; ++ks) { const v2u c = bf8_to_fp8(*(const GAS v4u*)(U + (size_t)qrow * INC + UC_Q + h * HD + 32 * ks + 8 * g)); qf[ks] = (long)(((unsigned long long)c.y << 32) | c.x); }
    f32x4 s[NT_];
#pragma unroll
    for (int t = 0; t < NT_; ++t) {
        const unsigned char* kp;
        if (t < NB) { const int kr = t >> 1, seg = t & 1; kp = KF + ((bh * 64 + (r0 + kr)) * 7 + ((wb >> 3) + 2 * seg)) * 1024 + F.lane * 16; } else kp = KFC + (bh * 16 + (t - NB)) * 1024 + F.lane * 16;
        const v4u kk2 = *(const GAS v4u*)kp;
        f32x4 a = (f32x4){0.f, 0.f, 0.f, 0.f};
        a = __builtin_amdgcn_mfma_f32_16x16x32_fp8_fp8((long)(((unsigned long long)kk2.y << 32) | kk2.x), qf[0], a, 0, 0, 0);
        s[t] = __builtin_amdgcn_mfma_f32_16x16x32_fp8_fp8((long)(((unsigned long long)kk2.w << 32) | kk2.z), qf[1], a, 0, 0, 0);
    }
    constexpr float SC = 1.44269504f * 0.125f / (A8_S * A8_S);
    float m = -3.0e38f;
    if (LAT) {
        const bf16* bm = (const bf16*)(F.ws + WS_BM) + (size_t)l * 245760 + ((size_t)((h * 4 + cb) * 15 + (r0 - r + 7)) * 64 + F.lane) * 8;
#pragma unroll
        for (int kr = 0; kr < 8; ++kr) { const v4u bw = *(const GAS v4u*)(bm + kr * 512);
            const f32x4 b0 = (f32x4){bflo(bw.x), bfhi(bw.x), bflo(bw.y), bfhi(bw.y)}, b1 = (f32x4){bflo(bw.z), bfhi(bw.z), bflo(bw.w), bfhi(bw.w)};
#pragma unroll
            for (int i = 0; i < 4; ++i) { const float v0 = s[2 * kr][i] * SC + b0[i], v1 = s[2 * kr + 1][i] * SC + b1[i]; s[2 * kr][i] = v0; s[2 * kr + 1][i] = v1; m = fmaxf(m, fmaxf(v0, v1)); } }
    }
#pragma unroll
    for (int t = NB; t < NT_; ++t)
#pragma unroll
        for (int i = 0; i < 4; ++i) { const float v = s[t][i] * SC; s[t][i] = v; m = fmaxf(m, v); }
    m = fmaxf(m, __shfl_xor(m, 16)); m = fmaxf(m, __shfl_xor(m, 32));
    m -= 8.0f;
    float sum = 0.f;
#pragma unroll
    for (int t = 0; t < NT_; ++t)
#pragma unroll
        for (int i = 0; i < 4; ++i) { const float p = __builtin_amdgcn_exp2f(s[t][i] - m); s[t][i] = p; sum += p; }
    sum += __shfl_xor(sum, 16); sum += __shfl_xor(sum, 32);
    f32x4 o[4];
#pragma unroll
    for (int dt = 0; dt < 4; ++dt) o[dt] = (f32x4){0.f, 0.f, 0.f, 0.f};
#pragma unroll
    for (int kk = 0; kk < NT_ / 2; ++kk) {
        const unsigned plo = pg8::cvt4_fp8(s[2 * kk][0], s[2 * kk][1], s[2 * kk][2], s[2 * kk][3]), phi = pg8::cvt4_fp8(s[2 * kk + 1][0], s[2 * kk + 1][1], s[2 * kk + 1][2], s[2 * kk + 1][3]);
        const long pf = (long)(((unsigned long long)phi << 32) | plo);
        const unsigned char* vbase;
        if (2 * kk < NB) vbase = VF + (((bh * 64 + (r0 + kk)) * 4 + cb) * 2) * 1024 + F.lane * 16; else vbase = VFC + ((bh * 8 + (kk - NB / 2)) * 2) * 1024 + F.lane * 16;
#pragma unroll
        for (int dtp = 0; dtp < 2; ++dtp) { const v4u vv = *(const GAS v4u*)(vbase + dtp * 1024);
            o[2 * dtp] = __builtin_amdgcn_mfma_f32_16x16x32_fp8_fp8((long)(((unsigned long long)vv.y << 32) | vv.x), pf, o[2 * dtp], 0, 0, 0);
            o[2 * dtp + 1] = __builtin_amdgcn_mfma_f32_16x16x32_fp8_fp8((long)(((unsigned long long)vv.w << 32) | vv.z), pf, o[2 * dtp + 1], 0, 0, 0); }
    }
    const float inv = 1.0f / (sum * A8_S); bf16* yp = Y + (size_t)qrow * D + 512 + h * HD + 4 * g;
#pragma unroll
    for (int dt = 0; dt < 4; ++dt) { v2u w; w.x = cvtpk(o[dt][0] * inv, o[dt][1] * inv); w.y = cvtpk(o[dt][2] * inv, o[dt][3] * inv); *(GAS v2u*)(yp + dt * 16) = w; }
}
__device__ __forceinline__ void attn_phase(Frame& F, int l, bool with_ctx) {
    const LAS float* rpbs = nullptr;
    const int gw = F.bid * NWAVES + F.wave, NGW = F.G * NWAVES;
    {
        const int x = F.bid & 7, lb = F.bid >> 3, nlb = (F.G - x + 7) >> 3;
#pragma unroll 1
        for (int uu = lb * NWAVES + F.wave; uu < 1024; uu += nlb * NWAVES) { const int bh = 4 * x + (uu >> 8), u = uu & 255; attn_unit<true>(F, l, bh >> 2, bh & 3, u >> 2, u & 3, rpbs); } }
    if (with_ctx) for (int uid = gw; uid < BATCH * NHEAD * 16; uid += NGW) { const int cb = uid & 15, h = (uid >> 4) & 3, b = uid >> 6; attn_unit<false>(F, l, b, h, 0, cb, rpbs); }
}
__device__ __forceinline__ void dft64_tables(Frame& F, int off) {
    LAS unsigned short* CT = (LAS unsigned short*)(F.lds + off); LAS unsigned short* ST = CT + 64 * 72;
    for (int i = F.tid; i < 4096; i += NT) { const int j = i >> 6, k = i & 63; const float rv = (float)((j * k) & 63) * (1.0f / 64.0f); const float s_ = __builtin_amdgcn_sinf(rv), c_ = __builtin_amdgcn_cosf(rv);     CT[j * 72 + k] = (unsigned short)f2bf(c_); ST[j * 72 + k] = (unsigned short)f2bf(s_); }
}
__device__ __forceinline__ void fourier_a(Frame& F) {
    const bf16* U = (const bf16*)(F.ws + WS_U); bf16* Zr = (bf16*)(F.ws + WS_Z); bf16* Zi = Zr + NZ;
    constexpr int O_CT = 0, O_TWC = 18432, O_TWS = O_TWC + 16384;
    const int q = F.lane & 15, g = F.lane >> 4;
    const int gw = F.bid * NWAVES + F.wave, NGW = F.G * NWAVES;
    bf16x8 tfa[2][4];
    auto tf_load = [&](int un) { const int b = un >> 8, h = (un >> 6) & 3, n2 = un & 63;
#pragma unroll
        for (int ks = 0; ks < 2; ++ks)
#pragma unroll
            for (int mt = 0; mt < 4; ++mt) tfa[ks][mt] = *(const GAS bf16x8*)(U + (size_t)(b * SEQ + 64 * (16 * mt + q) + n2) * INC + UC_F + h * HD + 32 * ks + 8 * g); };
    if (gw < BATCH * NHEAD * 64) tf_load(gw);
    dft64_tables(F, O_CT);
    { LAS float* twc = (LAS float*)(F.lds + O_TWC); LAS float* tws = (LAS float*)(F.lds + O_TWS);
      for (int i = F.tid; i < 4096; i += NT) { const float rv = (float)i * (1.0f / 4096.0f); const float s_ = __builtin_amdgcn_sinf(rv), c_ = __builtin_amdgcn_cosf(rv); twc[i] = c_; tws[i] = s_; } }
    __syncthreads();
    const LAS unsigned short* CT = (const LAS unsigned short*)(F.lds + O_CT); const LAS unsigned short* ST = CT + 64 * 72;
    const LAS float* twc = (const LAS float*)(F.lds + O_TWC); const LAS float* tws = (const LAS float*)(F.lds + O_TWS);
    for (int un = gw; un < BATCH * NHEAD * 64; un += NGW) {
        if (un != gw) tf_load(un);
        const int b = un >> 8, h = (un >> 6) & 3, n2 = un & 63;
        f32x4 xr[4][4], xw[4][4];
#pragma unroll
        for (int mt = 0; mt < 4; ++mt)
#pragma unroll
            for (int ct = 0; ct < 4; ++ct) { xr[mt][ct] = (f32x4){0.f, 0.f, 0.f, 0.f}; xw[mt][ct] = (f32x4){0.f, 0.f, 0.f, 0.f}; }
        __builtin_amdgcn_sched_barrier(0);
#pragma unroll
        for (int ks = 0; ks < 2; ++ks) {
            bf16x8 tf[4], cf[4], sf[4];
#pragma unroll
            for (int mt = 0; mt < 4; ++mt) tf[mt] = tfa[ks][mt];
#pragma unroll
            for (int ct = 0; ct < 4; ++ct) { cf[ct] = *(const LAS bf16x8*)(CT + (16 * ct + q) * 72 + 32 * ks + 8 * g); sf[ct] = *(const LAS bf16x8*)(ST + (16 * ct + q) * 72 + 32 * ks + 8 * g); }
#pragma unroll
            for (int mt = 0; mt < 4; ++mt)
#pragma unroll
                for (int ct = 0; ct < 4; ++ct) { xr[mt][ct] = __builtin_amdgcn_mfma_f32_16x16x32_bf16(tf[mt], cf[ct], xr[mt][ct], 0, 0, 0); xw[mt][ct] = __builtin_amdgcn_mfma_f32_16x16x32_bf16(tf[mt], sf[ct], xw[mt][ct], 0, 0, 0); }
        }
        __builtin_amdgcn_sched_barrier(0); asm volatile("s_nop 7\n\ts_nop 7" ::: "memory"); __builtin_amdgcn_sched_barrier(0);
        v4u ar[4][2], awn[4][2];
#pragma unroll
        for (int ct = 0; ct < 4; ++ct)
#pragma unroll
            for (int kb = 0; kb < 2; ++kb) {
                ar[ct][kb].x = cvtpk(xr[2 * kb][ct][0], xr[2 * kb][ct][1]); ar[ct][kb].y = cvtpk(xr[2 * kb][ct][2], xr[2 * kb][ct][3]);
                ar[ct][kb].z = cvtpk(xr[2 * kb + 1][ct][0], xr[2 * kb + 1][ct][1]); ar[ct][kb].w = cvtpk(xr[2 * kb + 1][ct][2], xr[2 * kb + 1][ct][3]);
                awn[ct][kb].x = cvtpk(-xw[2 * kb][ct][0], -xw[2 * kb][ct][1]); awn[ct][kb].y = cvtpk(-xw[2 * kb][ct][2], -xw[2 * kb][ct][3]);
                awn[ct][kb].z = cvtpk(-xw[2 * kb + 1][ct][0], -xw[2 * kb + 1][ct][1]); awn[ct][kb].w = cvtpk(-xw[2 * kb + 1][ct][2], -xw[2 * kb + 1][ct][3]); }
#pragma unroll
        for (int rt = 0; rt < 4; ++rt) {
            const int n1p = 16 * rt + q;
            bf16x8 cb_[2], sb_[2];
#pragma unroll
            for (int kb = 0; kb < 2; ++kb) { const LAS unsigned short* cp = CT + n1p * 72 + 32 * kb + 4 * g; const LAS unsigned short* sp = ST + n1p * 72 + 32 * kb + 4 * g;
                cb_[kb] = mk8(*(const LAS v2u*)cp, *(const LAS v2u*)(cp + 16)); sb_[kb] = mk8(*(const LAS v2u*)sp, *(const LAS v2u*)(sp + 16)); }
            const int tix = n2 * n1p; const float cw = twc[tix], sw = tws[tix];
            const size_t zbase = ((((size_t)(b * NHEAD + h) * 64 + n1p) * 64 + n2) * 64) + 4 * g;
#pragma unroll
            for (int ct = 0; ct < 4; ++ct) {
                f32x4 yr = (f32x4){0.f, 0.f, 0.f, 0.f}, yi = (f32x4){0.f, 0.f, 0.f, 0.f};
#pragma unroll
                for (int kb = 0; kb < 2; ++kb) {
                    const bf16x8 a_r = __builtin_bit_cast(bf16x8, ar[ct][kb]), a_wn = __builtin_bit_cast(bf16x8, awn[ct][kb]);
                    v4u nr = ar[ct][kb]; nr.x ^= 0x80008000u; nr.y ^= 0x80008000u; nr.z ^= 0x80008000u; nr.w ^= 0x80008000u; const bf16x8 a_rn = __builtin_bit_cast(bf16x8, nr);
                    yr = __builtin_amdgcn_mfma_f32_16x16x32_bf16(a_r, cb_[kb], yr, 0, 0, 0); yr = __builtin_amdgcn_mfma_f32_16x16x32_bf16(a_wn, sb_[kb], yr, 0, 0, 0);
                    yi = __builtin_amdgcn_mfma_f32_16x16x32_bf16(a_wn, cb_[kb], yi, 0, 0, 0); yi = __builtin_amdgcn_mfma_f32_16x16x32_bf16(a_rn, sb_[kb], yi, 0, 0, 0); }
                v2u wr_, wi_;
                wr_.x = cvtpk(yr[0] * cw + yi[0] * sw, yr[1] * cw + yi[1] * sw); wr_.y = cvtpk(yr[2] * cw + yi[2] * sw, yr[3] * cw + yi[3] * sw);
                wi_.x = cvtpk(yi[0] * cw - yr[0] * sw, yi[1] * cw - yr[1] * sw); wi_.y = cvtpk(yi[2] * cw - yr[2] * sw, yi[3] * cw - yr[3] * sw);
                *(GAS v2u*)(Zr + zbase + 16 * ct) = wr_; *(GAS v2u*)(Zi + zbase + 16 * ct) = wi_;
            }
        }
    }
}
__device__ __forceinline__ void fourier_b(Frame& F, bool with_ctx) {
    bf16* Y = (bf16*)(F.ws + WS_H); const bf16* Zr = (const bf16*)(F.ws + WS_Z);
    const LAS unsigned short* CT = (const LAS unsigned short*)(F.lds); const LAS unsigned short* ST = CT + 64 * 72;
    LAS unsigned short* ZT = (LAS unsigned short*)(F.lds + 18432 + F.wave * 9216);
    const int q = F.lane & 15, g = F.lane >> 4;
    const int gw = F.bid * NWAVES + F.wave, NGW = F.G * NWAVES;
    const int nun = BATCH * NHEAD * 64 + (with_ctx ? BATCH * NHEAD * 4 : 0);
    const bool bal = (F.G == 256) && with_ctx;
    for (int it = 0; ; ++it) {
        int un;
        if (!bal) { un = gw + it * NGW; if (un >= nun) break; }
        else if (it == 0) un = gw;
        else if (it == 1 && gw >= 64 * NWAVES && gw < 64 * NWAVES + BATCH * NHEAD * 4) un = BATCH * NHEAD * 64 + (gw - 64 * NWAVES);
        else break;
        const bool lat = un < BATCH * NHEAD * 64; const int uc = un - BATCH * NHEAD * 64;
        const int b = lat ? (un >> 8) : (uc >> 4), h = lat ? ((un >> 6) & 3) : ((uc >> 2) & 3), n1p = lat ? (un & 63) : (uc & 3);
        const size_t z0 = lat ? (((size_t)(b * NHEAD + h) * 64 + n1p) * 64) * 64 : 2 * NZ + (((size_t)(b * NHEAD + h) * 4 + n1p) * 64) * 64;
        const size_t zim = lat ? NZ : NZC;
        const int tok0 = lat ? (b * SEQ + n1p) : (NLAT + b * CTXL + n1p), tstride = lat ? 64 : 4; const float oscale = lat ? (1.0f / 512.0f) : (1.0f / 128.0f);
        f32x4 acc[4][4];
#pragma unroll
        for (int ct = 0; ct < 4; ++ct)
#pragma unroll
            for (int nt = 0; nt < 4; ++nt) acc[ct][nt] = (f32x4){0.f, 0.f, 0.f, 0.f};
#pragma unroll
        for (int comp = 0; comp < 2; ++comp) {
            const bf16* zp = Zr + z0 + (comp ? zim : 0); const LAS unsigned short* FT = comp ? ST : CT;
#pragma unroll
            for (int i = 0; i < 8; ++i) { const int p = F.lane + 64 * i, n2 = p >> 3, c8 = p & 7; const v4u w = __builtin_nontemporal_load((const GAS v4u*)(zp + (size_t)n2 * 64 + 8 * c8)); LAS unsigned short* tp = ZT + (8 * c8) * 72 + n2;
                tp[0 * 72] = (unsigned short)w.x; tp[1 * 72] = (unsigned short)(w.x >> 16); tp[2 * 72] = (unsigned short)w.y; tp[3 * 72] = (unsigned short)(w.y >> 16);
                tp[4 * 72] = (unsigned short)w.z; tp[5 * 72] = (unsigned short)(w.z >> 16); tp[6 * 72] = (unsigned short)w.w; tp[7 * 72] = (unsigned short)(w.w >> 16); }
            LDS_WAIT(); asm volatile("" ::: "memory");
#pragma unroll
            for (int ks = 0; ks < 2; ++ks) {
                bf16x8 af[4], bf_[4];
#pragma unroll
                for (int ct = 0; ct < 4; ++ct) af[ct] = *(const LAS bf16x8*)(ZT + (16 * ct + q) * 72 + 32 * ks + 8 * g);
#pragma unroll
                for (int nt = 0; nt < 4; ++nt) bf_[nt] = *(const LAS bf16x8*)(FT + (16 * nt + q) * 72 + 32 * ks + 8 * g);
#pragma unroll
                for (int ct = 0; ct < 4; ++ct)
#pragma unroll
                    for (int nt = 0; nt < 4; ++nt) acc[ct][nt] = __builtin_amdgcn_mfma_f32_16x16x32_bf16(af[ct], bf_[nt], acc[ct][nt], 0, 0, 0);
            }
            LDS_WAIT(); asm volatile("" ::: "memory");
        }
#pragma unroll
        for (int nt = 0; nt < 4; ++nt) { bf16* yp = Y + (size_t)(tok0 + tstride * (16 * nt + q)) * D + 768 + h * HD + 4 * g;
#pragma unroll
            for (int ct = 0; ct < 4; ++ct) { v2u w; w.x = cvtpk(acc[ct][nt][0] * oscale, acc[ct][nt][1] * oscale); w.y = cvtpk(acc[ct][nt][2] * oscale, acc[ct][nt][3] * oscale); *(GAS v2u*)(yp + 16 * ct) = w; } }
    }
}
__device__ __forceinline__ v4u mul_bf8(v4u a, v4u b) { v4u r; r.x = cvtpk(bflo(a.x) * bflo(b.x), bfhi(a.x) * bfhi(b.x)); r.y = cvtpk(bflo(a.y) * bflo(b.y), bfhi(a.y) * bfhi(b.y)); r.z = cvtpk(bflo(a.z) * bflo(b.z), bfhi(a.z) * bfhi(b.z)); r.w = cvtpk(bflo(a.w) * bflo(b.w), bfhi(a.w) * bfhi(b.w)); return r; }
__device__ __forceinline__ void convpool_phase(Frame& F, int l, int nrows) {
    const bf16* __restrict__ U = (const bf16*)(F.ws + WS_U); bf16* __restrict__ Y = (bf16*)(F.ws + WS_H);
    const bf16* PWT = (const bf16*)(F.ws + WS_PWT) + (size_t)l * 4 * 64 * 64;
    const float* cw = F.inp(I_CONVW) + (size_t)l * 3 * GWID; const float* ps = F.inp(I_POOLS) + (size_t)l * GWID;
    LAS unsigned* PX = (LAS unsigned*)(F.lds + RING_OFF + F.wave * 16384);
    LAS unsigned* DT = PX + 32 * 64;
    const int q = F.lane & 15, g = F.lane >> 4;
    const int c8 = F.tid & 31, tt = F.wave >> 1, ch = F.wave & 1;
    const f32x4 w0a = *(const GAS f32x4*)(cw + 8 * c8), w0b = *(const GAS f32x4*)(cw + 8 * c8 + 4), w1a = *(const GAS f32x4*)(cw + GWID + 8 * c8), w1b = *(const GAS f32x4*)(cw + GWID + 8 * c8 + 4),
                w2a = *(const GAS f32x4*)(cw + 2 * GWID + 8 * c8), w2b = *(const GAS f32x4*)(cw + 2 * GWID + 8 * c8 + 4);
    bf16x8 wf[2][4][2]; f32x4 psc[2][4];
#pragma unroll
    for (int gs = 0; gs < 2; ++gs)
#pragma unroll
        for (int dt = 0; dt < 4; ++dt) { const int gi = 2 * ch + gs; psc[gs][dt] = *(const GAS f32x4*)(ps + gi * 64 + 16 * dt + 4 * g);
#pragma unroll
            for (int ks = 0; ks < 2; ++ks) wf[gs][dt][ks] = *(const GAS bf16x8*)(PWT + ((size_t)gi * 64 + 16 * dt + q) * 64 + 32 * ks + 8 * g); }
    for (int tile = F.bid; tile < nrows / 64; tile += F.G) {
        const int r0 = tile * 64; int base, t0, L; seq_info(r0, base, t0, L);
        v4u pw_[8];
#pragma unroll
        for (int i = 0; i < 8; ++i) { const int p = F.lane + 64 * i, rr = p >> 4, c16 = p & 15, t = t0 + 16 * tt - 8 + rr; const bool in_ = (t >= 0) && (t < L); const int tc = in_ ? t : t0;
            const v4u w = *(const GAS v4u*)(U + (size_t)(base + tc) * INC + UC_P + ch * 128 + 8 * c16);
            pw_[i].x = in_ ? w.x : 0u; pw_[i].y = in_ ? w.y : 0u; pw_[i].z = in_ ? w.z : 0u; pw_[i].w = in_ ? w.w : 0u; }
        { const int rg = F.tid >> 5; const bf16* ub = U + (size_t)(r0 + 4 * rg) * INC + 8 * c8;
          v4u z[6];
#pragma unroll
          for (int hb = 0; hb < 2; ++hb) {
            constexpr int dummy = 0; (void)dummy;
            v4u zc_[4], zv_[4], ab_[2];
            const int i0 = hb == 0 ? 0 : 4, ni = hb == 0 ? 4 : 2;
#pragma unroll
            for (int i = 0; i < 4; ++i) if (i < ni) { zc_[i] = *(const GAS v4u*)(ub + (ptrdiff_t)(i0 + i - 1) * INC + UC_AC); zv_[i] = *(const GAS v4u*)(ub + (ptrdiff_t)(i0 + i - 1) * INC + UC_AV); }
#pragma unroll
            for (int j = 0; j < 2; ++j) ab_[j] = *(const GAS v4u*)(ub + (size_t)(2 * hb + j) * INC + UC_AB);
            __builtin_amdgcn_sched_barrier(0);
#pragma unroll
            for (int i = 0; i < 4; ++i) if (i < ni) z[i0 + i] = mul_bf8(zc_[i], zv_[i]);
#pragma unroll
            for (int jj = 0; jj < 2; ++jj) { const int j = 2 * hb + jj, tr = 4 * rg + j, t = t0 + tr;
                const v4u zc = z[j + 1]; v4u zp = z[j], zn = z[j + 2]; const v4u ab = ab_[jj];
                { const bool hp = t > 0, hn = t < L - 1; zp.x = hp ? zp.x : 0u; zp.y = hp ? zp.y : 0u; zp.z = hp ? zp.z : 0u; zp.w = hp ? zp.w : 0u; zn.x = hn ? zn.x : 0u; zn.y = hn ? zn.y : 0u; zn.z = hn ? zn.z : 0u; zn.w = hn ? zn.w : 0u; }
                v4u o;
                o.x = cvtpk(bflo(ab.x) * (w0a.x * bflo(zp.x) + w1a.x * bflo(zc.x) + w2a.x * bflo(zn.x)), bfhi(ab.x) * (w0a.y * bfhi(zp.x) + w1a.y * bfhi(zc.x) + w2a.y * bfhi(zn.x)));
                o.y = cvtpk(bflo(ab.y) * (w0a.z * bflo(zp.y) + w1a.z * bflo(zc.y) + w2a.z * bflo(zn.y)), bfhi(ab.y) * (w0a.w * bfhi(zp.y) + w1a.w * bfhi(zc.y) + w2a.w * bfhi(zn.y)));
                o.z = cvtpk(bflo(ab.z) * (w0b.x * bflo(zp.z) + w1b.x * bflo(zc.z) + w2b.x * bflo(zn.z)), bfhi(ab.z) * (w0b.y * bfhi(zp.z) + w1b.y * bfhi(zc.z) + w2b.y * bfhi(zn.z)));
                o.w = cvtpk(bflo(ab.w) * (w0b.z * bflo(zp.w) + w1b.z * bflo(zc.w) + w2b.z * bflo(zn.w)), bfhi(ab.w) * (w0b.w * bfhi(zp.w) + w1b.w * bfhi(zc.w) + w2b.w * bfhi(zn.w)));
                *(GAS v4u*)(Y + (size_t)(r0 + tr) * D + 8 * c8) = o; }
            __builtin_amdgcn_sched_barrier(0);
          }
        }
#pragma unroll
        for (int i = 0; i < 8; ++i) { const int p = F.lane + 64 * i, rr = p >> 4, c16 = p & 15; *(LAS v4u*)(PX + rr * 64 + 4 * c16) = pw_[i]; }
        LDS_WAIT(); asm volatile("" ::: "memory");
        { const int hw = 1 << (2 * ch + (F.lane >> 5));
          float s0 = 0.f, s1 = 0.f;
          for (int k = -hw; k < hw; ++k) { const unsigned w = PX[(8 + k) * 64 + F.lane]; s0 += bflo(w); s1 += bfhi(w); }
          for (int i = 0; i < 16; ++i) { const int t = t0 + 16 * tt + i;
              const int lo = t - hw > 0 ? t - hw : 0, hi = t + hw < L ? t + hw : L; const float rc = __builtin_amdgcn_rcpf((float)(hi - lo));
              const unsigned xc = PX[(i + 8) * 64 + F.lane];
              DT[i * 68 + F.lane] = cvtpk(s0 * rc - bflo(xc), s1 * rc - bfhi(xc));
              const unsigned wa = PX[(i + 8 + hw) * 64 + F.lane], wsb = PX[(i + 8 - hw) * 64 + F.lane];
              s0 += bflo(wa) - bflo(wsb); s1 += bfhi(wa) - bfhi(wsb); } }
        LDS_WAIT(); asm volatile("" ::: "memory");
#pragma unroll
        for (int gs = 0; gs < 2; ++gs) { const int gi = 2 * ch + gs;
            bf16x8 df[2];
#pragma unroll
            for (int ks = 0; ks < 2; ++ks) df[ks] = *(const LAS bf16x8*)(DT + q * 68 + gs * 32 + 16 * ks + 4 * g);
#pragma unroll
            for (int dt = 0; dt < 4; ++dt) { f32x4 a = (f32x4){0.f, 0.f, 0.f, 0.f};
                a = __builtin_amdgcn_mfma_f32_16x16x32_bf16(wf[gs][dt][0], df[0], a, 0, 0, 0); a = __builtin_amdgcn_mfma_f32_16x16x32_bf16(wf[gs][dt][1], df[1], a, 0, 0, 0);
                const int oc = gi * 64 + 16 * dt + 4 * g; const f32x4 sc = psc[gs][dt];
                v2u w; w.x = cvtpk(a[0] * sc.x, a[1] * sc.y); w.y = cvtpk(a[2] * sc.z, a[3] * sc.w);
                *(GAS v2u*)(Y + (size_t)(r0 + 16 * tt + q) * D + 256 + oc) = w; } }
        LDS_WAIT(); asm volatile("" ::: "memory");
    }
    __syncthreads();
}

__device__ __forceinline__ void fourier_ctx_a(Frame& F) {
    const bf16* U = (const bf16*)(F.ws + WS_U); bf16* Zc = (bf16*)(F.ws + WS_Z) + 2 * NZ;
    LAS float* cs = (LAS float*)(F.lds + TAB_OFF); LAS float* sn = cs + 64; LAS float* cs256 = cs + 128; LAS float* sn256 = cs + 384;
    if (F.tid < 64) { const float rv = (float)F.tid * (1.0f / 64.0f); cs[F.tid] = __builtin_amdgcn_cosf(rv); sn[F.tid] = __builtin_amdgcn_sinf(rv); }
    if (F.tid < 256) { const float rv = (float)F.tid * (1.0f / 256.0f); cs256[F.tid] = __builtin_amdgcn_cosf(rv); sn256[F.tid] = __builtin_amdgcn_sinf(rv); }
    __syncthreads();
    for (int item = F.bid * NT + F.tid; item < BATCH * NHEAD * 64 * 64; item += F.G * NT) {
        const int cp = item & 63, n2 = (item >> 6) & 63, h = (item >> 12) & 3, b = item >> 14;
        float xr[4], xi[4];
#pragma unroll
        for (int n1 = 0; n1 < 4; ++n1) { xr[n1] = 0.f; xi[n1] = 0.f; }
        for (int c8 = 0; c8 < 8; ++c8) {
            float cc[8], ss[8];
#pragma unroll
            for (int e = 0; e < 8; ++e) { const int idx = ((8 * c8 + e) * cp) & 63; cc[e] = cs[idx]; ss[e] = sn[idx]; }
#pragma unroll
            for (int n1 = 0; n1 < 4; ++n1) { const v4u w = *(const GAS v4u*)(U + (size_t)(NLAT + b * CTXL + 64 * n1 + n2) * INC + UC_F + h * HD + 8 * c8);
                const float f0 = bflo(w.x), f1 = bfhi(w.x), f2 = bflo(w.y), f3 = bfhi(w.y), f4 = bflo(w.z), f5 = bfhi(w.z), f6 = bflo(w.w), f7 = bfhi(w.w);
                xr[n1] += f0 * cc[0] + f1 * cc[1] + f2 * cc[2] + f3 * cc[3] + f4 * cc[4] + f5 * cc[5] + f6 * cc[6] + f7 * cc[7];
                xi[n1] -= f0 * ss[0] + f1 * ss[1] + f2 * ss[2] + f3 * ss[3] + f4 * ss[4] + f5 * ss[5] + f6 * ss[6] + f7 * ss[7]; }
        }
        float yr[4], yi[4];
        yr[0] = xr[0] + xr[1] + xr[2] + xr[3];           yi[0] = xi[0] + xi[1] + xi[2] + xi[3];
        yr[1] = xr[0] + xi[1] - xr[2] - xi[3];           yi[1] = xi[0] - xr[1] - xi[2] + xr[3];
        yr[2] = xr[0] - xr[1] + xr[2] - xr[3];           yi[2] = xi[0] - xi[1] + xi[2] - xi[3];
        yr[3] = xr[0] - xi[1] - xr[2] + xi[3];           yi[3] = xi[0] + xr[1] - xi[2] - xr[3];
#pragma unroll
        for (int k = 0; k < 4; ++k) { const int tix = (n2 * k) & 255; const float cw = cs256[tix], sw = sn256[tix];
            const size_t zi = ((((size_t)(b * NHEAD + h) * 4 + k) * 64 + n2) * 64) + cp;
            Zc[zi] = (bf16)f2bf(yr[k] * cw + yi[k] * sw); Zc[NZC + zi] = (bf16)f2bf(yi[k] * cw - yr[k] * sw); }
    }
}

__device__ __forceinline__ void mixa_phase(int l, bool with_ctx) { Frame F = mk_frame();
    const int nrows = with_ctx ? NROW : NLAT;
    convpool_phase(F, l, nrows);
    kv_prepass(F);
    __syncthreads();
    fourier_a(F);
    __syncthreads();
    if (with_ctx) fourier_ctx_a(F);
}
__device__ __forceinline__ void mixb_phase(int l, bool with_ctx) { Frame F = mk_frame();
    dft64_tables(F, 0);
    __syncthreads();
    fourier_b(F, with_ctx);
    attn_phase(F, l, with_ctx);
}

struct WinOrder {
    int G, c, nctx_cols, ctx_pn0;
    __device__ __forceinline__ bool next(int i, pg8::Unit& u) const {
        const long L = (long)i * G + c; const int nlatu = 1024, total = nlatu + 8 * nctx_cols; if (L >= total) return false;
        if (L < nlatu) { int wgid = (int)L; { const int xcd = wgid % 8, off = wgid / 8; wgid = xcd * 128 + off; }
            const int gid = wgid / 64, fm = gid * 8; u.pm = fm + ((wgid % 64) % 8); u.pn = (wgid % 64) / 8; }
        else { const int j = (int)L - nlatu; u.pm = 128 + (j % 8); u.pn = ctx_pn0 + j / 8; }
        u.pb = u.pn; u.lb = 0; u.nv = 256; return true;
    }
    __device__ __forceinline__ void a_ready(const pg8::Unit&) const {}
    __device__ __forceinline__ void done(const pg8::Unit&) const {}
    __device__ __forceinline__ int row_of(const pg8::Unit&, int i) const { return i; }
};

__device__ __forceinline__ void mini_gemm(Frame& F, const bf16* Arows, const bf16* Bt, bf16* Orows, int ldc, int col0, int nct) {
    LAS unsigned char* T = F.lds + RING_OFF;
    const int q = F.lane & 15, g = F.lane >> 4;
    bf16x8 bw[32];
    { const bf16* bp = Bt + (size_t)(col0 + F.wave * 16 + q) * D + 8 * g;
#pragma unroll
      for (int s2 = 0; s2 < 32; ++s2) bw[s2] = *(const GAS bf16x8*)(bp + s2 * 32); }
    __builtin_amdgcn_sched_barrier(0);
    __syncthreads();
#pragma unroll
    for (int hb = 0; hb < 2; ++hb) { v4u t[8];
#pragma unroll
      for (int i = 0; i < 8; ++i) { const int id = F.tid + NT * (hb * 8 + i); t[i] = *(const GAS v4u*)(Arows + (size_t)(id >> 7) * D + (id & 127) * 8); }
      __builtin_amdgcn_sched_barrier(0);
#pragma unroll
      for (int i = 0; i < 8; ++i) { const int id = F.tid + NT * (hb * 8 + i), r = id >> 7, c = id & 127; *(LAS v4u*)(T + r * 2048 + ((c ^ (r & 7)) << 4)) = t[i]; }
      __builtin_amdgcn_sched_barrier(0); }
    __syncthreads();
    float one = 1.0f; asm volatile("" : "+v"(one));
    const LAS unsigned char* TE = T + q * 2048 + (((((q >> 2) & 1) << 2) | (g ^ (q & 3))) << 4);
    const LAS unsigned char* TO = T + q * 2048 + ((((((q >> 2) & 1) ^ 1) << 2) | (g ^ (q & 3))) << 4);
#pragma unroll 1
    for (int ct = 0; ct < nct; ++ct) {
        const int cw = col0 + ct * 128 + F.wave * 16;
        f32x4 acc[4];
#pragma unroll
        for (int mt = 0; mt < 4; ++mt) acc[mt] = (f32x4){0.f, 0.f, 0.f, 0.f};
#pragma unroll
        for (int grp = 0; grp < 8; ++grp) {
            bf16x8 af[4][4];
#pragma unroll
            for (int k4 = 0; k4 < 4; ++k4) { const int s2 = grp * 4 + k4; const LAS unsigned char* ap = ((s2 & 1) ? TO : TE) + (s2 >> 1) * 128;
#pragma unroll
                for (int mt = 0; mt < 4; ++mt) af[k4][mt] = *(const LAS bf16x8*)(ap + (mt & 1) * 32768 + (mt >> 1) * 65536); }
            __builtin_amdgcn_sched_barrier(0);
#pragma unroll
            for (int k4 = 0; k4 < 4; ++k4)
#pragma unroll
                for (int mt = 0; mt < 4; ++mt) acc[mt] = __builtin_amdgcn_mfma_f32_16x16x32_bf16(bw[grp * 4 + k4], af[k4][mt], acc[mt], 0, 0, 0);
            __builtin_amdgcn_sched_barrier(0);
        }
        if (ct + 1 < nct) { const bf16* bp = Bt + (size_t)(cw + 128 + q) * D + 8 * g;
#pragma unroll
            for (int s2 = 0; s2 < 32; ++s2) bw[s2] = *(const GAS bf16x8*)(bp + s2 * 32); }
#pragma unroll
        for (int mt = 0; mt < 4; ++mt) { const f32x4 v = acc[mt] * one; v2u w; w.x = cvtpk(v[0], v[1]); w.y = cvtpk(v[2], v[3]);
            *(GAS v2u*)(Orows + (size_t)(mt * 16 + q) * ldc + cw + 4 * g) = w; }
        __builtin_amdgcn_sched_barrier(0);
    }
    __syncthreads();
}

struct Args { const float* in[20]; float* out; unsigned char* ws; int l, e; };
#define PH_PTRS() \
    bf16* H = (bf16*)(F.ws + WS_H); bf16* U = (bf16*)(F.ws + WS_U); bf16* HE = (bf16*)(F.ws + WS_U); bf16* Y2 = (bf16*)(F.ws + WS_S); \
    float* MOD = (float*)(F.ws + WS_MOD); float* XC = (float*)(F.ws + WS_XC); const uint2* INFO = (const uint2*)(F.ws + WS_INFO); \
    const bool first = (l == 0); const int M = first ? NROW : NLAT; const float* modl = MOD + (size_t)l * 9 * 6144; \
    (void)H; (void)U; (void)HE; (void)XC; (void)Y2; (void)INFO; (void)M; (void)modl;

#define XS_IN()  XStream{(const char*)F.inp(I_X), (const char*)F.inp(I_CTX), 4096, 4096}
#define XS_BF()  XStream{(const char*)F.out, (const char*)XC, 4096, 2048}
__device__ __forceinline__ void ph_norm1(int l) { Frame F = mk_frame(); PH_PTRS();
    norm_phase<0, false, false>(F, XS_IN(), XS_IN(), NROW, F.inp(I_N1G), modl, modl, 0, 1, H, nullptr, nullptr); }
__device__ __forceinline__ void ph_next(int l) { Frame F = mk_frame(); PH_PTRS();
    if (first) norm_phase<1, false, true>(F, XS_BF(), XS_BF(), NROW, F.inp(I_N1G) + D, MOD + (size_t)9 * 6144, modl, 0, 1, H, Y2, nullptr);
    else norm_phase<1, true, true>(F, XS_BF(), XS_BF(), NLAT, F.inp(I_FG), modl, modl, 0, 0, nullptr, Y2, F.out); }
__device__ __forceinline__ void ph_route(int l) { Frame F = mk_frame(); PH_PTRS();
    if (first) route_phase<false>(F, l, XS_IN(), XS_BF(), U, M, F.inp(I_N2G) + (size_t)l * D, modl, H, (uint2*)(F.ws + WS_INFO), (unsigned*)(F.ctl + CW_CNT + l * 16));
    else route_phase<true>(F, l, XS_BF(), XS_BF(), U, M, F.inp(I_N2G) + (size_t)l * D, modl, H, (uint2*)(F.ws + WS_INFO), (unsigned*)(F.ctl + CW_CNT + l * 16)); }
__device__ __forceinline__ void ph_win(int l) { Frame F = mk_frame(); PH_PTRS();
    pg8::Gemm g{H, (const bf16*)(F.ws + WS_WIN) + (size_t)l * INC * D, NROW, INC, D};
    const int rb = first ? (F.bid >> 3) : (F.bid >> 2); const int c0 = first ? (F.bid & 7) * 256 : UC_K + (F.bid & 3) * 128; const int nct = first ? 2 : 1;
    const bool have = rb < 32, early = have && (F.bid & 1) != 0;
    if (early) mini_gemm(F, H + (size_t)(NLAT + rb * 64) * D, g.Bt, U + (size_t)(NLAT + rb * 64) * INC, INC, c0, nct);
    WinOrder S{F.G, F.bid, 0, 0};
    pg8::EpiBf16 E{U, INC};
    pg8::gemm_phase<pg8::EpiBf16, WinOrder>(F.lds + RING_OFF, g, S, E);
    if (have && !early) mini_gemm(F, H + (size_t)(NLAT + rb * 64) * D, g.Bt, U + (size_t)(NLAT + rb * 64) * INC, INC, c0, nct); }
__device__ __forceinline__ void ph_wout(int l) { Frame F = mk_frame(); PH_PTRS();
    pg8::Gemm g{H, (const bf16*)(F.ws + WS_WOUT) + (size_t)l * D * D, NLAT, D, D};
    const int rb = F.bid >> 3; const bool have = first && rb < 32, early = have && (F.bid & 1) != 0;
    if (early) mini_gemm(F, H + (size_t)(NLAT + rb * 64) * D, g.Bt, U + (size_t)(NLAT + rb * 64) * D, D, (F.bid & 7) * 128, 1);
    pg8::StaticOrder S; S.init(NLAT, D, F.G, F.bid);
    pg8::EpiBf16 E{U, D};
    pg8::gemm_phase<pg8::EpiBf16, pg8::StaticOrder>(F.lds + RING_OFF, g, S, E);
    if (have && !early) mini_gemm(F, H + (size_t)(NLAT + rb * 64) * D, g.Bt, U + (size_t)(NLAT + rb * 64) * D, D, (F.bid & 7) * 128, 1); }
__device__ __forceinline__ void ph_moe1(int l) { Frame F = mk_frame(); PH_PTRS(); moe_table(F, l);
    pg8::Gemm g{H, (const bf16*)(F.ws + WS_W13 + (size_t)l * NEXP * 1024 * D), M, 1024, D / 2};
    pg8::MoeOrder S{F.G, F.bid, CAP, (const LAS int*)(F.lds + TAB_OFF), INFO}; S.load();
    pg8::EpiSwiGLU8 E{(unsigned char*)HE, MHID};
    pg8::gemm_phase<pg8::EpiSwiGLU8, pg8::MoeOrder, true, true>(F.lds + RING_OFF, g, S, E); }
__device__ __forceinline__ void ph_moe2(int l) { Frame F = mk_frame(); PH_PTRS();
    pg8::Gemm g{HE, (const bf16*)(F.ws + WS_W2 + (size_t)l * NEXP * D * MHID), M, D, MHID / 2};
    pg8::MoeOrder S{F.G, F.bid, CAP, (const LAS int*)(F.lds + TAB_OFF), INFO}; S.load();
    pg8::EpiScatter E{Y2, INFO, 1.0f / (pg8::F8_ACT * pg8::F8_W)};
    pg8::gemm_phase<pg8::EpiScatter, pg8::MoeOrder, false, true>(F.lds + RING_OFF, g, S, E); }

__device__ __forceinline__ void grid_bar() {
    Frame F = mk_frame(); XcdBarrier b; b.bar = (unsigned*)(F.ctl + CW_BAR); b.x = xb_xcc_id(); b.st = F.MISC + 8; xcd_barrier(b);
}
#define PMARK(name) asm volatile("; PHASE_MARK " name ::: "memory")
template <int L> __device__ __forceinline__ void layer_phases() {
    PMARK("win"); ph_win(L); grid_bar();
    PMARK("mixa"); mixa_phase(L, L == 0); grid_bar();
    PMARK("mixb"); mixb_phase(L, L == 0); grid_bar();
    PMARK("wout"); ph_wout(L); grid_bar();
    PMARK("route"); ph_route(L); grid_bar();
    PMARK("moe1"); ph_moe1(L); grid_bar();
    PMARK("moe2"); ph_moe2(L); grid_bar();
    PMARK("next"); ph_next(L);
}
__global__ void __launch_bounds__(NT, 2) fwd_all(Args args) {
    { Frame F = mk_frame();
      for (int u = F.tid; u < (LDS_BYTES - LDSCTL_OFF) / 4; u += NT) ((LAS unsigned*)(F.lds + LDSCTL_OFF))[u] = 0u;
      __syncthreads();
      (void)xcd_barrier_post((unsigned*)(F.ctl + CW_BAR), F.MISC + 8); }
    PMARK("pa"); pa_phase(); grid_bar();
    PMARK("norm1"); ph_norm1(0); grid_bar();
    layer_phases<0>(); grid_bar();
    layer_phases<1>();
}

typedef void (*kern_t)(Args);
extern "C" void kernel_launch(void* const* d_in, const int* in_sizes, int n_in, void* d_out, int out_size, void* d_ws, size_t ws_size, hipStream_t stream) {
    static int grid = 0;
    const kern_t kerns[] = {fwd_all};
    if (grid == 0) {
        if (n_in != 20 || out_size != NLAT * D || ws_size < WS_END) { fprintf(stderr, "kernel_launch: unexpected shapes (n_in %d out %d ws %zu)\n", n_in, out_size, ws_size); grid = -1; return; }
        int dev = 0, cus = 0;
        if (hipGetDevice(&dev) != hipSuccess || hipDeviceGetAttribute(&cus, hipDeviceAttributeMultiprocessorCount, dev) != hipSuccess) { grid = -1; return; }
        for (kern_t k : kerns) if (hipFuncSetAttribute((const void*)k, hipFuncAttributeMaxDynamicSharedMemorySize, LDS_BYTES) != hipSuccess) { fprintf(stderr, "kernel_launch: hipFuncSetAttribute failed\n"); grid = -1; return; }
        int per_cu = 0; (void)hipOccupancyMaxActiveBlocksPerMultiprocessor(&per_cu, (const void*)kerns[0], NT, LDS_BYTES); (void)hipGetLastError();
        grid = cus;
    }
    if (grid < 0) return;
    (void)hipMemsetAsync((char*)d_ws + WS_CTL, 0, CTL_ZERO_BYTES, stream);
    Args a{};
    for (int i = 0; i < 20; ++i) a.in[i] = (const float*)d_in[i];
    a.out = (float*)d_out; a.ws = (unsigned char*)d_ws;
    hipLaunchKernelGGL(fwd_all, dim3(grid), dim3(NT), LDS_BYTES, stream, a);
}
```
